# Optimizing an MI355X kernel written in HIP

```python
import jax, jax.numpy as jnp
from jax import lax
import numpy as np

D_MODEL = 4096
BATCH = 32
SEQ = 256
DEPTH = 1
DEC_BATCH = 4
DEC_SEQ = 1024
PAST_LEN = 512

GRID_W = 64
D_A = D_MODEL // 2
HEAD_A = 64
H_A = D_A // HEAD_A
R_DECAY = 128
R_A = 128
R_G = 480
LN_X_EPS = 64e-5
H_B = 16
Q_LORA = 1024
KV_LORA = 512
NOPE_DIM = 128
ROPE_DIM = 64
V_DIM = 128
QK_DIM = NOPE_DIM + ROPE_DIM
D_B = H_B * V_DIM
ROPE_THETA = 10000.0
Q_BLOCK = 128
D_FF = ((8 * D_MODEL // 3 + 255) // 256) * 256
NORM_EPS = 1e-6
IN_SIZES = (D_A, D_A, D_A, R_DECAY, R_DECAY, R_A, R_A, R_G, Q_LORA, KV_LORA, ROPE_DIM, D_MODEL, D_MODEL)
D_IN = sum(IN_SIZES)

kernel_name = 'hybrid_rwkv7_mla_prefix_dit_step'


def split_points():
    return [int(s) for s in np.cumsum(IN_SIZES)[:-1]]


def rms_norm(x, w):
    xf = x.astype(jnp.float32)
    y = xf * lax.rsqrt(jnp.mean(xf * xf, axis=-1, keepdims=True) + NORM_EPS)
    return (y * w.astype(jnp.float32)).astype(x.dtype)


def adaln_modulation(cond, w_mod, b_mod):
    m = jax.nn.silu(cond) @ w_mod + b_mod
    return m.reshape(cond.shape[0], 6, D_MODEL)


def axial_rope_tables(n_tokens):
    rows = n_tokens // GRID_W
    row = jnp.repeat(jnp.arange(rows), GRID_W).astype(jnp.float32)
    col = jnp.tile(jnp.arange(GRID_W), rows).astype(jnp.float32)
    n_freq = ROPE_DIM // 4
    inv = ROPE_THETA ** (-jnp.arange(n_freq, dtype=jnp.float32) / n_freq)
    ang = jnp.concatenate([row[:, None] * inv, col[:, None] * inv], axis=-1)
    return jnp.cos(ang), jnp.sin(ang)


def apply_axial_rope(x, cos, sin):
    x_nope, x_rot = x[..., :NOPE_DIM], x[..., NOPE_DIM:]
    x1, x2 = x_rot[..., :ROPE_DIM // 2], x_rot[..., ROPE_DIM // 2:]
    c, s = cos[None, :, None, :], sin[None, :, None, :]
    rot = jnp.concatenate([x1 * c - x2 * s, x1 * s + x2 * c], axis=-1).astype(x.dtype)
    return jnp.concatenate([x_nope, rot], axis=-1)


def wkv7_scan(r, decay, k, v, a, b, s0, reverse):
    def step(s, inp):
        r_t, w_t, k_t, v_t, a_t, b_t = inp
        sa = jnp.einsum('bhvk,bhk->bhv', s, a_t)
        s = s * w_t[:, :, None, :] + sa[..., None] * b_t[:, :, None, :] + v_t[..., None] * k_t[:, :, None, :]
        return s, jnp.einsum('bhvk,bhk->bhv', s, r_t)
    xs = tuple(jnp.swapaxes(t, 0, 1) for t in (r, decay, k, v, a, b))
    s_final, ys = lax.scan(step, s0.astype(jnp.float32), xs, reverse=reverse)
    return jnp.swapaxes(ys, 0, 1), s_final


def rwkv7_bidirectional(r, k, v, lw, la, lg, s0, lp):
    B, T, _ = r.shape
    f32 = jnp.float32

    def heads(t):
        return t.astype(f32).reshape(t.shape[:-1] + (H_A, HEAD_A))

    w = -jax.nn.softplus(-(lp['rwkv_w0'][:, None, None, :]
                           + jnp.einsum('dbtr,drc->dbtc', jnp.tanh(lw), lp['rwkv_w_lora_b']))) - 0.5
    decay = jnp.exp(-jnp.exp(w.astype(f32)))
    a = jax.nn.sigmoid(lp['rwkv_a0'][:, None, None, :] + jnp.einsum('dbtr,drc->dbtc', la, lp['rwkv_a_lora_b']))
    g = jax.nn.sigmoid(lg) @ lp['rwkv_g_lora_b']
    kk = heads(k * lp['rwkv_k_k'])
    kk = kk * lax.rsqrt(jnp.sum(kk * kk, axis=-1, keepdims=True) + 1e-12)
    k_dir = heads(k[None] * (1 + (a - 1) * lp['rwkv_k_a']))
    a_h, w_h = heads(a), heads(decay)
    r_h, v_h = heads(r), heads(v)
    y_f, s_f = wkv7_scan(r_h, w_h[0], k_dir[0], v_h, -kk, kk * a_h[0], s0[:, 0], False)
    y_b, s_b = wkv7_scan(r_h, w_h[1], k_dir[1], v_h, -kk, kk * a_h[1], s0[:, 1], True)
    y = y_f + y_b
    mu = jnp.mean(y, axis=-1, keepdims=True)
    var = jnp.mean(jnp.square(y - mu), axis=-1, keepdims=True)
    y = ((y - mu) * lax.rsqrt(var + LN_X_EPS)).reshape(B, T, D_A) * lp['rwkv_ln_w'] + lp['rwkv_ln_b']
    bonus = jnp.sum(r_h[None] * k_dir * lp['rwkv_r_k'], axis=-1, keepdims=True) * v_h[None]
    y = (y + bonus.sum(0).reshape(B, T, D_A)) * g
    return y.astype(r.dtype), jnp.stack([s_f, s_b], axis=1).astype(r.dtype)


def mla_query(q_lat, lp):
    B, T, _ = q_lat.shape
    q = rms_norm(q_lat, lp['mla_q_norm_w']) @ lp['mla_w_uq']
    return rms_norm(q.reshape(B, T, H_B, QK_DIM), lp['mla_q_head_norm'])


def mla_keys_values(c_kv, k_pe, lp):
    B, T, _ = c_kv.shape
    kv = (c_kv @ lp['mla_w_ukv']).reshape(B, T, H_B, NOPE_DIM + V_DIM)
    k_nope, v = kv[..., :NOPE_DIM], kv[..., NOPE_DIM:]
    k = jnp.concatenate([k_nope, jnp.broadcast_to(k_pe[:, :, None, :], (B, T, H_B, ROPE_DIM))], axis=-1)
    return rms_norm(k, lp['mla_k_head_norm']), v


def block_attention(q, k, v):
    B, Tq, H, Dh = q.shape
    n_blk = Tq // Q_BLOCK
    qb = q.reshape(B, n_blk, Q_BLOCK, H, Dh).transpose(1, 0, 2, 3, 4)
    scale = Dh ** -0.5

    def one_block(qi):
        s = jnp.einsum('bqhd,bkhd->bhqk', qi, k).astype(jnp.float32) * scale
        p = jax.nn.softmax(s, axis=-1).astype(v.dtype)
        return jnp.einsum('bhqk,bkhd->bqhd', p, v)

    out = lax.map(one_block, qb)
    return out.transpose(1, 0, 2, 3, 4).reshape(B, Tq, H, v.shape[-1])


def trunk_layer(x, mod, lp, s0, ctx_ckv, ctx_kpe, rope):
    B, T, _ = x.shape
    shift1, scale1, gate1, shift2, scale2, gate2 = (mod[:, i, None, :] for i in range(6))
    h = rms_norm(x, lp['norm_mix_w']) * (1 + scale1) + shift1
    (r, k, v, lw_f, lw_b, la_f, la_b, lg, q_lat, kv_lat, k_pe, gl_a, gl_b) = jnp.split(
        h @ lp['w_in'], split_points(), axis=-1)
    y_a, s_new = rwkv7_bidirectional(r, k, v, jnp.stack([lw_f, lw_b]), jnp.stack([la_f, la_b]), lg, s0, lp)
    c_kv = rms_norm(kv_lat, lp['mla_kv_norm_w'])
    q = mla_query(q_lat, lp)
    kh, vh = mla_keys_values(c_kv, k_pe, lp)
    if rope is not None:
        cos, sin = rope
        q = apply_axial_rope(q, cos, sin)
        kh = apply_axial_rope(kh, cos, sin)
        k_ctx, v_ctx = mla_keys_values(ctx_ckv, ctx_kpe, lp)
        kh = jnp.concatenate([k_ctx, kh], axis=1)
        vh = jnp.concatenate([v_ctx, vh], axis=1)
    y_b = block_attention(q, kh, vh).reshape(B, T, D_B)
    mixed = jax.nn.sigmoid(gl_a) * (y_a @ lp['w_o_rwkv']) + jax.nn.sigmoid(gl_b) * (y_b @ lp['w_o_mla'])
    x = x + gate1 * (mixed @ lp['w_out'])
    h2 = rms_norm(x, lp['norm_ffn_w']) * (1 + scale2) + shift2
    g_ffn, up = jnp.split(h2 @ lp['w_ffn_in'], 2, axis=-1)
    x = x + gate2 * ((jax.nn.silu(g_ffn) * up) @ lp['w_ffn_out'])
    return x, s_new, c_kv, k_pe


def setup_inputs(seed: int = 0) -> dict:
    key = jax.random.key(seed)
    ks = iter(jax.random.split(key, 40))

    def nrm(shape, s):
        return jax.random.normal(next(ks), shape, jnp.float32) * s

    L = DEPTH
    return {
        'x_prompt': nrm((BATCH, SEQ, D_MODEL), 1.0),
        'x_sample': nrm((DEC_BATCH, DEC_SEQ, D_MODEL), 1.0),
        'c': nrm((DEC_BATCH, D_MODEL), 1.0),
        'state_rwkv': nrm((DEC_BATCH, L, 2, H_A, HEAD_A, HEAD_A), 0.1),
        'cache_mla_ckv': nrm((DEC_BATCH, L, PAST_LEN, KV_LORA), 1.0),
        'cache_mla_kpe': nrm((DEC_BATCH, L, PAST_LEN, ROPE_DIM), 1.0),
        'c_ctx': nrm((D_MODEL,), 1.0),
        'w_mod': nrm((L, D_MODEL, 6 * D_MODEL), 0.5 * D_MODEL ** -0.5),
        'b_mod': nrm((L, 6 * D_MODEL), 0.02),
        'norm_mix_w': 1.0 + nrm((L, D_MODEL), 0.02),
        'w_in': nrm((L, D_MODEL, D_IN), D_MODEL ** -0.5),
        'rwkv_w0': -2.0 + nrm((L, 2, D_A), 0.5),
        'rwkv_w_lora_b': nrm((L, 2, R_DECAY, D_A), 0.1 * R_DECAY ** -0.5),
        'rwkv_a0': nrm((L, 2, D_A), 0.1),
        'rwkv_a_lora_b': nrm((L, 2, R_A, D_A), 0.1 * R_A ** -0.5),
        'rwkv_g_lora_b': nrm((L, R_G, D_A), R_G ** -0.5),
        'rwkv_k_k': 0.85 + nrm((L, D_A), 0.02),
        'rwkv_k_a': 1.0 + nrm((L, D_A), 0.02),
        'rwkv_r_k': nrm((L, H_A, HEAD_A), 0.1),
        'rwkv_ln_w': 1.0 + nrm((L, D_A), 0.02),
        'rwkv_ln_b': nrm((L, D_A), 0.02),
        'mla_q_norm_w': 1.0 + nrm((L, Q_LORA), 0.02),
        'mla_w_uq': nrm((L, Q_LORA, H_B * QK_DIM), Q_LORA ** -0.5),
        'mla_kv_norm_w': 1.0 + nrm((L, KV_LORA), 0.02),
        'mla_w_ukv': nrm((L, KV_LORA, H_B * (NOPE_DIM + V_DIM)), KV_LORA ** -0.5),
        'mla_q_head_norm': 1.0 + nrm((L, QK_DIM), 0.02),
        'mla_k_head_norm': 1.0 + nrm((L, QK_DIM), 0.02),
        'w_o_rwkv': nrm((L, D_A, D_MODEL), D_A ** -0.5),
        'w_o_mla': nrm((L, D_B, D_MODEL), D_B ** -0.5),
        'w_out': nrm((L, D_MODEL, D_MODEL), D_MODEL ** -0.5),
        'norm_ffn_w': 1.0 + nrm((L, D_MODEL), 0.02),
        'w_ffn_in': nrm((L, D_MODEL, 2 * D_FF), D_MODEL ** -0.5),
        'w_ffn_out': nrm((L, D_FF, D_MODEL), D_FF ** -0.5),
    }


def reference(x_prompt, x_sample, c, state_rwkv, cache_mla_ckv, cache_mla_kpe, c_ctx, w_mod, b_mod,
              norm_mix_w, w_in, rwkv_w0, rwkv_w_lora_b, rwkv_a0, rwkv_a_lora_b, rwkv_g_lora_b, rwkv_k_k,
              rwkv_k_a, rwkv_r_k, rwkv_ln_w, rwkv_ln_b, mla_q_norm_w, mla_w_uq, mla_kv_norm_w, mla_w_ukv,
              mla_q_head_norm, mla_k_head_norm, w_o_rwkv, w_o_mla, w_out, norm_ffn_w, w_ffn_in, w_ffn_out):
    rope = axial_rope_tables(x_sample.shape[1])
    zero_state = jnp.zeros((x_prompt.shape[0], 2, H_A, HEAD_A, HEAD_A), jnp.float32)
    y_p, y_s = x_prompt, x_sample
    new_s, new_ckv, new_kpe = [], [], []
    for l in range(DEPTH):
        lp = {
            'norm_mix_w': norm_mix_w[l], 'w_in': w_in[l],
            'rwkv_w0': rwkv_w0[l], 'rwkv_w_lora_b': rwkv_w_lora_b[l], 'rwkv_a0': rwkv_a0[l],
            'rwkv_a_lora_b': rwkv_a_lora_b[l], 'rwkv_g_lora_b': rwkv_g_lora_b[l], 'rwkv_k_k': rwkv_k_k[l],
            'rwkv_k_a': rwkv_k_a[l], 'rwkv_r_k': rwkv_r_k[l], 'rwkv_ln_w': rwkv_ln_w[l], 'rwkv_ln_b': rwkv_ln_b[l],
            'mla_q_norm_w': mla_q_norm_w[l], 'mla_w_uq': mla_w_uq[l], 'mla_kv_norm_w': mla_kv_norm_w[l],
            'mla_w_ukv': mla_w_ukv[l], 'mla_q_head_norm': mla_q_head_norm[l], 'mla_k_head_norm': mla_k_head_norm[l],
            'w_o_rwkv': w_o_rwkv[l], 'w_o_mla': w_o_mla[l], 'w_out': w_out[l],
            'norm_ffn_w': norm_ffn_w[l], 'w_ffn_in': w_ffn_in[l], 'w_ffn_out': w_ffn_out[l],
        }
        mod_ctx = adaln_modulation(c_ctx[None, :], w_mod[l], b_mod[l])
        mod_lat = adaln_modulation(c, w_mod[l], b_mod[l])
        y_p, s_l, ckv_l, kpe_l = trunk_layer(y_p, mod_ctx, lp, zero_state, None, None, None)
        new_s.append(s_l)
        new_ckv.append(ckv_l)
        new_kpe.append(kpe_l)
        y_s, _, _, _ = trunk_layer(y_s, mod_lat, lp, state_rwkv[:, l], cache_mla_ckv[:, l], cache_mla_kpe[:, l], rope)
    return (y_p, y_s, jnp.stack(new_s, axis=1), jnp.stack(new_ckv, axis=1), jnp.stack(new_kpe, axis=1))
```

```cpp
#include <hip/hip_runtime.h>
#include <cstdio>
#include <cstdint>
namespace pg8 {
#define PG8_LAS __attribute__((address_space(3)))
typedef unsigned short bf16_t;
typedef short bf16x8 __attribute__((ext_vector_type(8)));
typedef float f32x4 __attribute__((ext_vector_type(4)));
typedef unsigned u32x4 __attribute__((ext_vector_type(4)));
constexpr int BM = 256, BK = 64, HALF = 128, HTB = HALF * BK * 2  , STAGE_BYTES = 8 * HTB, NXCD = 8, WGM = 8;

__host__ __device__ __forceinline__ int lds_byte(int r, int c) { const int st = (r >> 4) * 2 + (c >> 5), rr = r & 15, cc = c & 31, ob = rr * 64 + cc * 2; return st * 1024 + (ob ^ (((ob >> 9) & 1) << 5)); }
__host__ __device__ __forceinline__ void stage_rc(int b, int& R, int& C) { const int st = b / 1024, sb = b % 1024, swz = sb ^ (((sb >> 9) & 1) << 5); R = (st >> 1) * 16 + swz / 64; C = (st & 1) * 32 + (swz % 64) / 2; }
__host__ __device__ __forceinline__ int perm32(int rho) { const int n = rho >> 4, i = rho & 15; return 8 * (i >> 2) + 4 * n + (i & 3); }

struct Unit { int pm, pn; };
struct Gemm { const bf16_t* A; const bf16_t* Bt; int M, N, K; };

struct StaticOrder {
    int nM, nN, nwg, G, c;
    __host__ __device__ void init(int M, int N, int G_, int c_) { nM = M / BM; nN = N / BM; nwg = nM * nN; G = G_; c = c_; }
    __host__ __device__ bool next(int i, Unit& u) const {
        const long L = (long)i * G + c; if (L >= nwg) return false;
        int wgid = (int)L; { const int q = nwg / NXCD, r = nwg % NXCD, xcd = wgid % NXCD, off = wgid / NXCD; wgid = (xcd < r ? xcd * (q + 1) : r * (q + 1) + (xcd - r) * q) + off; }
        const int nig = WGM * nN, gid = wgid / nig, fm = gid * WGM, gsz = (nM - fm) < WGM ? (nM - fm) : WGM;
        u.pm = fm + ((wgid % nig) % gsz); u.pn = (wgid % nig) / gsz; return true;
    }
    __device__ __forceinline__ void a_ready(const Unit&) const {}
    __device__ __forceinline__ void done(const Unit&) const {}
};

typedef float cvt_f32x2_t __attribute__((ext_vector_type(2)));
typedef __bf16 cvt_bf16x2_t __attribute__((ext_vector_type(2)));
__device__ __forceinline__ unsigned cvt_pk_bf16(float lo, float hi) { cvt_f32x2_t v = {lo, hi}; cvt_bf16x2_t b = __builtin_convertvector(v, cvt_bf16x2_t); return __builtin_bit_cast(unsigned, b); }
typedef float f32x2 __attribute__((ext_vector_type(2)));
template <class Epi, class Sched, bool ALIGN_EPI = false, bool SP2 = false>
__device__ __forceinline__ void gemm_phase(PG8_LAS unsigned char* lds, const Gemm g, const Sched& S, const Epi& E) {
    int tid_o = threadIdx.x; asm volatile("" : "+v"(tid_o));
    const int tid = tid_o, wid = __builtin_amdgcn_readfirstlane(tid >> 6), lane = tid & 63, wr = wid >> 2, wc = wid & 3, fr = lane & 15, fq = lane >> 4;
    const int K = g.K, nt = K / BK;
    unsigned voffA[2], voffB[2];
#pragma unroll
    for (int i = 0; i < 2; ++i) { int R, C; stage_rc(tid * 16 + i * 8192, R, C); const int Rb = Epi::PERM ? ((R & ~31) + perm32(R & 31)) : R;
        voffA[i] = (unsigned)(R * K + C) * 2u; voffB[i] = (unsigned)(Rb * K + C) * 2u; }
    const size_t kstep = (size_t)(BK * 2);
    const size_t hstep = (size_t)HALF * K * 2;
    const size_t tstep = 2 * hstep;
    const unsigned ldsw = (unsigned)wid * 1024u;
    const int aoff = lds_byte(wr * 64 + fr, fq * 8), boff = lds_byte(wc * 32 + fr, fq * 8);
#define PG8_SA(b, h) (((b) * 2 + (h)) * HTB)
#define PG8_SB(b, h) ((4 + (b) * 2 + (h)) * HTB)
#define PG8_STAGE(bufoff, gbase, voff) do { _Pragma("unroll") for (int _i = 0; _i < 2; ++_i) \
        __builtin_amdgcn_global_load_lds((const unsigned*)((const char*)(gbase) + (voff)[_i]), (PG8_LAS unsigned*)(lds + (bufoff) + ldsw + _i * 8192), 16, 0, 0); } while (0)
#define PG8_LDA(dst, b, h) do { _Pragma("unroll") for (int m = 0; m < 4; ++m) _Pragma("unroll") for (int k = 0; k < 2; ++k) dst[m][k] = *(const PG8_LAS bf16x8*)(lds + PG8_SA(b, h) + aoff + m * 2048 + k * 1024); } while (0)
#define PG8_LDB(dst, b, h) do { _Pragma("unroll") for (int n = 0; n < 2; ++n) _Pragma("unroll") for (int k = 0; k < 2; ++k) dst[n][k] = *(const PG8_LAS bf16x8*)(lds + PG8_SB(b, h) + boff + n * 2048 + k * 1024); } while (0)
#define PG8_MMA(ai, bj, At, Bt) do { __builtin_amdgcn_s_setprio(1); _Pragma("unroll") for (int m = 0; m < 4; ++m) _Pragma("unroll") for (int n = 0; n < 2; ++n) _Pragma("unroll") for (int k = 0; k < 2; ++k) \
        acc[ai][bj][m][n] = __builtin_amdgcn_mfma_f32_16x16x32_bf16(Bt[n][k], At[m][k], acc[ai][bj][m][n], 0, 0, 0); __builtin_amdgcn_s_setprio(0); } while (0)
#define PG8_WAIT_V(n) asm volatile("s_waitcnt vmcnt(" #n ")" ::: "memory")
#define PG8_WAIT_L(n) asm volatile("s_waitcnt lgkmcnt(" #n ")" ::: "memory")
#define PG8_BAR __builtin_amdgcn_s_barrier()
#define PG8_SCHED __builtin_amdgcn_sched_barrier(0)
    Unit cur, nxt; int ui = 0;
    if (!S.next(0, cur)) return;
    f32x4 acc[2][2][4][2];
#pragma unroll
    for (int a = 0; a < 2; ++a)
#pragma unroll
        for (int b = 0; b < 2; ++b)
#pragma unroll
            for (int m = 0; m < 4; ++m)
#pragma unroll
                for (int n = 0; n < 2; ++n) acc[a][b][m][n] = (f32x4){0.f, 0.f, 0.f, 0.f};
    bf16x8 At[4][2], B0[2][2], B1[2][2];
    const char* cA = (const char*)g.A + (size_t)cur.pm * tstep; const char* cB = (const char*)g.Bt + (size_t)cur.pn * tstep;
    S.a_ready(cur);
    if constexpr (SP2) {
        PG8_STAGE(PG8_SB(0, 0), cB, voffB); PG8_STAGE(PG8_SB(0, 1), cB + hstep, voffB); PG8_STAGE(PG8_SA(0, 0), cA, voffA); PG8_STAGE(PG8_SA(0, 1), cA + hstep, voffA);
        if (wr == 1) PG8_BAR;
        PG8_WAIT_V(2); PG8_BAR;
        PG8_STAGE(PG8_SB(1, 0), cB + kstep, voffB); PG8_STAGE(PG8_SA(1, 0), cA + kstep, voffA); PG8_STAGE(PG8_SB(1, 1), cB + hstep + kstep, voffB);
        PG8_WAIT_V(6); PG8_BAR;
    } else {
        PG8_STAGE(PG8_SB(0, 0), cB, voffB); PG8_STAGE(PG8_SA(0, 0), cA, voffA); PG8_STAGE(PG8_SB(0, 1), cB + hstep, voffB); PG8_STAGE(PG8_SA(0, 1), cA + hstep, voffA);
        if (wr == 1) PG8_BAR;
        PG8_WAIT_V(4); PG8_BAR;
        PG8_STAGE(PG8_SB(1, 0), cB + kstep, voffB); PG8_STAGE(PG8_SA(1, 0), cA + kstep, voffA); PG8_STAGE(PG8_SB(1, 1), cB + hstep + kstep, voffB);
        PG8_WAIT_V(6); PG8_BAR;
    }
    for (;;) {
        const bool has_next = S.next(ui + 1, nxt);
        const char* nA = has_next ? (const char*)g.A + (size_t)nxt.pm * tstep : cA; const char* nB = has_next ? (const char*)g.Bt + (size_t)nxt.pn * tstep : cB;
        for (int t = 0; t < nt; t += 2) {
            const bool last = (t == nt - 2);
            const char* a1 = cA + (size_t)(t + 1) * kstep;
            const char* a2 = last ? nA : cA + (size_t)(t + 2) * kstep; const char* b2 = last ? nB : cB + (size_t)(t + 2) * kstep;
            const char* a3 = a2 + kstep; const char* b3 = b2 + kstep;
            if (last && has_next) S.a_ready(nxt);
            if constexpr (SP2) {
            PG8_LDB(B0, 0, 0); PG8_LDB(B1, 0, 1); PG8_SCHED; PG8_LDA(At, 0, 0); PG8_STAGE(PG8_SA(1, 1), a1 + hstep, voffA);
            PG8_WAIT_V(8); PG8_WAIT_L(0); PG8_BAR; PG8_MMA(0, 0, At, B0); PG8_MMA(0, 1, At, B1); PG8_BAR; PG8_SCHED;
            PG8_LDA(At, 0, 1); PG8_STAGE(PG8_SB(0, 0), b2, voffB); PG8_STAGE(PG8_SB(0, 1), b2 + hstep, voffB); PG8_STAGE(PG8_SA(0, 0), a2, voffA);
            PG8_WAIT_V(8); PG8_WAIT_L(0); PG8_BAR; PG8_MMA(1, 0, At, B0); PG8_MMA(1, 1, At, B1); PG8_BAR; PG8_SCHED;
            PG8_LDB(B0, 1, 0); PG8_LDB(B1, 1, 1); PG8_SCHED; PG8_LDA(At, 1, 0); PG8_STAGE(PG8_SA(0, 1), a2 + hstep, voffA);
            PG8_WAIT_V(8); PG8_WAIT_L(0); PG8_BAR; PG8_MMA(0, 0, At, B0); PG8_MMA(0, 1, At, B1); PG8_BAR; PG8_SCHED;
            PG8_LDA(At, 1, 1); PG8_STAGE(PG8_SB(1, 0), b3, voffB); PG8_STAGE(PG8_SB(1, 1), b3 + hstep, voffB); PG8_STAGE(PG8_SA(1, 0), a3, voffA);
            PG8_WAIT_V(8); PG8_WAIT_L(0); PG8_BAR; PG8_MMA(1, 0, At, B0); PG8_MMA(1, 1, At, B1); PG8_BAR; PG8_SCHED;
            } else {
            PG8_LDB(B0, 0, 0); PG8_SCHED; PG8_LDA(At, 0, 0); PG8_STAGE(PG8_SA(1, 1), a1 + hstep, voffA);
            PG8_WAIT_L(8); PG8_BAR; PG8_WAIT_L(0); PG8_MMA(0, 0, At, B0); PG8_BAR; PG8_SCHED;
            PG8_LDB(B1, 0, 1); PG8_STAGE(PG8_SB(0, 0), b2, voffB);
            PG8_BAR; PG8_WAIT_L(0); PG8_MMA(0, 1, At, B1); PG8_BAR;
            PG8_LDA(At, 0, 1); PG8_STAGE(PG8_SA(0, 0), a2, voffA);
            PG8_BAR; PG8_WAIT_L(0); PG8_MMA(1, 0, At, B0); PG8_BAR; PG8_SCHED;
            PG8_STAGE(PG8_SB(0, 1), b2 + hstep, voffB);
            PG8_WAIT_V(6); PG8_BAR; PG8_MMA(1, 1, At, B1); PG8_BAR;
            PG8_LDB(B0, 1, 0); PG8_SCHED; PG8_LDA(At, 1, 0); PG8_STAGE(PG8_SA(0, 1), a2 + hstep, voffA);
            PG8_WAIT_L(8); PG8_BAR; PG8_WAIT_L(0); PG8_MMA(0, 0, At, B0); PG8_BAR; PG8_SCHED;
            PG8_LDB(B1, 1, 1); PG8_STAGE(PG8_SB(1, 0), b3, voffB);
            PG8_BAR; PG8_WAIT_L(0); PG8_MMA(0, 1, At, B1); PG8_BAR;
            PG8_LDA(At, 1, 1); PG8_STAGE(PG8_SA(1, 0), a3, voffA);
            PG8_BAR; PG8_WAIT_L(0); PG8_MMA(1, 0, At, B0); PG8_BAR; PG8_SCHED;
            PG8_STAGE(PG8_SB(1, 1), b3 + hstep, voffB);
            PG8_WAIT_V(6); PG8_BAR; PG8_MMA(1, 1, At, B1); PG8_BAR;
            }
        }
        if constexpr (ALIGN_EPI) { if (wr == 0) PG8_BAR; }
        if constexpr (!Epi::AFTER_DRAIN) { E(acc, cur, wr, wc, fr, fq); S.done(cur); }
        if (!has_next) break;
#pragma unroll
        for (int a = 0; a < 2; ++a)
#pragma unroll
            for (int b = 0; b < 2; ++b)
#pragma unroll
                for (int m = 0; m < 4; ++m)
#pragma unroll
                    for (int n = 0; n < 2; ++n) acc[a][b][m][n] = (f32x4){0.f, 0.f, 0.f, 0.f};
        cur = nxt; cA = nA; cB = nB; ++ui;
        if constexpr (ALIGN_EPI) { if (wr == 1) PG8_BAR; }
    }
    PG8_WAIT_V(0);
    if constexpr (!ALIGN_EPI) { if (wr == 0) PG8_BAR; }
    PG8_BAR;
    if constexpr (Epi::AFTER_DRAIN) { E.fused(acc, cur, wr, wc, fr, fq, lds, wid, lane); S.done(cur); }
#undef PG8_SA
#undef PG8_SB
#undef PG8_STAGE
#undef PG8_LDA
#undef PG8_LDB
#undef PG8_MMA
#undef PG8_WAIT_V
#undef PG8_WAIT_L
#undef PG8_BAR
#undef PG8_SCHED
}
}
constexpr int T_P = 8192, T_S = 4096, T = T_P + T_S;
constexpr int DM = 4096, DA = 2048, DFF = 11008, NIN = 17152  , KVROWS = 14336;
constexpr int QL = 1024, KVL = 512, NMOD = 6 * DM;
constexpr float NORM_EPS = 1e-6f;

namespace pg8 {
typedef _Float16 f16_t;
typedef _Float16 f16x2 __attribute__((ext_vector_type(2)));
typedef unsigned u32x2 __attribute__((ext_vector_type(2)));
__device__ __forceinline__ float sigm(float x) { return __builtin_amdgcn_rcpf(1.0f + __builtin_amdgcn_exp2f(-1.4426950408889634f * x)); }
__device__ __forceinline__ f32x4 sigm4(f32x4 v) { return (f32x4){sigm(v[0]), sigm(v[1]), sigm(v[2]), sigm(v[3])}; }
__device__ __forceinline__ unsigned pk_f16(float lo, float hi) { f16x2 h = {(f16_t)lo, (f16_t)hi}; return __builtin_bit_cast(unsigned, h); }
__device__ __forceinline__ u32x4 pack_bf16x8(f32x4 a, f32x4 b) { u32x4 w; w.x = cvt_pk_bf16(a[0], a[1]); w.y = cvt_pk_bf16(a[2], a[3]); w.z = cvt_pk_bf16(b[0], b[1]); w.w = cvt_pk_bf16(b[2], b[3]); return w; }
__device__ __forceinline__ u32x4 pack_f16x8(f32x4 a, f32x4 b) { u32x4 w; w.x = pk_f16(a[0], a[1]); w.y = pk_f16(a[2], a[3]); w.z = pk_f16(b[0], b[1]); w.w = pk_f16(b[2], b[3]); return w; }
__device__ __forceinline__ float bflo(unsigned w) { return __builtin_bit_cast(float, w << 16); }
__device__ __forceinline__ float bfhi(unsigned w) { return __builtin_bit_cast(float, w & 0xffff0000u); }
__device__ __forceinline__ void unpack_bf16x8(u32x4 w, f32x4& a, f32x4& b) { a = (f32x4){bflo(w.x), bfhi(w.x), bflo(w.y), bfhi(w.y)}; b = (f32x4){bflo(w.z), bfhi(w.z), bflo(w.w), bfhi(w.w)}; }

struct BatchedOrder {
    int nM, nN, nb, G, c;
    __device__ void init(int nM_, int nN_, int nb_, int G_, int c_) { nM = nM_; nN = nN_; nb = nb_; G = G_; c = c_; }
    __device__ bool next(int i, Unit& u) const {
        const int L = i * G + c; const int per = nM * nN; if (L >= per * nb) return false;
        const int b = L / per, l = L - b * per;
        u.pm = b * nM + (l % nM); u.pn = b * nN + (l / nM); return true;
    }
    __device__ __forceinline__ void a_ready(const Unit&) const {}
    __device__ __forceinline__ void done(const Unit&) const {}
};

#define EPI_LANE() int tid_ = (int)threadIdx.x; asm volatile("" : "+v"(tid_)); const int fr_ = tid_ & 15, fq_ = (tid_ >> 4) & 3
#define EPI_LOOP(...) \
    _Pragma("unroll") for (int ai = 0; ai < 2; ++ai) _Pragma("unroll") for (int m = 0; m < 4; ++m) { const int row = row0 + ai * HALF + m * 16; \
    _Pragma("unroll") for (int bj = 0; bj < 2; ++bj) { const f32x4 v0 = acc[ai][bj][m][0], v1 = acc[ai][bj][m][1]; const int colt = bj * HALF + cl; __VA_ARGS__ } }

struct EpiIn {
    static constexpr bool PERM = true, AFTER_DRAIN = false;
    f16_t* RKV; bf16_t* LWA; bf16_t* LG; float* QLAT; float* KVLAT; float* KPE; bf16_t* GA; bf16_t* GB;
    __device__ __forceinline__ void operator()(const f32x4 (&acc)[2][2][4][2], const Unit& u, int wr, int wc, int fr, int fq) const {
        EPI_LANE(); const int pn = u.pn, row0 = u.pm * BM + wr * 64 + fr_, cl = wc * 32 + 8 * fq_;
        if (pn < 24) {
            EPI_LOOP( *(u32x4*)(RKV + (size_t)row * 6144 + pn * 256 + colt) = pack_f16x8(v0, v1); )
        } else if (pn == 24) {
            EPI_LOOP( f32x4 a = sigm4(v0 * 2.0f) * 2.0f - 1.0f, b = sigm4(v1 * 2.0f) * 2.0f - 1.0f; *(u32x4*)(LWA + ((size_t)bj * T + row) * 256 + cl) = pack_bf16x8(a, b); )
        } else if (pn == 25) {
            EPI_LOOP( *(u32x4*)(LWA + ((size_t)bj * T + row) * 256 + 128 + cl) = pack_bf16x8(v0, v1); )
        } else if (pn < 28) {
            EPI_LOOP( *(u32x4*)(LG + (size_t)row * 512 + (pn - 26) * 256 + colt) = pack_bf16x8(sigm4(v0), sigm4(v1)); )
        } else if (pn < 32) {
            EPI_LOOP( float* p = QLAT + (size_t)row * QL + (pn - 28) * 256 + colt; *(f32x4*)p = v0; *(f32x4*)(p + 4) = v1; )
        } else if (pn < 34) {
            EPI_LOOP( float* p = KVLAT + (size_t)row * KVL + (pn - 32) * 256 + colt; *(f32x4*)p = v0; *(f32x4*)(p + 4) = v1; )
        } else if (pn == 34) {
            EPI_LOOP( if (colt < 64) { float* p = KPE + (size_t)row * 64 + colt; *(f32x4*)p = v0; *(f32x4*)(p + 4) = v1; } )
        } else if (pn < 51) {
            EPI_LOOP( *(u32x4*)(GA + (size_t)row * DM + (pn - 35) * 256 + colt) = pack_bf16x8(sigm4(v0), sigm4(v1)); )
        } else {
            EPI_LOOP( *(u32x4*)(GB + (size_t)row * DM + (pn - 51) * 256 + colt) = pack_bf16x8(sigm4(v0), sigm4(v1)); )
        }
    }
};

struct EpiLora {
    static constexpr bool PERM = true, AFTER_DRAIN = false;
    f16_t* EWAA; const float* lbias;
    __device__ __forceinline__ void operator()(const f32x4 (&acc)[2][2][4][2], const Unit& u, int wr, int wc, int fr, int fq) const {
        EPI_LANE(); const int dir = u.pn >> 4, jn = u.pn & 15, row0 = (u.pm - dir * (T / BM)) * BM + wr * 64 + fr_, cl = wc * 32 + 8 * fq_;
        const int isa = jn >> 3;
        const float* bias = lbias + isa * (2 * DA) + dir * DA + (jn & 7) * 256; f16_t* O = EWAA + (size_t)(isa * 2 + dir) * T * DA + (jn & 7) * 256;
        const float sc = isa ? 1.0f : 0.60653065971263342f;
        f32x4 bv[2][2];
#pragma unroll
        for (int bj = 0; bj < 2; ++bj) { bv[bj][0] = *(const f32x4*)(bias + bj * HALF + cl); bv[bj][1] = *(const f32x4*)(bias + bj * HALF + cl + 4); }
        EPI_LOOP( *(u32x4*)(O + (size_t)row * DA + colt) = pack_f16x8(sigm4(v0 + bv[bj][0]) * sc, sigm4(v1 + bv[bj][1]) * sc); )
    }
};

struct EpiPlain {
    static constexpr bool PERM = true, AFTER_DRAIN = false;
    bf16_t* O; int ldc;
    __device__ __forceinline__ void operator()(const f32x4 (&acc)[2][2][4][2], const Unit& u, int wr, int wc, int fr, int fq) const {
        EPI_LANE(); const int row0 = u.pm * BM + wr * 64 + fr_, cl = wc * 32 + 8 * fq_;
        EPI_LOOP( *(u32x4*)(O + (size_t)row * ldc + u.pn * 256 + colt) = pack_bf16x8(v0, v1); )
    }
};

struct EpiMix1 {
    static constexpr bool PERM = true, AFTER_DRAIN = false;
    const bf16_t* GA; float* TMP;
    __device__ __forceinline__ void operator()(const f32x4 (&acc)[2][2][4][2], const Unit& u, int wr, int wc, int fr, int fq) const {
        EPI_LANE(); const int row0 = u.pm * BM + wr * 64 + fr_, cl = wc * 32 + 8 * fq_;
        EPI_LOOP( const size_t o = (size_t)row * DM + u.pn * 256 + colt; f32x4 g0, g1; unpack_bf16x8(*(const u32x4*)(GA + o), g0, g1); *(f32x4*)(TMP + o) = g0 * v0; *(f32x4*)(TMP + o + 4) = g1 * v1; )
    }
};
struct EpiMix2 {
    static constexpr bool PERM = true, AFTER_DRAIN = false;
    const bf16_t* GB; const float* TMP; bf16_t* MIXED;
    __device__ __forceinline__ void operator()(const f32x4 (&acc)[2][2][4][2], const Unit& u, int wr, int wc, int fr, int fq) const {
        EPI_LANE(); const int row0 = u.pm * BM + wr * 64 + fr_, cl = wc * 32 + 8 * fq_;
        EPI_LOOP( const size_t o = (size_t)row * DM + u.pn * 256 + colt; f32x4 g0, g1; unpack_bf16x8(*(const u32x4*)(GB + o), g0, g1);
                  const f32x4 t0 = *(const f32x4*)(TMP + o), t1 = *(const f32x4*)(TMP + o + 4); *(u32x4*)(MIXED + o) = pack_bf16x8(t0 + g0 * v0, t1 + g1 * v1); )
    }
};
struct EpiRes {
    static constexpr bool PERM = true, AFTER_DRAIN = false;
    const float* xp; const float* xs; float* out; const float* gate;
    __device__ __forceinline__ void operator()(const f32x4 (&acc)[2][2][4][2], const Unit& u, int wr, int wc, int fr, int fq) const {
        EPI_LANE(); const int row0 = u.pm * BM + wr * 64 + fr_, cl = wc * 32 + 8 * fq_;
        const int rbase = u.pm * BM, mi = rbase < T_P ? 0 : 1 + ((rbase - T_P) >> 10);
        const float* gp = gate + (size_t)mi * NMOD + u.pn * 256;
        const float* base = rbase < T_P ? xp : xs - (size_t)T_P * DM;
        f32x4 gv[2][2];
#pragma unroll
        for (int bj = 0; bj < 2; ++bj) { gv[bj][0] = *(const f32x4*)(gp + bj * HALF + cl); gv[bj][1] = *(const f32x4*)(gp + bj * HALF + cl + 4); }
        EPI_LOOP( const size_t o = (size_t)row * DM + u.pn * 256 + colt; const f32x4 b0 = *(const f32x4*)(base + o), b1 = *(const f32x4*)(base + o + 4);
                  *(f32x4*)(out + o) = b0 + gv[bj][0] * v0; *(f32x4*)(out + o + 4) = b1 + gv[bj][1] * v1; )
    }
};
struct EpiSwiglu {
    static constexpr bool PERM = true, AFTER_DRAIN = false;
    bf16_t* ACT;
    __device__ __forceinline__ void operator()(const f32x4 (&acc)[2][2][4][2], const Unit& u, int wr, int wc, int fr, int fq) const {
        EPI_LANE(); const int row0 = u.pm * BM + wr * 64 + fr_, cl = wc * 32 + 8 * fq_;
#pragma unroll
        for (int ai = 0; ai < 2; ++ai)
#pragma unroll
            for (int m = 0; m < 4; ++m) { const int row = row0 + ai * HALF + m * 16;
                const f32x4 g0 = acc[ai][0][m][0], g1 = acc[ai][0][m][1], u0 = acc[ai][1][m][0], u1 = acc[ai][1][m][1];
                *(u32x4*)(ACT + (size_t)row * DFF + u.pn * 128 + cl) = pack_bf16x8(g0 * sigm4(g0) * u0, g1 * sigm4(g1) * u1); }
    }
};
#undef EPI_LOOP
}
#define GAS __attribute__((address_space(1)))
#define LAS __attribute__((address_space(3)))
typedef unsigned short bf16;
typedef unsigned v4u __attribute__((ext_vector_type(4)));
typedef float f32x4 __attribute__((ext_vector_type(4)));
typedef short bf16x8 __attribute__((ext_vector_type(8)));
typedef GAS unsigned gu32;
typedef GAS unsigned long long gu64;
#define RLX_AGENT __ATOMIC_RELAXED, __HIP_MEMORY_SCOPE_AGENT
#define LDS_WAIT() asm volatile("s_waitcnt lgkmcnt(0)" ::: "memory")
#define VM_WAIT() asm volatile("s_waitcnt vmcnt(0)" ::: "memory")
__device__ __forceinline__ unsigned long long rt() { return __builtin_amdgcn_s_memrealtime(); }
__device__ __forceinline__ unsigned f2bf(float f) { unsigned u = __builtin_bit_cast(unsigned, f); return (u + 0x7fffu + ((u >> 16) & 1u)) >> 16; }
__device__ __forceinline__ unsigned pk2(float lo, float hi) { return f2bf(lo) | (f2bf(hi) << 16); }
constexpr size_t MiB = 1u << 20;
constexpr size_t WS_CTL = 0, CTL_ZERO_BYTES = 1 * MiB;
constexpr size_t WS_MOD = 1 * MiB, WS_COS = 1 * MiB + 512 * 1024, WS_SIN = 1 * MiB + 640 * 1024, WS_LBIAS = 1 * MiB + 768 * 1024;
constexpr size_t WS_WFI = 2 * MiB, WS_WFO = 174 * MiB, WS_WOUT = 260 * MiB, WS_WOR = 292 * MiB, WS_WOM = 308 * MiB;
constexpr size_t WS_WIN = 324 * MiB, WS_WUQ = 458 * MiB, WS_WUKV = 464 * MiB, WS_WLORA = 468 * MiB, WS_WG = 472 * MiB;
constexpr size_t WS_YS = 324 * MiB, WS_BON = 420 * MiB, WS_YB = 423 * MiB;
constexpr size_t WS_HB = 474 * MiB;
constexpr size_t WS_RKV = 570 * MiB, WS_GA = 714 * MiB, WS_GB = 810 * MiB;
constexpr size_t WS_MIXED = 570 * MiB, WS_ACT = 570 * MiB;
constexpr size_t WS_LWA = 906 * MiB, WS_LG = 918 * MiB;
constexpr size_t WS_QLAT = 930 * MiB, WS_KVLAT = 978 * MiB, WS_Q = 930 * MiB;
constexpr size_t WS_KPE = 1002 * MiB;
constexpr size_t WS_QN = 1005 * MiB, WS_CKVA = 1029 * MiB;
constexpr size_t WS_EW = 1043 * MiB, WS_AA = 1139 * MiB, WS_TMP = 1043 * MiB;
constexpr size_t WS_G = 1235 * MiB;
constexpr size_t WS_KV = 1283 * MiB, WS_YA = 1479 * MiB;
constexpr size_t WS_KP = 1395 * MiB;
constexpr size_t WS_END = 1527 * MiB;
static_assert(WS_WIN + (size_t)NIN * DM * 2 <= WS_WUQ && WS_WFI + (size_t)2 * DFF * DM * 2 <= WS_WFO && WS_WFO + (size_t)DM * DFF * 2 <= WS_WOUT, "weights map");
static_assert(WS_YS + (size_t)2 * T * DA * 2 <= WS_BON && WS_BON + (size_t)2 * T * 32 * 4 <= WS_YB && WS_YB + (size_t)T * DA * 2 <= WS_HB, "overlay map");
static_assert(WS_RKV + (size_t)T * 6144 * 2 <= WS_GA && WS_ACT + (size_t)T * DFF * 2 <= WS_LWA && WS_Q + (size_t)T * 3072 * 2 <= WS_KPE && WS_KV + (size_t)KVROWS * 4096 * 2 <= WS_KP && WS_KP + (size_t)KVROWS * 3072 * 2 <= WS_YA && WS_YA + (size_t)T * DA * 2 <= WS_END, "act map");
static_assert(WS_AA == WS_EW + (size_t)2 * T * DA * 2, "AA follows EW");
constexpr int CW_BAR = 4096;

constexpr int RING_OFF = 0, RING_BYTES = 131072;
constexpr int LDSCTL_OFF = RING_BYTES, MISC_OFF = LDSCTL_OFF + 320;
constexpr int LDS_BYTES = 147456;
constexpr int NWAVES = 8;

constexpr size_t OUT_YP = 0, OUT_YS = (size_t)T_P * DM, OUT_STATE = (size_t)T * DM, OUT_CKV = OUT_STATE + (size_t)32 * 2 * 32 * 64 * 64, OUT_KPE = OUT_CKV + (size_t)T_P * KVL;

typedef _Float16 f16;
typedef unsigned v2u __attribute__((ext_vector_type(2)));
typedef float f32x2 __attribute__((ext_vector_type(2)));
#define XB_TMO      128
#define XB_XCNT(j)  (256  + 64 * (j))
#define XB_XSUB(j)  (1280 + 64 * (j))
#define XB_XGEN(j)  (2304 + 64 * (j))
#define XB_TOP      3328
#define XB_TOPGEN   3392
#define XCD_BAR_WORDS 3456
#define XB_SPIN_CAP (1u << 18)

__device__ __forceinline__ unsigned xb_ld(unsigned* p)              { return __hip_atomic_load(p, __ATOMIC_RELAXED, __HIP_MEMORY_SCOPE_AGENT); }
__device__ __forceinline__ unsigned xb_add(unsigned* p, unsigned v) { return __hip_atomic_fetch_add(p, v, __ATOMIC_RELAXED, __HIP_MEMORY_SCOPE_AGENT); }
__device__ __forceinline__ unsigned xb_xcc_id() { return (unsigned)__builtin_amdgcn_s_getreg((3 << 11) | 20) & 0xFu; }
#define XB_SPIN(cond, bar) do { unsigned _sp = 0; while (cond) { __builtin_amdgcn_s_sleep(1); \
    if ((++_sp & 255u) == 0u) { if (xb_ld(&(bar)[XB_TMO])) break; if (_sp > XB_SPIN_CAP) { atomicAdd(&(bar)[XB_TMO], 1u); break; } } } } while (0)

struct XcdBarrier {
    unsigned* bar; unsigned x;
    volatile LAS unsigned* st;
};

__device__ __forceinline__ XcdBarrier xcd_barrier_post(unsigned* bar, volatile LAS unsigned* st) {
    XcdBarrier b; b.bar = bar; b.x = xb_xcc_id(); b.st = st;
    if (threadIdx.x == 0) (void)xb_add(&bar[XB_XCNT(b.x)], 1u);
    return b;
}
__device__ __forceinline__ void xcd_barrier_complete(unsigned* bar, unsigned x, unsigned& nloc, unsigned& nx) {
    const unsigned G = gridDim.x * gridDim.y * gridDim.z;
    unsigned sum, cnt, mine, sp = 0u;
    for (;;) {
        sum = 0u; cnt = 0u; mine = 0u;
#pragma unroll
        for (unsigned j = 0; j < 16; ++j) { const unsigned c = xb_ld(&bar[XB_XCNT(j)]); sum += c; cnt += (c > 0u) ? 1u : 0u; mine = (j == x) ? c : mine; }
        if (sum == G) break;
        __builtin_amdgcn_s_sleep(1);
        if ((++sp & 255u) == 0u) { if (xb_ld(&bar[XB_TMO])) break; if (sp > XB_SPIN_CAP) { atomicAdd(&bar[XB_TMO], 1u); break; } }
    }
    nloc = mine > 0u ? mine : 1u; nx = cnt > 0u ? cnt : 1u;
}

__device__ __forceinline__ void xcd_barrier(const XcdBarrier& b) {
    asm volatile("s_waitcnt vmcnt(0)" ::: "memory");
    __syncthreads();
    if (threadIdx.x == 0) {
        unsigned* bar = b.bar;
        __builtin_amdgcn_s_waitcnt(0);
        unsigned nloc = b.st[0], nx = b.st[1];
        if (nloc == 0u) { xcd_barrier_complete(bar, b.x, nloc, nx); b.st[0] = nloc; b.st[1] = nx; }
        const unsigned old = xb_add(&bar[XB_XSUB(b.x)], 1u);
        const unsigned gen = old / nloc;
        if (old + 1u == (gen + 1u) * nloc) {
            __builtin_amdgcn_fence(__ATOMIC_RELEASE, "agent");
            asm volatile("s_waitcnt vmcnt(0)" ::: "memory");
            const unsigned og = xb_add(&bar[XB_TOP], 1u);
            const unsigned tg = og / nx;
            if (og + 1u == (tg + 1u) * nx) xb_add(&bar[XB_TOPGEN], 1u);
            else XB_SPIN(xb_ld(&bar[XB_TOPGEN]) == tg, bar);
            __builtin_amdgcn_fence(__ATOMIC_ACQUIRE, "agent");
            xb_add(&bar[XB_XGEN(b.x)], 1u);
            asm volatile("s_waitcnt vmcnt(0)" ::: "memory");
        } else {
            XB_SPIN(xb_ld(&bar[XB_XGEN(b.x)]) == gen, bar);
            __builtin_amdgcn_fence(__ATOMIC_ACQUIRE, "agent");
            asm volatile("s_waitcnt vmcnt(0)" ::: "memory");
        }
    }
    __syncthreads();
}
struct Args { const float* in[33]; float* out; unsigned char* ws; int ph_lo, ph_hi; };
enum { I_XP = 0, I_XS, I_C, I_STATE, I_CCKV, I_CKPE, I_CCTX, I_WMOD, I_BMOD, I_NMIX, I_WIN, I_W0, I_WLB, I_A0, I_ALB, I_GLB, I_KK, I_KA, I_RK, I_LNW, I_LNB,
       I_QNW, I_WUQ, I_KVNW, I_WUKV, I_QHN, I_KHN, I_WOR, I_WOM, I_WOUT, I_NFFN, I_WFI, I_WFO };
struct Frame { LAS unsigned char* lds; volatile LAS unsigned* MISC; gu32* ctl; int tid, lane, wave, G, gw, ngw; };

__device__ __forceinline__ float wave_sum(float v) {
#pragma unroll
    for (int o = 1; o < 64; o <<= 1) v += __shfl_xor(v, o);
    return v;
}
__device__ __forceinline__ float dpp_f(float x, const int ctrl_sel) {
    const int xi = __builtin_bit_cast(int, x); int r;
    if (ctrl_sel == 0) r = __builtin_amdgcn_update_dpp(0, xi, 0xB1, 0xF, 0xF, true);
    else if (ctrl_sel == 1) r = __builtin_amdgcn_update_dpp(0, xi, 0x4E, 0xF, 0xF, true);
    else if (ctrl_sel == 2) r = __builtin_amdgcn_update_dpp(0, xi, 0x141, 0xF, 0xF, true);
    else r = __builtin_amdgcn_update_dpp(0, xi, 0x140, 0xF, 0xF, true);
    return __builtin_bit_cast(float, r);
}
__device__ __forceinline__ float row16_sum(float x) { x += dpp_f(x, 0); x += dpp_f(x, 1); x += dpp_f(x, 2); x += dpp_f(x, 3); return x; }
__device__ __forceinline__ float sigm(float x) { return pg8::sigm(x); }
__device__ __forceinline__ int mod_index(int row) { return row < T_P ? 0 : 1 + ((row - T_P) >> 10); }

__device__ __forceinline__ void p0_adaln(const Args& a, Frame& F) {
    LAS float* SC = (LAS float*)(F.lds);
    LAS float* RED = (LAS float*)(F.lds + 81920);
    const float* c = a.in[I_C]; const float* cctx = a.in[I_CCTX]; const float* wmod = a.in[I_WMOD]; const float* bmod = a.in[I_BMOD];
    float* MOD = (float*)(a.ws + WS_MOD);
    for (int i = F.tid; i < 5 * 4096; i += 512) { const int r = i >> 12, k = i & 4095; const float v = (r == 0) ? cctx[k] : c[(r - 1) * 4096 + k]; SC[i] = v * sigm(v); }
    __syncthreads();
    const int kk = F.lane / 24, cg = F.lane % 24;
    for (int cb = blockIdx.x; cb < 256; cb += F.G) {
        f32x4 acc[5];
#pragma unroll
        for (int r = 0; r < 5; ++r) acc[r] = (f32x4){0.f, 0.f, 0.f, 0.f};
        if (F.lane < 48) {
            const float* wp = wmod + (size_t)(512 * F.wave + kk) * NMOD + 96 * cb + 4 * cg;
            const LAS float* sp = SC + 512 * F.wave + kk;
#pragma unroll 8
            for (int k2 = 0; k2 < 512; k2 += 2) {
                const f32x4 w = *(const f32x4*)(wp + (size_t)k2 * NMOD);
#pragma unroll
                for (int r = 0; r < 5; ++r) acc[r] += w * sp[r * 4096 + k2];
            }
#pragma unroll
            for (int r = 0; r < 5; ++r) *(LAS f32x4*)(RED + ((F.wave * 2 + kk) * 5 + r) * 96 + 4 * cg) = acc[r];
        }
        __syncthreads();
        if (F.tid < 480) { const int r = F.tid / 96, col = F.tid % 96; float s = bmod[96 * cb + col];
#pragma unroll
            for (int p = 0; p < 16; ++p) s += RED[(p * 5 + r) * 96 + col];
            MOD[(size_t)r * NMOD + 96 * cb + col] = s; }
        __syncthreads();
    }
}

__device__ __forceinline__ void tr_item(const float* W, int ldw, int k0, int kvalid, int srcn0, bf16* WT, int ldt, int drow0, int dk0, LAS float* scr, int lane) {
    const int c = lane & 7;
    if (srcn0 < 0) {
#pragma unroll
        for (int j = 0; j < 4; ++j) { const int n = (lane >> 3) + 8 * j; *(GAS v4u*)(WT + (size_t)(drow0 + n) * ldt + dk0 + 8 * c) = (v4u){0u, 0u, 0u, 0u}; }
        return;
    }
#pragma unroll 8
    for (int i = 0; i < 32; ++i) { const int kk = 2 * i + (lane >> 5); scr[kk * 33 + (lane & 31)] = (kk < kvalid) ? W[(size_t)(k0 + kk) * ldw + srcn0 + (lane & 31)] : 0.f; }
    LDS_WAIT(); asm volatile("" ::: "memory");
#pragma unroll
    for (int j = 0; j < 4; ++j) { const int n = (lane >> 3) + 8 * j; const LAS float* s = scr + (8 * c) * 33 + n;
        v4u o; o.x = pg8::cvt_pk_bf16(s[0 * 33], s[1 * 33]); o.y = pg8::cvt_pk_bf16(s[2 * 33], s[3 * 33]); o.z = pg8::cvt_pk_bf16(s[4 * 33], s[5 * 33]); o.w = pg8::cvt_pk_bf16(s[6 * 33], s[7 * 33]);
        *(GAS v4u*)(WT + (size_t)(drow0 + n) * ldt + dk0 + 8 * c) = o; }
    LDS_WAIT(); asm volatile("" ::: "memory");
}
__device__ __forceinline__ int map_in(int n0) {
    if (n0 < 7136) return n0;
    if (n0 < 7168) return -1;
    if (n0 < 8192) return 7136 + (n0 - 7168);
    if (n0 < 8704) return 8160 + (n0 - 8192);
    if (n0 < 8768) return 8672 + (n0 - 8704);
    if (n0 < 8960) return -1;
    if (n0 < 13056) return 8736 + (n0 - 8960);
    return 12832 + (n0 - 13056);
}
__device__ __forceinline__ void p0_weights(const Args& a, Frame& F) {
    LAS float* scr = (LAS float*)(F.lds + F.wave * 16384);
    constexpr int I_IN = (NIN / 32) * 64, I_FI = (2 * DFF / 32) * 64, I_FO = (DM / 32) * (DFF / 64), I_OUT = 128 * 64, I_OR = 128 * 32, I_OM = 128 * 32, I_UQ = 96 * 16, I_UKV = 128 * 8, I_LORA = 256 * 4, I_G = 64 * 8;
    constexpr int NITEMS = I_IN + I_FI + I_FO + I_OUT + I_OR + I_OM + I_UQ + I_UKV + I_LORA + I_G;
    unsigned char* ws = a.ws;
    for (int it = F.gw; it < NITEMS; it += F.ngw) {
        int r = it;
        if (r < I_IN) { const int nblk = NIN / 32, kb = r / nblk, nb = r % nblk; tr_item(a.in[I_WIN], 16928, 64 * kb, 64, map_in(32 * nb), (bf16*)(ws + WS_WIN), DM, 32 * nb, 64 * kb, scr, F.lane); continue; } r -= I_IN;
        if (r < I_FI) { const int nblk = 2 * DFF / 32, kb = r / nblk, nb = r % nblk, n0 = 32 * nb, pn = n0 >> 8, j = n0 & 255; const int src = (j < 128) ? 128 * pn + j : DFF + 128 * pn + (j - 128);
            tr_item(a.in[I_WFI], 2 * DFF, 64 * kb, 64, src, (bf16*)(ws + WS_WFI), DM, n0, 64 * kb, scr, F.lane); continue; } r -= I_FI;
        if (r < I_FO) { const int nblk = DM / 32, kb = r / nblk, nb = r % nblk; tr_item(a.in[I_WFO], DM, 64 * kb, 64, 32 * nb, (bf16*)(ws + WS_WFO), DFF, 32 * nb, 64 * kb, scr, F.lane); continue; } r -= I_FO;
        if (r < I_OUT) { const int nblk = 128, kb = r / nblk, nb = r % nblk; tr_item(a.in[I_WOUT], DM, 64 * kb, 64, 32 * nb, (bf16*)(ws + WS_WOUT), DM, 32 * nb, 64 * kb, scr, F.lane); continue; } r -= I_OUT;
        if (r < I_OR) { const int nblk = 128, kb = r / nblk, nb = r % nblk; tr_item(a.in[I_WOR], DM, 64 * kb, 64, 32 * nb, (bf16*)(ws + WS_WOR), DA, 32 * nb, 64 * kb, scr, F.lane); continue; } r -= I_OR;
        if (r < I_OM) { const int nblk = 128, kb = r / nblk, nb = r % nblk; tr_item(a.in[I_WOM], DM, 64 * kb, 64, 32 * nb, (bf16*)(ws + WS_WOM), DA, 32 * nb, 64 * kb, scr, F.lane); continue; } r -= I_OM;
        if (r < I_UQ) { const int nblk = 96, kb = r / nblk, nb = r % nblk; tr_item(a.in[I_WUQ], 3072, 64 * kb, 64, 32 * nb, (bf16*)(ws + WS_WUQ), QL, 32 * nb, 64 * kb, scr, F.lane); continue; } r -= I_UQ;
        if (r < I_UKV) { const int nblk = 128, kb = r / nblk, nb = r % nblk; tr_item(a.in[I_WUKV], 4096, 64 * kb, 64, 32 * nb, (bf16*)(ws + WS_WUKV), KVL, 32 * nb, 64 * kb, scr, F.lane); continue; } r -= I_UKV;
        if (r < I_LORA) {
            const int nblk = 256, kb = r / nblk, nb = r % nblk, n0 = 32 * nb, dir = n0 >> 12, j = n0 & 4095; const bool isw = j < 2048; const bool live = isw ? (kb < 2) : (kb >= 2);
            const float* src = (isw ? a.in[I_WLB] : a.in[I_ALB]) + (size_t)dir * 128 * DA;
            tr_item(src, DA, 64 * (kb & 1), 64, live ? (isw ? j : j - 2048) : -1, (bf16*)(ws + WS_WLORA), 256, n0, 64 * kb, scr, F.lane); continue; } r -= I_LORA;
        { const int nblk = 64, kb = r / nblk, nb = r % nblk; const int kv = 480 - 64 * kb; tr_item(a.in[I_GLB], DA, 64 * kb, kv < 0 ? 0 : kv, 32 * nb, (bf16*)(ws + WS_WG), 512, 32 * nb, 64 * kb, scr, F.lane); }
    }
}

__device__ __forceinline__ void sincos_small(double x, double& s, double& c) {
    const double n = __builtin_rint(x * 0.63661977236758134308);
    double r = __builtin_fma(-n, 1.57079632679489655800e+00, x); r = __builtin_fma(-n, 6.12323399573676603587e-17, r);
    const double r2 = r * r;
    double sp = -7.6471637318198164759e-13; sp = sp * r2 + 1.6059043836821614599e-10; sp = sp * r2 - 2.5052108385441718775e-08; sp = sp * r2 + 2.7557319223985890653e-06;
    sp = sp * r2 - 1.9841269841269841270e-04; sp = sp * r2 + 8.3333333333333333333e-03; sp = sp * r2 - 1.6666666666666666667e-01; const double sr = r + r * r2 * sp;
    double cp = 4.7794773323873852974e-14; cp = cp * r2 - 1.1470745597729724714e-11; cp = cp * r2 + 2.0876756987868098979e-09; cp = cp * r2 - 2.7557319223985890653e-07;
    cp = cp * r2 + 2.4801587301587301587e-05; cp = cp * r2 - 1.3888888888888888889e-03; cp = cp * r2 + 4.1666666666666666667e-02; cp = cp * r2 - 0.5; const double cr = 1.0 + r2 * cp;
    const int q = ((int)n) & 3;
    s = (q == 0) ? sr : (q == 1) ? cr : (q == 2) ? -sr : -cr;
    c = (q == 0) ? cr : (q == 1) ? -sr : (q == 2) ? -cr : sr;
}
__device__ __forceinline__ double rope_inv(int j) {
    switch (j) { case 0: return 1.0; case 1: return 0.56234132519034908; case 2: return 0.31622776601683794; case 3: return 0.17782794100389229; case 4: return 0.1; case 5: return 0.056234132519034911;
        case 6: return 0.031622776601683791; case 7: return 0.017782794100389229; case 8: return 0.01; case 9: return 0.0056234132519034910; case 10: return 0.0031622776601683794; case 11: return 0.0017782794100389228;
        case 12: return 0.001; case 13: return 0.00056234132519034910; case 14: return 0.00031622776601683794; default: return 0.00017782794100389228; }
}
__device__ __forceinline__ void p0_rope(const Args& a, Frame& F) {
    float* COS = (float*)(a.ws + WS_COS); float* SIN = (float*)(a.ws + WS_SIN); float* LB = (float*)(a.ws + WS_LBIAS);
    for (int i = blockIdx.x * 512 + F.tid; i < 8192; i += F.G * 512) LB[i] = (i < 4096) ? a.in[I_W0][i] : a.in[I_A0][i - 4096];
    for (int i = blockIdx.x * 512 + F.tid; i < 1024 * 32; i += F.G * 512) { const int t = i >> 5, f = i & 31;
        const double pos = (f < 16) ? (double)(t >> 6) : (double)(t & 63); const double ang = pos * rope_inv(f & 15);
        double s, c; sincos_small(ang, s, c); COS[i] = (float)c; SIN[i] = (float)s; }
}

__device__ __forceinline__ void modnorm_rows(Frame& F, const float* x0, const float* x1, const float* nw, const float* MOD, int shift_slot, bf16* H) {
    for (int row = F.gw; row < T; row += F.ngw) {
        const float* xr = row < T_P ? x0 + (size_t)row * DM : x1 + (size_t)(row - T_P) * DM;
        const float* md = MOD + (size_t)mod_index(row) * NMOD + shift_slot * DM;
        f32x4 v[16]; float ss = 0.f;
#pragma unroll
        for (int j = 0; j < 16; ++j) { v[j] = *((const GAS f32x4*)xr + F.lane + 64 * j); ss += (v[j].x * v[j].x + v[j].y * v[j].y) + (v[j].z * v[j].z + v[j].w * v[j].w); }
        const float rstd = 1.0f / sqrtf(wave_sum(ss) * (1.0f / DM) + NORM_EPS);
#pragma unroll
        for (int j = 0; j < 16; ++j) { const int col = 4 * (F.lane + 64 * j);
            const f32x4 w = *(const f32x4*)(nw + col), sh = *(const f32x4*)(md + col), sc = *(const f32x4*)(md + DM + col);
            const f32x4 o = v[j] * rstd * w * (sc + 1.0f) + sh;
            v2u p; p.x = pg8::cvt_pk_bf16(o.x, o.y); p.y = pg8::cvt_pk_bf16(o.z, o.w); *(GAS v2u*)(H + (size_t)row * DM + col) = p; }
    }
}

__device__ __forceinline__ int kv_row_of_token(int row) { return row < T_P ? row : T_P + ((row - T_P) >> 10) * 1536 + 512 + ((row - T_P) & 1023); }
__device__ __forceinline__ void p3_post(const Args& a, Frame& F) {
    const float* QLAT = (const float*)(a.ws + WS_QLAT); const float* KVLAT = (const float*)(a.ws + WS_KVLAT); const float* KPE = (const float*)(a.ws + WS_KPE);
    bf16* QN = (bf16*)(a.ws + WS_QN); bf16* CKVA = (bf16*)(a.ws + WS_CKVA);
    const float* qnw = a.in[I_QNW]; const float* kvnw = a.in[I_KVNW];
    for (int task = F.gw; task < T + 2048; task += F.ngw) {
        if (task < T) { const int row = task;
            { f32x4 v[4]; float ss = 0.f;
#pragma unroll
              for (int j = 0; j < 4; ++j) { v[j] = *((const GAS f32x4*)(QLAT + (size_t)row * QL) + F.lane + 64 * j); ss += (v[j].x * v[j].x + v[j].y * v[j].y) + (v[j].z * v[j].z + v[j].w * v[j].w); }
              const float rstd = 1.0f / sqrtf(wave_sum(ss) * (1.0f / QL) + NORM_EPS);
#pragma unroll
              for (int j = 0; j < 4; ++j) { const int col = 4 * (F.lane + 64 * j); const f32x4 o = v[j] * rstd * *(const f32x4*)(qnw + col);
                  v2u p; p.x = pg8::cvt_pk_bf16(o.x, o.y); p.y = pg8::cvt_pk_bf16(o.z, o.w); *(GAS v2u*)(QN + (size_t)row * QL + col) = p; } }
            { f32x4 v[2]; float ss = 0.f;
#pragma unroll
              for (int j = 0; j < 2; ++j) { v[j] = *((const GAS f32x4*)(KVLAT + (size_t)row * KVL) + F.lane + 64 * j); ss += (v[j].x * v[j].x + v[j].y * v[j].y) + (v[j].z * v[j].z + v[j].w * v[j].w); }
              const float rstd = 1.0f / sqrtf(wave_sum(ss) * (1.0f / KVL) + NORM_EPS);
              const int kr = kv_row_of_token(row);
#pragma unroll
              for (int j = 0; j < 2; ++j) { const int col = 4 * (F.lane + 64 * j); const f32x4 o = v[j] * rstd * *(const f32x4*)(kvnw + col);
                  v2u p; p.x = pg8::cvt_pk_bf16(o.x, o.y); p.y = pg8::cvt_pk_bf16(o.z, o.w); *(GAS v2u*)(CKVA + (size_t)kr * KVL + col) = p;
                  if (row < T_P) *(GAS f32x4*)(a.out + OUT_CKV + (size_t)row * KVL + col) = o; } }
            if (row < T_P) a.out[OUT_KPE + (size_t)row * 64 + F.lane] = KPE[(size_t)row * 64 + F.lane];
        } else { const int idx = task - T, b = idx >> 9, p = idx & 511; const float* src = a.in[I_CCKV] + (size_t)idx * KVL; const int kr = T_P + b * 1536 + p;
#pragma unroll
            for (int j = 0; j < 2; ++j) { const int col = 4 * (F.lane + 64 * j); const f32x4 o = *(const GAS f32x4*)(src + col);
                v2u pk; pk.x = pg8::cvt_pk_bf16(o.x, o.y); pk.y = pg8::cvt_pk_bf16(o.z, o.w); *(GAS v2u*)(CKVA + (size_t)kr * KVL + col) = pk; }
        }
    }
}
constexpr int SC_TS = 16, SC_NCH = 96, SC_BUF_FLOATS = SC_TS * 6 * 64;
struct ScanChain { int row0, L, h, dir, b, is_sample; };
__device__ __forceinline__ ScanChain scan_chain(int gid, int idx) {
    ScanChain c; int code;
    if (gid < 256) { if (idx == 0) { code = gid; c.is_sample = 1; } else { code = 2 * gid + (idx - 1); c.is_sample = 0; } }
    else { code = 512 + 6 * (gid - 256) + idx; c.is_sample = 0; }
    c.b = code >> 6; c.h = (code >> 1) & 31; c.dir = code & 1;
    if (c.is_sample) { c.row0 = T_P + c.b * 1024; c.L = 1024; } else { c.row0 = c.b * 256; c.L = 256; }
    return c;
}
__device__ __forceinline__ void scan_locate(int gid, int ci, int& idx, int& chunk) {
    if (gid < 256) { if (ci < 64) { idx = 0; chunk = ci; } else { idx = 1 + ((ci - 64) >> 4); chunk = (ci - 64) & 15; } }
    else { idx = ci >> 4; chunk = ci & 15; }
}
struct ScanPref { unsigned short r[4], k[4], v[4], e[4], a[4]; };
__device__ __forceinline__ float h2f(unsigned short u) { return (float)__builtin_bit_cast(_Float16, u); }

__device__ __forceinline__ void p5_scan(const Args& a, Frame& F) {
    const unsigned short* RKV = (const unsigned short*)(a.ws + WS_RKV); const unsigned short* EW = (const unsigned short*)(a.ws + WS_EW); const unsigned short* AA = (const unsigned short*)(a.ws + WS_AA);
    _Float16* YS = (_Float16*)(a.ws + WS_YS); float* BON = (float*)(a.ws + WS_BON);
    const float* k_k = a.in[I_KK]; const float* k_a = a.in[I_KA]; const float* r_k = a.in[I_RK];
    const int grp = F.wave >> 2, wq = F.wave & 3, lane = F.lane, vg = lane >> 4, kq = lane & 15;
    LAS float* buf0 = (LAS float*)F.lds + (grp * 2) * SC_BUF_FLOATS;
    if (F.G != 256) return;
    const int gid = grp == 0 ? (int)blockIdx.x : 256 + (int)blockIdx.x;

    ScanPref P;
#define SC_LOAD(ci_) do { int idx_, ch_; scan_locate(gid, (ci_), idx_, ch_); const ScanChain c_ = scan_chain(gid, idx_); \
        _Pragma("unroll") for (int j = 0; j < 4; ++j) { const int s_ = ch_ * SC_TS + 4 * wq + j; const int t_ = c_.dir ? c_.L - 1 - s_ : s_; const size_t row_ = (size_t)(c_.row0 + t_); \
            const unsigned short* rp = RKV + row_ * 6144 + c_.h * 64 + lane; P.r[j] = rp[0]; P.k[j] = rp[2048]; P.v[j] = rp[4096]; \
            const size_t o_ = ((size_t)c_.dir * T + row_) * DA + c_.h * 64 + lane; P.e[j] = EW[o_]; P.a[j] = AA[o_]; } } while (0)
#define SC_STAGE(ci_, pb_) do { int idx_, ch_; scan_locate(gid, (ci_), idx_, ch_); const ScanChain c_ = scan_chain(gid, idx_); LAS float* B_ = buf0 + (pb_) * SC_BUF_FLOATS; \
        const float kkw = k_k[c_.h * 64 + lane], kaw = k_a[c_.h * 64 + lane], rkw = r_k[c_.h * 64 + lane]; \
        _Pragma("unroll") for (int j = 0; j < 4; ++j) { const int i_ = 4 * wq + j; const int s_ = ch_ * SC_TS + i_; const int t_ = c_.dir ? c_.L - 1 - s_ : s_; const size_t row_ = (size_t)(c_.row0 + t_); \
            const float r_ = h2f(P.r[j]), k_ = h2f(P.k[j]), v_ = h2f(P.v[j]), e_ = h2f(P.e[j]), a_ = h2f(P.a[j]); \
            const float kr_ = k_ * kkw; const float kk_ = kr_ * (1.0f / sqrtf(wave_sum(kr_ * kr_) + 1e-12f)); \
            const float kd_ = k_ * (1.0f + (a_ - 1.0f) * kaw); const float bon_ = wave_sum(r_ * kd_ * rkw); \
            LAS float* o_ = B_ + i_ * 6 * 64 + lane; o_[0] = -kk_; o_[64] = __expf(-e_); o_[128] = kk_ * a_; o_[192] = kd_; o_[256] = r_; o_[320] = v_; \
            if (lane == 0) BON[((size_t)c_.dir * T + row_) * 32 + c_.h] = bon_; } } while (0)

    SC_LOAD(0); SC_STAGE(0, 0);
    asm volatile("s_waitcnt lgkmcnt(0)" ::: "memory"); __syncthreads();

    float S[4][4];
    for (int ci = 0; ci < SC_NCH; ++ci) {
        int idx, chunk; scan_locate(gid, ci, idx, chunk); const ScanChain c = scan_chain(gid, idx);
        if (ci + 1 < SC_NCH) SC_LOAD(ci + 1);
        const size_t sbase = (c.is_sample ? (size_t)((c.b * 2 + c.dir) * 32 + c.h) : (size_t)((c.b * 2 + c.dir) * 32 + c.h)) * 4096 + (size_t)(16 * wq + 4 * vg) * 64 + 4 * kq;
        if (chunk == 0) {
            if (c.is_sample) {
#pragma unroll
                for (int rr = 0; rr < 4; ++rr) { const f32x4 s4 = *(const f32x4*)(a.in[I_STATE] + sbase + rr * 64); S[rr][0] = s4.x; S[rr][1] = s4.y; S[rr][2] = s4.z; S[rr][3] = s4.w; }
            } else {
#pragma unroll
                for (int rr = 0; rr < 4; ++rr) { S[rr][0] = 0.f; S[rr][1] = 0.f; S[rr][2] = 0.f; S[rr][3] = 0.f; }
            }
        }
        const LAS float* B = buf0 + (ci & 1) * SC_BUF_FLOATS;
        _Float16* yout = YS + (size_t)c.dir * T * DA + c.h * 64 + 16 * wq + 4 * vg;
#pragma unroll 4
        for (int i = 0; i < SC_TS; ++i) {
            const LAS float* O = B + i * 6 * 64;
            const f32x4 a4 = *(const LAS f32x4*)(O + 4 * kq), w4 = *(const LAS f32x4*)(O + 64 + 4 * kq), b4 = *(const LAS f32x4*)(O + 128 + 4 * kq),
                        k4 = *(const LAS f32x4*)(O + 192 + 4 * kq), r4 = *(const LAS f32x4*)(O + 256 + 4 * kq), v4 = *(const LAS f32x4*)(O + 320 + 16 * wq + 4 * vg);
            float sa[4], y[4];
#pragma unroll
            for (int rr = 0; rr < 4; ++rr) sa[rr] = row16_sum((S[rr][0] * a4.x + S[rr][1] * a4.y) + (S[rr][2] * a4.z + S[rr][3] * a4.w));
#pragma unroll
            for (int rr = 0; rr < 4; ++rr) {
#pragma unroll
                for (int j = 0; j < 4; ++j) S[rr][j] = S[rr][j] * w4[j] + sa[rr] * b4[j] + v4[rr] * k4[j];
                y[rr] = row16_sum((S[rr][0] * r4.x + S[rr][1] * r4.y) + (S[rr][2] * r4.z + S[rr][3] * r4.w));
            }
            if (kq == 0) { const int s = chunk * SC_TS + i; const int t = c.dir ? c.L - 1 - s : s;
                v2u pk; pk.x = pg8::pk_f16(y[0], y[1]); pk.y = pg8::pk_f16(y[2], y[3]); *(GAS v2u*)(yout + (size_t)(c.row0 + t) * DA) = pk; }
        }
        if (!c.is_sample && chunk == (c.L / SC_TS) - 1) {
#pragma unroll
            for (int rr = 0; rr < 4; ++rr) *(GAS f32x4*)(a.out + OUT_STATE + sbase + rr * 64) = (f32x4){S[rr][0], S[rr][1], S[rr][2], S[rr][3]};
        }
        if (ci + 1 < SC_NCH) SC_STAGE(ci + 1, (ci + 1) & 1);
        asm volatile("s_waitcnt lgkmcnt(0)" ::: "memory"); __syncthreads();
    }
#undef SC_LOAD
#undef SC_STAGE
}
__device__ __forceinline__ float bf2f(bf16 b) { return __builtin_bit_cast(float, (unsigned)b << 16); }
__device__ __forceinline__ bf16 f2bf_rne(float f) { return (bf16)(pg8::cvt_pk_bf16(f, 0.f) & 0xffffu); }
__device__ __forceinline__ void p5_qkprep(const Args& a, Frame& F) {
    bf16* Q = (bf16*)(a.ws + WS_Q); const bf16* KV = (const bf16*)(a.ws + WS_KV); bf16* KP = (bf16*)(a.ws + WS_KP); const float* KPE = (const float*)(a.ws + WS_KPE);
    const float* COS = (const float*)(a.ws + WS_COS); const float* SIN = (const float*)(a.ws + WS_SIN);
    const int lane = F.lane;
    for (int task = F.gw; task < T + KVROWS; task += F.ngw) {
        const bool isq = task < T;
        int pos = -1; const float* kpe = nullptr; size_t qrow = 0, kvrow = 0;
        if (isq) { qrow = task; if (task >= T_P) pos = (task - T_P) & 1023; }
        else { kvrow = task - T;
            if (kvrow < (size_t)T_P) kpe = KPE + kvrow * 64;
            else { const int r = (int)kvrow - T_P, b = r / 1536, p = r % 1536;
                if (p < 512) kpe = a.in[I_CKPE] + (size_t)(b * 512 + p) * 64; else { pos = p - 512; kpe = KPE + (size_t)(T_P + b * 1024 + pos) * 64; } } }
        const float* hn = isq ? a.in[I_QHN] : a.in[I_KHN];
        const float w0 = hn[lane], w1 = hn[64 + lane], w2 = hn[128 + lane];
        float cs = 1.f, sn = 0.f; if (pos >= 0) { cs = COS[pos * 32 + (lane & 31)]; sn = SIN[pos * 32 + (lane & 31)]; }
        const float kx2 = isq ? 0.f : kpe[lane];
#pragma unroll 4
        for (int h = 0; h < 16; ++h) {
            float x0, x1, x2;
            if (isq) { const bf16* p = Q + qrow * 3072 + h * 192; x0 = bf2f(p[lane]); x1 = bf2f(p[64 + lane]); x2 = bf2f(p[128 + lane]); }
            else { const bf16* p = KV + kvrow * 4096 + h * 256; x0 = bf2f(p[lane]); x1 = bf2f(p[64 + lane]); x2 = kx2; }
            const float rs = 1.0f / sqrtf(wave_sum(x0 * x0 + x1 * x1 + x2 * x2) * (1.0f / 192.0f) + NORM_EPS);
            const float y0 = x0 * rs * w0, y1 = x1 * rs * w1; float y2 = x2 * rs * w2;
            if (pos >= 0) { const float pr = __shfl_xor(y2, 32); y2 = (lane < 32) ? y2 * cs - pr * sn : pr * sn + y2 * cs; }
            bf16* o = isq ? Q + qrow * 3072 + h * 192 : KP + kvrow * 3072 + h * 192;
            o[lane] = f2bf_rne(y0); o[64 + lane] = f2bf_rne(y1); o[128 + lane] = f2bf_rne(y2);
        }
    }
}

namespace attn {
using bf16x8 = __attribute__((ext_vector_type(8))) short;
using s16x4  = __attribute__((ext_vector_type(4))) short;
using f32x16 = __attribute__((ext_vector_type(16))) float;
using u32x4  = __attribute__((ext_vector_type(4))) unsigned;
constexpr int DQK = 192, DV = 128, NW = 8, QBLK = 32, KVBLK = 64;
constexpr int LDQ = 3072, LDK = 3072, LDV = 4096, LDO = 2048;
constexpr float SCALE = 0.07216878364870322f;
constexpr float THR = 8.f;
constexpr size_t SHM_V = KVBLK * DV * 2, SHM_K = KVBLK * DQK * 2, SHM_ATTN = 2 * SHM_V + 2 * SHM_K + NW * 64 * 4;
#define KSWZ(row, colB) ((row) * 384 + ((colB) ^ (((row) & 7) << 4)))
#define SBAR() __builtin_amdgcn_sched_barrier(0)
__device__ __forceinline__ int crow(int r, int hi) { return (r & 3) + 8 * (r >> 2) + 4 * hi; }
__device__ __forceinline__ unsigned cvtpk(float lo, float hi) { return pg8::cvt_pk_bf16(lo, hi); }

__device__ __forceinline__ void partialSM(f32x16& p0, f32x16& p1, float& m_reg, float& mn, float& alpha) {
  constexpr float C = SCALE * 1.4426950408889634f;
  float pmax = p0[0];
#pragma unroll
  for (int r = 1; r < 16; ++r) pmax = fmaxf(pmax, p0[r]);
#pragma unroll
  for (int r = 0; r < 16; ++r) pmax = fmaxf(pmax, p1[r]);
  { auto rr = __builtin_amdgcn_permlane32_swap(__float_as_uint(pmax), __float_as_uint(pmax), false, false);
    pmax = fmaxf(__uint_as_float(rr[0]), __uint_as_float(rr[1])); }
  if (__builtin_expect(__all(pmax - m_reg <= THR / SCALE), 1)) { mn = m_reg; alpha = 1.f; }
  else { mn = fmaxf(m_reg, pmax); alpha = __builtin_amdgcn_exp2f((m_reg - mn) * C); m_reg = mn; }
  float mnC = -mn * C;
#pragma unroll
  for (int r = 0; r < 16; ++r) p0[r] = fmaf(p0[r], C, mnC);
#pragma unroll
  for (int r = 0; r < 16; ++r) p1[r] = fmaf(p1[r], C, mnC);
#pragma unroll
  for (int r = 0; r < 16; ++r) p0[r] = __builtin_amdgcn_exp2f(p0[r]);
}
__device__ __forceinline__ void finishSM(f32x16& p0, f32x16& p1, float alpha, float& l_reg, bf16x8& pa0, bf16x8& pa1, bf16x8& pa2, bf16x8& pa3) {
#pragma unroll
  for (int r = 0; r < 16; ++r) p1[r] = __builtin_amdgcn_exp2f(p1[r]);
  float ps = 0;
#pragma unroll
  for (int r = 0; r < 16; ++r) ps += p0[r];
#pragma unroll
  for (int r = 0; r < 16; ++r) ps += p1[r];
  { auto rr = __builtin_amdgcn_permlane32_swap(__float_as_uint(ps), __float_as_uint(ps), false, false);
    ps = __uint_as_float(rr[0]) + __uint_as_float(rr[1]); }
  l_reg = l_reg * alpha + ps;
#define PK4(P, BASE, OUT) do { unsigned a0 = cvtpk(P[BASE + 0], P[BASE + 1]), a1 = cvtpk(P[BASE + 2], P[BASE + 3]);   \
    unsigned b0 = cvtpk(P[BASE + 4], P[BASE + 5]), b1 = cvtpk(P[BASE + 6], P[BASE + 7]);                              \
    auto r0 = __builtin_amdgcn_permlane32_swap(a0, b0, false, false); auto r1 = __builtin_amdgcn_permlane32_swap(a1, b1, false, false); \
    u32x4 w = {r0[0], r1[0], r0[1], r1[1]}; OUT = *reinterpret_cast<bf16x8*>(&w); } while (0)
  PK4(p0, 0, pa0); PK4(p0, 8, pa1); PK4(p1, 0, pa2); PK4(p1, 8, pa3);
#undef PK4
}
__device__ __forceinline__ void qkt(f32x16& p0, f32x16& p1, const char* Ks, const bf16x8* qr, int r32, int hi) {
  p0 = f32x16{}; p1 = f32x16{};
#pragma unroll
  for (int d0 = 0; d0 < 12; ++d0) { int cb = (d0 * 16 + hi * 8) * 2;
    bf16x8 b0 = *reinterpret_cast<const bf16x8*>(Ks + KSWZ(r32, cb));
    bf16x8 b1 = *reinterpret_cast<const bf16x8*>(Ks + KSWZ(32 + r32, cb));
    p0 = __builtin_amdgcn_mfma_f32_32x32x16_bf16(b0, qr[d0], p0, 0, 0, 0);
    p1 = __builtin_amdgcn_mfma_f32_32x32x16_bf16(b1, qr[d0], p1, 0, 0, 0); }
}
__device__ __forceinline__ int v_st(int k, int c) { const int kk = (k & ~0xC) | ((k & 4) << 1) | ((k & 8) >> 1); return ((kk >> 3) * 4 + (c >> 5)) * 512 + ((kk & 7) * 32 + (c & 31)) * 2; }
__device__ __forceinline__ int v_rd_base(int lane) { return ((lane & 3) << 3) | (((lane >> 2) & 3) << 6) | (((lane >> 4) & 1) << 5) | (((lane >> 5) & 1) << 8); }
constexpr int v_rd_off(int d0, int ks, int half) { return d0 * 512 + ks * 4096 + half * 2048; }
template <int OFF> __device__ __forceinline__ s16x4 tr_read(int vb) {
  s16x4 r; asm volatile("ds_read_b64_tr_b16 %0, %1 offset:%2" : "=&v"(r) : "v"(vb), "i"(OFF) : "memory"); return r;
}
template <int D0> __device__ __forceinline__ void pv_one(f32x16& od, int vb, bf16x8 pa0, bf16x8 pa1, bf16x8 pa2, bf16x8 pa3) {
#define PK(L, H) (bf16x8){L[0], L[1], L[2], L[3], H[0], H[1], H[2], H[3]}
  { const s16x4 l0 = tr_read<v_rd_off(D0, 0, 0)>(vb), h0 = tr_read<v_rd_off(D0, 0, 1)>(vb), l1 = tr_read<v_rd_off(D0, 1, 0)>(vb), h1 = tr_read<v_rd_off(D0, 1, 1)>(vb);
    asm volatile("s_waitcnt lgkmcnt(0)" ::: "memory"); SBAR();
    od = __builtin_amdgcn_mfma_f32_32x32x16_bf16(pa0, PK(l0, h0), od, 0, 0, 0);
    od = __builtin_amdgcn_mfma_f32_32x32x16_bf16(pa1, PK(l1, h1), od, 0, 0, 0); }
  { const s16x4 l2 = tr_read<v_rd_off(D0, 2, 0)>(vb), h2 = tr_read<v_rd_off(D0, 2, 1)>(vb), l3 = tr_read<v_rd_off(D0, 3, 0)>(vb), h3 = tr_read<v_rd_off(D0, 3, 1)>(vb);
    asm volatile("s_waitcnt lgkmcnt(0)" ::: "memory"); SBAR();
    od = __builtin_amdgcn_mfma_f32_32x32x16_bf16(pa2, PK(l2, h2), od, 0, 0, 0);
    od = __builtin_amdgcn_mfma_f32_32x32x16_bf16(pa3, PK(l3, h3), od, 0, 0, 0); }
#undef PK
}
__device__ __forceinline__ void pv_d0(f32x16* o, int vb, bf16x8 pa0, bf16x8 pa1, bf16x8 pa2, bf16x8 pa3) {
  pv_one<0>(o[0], vb, pa0, pa1, pa2, pa3); pv_one<1>(o[1], vb, pa0, pa1, pa2, pa3); pv_one<2>(o[2], vb, pa0, pa1, pa2, pa3); pv_one<3>(o[3], vb, pa0, pa1, pa2, pa3);
}

__device__ __forceinline__ void attn_dense_body(const bf16* __restrict__ Qb, const bf16* __restrict__ Kh, const bf16* __restrict__ Vh, bf16* __restrict__ Ob, int seq, char* lds) {
  int tid_ = threadIdx.x; asm volatile("" : "+v"(tid_));
  const int tid = tid_, wid = __builtin_amdgcn_readfirstlane(tid >> 6), lane = tid & 63, r32 = lane & 31, hi = lane >> 5;
  char* V_lds = lds; char* K_lds = lds + 2 * SHM_V;
  float* ws = (float*)(lds + 2 * SHM_V + 2 * SHM_K) + wid * 64; float* li_l = ws; float* al_l = ws + 32;
  float m_reg = -1e30f, l_reg = 0; f32x16 o[4] = {}; bf16x8 qr[12];
  const bf16* Qw = Qb + (long)(wid * QBLK + r32) * LDQ + hi * 8;
#pragma unroll
  for (int d0 = 0; d0 < 12; ++d0) qr[d0] = *reinterpret_cast<const bf16x8*>(Qw + d0 * 16);
  const int sr = tid >> 4, sc = (tid & 15) * 8, vst0 = v_st(sr, sc), vst1 = v_st(32 + sr, sc);
  const int kr2 = tid >> 3, kc2 = 128 + (tid & 7) * 8;
  const int vb0 = (int)(uintptr_t)V_lds + v_rd_base(lane);
  bf16x8 vs0, vs1, ks0, ks1, ks2;
  const unsigned ovs0 = (unsigned)(sr * LDV + sc) * 2u, ovs1 = (unsigned)((32 + sr) * LDV + sc) * 2u, oks0 = (unsigned)(sr * LDK + sc) * 2u, oks1 = (unsigned)((32 + sr) * LDK + sc) * 2u, oks2 = (unsigned)(kr2 * LDK + kc2) * 2u;
#define SLOAD(k0) do { const char* vt_ = (const char*)Vh + (size_t)(k0) * (LDV * 2); const char* kt_ = (const char*)Kh + (size_t)(k0) * (LDK * 2); \
    vs0 = *reinterpret_cast<const bf16x8*>(vt_ + ovs0); vs1 = *reinterpret_cast<const bf16x8*>(vt_ + ovs1); \
    ks0 = *reinterpret_cast<const bf16x8*>(kt_ + oks0); ks1 = *reinterpret_cast<const bf16x8*>(kt_ + oks1); ks2 = *reinterpret_cast<const bf16x8*>(kt_ + oks2); } while (0)
#define SWRITE(b) do { *(bf16x8*)(V_lds + (b) * SHM_V + vst0) = vs0; *(bf16x8*)(V_lds + (b) * SHM_V + vst1) = vs1; \
    *(bf16x8*)(K_lds + (b) * SHM_K + KSWZ(sr, sc * 2)) = ks0; *(bf16x8*)(K_lds + (b) * SHM_K + KSWZ(32 + sr, sc * 2)) = ks1; \
    *(bf16x8*)(K_lds + (b) * SHM_K + KSWZ(kr2, kc2 * 2)) = ks2; } while (0)
#define RESC(a) do { if (__any((a) < 1.f)) { if (hi == 0) al_l[r32] = (a); asm volatile("s_waitcnt lgkmcnt(0)" ::: "memory"); \
    _Pragma("unroll") for (int d = 0; d < 4; ++d) _Pragma("unroll") for (int r = 0; r < 16; ++r) o[d][r] *= al_l[crow(r, hi)]; } } while (0)
  f32x16 p0, p1; float mn, al; bf16x8 pa0, pa1, pa2, pa3; const int NT = seq / KVBLK;
  SLOAD(0); asm volatile("s_waitcnt vmcnt(0)" ::: "memory"); SWRITE(0); __syncthreads();
  SLOAD(KVBLK);
  for (int j = 0; j < NT; ++j) {
    const int bsel = j & 1;
    SBAR(); qkt(p0, p1, K_lds + bsel * SHM_K, qr, r32, hi);
    partialSM(p0, p1, m_reg, mn, al); finishSM(p0, p1, al, l_reg, pa0, pa1, pa2, pa3); SBAR();
    RESC(al);
    if (j + 1 < NT) { asm volatile("s_waitcnt vmcnt(0)" ::: "memory"); SWRITE(bsel ^ 1); }
    if (j + 2 < NT) SLOAD((j + 2) * KVBLK);
    SBAR(); pv_d0(o, vb0 + bsel * (int)SHM_V, pa0, pa1, pa2, pa3);
    __syncthreads();
  }
  if (hi == 0) li_l[r32] = l_reg; asm volatile("s_waitcnt lgkmcnt(0)" ::: "memory");
  float rli[16];
#pragma unroll
  for (int r = 0; r < 16; ++r) rli[r] = __builtin_amdgcn_rcpf(li_l[crow(r, hi)]);
  bf16* Ow = Ob + (long)(wid * QBLK) * LDO;
#pragma unroll
  for (int r = 0; r < 16; ++r) { int orow = crow(r, hi);
#pragma unroll
    for (int d0 = 0; d0 < 4; ++d0) Ow[(long)orow * LDO + d0 * 32 + r32] = (bf16)(cvtpk(o[d0][r] * rli[r], 0.f) & 0xffffu); }
  __syncthreads();
#undef SLOAD
#undef SWRITE
#undef RESC
}
#undef KSWZ
#undef SBAR
}

__device__ __forceinline__ void p6_attention(const Args& a, Frame& F) {
    const bf16* QP = (const bf16*)(a.ws + WS_Q); const bf16* KP = (const bf16*)(a.ws + WS_KP); const bf16* KV = (const bf16*)(a.ws + WS_KV); bf16* YB = (bf16*)(a.ws + WS_YB);
    char* lds = (char*)(unsigned char*)F.lds;
    for (int u = blockIdx.x; u < 256; u += F.G) {
        const int b = u >> 6, h = (u >> 2) & 15, qb = u & 3; const size_t row0 = (size_t)T_P + b * 1024 + qb * 256, kv0 = (size_t)T_P + b * 1536;
        attn::attn_dense_body(QP + row0 * 3072 + h * 192, KP + kv0 * 3072 + h * 192, KV + kv0 * 4096 + h * 256 + 128, YB + row0 * 2048 + h * 128, 1536, lds);
    }
    for (int u = blockIdx.x; u < 512; u += F.G) {
        const int b = u >> 4, h = u & 15; const size_t row0 = (size_t)b * 256;
        attn::attn_dense_body(QP + row0 * 3072 + h * 192, KP + row0 * 3072 + h * 192, KV + row0 * 4096 + h * 256 + 128, YB + row0 * 2048 + h * 128, 256, lds);
    }
}

__device__ __forceinline__ float grp16_sum(float v) { v += __shfl_xor(v, 1); v += __shfl_xor(v, 2); v += __shfl_xor(v, 4); v += __shfl_xor(v, 8); return v; }
#ifndef P7_NOLN
#define P7_NOLN 0
#endif
#ifndef P7_TRIVIAL
#define P7_TRIVIAL 0
#endif
__device__ __forceinline__ void p7_postscan(const Args& a, Frame& F) {
    const unsigned short* YS = (const unsigned short*)(a.ws + WS_YS); const float* BON = (const float*)(a.ws + WS_BON); const unsigned short* RKV = (const unsigned short*)(a.ws + WS_RKV);
    const bf16* G = (const bf16*)(a.ws + WS_G); bf16* YA = (bf16*)(a.ws + WS_YA); const float* lnw = a.in[I_LNW]; const float* lnb = a.in[I_LNB];
    for (int row = F.gw; row < T; row += F.ngw) {
#pragma unroll 2
        for (int p = 0; p < 8; ++p) { const int c = p * 256 + F.lane * 4, h = c >> 6;
            const v2u yf = *(const GAS v2u*)(YS + (size_t)row * DA + c), yb = *(const GAS v2u*)(YS + ((size_t)T + row) * DA + c), vv = *(const GAS v2u*)(RKV + (size_t)row * 6144 + 4096 + c), gg = *(const GAS v2u*)(G + (size_t)row * DA + c);
            const float bon = BON[(size_t)row * 32 + h] + BON[((size_t)T + row) * 32 + h];
            float y[4], v[4], g[4];
            y[0] = h2f(yf.x & 0xffff) + h2f(yb.x & 0xffff); y[1] = h2f(yf.x >> 16) + h2f(yb.x >> 16); y[2] = h2f(yf.y & 0xffff) + h2f(yb.y & 0xffff); y[3] = h2f(yf.y >> 16) + h2f(yb.y >> 16);
            v[0] = h2f(vv.x & 0xffff); v[1] = h2f(vv.x >> 16); v[2] = h2f(vv.y & 0xffff); v[3] = h2f(vv.y >> 16);
            g[0] = pg8::bflo(gg.x); g[1] = pg8::bfhi(gg.x); g[2] = pg8::bflo(gg.y); g[3] = pg8::bfhi(gg.y);
            const float mu = grp16_sum((y[0] + y[1]) + (y[2] + y[3])) * (1.0f / 64.0f);
            float d[4]; float q = 0.f;
#pragma unroll
            for (int i = 0; i < 4; ++i) { d[i] = y[i] - mu; q += d[i] * d[i]; }
            const float rstd = 1.0f / sqrtf(grp16_sum(q) * (1.0f / 64.0f) + 64e-5f);
            const f32x4 w4 = P7_NOLN ? (f32x4){1.f, 1.f, 1.f, 1.f} : *(const f32x4*)(lnw + c), b4 = P7_NOLN ? (f32x4){0.f, 0.f, 0.f, 0.f} : *(const f32x4*)(lnb + c);
            float o[4];
#pragma unroll
            for (int i = 0; i < 4; ++i) o[i] = P7_TRIVIAL == 1 ? y[i] : P7_TRIVIAL == 2 ? d[i] * rstd : P7_TRIVIAL == 3 ? bon * v[i] : P7_TRIVIAL == 4 ? g[i] * y[i] : (d[i] * rstd * w4[i] + b4[i] + bon * v[i]) * g[i];
            v2u pk; pk.x = pg8::cvt_pk_bf16(o[0], o[1]); pk.y = pg8::cvt_pk_bf16(o[2], o[3]); *(GAS v2u*)(YA + (size_t)row * DA + c) = pk; }
    }
}
#ifndef MK_PER_PHASE
#define MK_PER_PHASE 0
#endif
constexpr int N_PHASES = 13;
__global__ void __launch_bounds__(NWAVES * 64, 2) fwd_kernel(Args args) {
    extern __shared__ __attribute__((aligned(16))) unsigned char lds[];
    Frame F;
    F.lds = (LAS unsigned char*)lds; F.MISC = (volatile LAS unsigned*)(F.lds + MISC_OFF);
    F.tid = threadIdx.x; F.lane = F.tid & 63; F.wave = __builtin_amdgcn_readfirstlane(F.tid >> 6);
    F.G = gridDim.x; F.gw = blockIdx.x * NWAVES + F.wave; F.ngw = F.G * NWAVES;
    unsigned char* ws = args.ws; F.ctl = (gu32*)(ws + WS_CTL);
    for (int u = F.tid; u < (LDS_BYTES - LDSCTL_OFF) / 4; u += NWAVES * 64) ((LAS unsigned*)(F.lds + LDSCTL_OFF))[u] = 0u;
    __syncthreads();
    const int lo = args.ph_lo, hi = args.ph_hi;
    XcdBarrier bar; bar.bar = (unsigned*)(F.ctl + CW_BAR); bar.x = 0; bar.st = nullptr;
    if (hi - lo > 1) bar = xcd_barrier_post((unsigned*)(F.ctl + CW_BAR), F.MISC + 8);
#ifndef P4_MASK
#define P4_MASK 15
#endif
#ifndef PH_MASK
#define PH_MASK 0xFFFFFFFFu
#endif
#define IN(k) (((PH_MASK >> (k)) & 1u) && lo <= (k) && (k) < hi)
#define SEAM(k) do { if (IN(k) && IN((k) + 1)) xcd_barrier(bar); } while (0)
    LAS unsigned char* ring = F.lds + RING_OFF;
    float* MOD = (float*)(ws + WS_MOD);

    if (IN(0)) { p0_adaln(args, F); p0_weights(args, F); p0_rope(args, F); }
    SEAM(0);
    if (IN(1)) { modnorm_rows(F, args.in[I_XP], args.in[I_XS], args.in[I_NMIX], MOD, 0, (bf16*)(ws + WS_HB)); }
    SEAM(1);
    if (IN(2)) {
        pg8::Gemm g{(const pg8::bf16_t*)(ws + WS_HB), (const pg8::bf16_t*)(ws + WS_WIN), T, NIN, DM}; pg8::StaticOrder S; S.init(T, NIN, F.G, (int)blockIdx.x);
        pg8::EpiIn E{(pg8::f16_t*)(ws + WS_RKV), (pg8::bf16_t*)(ws + WS_LWA), (pg8::bf16_t*)(ws + WS_LG), (float*)(ws + WS_QLAT), (float*)(ws + WS_KVLAT), (float*)(ws + WS_KPE), (pg8::bf16_t*)(ws + WS_GA), (pg8::bf16_t*)(ws + WS_GB)};
        pg8::gemm_phase<pg8::EpiIn, pg8::StaticOrder, true, true>(ring, g, S, E);
    }
    SEAM(2);
    if (IN(3)) { p3_post(args, F); }
    SEAM(3);
    if (IN(4)) {
        if (P4_MASK & 1) { int kl = 256; asm volatile("" : "+s"(kl));
          pg8::Gemm g{(const pg8::bf16_t*)(ws + WS_LWA), (const pg8::bf16_t*)(ws + WS_WLORA), 2 * T, 8192, kl}; pg8::BatchedOrder S; S.init(T / 256, 16, 2, F.G, (int)blockIdx.x);
          pg8::EpiLora E{(pg8::f16_t*)(ws + WS_EW), (const float*)(ws + WS_LBIAS)};
          pg8::gemm_phase<pg8::EpiLora, pg8::BatchedOrder, true, true>(ring, g, S, E); }
        if (P4_MASK & 2) { pg8::Gemm g{(const pg8::bf16_t*)(ws + WS_LG), (const pg8::bf16_t*)(ws + WS_WG), T, DA, 512}; pg8::StaticOrder S; S.init(T, DA, F.G, (int)blockIdx.x);
          pg8::EpiPlain E{(pg8::bf16_t*)(ws + WS_G), DA};
          pg8::gemm_phase<pg8::EpiPlain, pg8::StaticOrder, true, true>(ring, g, S, E); }
        if (P4_MASK & 4) { pg8::Gemm g{(const pg8::bf16_t*)(ws + WS_QN), (const pg8::bf16_t*)(ws + WS_WUQ), T, 3072, QL}; pg8::StaticOrder S; S.init(T, 3072, F.G, (int)blockIdx.x);
          pg8::EpiPlain E{(pg8::bf16_t*)(ws + WS_Q), 3072};
          pg8::gemm_phase<pg8::EpiPlain, pg8::StaticOrder, true, true>(ring, g, S, E); }
        if (P4_MASK & 8) { pg8::Gemm g{(const pg8::bf16_t*)(ws + WS_CKVA), (const pg8::bf16_t*)(ws + WS_WUKV), KVROWS, 4096, KVL}; pg8::StaticOrder S; S.init(KVROWS, 4096, F.G, (int)blockIdx.x);
          pg8::EpiPlain E{(pg8::bf16_t*)(ws + WS_KV), 4096};
          pg8::gemm_phase<pg8::EpiPlain, pg8::StaticOrder, true, true>(ring, g, S, E); }
    }
    SEAM(4);
    if (IN(5)) { p5_qkprep(args, F); }
    SEAM(5);
    if (IN(6)) { p5_scan(args, F); __syncthreads(); p6_attention(args, F); }
    SEAM(6);
    if (IN(7)) { p7_postscan(args, F); }
    SEAM(7);
    if (IN(8)) {
        { pg8::Gemm g{(const pg8::bf16_t*)(ws + WS_YA), (const pg8::bf16_t*)(ws + WS_WOR), T, DM, DA}; pg8::StaticOrder S; S.init(T, DM, F.G, (int)blockIdx.x);
          pg8::EpiMix1 E{(const pg8::bf16_t*)(ws + WS_GA), (float*)(ws + WS_TMP)};
          pg8::gemm_phase<pg8::EpiMix1, pg8::StaticOrder, true, true>(ring, g, S, E); }
        { pg8::Gemm g{(const pg8::bf16_t*)(ws + WS_YB), (const pg8::bf16_t*)(ws + WS_WOM), T, DM, DA}; pg8::StaticOrder S; S.init(T, DM, F.G, (int)blockIdx.x);
          pg8::EpiMix2 E{(const pg8::bf16_t*)(ws + WS_GB), (const float*)(ws + WS_TMP), (pg8::bf16_t*)(ws + WS_MIXED)};
          pg8::gemm_phase<pg8::EpiMix2, pg8::StaticOrder, true, true>(ring, g, S, E); }
    }
    SEAM(8);
    if (IN(9)) {
        pg8::Gemm g{(const pg8::bf16_t*)(ws + WS_MIXED), (const pg8::bf16_t*)(ws + WS_WOUT), T, DM, DM}; pg8::StaticOrder S; S.init(T, DM, F.G, (int)blockIdx.x);
        pg8::EpiRes E{args.in[I_XP], args.in[I_XS], args.out, MOD + 2 * DM};
        pg8::gemm_phase<pg8::EpiRes, pg8::StaticOrder, true, true>(ring, g, S, E);
    }
    SEAM(9);
    if (IN(10)) { modnorm_rows(F, args.out, args.out + (size_t)T_P * DM, args.in[I_NFFN], MOD, 3, (bf16*)(ws + WS_HB)); }
    SEAM(10);
    if (IN(11)) {
        pg8::Gemm g{(const pg8::bf16_t*)(ws + WS_HB), (const pg8::bf16_t*)(ws + WS_WFI), T, 2 * DFF, DM}; pg8::StaticOrder S; S.init(T, 2 * DFF, F.G, (int)blockIdx.x);
        pg8::EpiSwiglu E{(pg8::bf16_t*)(ws + WS_ACT)};
        pg8::gemm_phase<pg8::EpiSwiglu, pg8::StaticOrder, true, true>(ring, g, S, E);
    }
    SEAM(11);
    if (IN(12)) {
        pg8::Gemm g{(const pg8::bf16_t*)(ws + WS_ACT), (const pg8::bf16_t*)(ws + WS_WFO), T, DM, DFF}; pg8::StaticOrder S; S.init(T, DM, F.G, (int)blockIdx.x);
        pg8::EpiRes E{args.out, args.out + (size_t)T_P * DM, args.out, MOD + 5 * DM};
        pg8::gemm_phase<pg8::EpiRes, pg8::StaticOrder, true, true>(ring, g, S, E);
    }
#undef IN
#undef SEAM
}

extern "C" void kernel_launch(void* const* d_in, const int* in_sizes, int n_in, void* d_out, int out_size, void* d_ws, size_t ws_size, hipStream_t stream) {
    static int grid = 0;
    if (grid == 0) {
        if (n_in != 33 || ws_size < WS_END) { fprintf(stderr, "kernel_launch: n_in %d ws %zu (need 33 inputs, >= %zu bytes)\n", n_in, ws_size, (size_t)WS_END); grid = -1; return; }
        if (hipFuncSetAttribute((const void*)fwd_kernel, hipFuncAttributeMaxDynamicSharedMemorySize, LDS_BYTES) != hipSuccess) { fprintf(stderr, "kernel_launch: hipFuncSetAttribute failed\n"); grid = -1; return; }
        int per_cu = 0;
        if (hipOccupancyMaxActiveBlocksPerMultiprocessor(&per_cu, (const void*)fwd_kernel, NWAVES * 64, LDS_BYTES) != hipSuccess || per_cu < 1) fprintf(stderr, "kernel_launch: occupancy query reports %d\n", per_cu);
        (void)hipGetLastError();
        grid = 256;
    }
    if (grid < 0) return;
    if (hipMemsetAsync((char*)d_ws + WS_CTL, 0, CTL_ZERO_BYTES, stream) != hipSuccess) return;
    Args a{};
    for (int i = 0; i < 33; ++i) a.in[i] = (const float*)d_in[i];
    a.out = (float*)d_out; a.ws = (unsigned char*)d_ws;
#if MK_PER_PHASE
    for (int p = 0; p < N_PHASES; ++p) { a.ph_lo = p; a.ph_hi = p + 1; hipLaunchKernelGGL(fwd_kernel, dim3(grid), dim3(NWAVES * 64), LDS_BYTES, stream, a); }
#else
    a.ph_lo = 0; a.ph_hi = N_PHASES; hipLaunchKernelGGL(fwd_kernel, dim3(grid), dim3(NWAVES * 64), LDS_BYTES, stream, a);
#endif
    const hipError_t le = hipPeekAtLastError();
    if (le != hipSuccess) fprintf(stderr, "kernel_launch: launch failed: %s\n", hipGetErrorName(le));
}
```

```cpp
#include <hip/hip_runtime.h>
#include <cstdio>
#include <cstdint>
namespace pg8 {
#define PG8_LAS __attribute__((address_space(3)))
typedef unsigned short bf16_t;
typedef short bf16x8 __attribute__((ext_vector_type(8)));
typedef float f32x4 __attribute__((ext_vector_type(4)));
typedef unsigned u32x4 __attribute__((ext_vector_type(4)));
constexpr int BM = 256, BK = 64, HALF = 128, HTB = HALF * BK * 2  , STAGE_BYTES = 8 * HTB, NXCD = 8, WGM = 8;

__host__ __device__ __forceinline__ int lds_byte(int r, int c) { const int st = (r >> 4) * 2 + (c >> 5), rr = r & 15, cc = c & 31, ob = rr * 64 + cc * 2; return st * 1024 + (ob ^ (((ob >> 9) & 1) << 5)); }
__host__ __device__ __forceinline__ void stage_rc(int b, int& R, int& C) { const int st = b / 1024, sb = b % 1024, swz = sb ^ (((sb >> 9) & 1) << 5); R = (st >> 1) * 16 + swz / 64; C = (st & 1) * 32 + (swz % 64) / 2; }
__host__ __device__ __forceinline__ int perm32(int rho) { const int n = rho >> 4, i = rho & 15; return 8 * (i >> 2) + 4 * n + (i & 3); }

struct Unit { int pm, pn; };
struct Gemm { const bf16_t* A; const bf16_t* Bt; int M, N, K; };

struct StaticOrder {
    int nM, nN, nwg, G, c;
    __host__ __device__ void init(int M, int N, int G_, int c_, int rot = 0) { nM = M / BM; nN = N / BM; nwg = nM * nN; G = G_; c = (c_ + rot) % G_; }
    __host__ __device__ bool next(int i, Unit& u) const {
        const long L = (long)i * G + c; if (L >= nwg) return false;
        int wgid = (int)L; { const int q = nwg / NXCD, r = nwg % NXCD, xcd = wgid % NXCD, off = wgid / NXCD; wgid = (xcd < r ? xcd * (q + 1) : r * (q + 1) + (xcd - r) * q) + off; }
        const int nig = WGM * nN, gid = wgid / nig, fm = gid * WGM, gsz = (nM - fm) < WGM ? (nM - fm) : WGM;
        u.pm = fm + ((wgid % nig) % gsz); u.pn = (wgid % nig) / gsz; return true;
    }
    __device__ __forceinline__ void a_ready(const Unit&) const {}
    __device__ __forceinline__ void done(const Unit&) const {}
};

typedef float cvt_f32x2_t __attribute__((ext_vector_type(2)));
typedef __bf16 cvt_bf16x2_t __attribute__((ext_vector_type(2)));
__device__ __forceinline__ unsigned cvt_pk_bf16(float lo, float hi) { cvt_f32x2_t v = {lo, hi}; cvt_bf16x2_t b = __builtin_convertvector(v, cvt_bf16x2_t); return __builtin_bit_cast(unsigned, b); }
typedef float f32x2 __attribute__((ext_vector_type(2)));
template <class Epi, class Sched, bool ALIGN_EPI = false, bool SP2 = false, int MODE = 0>
__device__ __forceinline__ void gemm_phase(PG8_LAS unsigned char* lds, const Gemm g, const Sched& S, const Epi& E) {
    int tid_o = threadIdx.x; asm volatile("" : "+v"(tid_o));
    const int tid = tid_o, wid = __builtin_amdgcn_readfirstlane(tid >> 6), lane = tid & 63, wr = wid >> 2, wc = wid & 3, fr = lane & 15, fq = lane >> 4;
    const int K = g.K, nt = K / BK;
    unsigned voffA[2], voffB[2];
#pragma unroll
    for (int i = 0; i < 2; ++i) { int R, C; stage_rc(tid * 16 + i * 8192, R, C); const int Rb = Epi::PERM ? ((R & ~31) + perm32(R & 31)) : R;
        voffA[i] = (unsigned)(R * K + C) * 2u; voffB[i] = (unsigned)(Rb * K + C) * 2u; }
    const size_t kstep = (size_t)(BK * 2);
    const size_t hstep = (size_t)HALF * K * 2;
    const size_t tstep = 2 * hstep;
    const unsigned ldsw = (unsigned)wid * 1024u;
    const int aoff = lds_byte(wr * 64 + fr, fq * 8), boff = lds_byte(wc * 32 + fr, fq * 8);
#define PG8_SA(b, h) (((b) * 2 + (h)) * HTB)
#define PG8_SB(b, h) ((4 + (b) * 2 + (h)) * HTB)
#define PG8_STAGE(bufoff, gbase, voff) do { _Pragma("unroll") for (int _i = 0; _i < 2; ++_i) \
        __builtin_amdgcn_global_load_lds((const unsigned*)((const char*)(gbase) + (voff)[_i]), (PG8_LAS unsigned*)(lds + (bufoff) + ldsw + _i * 8192), 16, 0, 0); } while (0)
#define PG8_LDA(dst, b, h) do { _Pragma("unroll") for (int m = 0; m < 4; ++m) { dst[m].lo = *(const PG8_LAS bf16x8*)(lds + PG8_SA(b, h) + aoff + m * 2048); dst[m].hi = *(const PG8_LAS bf16x8*)(lds + PG8_SA(b, h) + aoff + m * 2048 + 1024); } } while (0)
#define PG8_LDB(dst, b, h) do { _Pragma("unroll") for (int n = 0; n < 2; ++n) { dst[n].lo = *(const PG8_LAS bf16x8*)(lds + PG8_SB(b, h) + boff + n * 2048); dst[n].hi = *(const PG8_LAS bf16x8*)(lds + PG8_SB(b, h) + boff + n * 2048 + 1024); } } while (0)
#define PG8_MMA(ai, bj, At, Bt) do { __builtin_amdgcn_s_setprio(1); _Pragma("unroll") for (int m = 0; m < 4; ++m) _Pragma("unroll") for (int n = 0; n < 2; ++n) { \
        if constexpr (MODE == 1) { typedef int v8i_t __attribute__((ext_vector_type(8))); \
            asm("v_mfma_scale_f32_16x16x128_f8f6f4 %0, %1, %2, %0, %3, %3 op_sel_hi:[0,0,0]" : "+v"(acc[ai][bj][m][n]) : "v"(__builtin_bit_cast(v8i_t, Bt[n])), "v"(__builtin_bit_cast(v8i_t, At[m])), "v"(f8_unit_scale)); } \
        else if constexpr (MODE == 2) { typedef int v4i_t __attribute__((ext_vector_type(4))); \
            v4i_t c_ = __builtin_bit_cast(v4i_t, acc[ai][bj][m][n]); \
            const bf16x8 bl_ = Bt[n].lo, bh_ = Bt[n].hi, al_ = At[m].lo, ah_ = At[m].hi;     \
            c_ = __builtin_amdgcn_mfma_i32_16x16x64_i8(__builtin_bit_cast(v4i_t, bl_), __builtin_bit_cast(v4i_t, al_), c_, 0, 0, 0); \
            c_ = __builtin_amdgcn_mfma_i32_16x16x64_i8(__builtin_bit_cast(v4i_t, bh_), __builtin_bit_cast(v4i_t, ah_), c_, 0, 0, 0); \
            acc[ai][bj][m][n] = __builtin_bit_cast(f32x4, c_); } \
        else { acc[ai][bj][m][n] = __builtin_amdgcn_mfma_f32_16x16x32_bf16(Bt[n].lo, At[m].lo, acc[ai][bj][m][n], 0, 0, 0); \
               acc[ai][bj][m][n] = __builtin_amdgcn_mfma_f32_16x16x32_bf16(Bt[n].hi, At[m].hi, acc[ai][bj][m][n], 0, 0, 0); } } \
        __builtin_amdgcn_s_setprio(0); } while (0)
#define PG8_WAIT_V(n) asm volatile("s_waitcnt vmcnt(" #n ")" ::: "memory")
#define PG8_WAIT_L(n) asm volatile("s_waitcnt lgkmcnt(" #n ")" ::: "memory")
#define PG8_BAR __builtin_amdgcn_s_barrier()
#define PG8_SCHED __builtin_amdgcn_sched_barrier(0)
    Unit cur, nxt; int ui = 0;
    if (!S.next(0, cur)) return;
    f32x4 acc[2][2][4][2];
#pragma unroll
    for (int a = 0; a < 2; ++a)
#pragma unroll
        for (int b = 0; b < 2; ++b)
#pragma unroll
            for (int m = 0; m < 4; ++m)
#pragma unroll
                for (int n = 0; n < 2; ++n) acc[a][b][m][n] = (f32x4){0.f, 0.f, 0.f, 0.f};
    const int f8_unit_scale = 0x7F7F7F7F;
    typedef short bf16x16 __attribute__((ext_vector_type(16)));
    bf16x16 At[4], B0[2], B1[2];
    const char* cA = (const char*)g.A + (size_t)cur.pm * tstep; const char* cB = (const char*)g.Bt + (size_t)cur.pn * tstep;
    S.a_ready(cur);
    if constexpr (SP2) {
        PG8_STAGE(PG8_SB(0, 0), cB, voffB); PG8_STAGE(PG8_SB(0, 1), cB + hstep, voffB); PG8_STAGE(PG8_SA(0, 0), cA, voffA); PG8_STAGE(PG8_SA(0, 1), cA + hstep, voffA);
        if (wr == 1) PG8_BAR;
        PG8_WAIT_V(2); PG8_BAR;
        PG8_STAGE(PG8_SB(1, 0), cB + kstep, voffB); PG8_STAGE(PG8_SA(1, 0), cA + kstep, voffA); PG8_STAGE(PG8_SB(1, 1), cB + hstep + kstep, voffB);
        PG8_WAIT_V(6); PG8_BAR;
    } else {
        PG8_STAGE(PG8_SB(0, 0), cB, voffB); PG8_STAGE(PG8_SA(0, 0), cA, voffA); PG8_STAGE(PG8_SB(0, 1), cB + hstep, voffB); PG8_STAGE(PG8_SA(0, 1), cA + hstep, voffA);
        if (wr == 1) PG8_BAR;
        PG8_WAIT_V(4); PG8_BAR;
        PG8_STAGE(PG8_SB(1, 0), cB + kstep, voffB); PG8_STAGE(PG8_SA(1, 0), cA + kstep, voffA); PG8_STAGE(PG8_SB(1, 1), cB + hstep + kstep, voffB);
        PG8_WAIT_V(6); PG8_BAR;
    }
    for (;;) {
        const bool has_next = S.next(ui + 1, nxt);
        const char* nA = has_next ? (const char*)g.A + (size_t)nxt.pm * tstep : cA; const char* nB = has_next ? (const char*)g.Bt + (size_t)nxt.pn * tstep : cB;
        for (int t = 0; t < nt; t += 2) {
            const bool last = (t == nt - 2);
            const char* a1 = cA + (size_t)(t + 1) * kstep;
            const char* a2 = last ? nA : cA + (size_t)(t + 2) * kstep; const char* b2 = last ? nB : cB + (size_t)(t + 2) * kstep;
            const char* a3 = a2 + kstep; const char* b3 = b2 + kstep;
            if (last && has_next) S.a_ready(nxt);
            if constexpr (SP2) {
            PG8_LDB(B0, 0, 0); PG8_LDB(B1, 0, 1); PG8_SCHED; PG8_LDA(At, 0, 0); PG8_STAGE(PG8_SA(1, 1), a1 + hstep, voffA);
            PG8_WAIT_V(8); PG8_WAIT_L(0); PG8_BAR; PG8_MMA(0, 0, At, B0); PG8_MMA(0, 1, At, B1); PG8_BAR; PG8_SCHED;
            PG8_LDA(At, 0, 1); PG8_STAGE(PG8_SB(0, 0), b2, voffB); PG8_STAGE(PG8_SB(0, 1), b2 + hstep, voffB); PG8_STAGE(PG8_SA(0, 0), a2, voffA);
            PG8_WAIT_V(8); PG8_WAIT_L(0); PG8_BAR; PG8_MMA(1, 0, At, B0); PG8_MMA(1, 1, At, B1); PG8_BAR; PG8_SCHED;
            PG8_LDB(B0, 1, 0); PG8_LDB(B1, 1, 1); PG8_SCHED; PG8_LDA(At, 1, 0); PG8_STAGE(PG8_SA(0, 1), a2 + hstep, voffA);
            PG8_WAIT_V(8); PG8_WAIT_L(0); PG8_BAR; PG8_MMA(0, 0, At, B0); PG8_MMA(0, 1, At, B1); PG8_BAR; PG8_SCHED;
            PG8_LDA(At, 1, 1); PG8_STAGE(PG8_SB(1, 0), b3, voffB); PG8_STAGE(PG8_SB(1, 1), b3 + hstep, voffB); PG8_STAGE(PG8_SA(1, 0), a3, voffA);
            PG8_WAIT_V(8); PG8_WAIT_L(0); PG8_BAR; PG8_MMA(1, 0, At, B0); PG8_MMA(1, 1, At, B1); PG8_BAR; PG8_SCHED;
            } else {
            PG8_LDB(B0, 0, 0); PG8_SCHED; PG8_LDA(At, 0, 0); PG8_STAGE(PG8_SA(1, 1), a1 + hstep, voffA);
            PG8_WAIT_L(8); PG8_BAR; PG8_WAIT_L(0); PG8_MMA(0, 0, At, B0); PG8_BAR; PG8_SCHED;
            PG8_LDB(B1, 0, 1); PG8_STAGE(PG8_SB(0, 0), b2, voffB);
            PG8_BAR; PG8_WAIT_L(0); PG8_MMA(0, 1, At, B1); PG8_BAR;
            PG8_LDA(At, 0, 1); PG8_STAGE(PG8_SA(0, 0), a2, voffA);
            PG8_BAR; PG8_WAIT_L(0); PG8_MMA(1, 0, At, B0); PG8_BAR; PG8_SCHED;
            PG8_STAGE(PG8_SB(0, 1), b2 + hstep, voffB);
            PG8_WAIT_V(6); PG8_BAR; PG8_MMA(1, 1, At, B1); PG8_BAR;
            PG8_LDB(B0, 1, 0); PG8_SCHED; PG8_LDA(At, 1, 0); PG8_STAGE(PG8_SA(0, 1), a2 + hstep, voffA);
            PG8_WAIT_L(8); PG8_BAR; PG8_WAIT_L(0); PG8_MMA(0, 0, At, B0); PG8_BAR; PG8_SCHED;
            PG8_LDB(B1, 1, 1); PG8_STAGE(PG8_SB(1, 0), b3, voffB);
            PG8_BAR; PG8_WAIT_L(0); PG8_MMA(0, 1, At, B1); PG8_BAR;
            PG8_LDA(At, 1, 1); PG8_STAGE(PG8_SA(1, 0), a3, voffA);
            PG8_BAR; PG8_WAIT_L(0); PG8_MMA(1, 0, At, B0); PG8_BAR; PG8_SCHED;
            PG8_STAGE(PG8_SB(1, 1), b3 + hstep, voffB);
            PG8_WAIT_V(6); PG8_BAR; PG8_MMA(1, 1, At, B1); PG8_BAR;
            }
        }
        if constexpr (MODE == 1) asm volatile("s_nop 15\n\ts_nop 15" ::: "memory");
        if constexpr (ALIGN_EPI) { if (wr == 0) PG8_BAR; }
        if constexpr (!Epi::AFTER_DRAIN) { E(acc, cur, wr, wc, fr, fq); S.done(cur); }
        if (!has_next) break;
#pragma unroll
        for (int a = 0; a < 2; ++a)
#pragma unroll
            for (int b = 0; b < 2; ++b)
#pragma unroll
                for (int m = 0; m < 4; ++m)
#pragma unroll
                    for (int n = 0; n < 2; ++n) acc[a][b][m][n] = (f32x4){0.f, 0.f, 0.f, 0.f};
        cur = nxt; cA = nA; cB = nB; ++ui;
        if constexpr (ALIGN_EPI) { if (wr == 1) PG8_BAR; }
    }
    PG8_WAIT_V(0);
    if constexpr (!ALIGN_EPI) { if (wr == 0) PG8_BAR; }
    PG8_BAR;
    if constexpr (Epi::AFTER_DRAIN) { E.fused(acc, cur, wr, wc, fr, fq, lds, wid, lane); S.done(cur); }
#undef PG8_SA
#undef PG8_SB
#undef PG8_STAGE
#undef PG8_LDA
#undef PG8_LDB
#undef PG8_MMA
#undef PG8_WAIT_V
#undef PG8_WAIT_L
#undef PG8_BAR
#undef PG8_SCHED
}
}
constexpr int T_P = 8192, T_S = 4096, T = T_P + T_S;
constexpr int DM = 4096, DA = 2048, DFF = 11008, NIN = 17152  , KVROWS = 14336;
constexpr int QL = 1024, KVL = 512, NMOD = 6 * DM;
constexpr float NORM_EPS = 1e-6f;

namespace pg8 {
typedef _Float16 f16_t;
typedef _Float16 f16x2 __attribute__((ext_vector_type(2)));
typedef unsigned u32x2 __attribute__((ext_vector_type(2)));
__device__ __forceinline__ float ubf(unsigned u) { return __builtin_bit_cast(float, u); }
__device__ __forceinline__ float sigm(float x) { return __builtin_amdgcn_rcpf(1.0f + __builtin_amdgcn_exp2f(-1.4426950408889634f * x)); }
__device__ __forceinline__ f32x4 sigm4(f32x4 v) { return (f32x4){sigm(v[0]), sigm(v[1]), sigm(v[2]), sigm(v[3])}; }
__device__ __forceinline__ unsigned pk_f16(float lo, float hi) { f16x2 h = {(f16_t)lo, (f16_t)hi}; return __builtin_bit_cast(unsigned, h); }
__device__ __forceinline__ u32x4 pack_bf16x8(f32x4 a, f32x4 b) { u32x4 w; w.x = cvt_pk_bf16(a[0], a[1]); w.y = cvt_pk_bf16(a[2], a[3]); w.z = cvt_pk_bf16(b[0], b[1]); w.w = cvt_pk_bf16(b[2], b[3]); return w; }
__device__ __forceinline__ u32x4 pack_f16x8(f32x4 a, f32x4 b) { u32x4 w; w.x = pk_f16(a[0], a[1]); w.y = pk_f16(a[2], a[3]); w.z = pk_f16(b[0], b[1]); w.w = pk_f16(b[2], b[3]); return w; }
__device__ __forceinline__ unsigned pack_u8x4(f32x4 v, float sc) {
    const unsigned q0 = __builtin_bit_cast(unsigned, __builtin_fmaf(v[0], sc, 12582912.0f)), q1 = __builtin_bit_cast(unsigned, __builtin_fmaf(v[1], sc, 12582912.0f));
    const unsigned q2 = __builtin_bit_cast(unsigned, __builtin_fmaf(v[2], sc, 12582912.0f)), q3 = __builtin_bit_cast(unsigned, __builtin_fmaf(v[3], sc, 12582912.0f));
    return __builtin_amdgcn_perm(q1, q0, 0x0c0c0400u) | __builtin_amdgcn_perm(q3, q2, 0x04000c0cu); }
__device__ __forceinline__ f32x4 unpack_u8x4(unsigned w) { return (f32x4){(float)(w & 0xffu), (float)((w >> 8) & 0xffu), (float)((w >> 16) & 0xffu), (float)(w >> 24)}; }
__device__ __forceinline__ float bflo(unsigned w) { return __builtin_bit_cast(float, w << 16); }
__device__ __forceinline__ float bfhi(unsigned w) { return __builtin_bit_cast(float, w & 0xffff0000u); }
__device__ __forceinline__ void unpack_bf16x8(u32x4 w, f32x4& a, f32x4& b) { a = (f32x4){bflo(w.x), bfhi(w.x), bflo(w.y), bfhi(w.y)}; b = (f32x4){bflo(w.z), bfhi(w.z), bflo(w.w), bfhi(w.w)}; }

struct BatchedOrder {
    int nM, nN, nb, G, c;
    __device__ void init(int nM_, int nN_, int nb_, int G_, int c_) { nM = nM_; nN = nN_; nb = nb_; G = G_; c = c_; }
    __device__ bool next(int i, Unit& u) const {
        const int L = i * G + c; const int per = nM * nN; if (L >= per * nb) return false;
        const int b = L / per, l = L - b * per;
        u.pm = b * nM + (l % nM); u.pn = b * nN + (l / nM); return true;
    }
    __device__ __forceinline__ void a_ready(const Unit&) const {}
    __device__ __forceinline__ void done(const Unit&) const {}
};

#define EPI_LANE() int tid_ = (int)threadIdx.x; asm volatile("" : "+v"(tid_)); const int fr_ = tid_ & 15, fq_ = (tid_ >> 4) & 3
#define EPI_LOOP(...) \
    _Pragma("unroll") for (int ai = 0; ai < 2; ++ai) _Pragma("unroll") for (int m = 0; m < 4; ++m) { const int row = row0 + ai * HALF + m * 16; \
    _Pragma("unroll") for (int bj = 0; bj < 2; ++bj) { const f32x4 v0 = acc[ai][bj][m][0], v1 = acc[ai][bj][m][1]; const int colt = bj * HALF + cl; __VA_ARGS__ } }

struct EpiIn {
    static constexpr bool PERM = true, AFTER_DRAIN = false;
    f16_t* RKV; bf16_t* LWA; bf16_t* LG; float* QLAT; float* KVLAT; float* KPE; bf16_t* GA; bf16_t* GB;
    __device__ __forceinline__ void operator()(const f32x4 (&acc)[2][2][4][2], const Unit& u, int wr, int wc, int fr, int fq) const {
        EPI_LANE(); const int pn = u.pn < 16 ? 8 + u.pn : (u.pn < 18 ? 8 + u.pn : 14 + u.pn);
        const int row0 = u.pm * BM + wr * 64 + fr_, cl = wc * 32 + 8 * fq_;
        if (pn < 24) {
            EPI_LOOP( *(u32x4*)(RKV + (size_t)row * 6144 + pn * 256 + colt) = pack_f16x8(v0, v1); )
        } else if (pn == 24) {
            EPI_LOOP( f32x4 a = sigm4(v0 * 2.0f) * 2.0f - 1.0f, b = sigm4(v1 * 2.0f) * 2.0f - 1.0f; *(u32x4*)(LWA + ((size_t)bj * T + row) * 256 + cl) = pack_bf16x8(a, b); )
        } else if (pn == 25) {
            EPI_LOOP( *(u32x4*)(LWA + ((size_t)bj * T + row) * 256 + 128 + cl) = pack_bf16x8(v0, v1); )
        } else if (pn < 28) {
            EPI_LOOP( *(u32x4*)(LG + (size_t)row * 512 + (pn - 26) * 256 + colt) = pack_bf16x8(sigm4(v0), sigm4(v1)); )
        } else if (pn < 32) {
            EPI_LOOP( float* p = QLAT + (size_t)row * QL + (pn - 28) * 256 + colt; *(f32x4*)p = v0; *(f32x4*)(p + 4) = v1; )
        } else if (pn < 34) {
            EPI_LOOP( float* p = KVLAT + (size_t)row * KVL + (pn - 32) * 256 + colt; *(f32x4*)p = v0; *(f32x4*)(p + 4) = v1; )
        } else if (pn == 34) {
            EPI_LOOP( if (colt < 64) { float* p = KPE + (size_t)row * 64 + colt; *(f32x4*)p = v0; *(f32x4*)(p + 4) = v1; } )
        } else if (pn < 51) {
            EPI_LOOP( *(u32x4*)(GA + (size_t)row * DM + (pn - 35) * 256 + colt) = pack_bf16x8(sigm4(v0), sigm4(v1)); )
        } else {
            EPI_LOOP( *(u32x4*)(GB + (size_t)row * DM + (pn - 51) * 256 + colt) = pack_bf16x8(sigm4(v0), sigm4(v1)); )
        }
    }
};

struct EpiLora {
    static constexpr bool PERM = true, AFTER_DRAIN = false;
    unsigned char* EWAA; const float* lbias;
    __device__ __forceinline__ void operator()(const f32x4 (&acc)[2][2][4][2], const Unit& u, int wr, int wc, int fr, int fq) const {
        EPI_LANE(); const int dir = u.pn >> 4, jn = u.pn & 15, row0 = (u.pm - dir * (T / BM)) * BM + wr * 64 + fr_, cl = wc * 32 + 8 * fq_;
        const int isa = jn >> 3;
        const float* bias = lbias + isa * (2 * DA) + dir * DA + (jn & 7) * 256; unsigned char* O = EWAA + (size_t)(isa * 2 + dir) * T * DA + (jn & 7) * 256;
        f32x4 bv[2][2];
#pragma unroll
        for (int bj = 0; bj < 2; ++bj) { bv[bj][0] = *(const f32x4*)(bias + bj * HALF + cl); bv[bj][1] = *(const f32x4*)(bias + bj * HALF + cl + 4); }
        EPI_LOOP( u32x2 w; w.x = pack_u8x4(sigm4(v0 + bv[bj][0]), 255.0f); w.y = pack_u8x4(sigm4(v1 + bv[bj][1]), 255.0f); *(u32x2*)(O + (size_t)row * DA + colt) = w; )
    }
};

struct EpiPlain {
    static constexpr bool PERM = true, AFTER_DRAIN = false;
    bf16_t* O; int ldc;
    __device__ __forceinline__ void operator()(const f32x4 (&acc)[2][2][4][2], const Unit& u, int wr, int wc, int fr, int fq) const {
        EPI_LANE(); const int row0 = u.pm * BM + wr * 64 + fr_, cl = wc * 32 + 8 * fq_;
        EPI_LOOP( *(u32x4*)(O + (size_t)row * ldc + u.pn * 256 + colt) = pack_bf16x8(v0, v1); )
    }
};

struct EpiPlainI8 {
    static constexpr bool PERM = true, AFTER_DRAIN = false;
    bf16_t* O; int ldc; const float* rows; const unsigned* cmax;
    __device__ __forceinline__ void operator()(const f32x4 (&acc)[2][2][4][2], const Unit& u, int wr, int wc, int fr, int fq) const {
        typedef int v4i_t __attribute__((ext_vector_type(4)));
        EPI_LANE(); const int row0 = u.pm * BM + wr * 64 + fr_, cl = wc * 32 + 8 * fq_;
        f32x4 cs[2][2];
#pragma unroll
        for (int bj = 0; bj < 2; ++bj)
#pragma unroll
            for (int n = 0; n < 2; ++n) { const u32x4 m4 = *(const u32x4*)(cmax + u.pn * 256 + bj * HALF + cl + 4 * n);
                cs[bj][n] = (f32x4){ubf(m4.x), ubf(m4.y), ubf(m4.z), ubf(m4.w)} * (1.0f / 127.0f); }
        float rs8[2][4];
#pragma unroll
        for (int ai = 0; ai < 2; ++ai)
#pragma unroll
            for (int m = 0; m < 4; ++m) rs8[ai][m] = rows[row0 + ai * HALF + m * 16];
#pragma unroll
        for (int ai = 0; ai < 2; ++ai)
#pragma unroll
            for (int m = 0; m < 4; ++m) { const int row = row0 + ai * HALF + m * 16; const float rs = rs8[ai][m];
#pragma unroll
                for (int bj = 0; bj < 2; ++bj) { const v4i_t c0 = __builtin_bit_cast(v4i_t, acc[ai][bj][m][0]), c1 = __builtin_bit_cast(v4i_t, acc[ai][bj][m][1]);
                    const f32x4 v0 = (f32x4){(float)c0[0], (float)c0[1], (float)c0[2], (float)c0[3]} * cs[bj][0] * rs, v1 = (f32x4){(float)c1[0], (float)c1[1], (float)c1[2], (float)c1[3]} * cs[bj][1] * rs;
                    *(u32x4*)(O + (size_t)row * ldc + u.pn * 256 + bj * HALF + cl) = pack_bf16x8(v0, v1); } }
    }
};
struct EpiMix1 {
    static constexpr bool PERM = true, AFTER_DRAIN = false;
    const bf16_t* GA; float* TMP;
    __device__ __forceinline__ void operator()(const f32x4 (&acc)[2][2][4][2], const Unit& u, int wr, int wc, int fr, int fq) const {
        EPI_LANE(); const int row0 = u.pm * BM + wr * 64 + fr_, cl = wc * 32 + 8 * fq_;
        EPI_LOOP( const size_t o = (size_t)row * DM + u.pn * 256 + colt; f32x4 g0, g1; unpack_bf16x8(*(const u32x4*)(GA + o), g0, g1); *(f32x4*)(TMP + o) = g0 * v0; *(f32x4*)(TMP + o + 4) = g1 * v1; )
    }
};
struct EpiMix2 {
    static constexpr bool PERM = true, AFTER_DRAIN = false;
    const bf16_t* GB; const float* TMP; bf16_t* MIXED; unsigned* rmax;
    __device__ __forceinline__ void operator()(const f32x4 (&acc)[2][2][4][2], const Unit& u, int wr, int wc, int fr, int fq) const {
        EPI_LANE(); const int row0 = u.pm * BM + wr * 64 + fr_, cl = wc * 32 + 8 * fq_;
#pragma unroll
        for (int ai = 0; ai < 2; ++ai)
#pragma unroll
            for (int m = 0; m < 4; ++m) { const int row = row0 + ai * HALF + m * 16; float mx = 0.f;
#pragma unroll
                for (int bj = 0; bj < 2; ++bj) { const f32x4 v0 = acc[ai][bj][m][0], v1 = acc[ai][bj][m][1]; const size_t o = (size_t)row * DM + u.pn * 256 + bj * HALF + cl;
                    f32x4 g0, g1; unpack_bf16x8(*(const u32x4*)(GB + o), g0, g1); const f32x4 t0 = *(const f32x4*)(TMP + o) + g0 * v0, t1 = *(const f32x4*)(TMP + o + 4) + g1 * v1;
                    *(u32x4*)(MIXED + o) = pack_bf16x8(t0, t1);
                    const f32x4 a0 = __builtin_elementwise_abs(t0), a1 = __builtin_elementwise_abs(t1); mx = fmaxf(mx, fmaxf(fmaxf(fmaxf(a0[0], a0[1]), fmaxf(a0[2], a0[3])), fmaxf(fmaxf(a1[0], a1[1]), fmaxf(a1[2], a1[3])))); }
                mx = fmaxf(mx, __shfl_xor(mx, 16)); mx = fmaxf(mx, __shfl_xor(mx, 32));
                if (fq_ == 0) atomicMax(rmax + row, __builtin_bit_cast(unsigned, mx)); }
    }
};
struct EpiRes {
    static constexpr bool PERM = true, AFTER_DRAIN = false;
    const bf16_t* x1; float* out; const float* gate; float accs;
    __device__ __forceinline__ void operator()(const f32x4 (&acc)[2][2][4][2], const Unit& u, int wr, int wc, int fr, int fq) const {
        EPI_LANE(); const int row0 = u.pm * BM + wr * 64 + fr_, cl = wc * 32 + 8 * fq_;
        const int rbase = u.pm * BM, mi = rbase < T_P ? 0 : 1 + ((rbase - T_P) >> 10);
        const float* gp = gate + (size_t)mi * NMOD + u.pn * 256;
        f32x4 gv[2][2];
#pragma unroll
        for (int bj = 0; bj < 2; ++bj) { gv[bj][0] = *(const f32x4*)(gp + bj * HALF + cl) * accs; gv[bj][1] = *(const f32x4*)(gp + bj * HALF + cl + 4) * accs; }
        EPI_LOOP( const size_t o = (size_t)row * DM + u.pn * 256 + colt; f32x4 b0, b1; unpack_bf16x8(*(const u32x4*)(x1 + o), b0, b1);
                  __builtin_nontemporal_store(b0 + gv[bj][0] * v0, (f32x4*)(out + o)); __builtin_nontemporal_store(b1 + gv[bj][1] * v1, (f32x4*)(out + o + 4)); )
    }
};
struct EpiSwiglu {
    static constexpr bool PERM = true, AFTER_DRAIN = false;
    unsigned char* ACT;
    __device__ __forceinline__ void operator()(const f32x4 (&acc)[2][2][4][2], const Unit& u, int wr, int wc, int fr, int fq) const {
        EPI_LANE(); const int row0 = u.pm * BM + wr * 64 + fr_, cl = wc * 32 + 8 * fq_;
#pragma unroll
        for (int ai = 0; ai < 2; ++ai)
#pragma unroll
            for (int m = 0; m < 4; ++m) { const int row = row0 + ai * HALF + m * 16;
                const f32x4 g0 = acc[ai][0][m][0], g1 = acc[ai][0][m][1], u0 = acc[ai][1][m][0], u1 = acc[ai][1][m][1];
                const f32x4 a0 = g0 * sigm4(g0) * u0, a1 = g1 * sigm4(g1) * u1;
                unsigned w0 = 0u, w1 = 0u;
                w0 = __builtin_amdgcn_cvt_pk_fp8_f32(a0[0], a0[1], w0, false); w0 = __builtin_amdgcn_cvt_pk_fp8_f32(a0[2], a0[3], w0, true);
                w1 = __builtin_amdgcn_cvt_pk_fp8_f32(a1[0], a1[1], w1, false); w1 = __builtin_amdgcn_cvt_pk_fp8_f32(a1[2], a1[3], w1, true);
                u32x2 pk; pk.x = w0; pk.y = w1; *(u32x2*)(ACT + (size_t)row * DFF + u.pn * 128 + cl) = pk; }
    }
};
struct EpiSwigluI8 {
    static constexpr bool PERM = true, AFTER_DRAIN = false;
    unsigned char* ACT; const float* rows; const unsigned* cmax;
    __device__ __forceinline__ void operator()(const f32x4 (&acc)[2][2][4][2], const Unit& u, int wr, int wc, int fr, int fq) const {
        typedef int v4i_t __attribute__((ext_vector_type(4)));
        EPI_LANE(); const int row0 = u.pm * BM + wr * 64 + fr_, cl = wc * 32 + 8 * fq_;
        f32x4 cs[2][2];
#pragma unroll
        for (int bj = 0; bj < 2; ++bj)
#pragma unroll
            for (int n = 0; n < 2; ++n) { const u32x4 m4 = *(const u32x4*)(cmax + bj * DFF + u.pn * 128 + cl + 4 * n);
                cs[bj][n] = (f32x4){ubf(m4.x), ubf(m4.y), ubf(m4.z), ubf(m4.w)} * (1.0f / 127.0f); }
        float rs8[2][4];
#pragma unroll
        for (int ai = 0; ai < 2; ++ai)
#pragma unroll
            for (int m = 0; m < 4; ++m) rs8[ai][m] = rows[row0 + ai * HALF + m * 16];
#pragma unroll
        for (int ai = 0; ai < 2; ++ai)
#pragma unroll
            for (int m = 0; m < 4; ++m) { const int row = row0 + ai * HALF + m * 16; const float rs = rs8[ai][m];
                f32x4 v[2][2];
#pragma unroll
                for (int bj = 0; bj < 2; ++bj)
#pragma unroll
                    for (int n = 0; n < 2; ++n) { const v4i_t c = __builtin_bit_cast(v4i_t, acc[ai][bj][m][n]); v[bj][n] = (f32x4){(float)c[0], (float)c[1], (float)c[2], (float)c[3]} * cs[bj][n] * rs; }
                const f32x4 a0 = v[0][0] * sigm4(v[0][0]) * v[1][0], a1 = v[0][1] * sigm4(v[0][1]) * v[1][1];
                unsigned w0 = 0u, w1 = 0u;
                w0 = __builtin_amdgcn_cvt_pk_fp8_f32(a0[0], a0[1], w0, false); w0 = __builtin_amdgcn_cvt_pk_fp8_f32(a0[2], a0[3], w0, true);
                w1 = __builtin_amdgcn_cvt_pk_fp8_f32(a1[0], a1[1], w1, false); w1 = __builtin_amdgcn_cvt_pk_fp8_f32(a1[2], a1[3], w1, true);
                u32x2 pk; pk.x = w0; pk.y = w1; *(u32x2*)(ACT + (size_t)row * DFF + u.pn * 128 + cl) = pk; }
    }
};
struct EpiGate8 {
    static constexpr bool PERM = true, AFTER_DRAIN = false;
    unsigned char* GA; unsigned char* GB; const float* rows;     const unsigned* cmax; f16_t* RKV; bf16_t* LG; float* QLAT; int pn0;
    __device__ __forceinline__ void operator()(const f32x4 (&acc)[2][2][4][2], const Unit& u, int wr, int wc, int fr, int fq) const {
        typedef int v4i_t __attribute__((ext_vector_type(4)));
        EPI_LANE(); const int row0 = u.pm * BM + wr * 64 + fr_, cl = wc * 32 + 8 * fq_, pn = u.pn + pn0;
        f32x4 cs[2][2];
#pragma unroll
        for (int bj = 0; bj < 2; ++bj)
#pragma unroll
            for (int n = 0; n < 2; ++n) { const u32x4 m4 = *(const u32x4*)(cmax + pn * 256 + bj * HALF + cl + 4 * n);
                cs[bj][n] = (f32x4){ubf(m4.x), ubf(m4.y), ubf(m4.z), ubf(m4.w)} * (1.0f / 127.0f); }
        float rs8[2][4];
#pragma unroll
        for (int ai = 0; ai < 2; ++ai)
#pragma unroll
            for (int m = 0; m < 4; ++m) rs8[ai][m] = rows[row0 + ai * HALF + m * 16];
#pragma unroll
        for (int ai = 0; ai < 2; ++ai)
#pragma unroll
            for (int m = 0; m < 4; ++m) { const int row = row0 + ai * HALF + m * 16; const float rs = rs8[ai][m];
#pragma unroll
                for (int bj = 0; bj < 2; ++bj) { const v4i_t c0 = __builtin_bit_cast(v4i_t, acc[ai][bj][m][0]), c1 = __builtin_bit_cast(v4i_t, acc[ai][bj][m][1]);
                    const f32x4 v0 = (f32x4){(float)c0[0], (float)c0[1], (float)c0[2], (float)c0[3]} * cs[bj][0] * rs, v1 = (f32x4){(float)c1[0], (float)c1[1], (float)c1[2], (float)c1[3]} * cs[bj][1] * rs;
                    const int colt = bj * HALF + cl;
                    if (pn < 32) { unsigned char* O = (pn < 16 ? GA : GB - (size_t)16 * 256) + pn * 256; u32x2 w; w.x = pack_u8x4(sigm4(v0), 255.0f); w.y = pack_u8x4(sigm4(v1), 255.0f); *(u32x2*)(O + (size_t)row * DM + colt) = w; }
                    else if (pn < 40) { *(u32x4*)(RKV + (size_t)row * 6144 + (pn - 32) * 256 + colt) = pack_f16x8(v0, v1); }
                    else if (pn < 42) { *(u32x4*)(LG + (size_t)row * 512 + (pn - 40) * 256 + colt) = pack_bf16x8(sigm4(v0), sigm4(v1)); }
                    else { *(u32x4*)((f16_t*)QLAT + (size_t)row * QL + (pn - 42) * 256 + colt) = pack_f16x8(v0, v1); } } }
    }
};
struct EpiMix1I8 {
    static constexpr bool PERM = true, AFTER_DRAIN = false;
    const unsigned char* GA; bf16_t* TMP;     const float* rows; const unsigned* cmax;
    __device__ __forceinline__ void operator()(const f32x4 (&acc)[2][2][4][2], const Unit& u, int wr, int wc, int fr, int fq) const {
        typedef int v4i_t __attribute__((ext_vector_type(4)));
        EPI_LANE(); const int row0 = u.pm * BM + wr * 64 + fr_, cl = wc * 32 + 8 * fq_;
        f32x4 cs[2][2];
#pragma unroll
        for (int bj = 0; bj < 2; ++bj)
#pragma unroll
            for (int n = 0; n < 2; ++n) { const u32x4 m4 = *(const u32x4*)(cmax + u.pn * 256 + bj * HALF + cl + 4 * n);
                cs[bj][n] = (f32x4){ubf(m4.x), ubf(m4.y), ubf(m4.z), ubf(m4.w)} * (1.0f / 127.0f); }
        float rs8[2][4];
#pragma unroll
        for (int ai = 0; ai < 2; ++ai)
#pragma unroll
            for (int m = 0; m < 4; ++m) rs8[ai][m] = rows[row0 + ai * HALF + m * 16];
#pragma unroll
        for (int ai = 0; ai < 2; ++ai)
#pragma unroll
            for (int m = 0; m < 4; ++m) { const int row = row0 + ai * HALF + m * 16; const float rs = rs8[ai][m];
#pragma unroll
                for (int bj = 0; bj < 2; ++bj) { const v4i_t c0 = __builtin_bit_cast(v4i_t, acc[ai][bj][m][0]), c1 = __builtin_bit_cast(v4i_t, acc[ai][bj][m][1]);
                    const f32x4 v0 = (f32x4){(float)c0[0], (float)c0[1], (float)c0[2], (float)c0[3]} * cs[bj][0] * rs, v1 = (f32x4){(float)c1[0], (float)c1[1], (float)c1[2], (float)c1[3]} * cs[bj][1] * rs;
                    const size_t o = (size_t)row * DM + u.pn * 256 + bj * HALF + cl; const u32x2 gw = *(const u32x2*)(GA + o); const f32x4 g0 = unpack_u8x4(gw.x) * (1.0f / 255.0f), g1 = unpack_u8x4(gw.y) * (1.0f / 255.0f);
                    *(u32x4*)(TMP + o) = pack_bf16x8(g0 * v0, g1 * v1); } }
    }
};
struct EpiMix2I8 {
    static constexpr bool PERM = true, AFTER_DRAIN = false;
    const unsigned char* GB; const bf16_t* TMP; bf16_t* MIXED; unsigned* rmax; const float* rows; const unsigned* cmax;
    __device__ __forceinline__ void operator()(const f32x4 (&acc)[2][2][4][2], const Unit& u, int wr, int wc, int fr, int fq) const {
        typedef int v4i_t __attribute__((ext_vector_type(4)));
        EPI_LANE(); const int row0 = u.pm * BM + wr * 64 + fr_, cl = wc * 32 + 8 * fq_;
        f32x4 cs[2][2];
#pragma unroll
        for (int bj = 0; bj < 2; ++bj)
#pragma unroll
            for (int n = 0; n < 2; ++n) { const u32x4 m4 = *(const u32x4*)(cmax + u.pn * 256 + bj * HALF + cl + 4 * n);
                cs[bj][n] = (f32x4){ubf(m4.x), ubf(m4.y), ubf(m4.z), ubf(m4.w)} * (1.0f / 127.0f); }
        float rs8[2][4];
#pragma unroll
        for (int ai = 0; ai < 2; ++ai)
#pragma unroll
            for (int m = 0; m < 4; ++m) rs8[ai][m] = rows[row0 + ai * HALF + m * 16];
#pragma unroll
        for (int ai = 0; ai < 2; ++ai)
#pragma unroll
            for (int m = 0; m < 4; ++m) { const int row = row0 + ai * HALF + m * 16; const float rs = rs8[ai][m]; float mx = 0.f;
#pragma unroll
                for (int bj = 0; bj < 2; ++bj) { const v4i_t c0 = __builtin_bit_cast(v4i_t, acc[ai][bj][m][0]), c1 = __builtin_bit_cast(v4i_t, acc[ai][bj][m][1]);
                    const f32x4 v0 = (f32x4){(float)c0[0], (float)c0[1], (float)c0[2], (float)c0[3]} * cs[bj][0] * rs, v1 = (f32x4){(float)c1[0], (float)c1[1], (float)c1[2], (float)c1[3]} * cs[bj][1] * rs;
                    const size_t o = (size_t)row * DM + u.pn * 256 + bj * HALF + cl;
                    const u32x2 gw = *(const u32x2*)(GB + o); const f32x4 g0 = unpack_u8x4(gw.x) * (1.0f / 255.0f), g1 = unpack_u8x4(gw.y) * (1.0f / 255.0f); f32x4 p0, p1; unpack_bf16x8(*(const u32x4*)(TMP + o), p0, p1); const f32x4 t0 = p0 + g0 * v0, t1 = p1 + g1 * v1;
                    *(u32x4*)(MIXED + o) = pack_bf16x8(t0, t1);
                    const f32x4 a0 = __builtin_elementwise_abs(t0), a1 = __builtin_elementwise_abs(t1); mx = fmaxf(mx, fmaxf(fmaxf(fmaxf(a0[0], a0[1]), fmaxf(a0[2], a0[3])), fmaxf(fmaxf(a1[0], a1[1]), fmaxf(a1[2], a1[3])))); }
                mx = fmaxf(mx, __shfl_xor(mx, 16)); mx = fmaxf(mx, __shfl_xor(mx, 32));
                if (fq_ == 0) atomicMax(rmax + row, __builtin_bit_cast(unsigned, mx)); }
    }
};
struct EpiResI8 {
    static constexpr bool PERM = true, AFTER_DRAIN = false;
    const float* xp; const float* xs; bf16_t* x1; const float* gate; const float* rows; const unsigned* cmax;
    __device__ __forceinline__ void operator()(const f32x4 (&acc)[2][2][4][2], const Unit& u, int wr, int wc, int fr, int fq) const {
        typedef int v4i_t __attribute__((ext_vector_type(4)));
        EPI_LANE(); const int row0 = u.pm * BM + wr * 64 + fr_, cl = wc * 32 + 8 * fq_;
        const int rbase = u.pm * BM, mi = rbase < T_P ? 0 : 1 + ((rbase - T_P) >> 10);
        const float* gp = gate + (size_t)mi * NMOD + u.pn * 256;
        const float* base = rbase < T_P ? xp : xs - (size_t)T_P * DM;
        f32x4 gv[2][2];
#pragma unroll
        for (int bj = 0; bj < 2; ++bj)
#pragma unroll
            for (int n = 0; n < 2; ++n) { const u32x4 m4 = *(const u32x4*)(cmax + u.pn * 256 + bj * HALF + cl + 4 * n);
                gv[bj][n] = *(const f32x4*)(gp + bj * HALF + cl + 4 * n) * ((f32x4){ubf(m4.x), ubf(m4.y), ubf(m4.z), ubf(m4.w)} * (1.0f / 127.0f)); }
        float rs8[2][4];
#pragma unroll
        for (int ai = 0; ai < 2; ++ai)
#pragma unroll
            for (int m = 0; m < 4; ++m) rs8[ai][m] = rows[row0 + ai * HALF + m * 16];
#pragma unroll
        for (int ai = 0; ai < 2; ++ai)
#pragma unroll
            for (int m = 0; m < 4; ++m) { const int row = row0 + ai * HALF + m * 16; const float rs = rs8[ai][m];
#pragma unroll
                for (int bj = 0; bj < 2; ++bj) { const v4i_t c0 = __builtin_bit_cast(v4i_t, acc[ai][bj][m][0]), c1 = __builtin_bit_cast(v4i_t, acc[ai][bj][m][1]);
                    const f32x4 v0 = (f32x4){(float)c0[0], (float)c0[1], (float)c0[2], (float)c0[3]} * rs, v1 = (f32x4){(float)c1[0], (float)c1[1], (float)c1[2], (float)c1[3]} * rs;
                    const size_t o = (size_t)row * DM + u.pn * 256 + bj * HALF + cl; const f32x4 b0 = *(const f32x4*)(base + o), b1 = *(const f32x4*)(base + o + 4);
                    *(u32x4*)(x1 + o) = pack_bf16x8(b0 + gv[bj][0] * v0, b1 + gv[bj][1] * v1); } }
    }
};
#undef EPI_LOOP
}
#define GAS __attribute__((address_space(1)))
#define LAS __attribute__((address_space(3)))
typedef unsigned short bf16;
typedef unsigned v4u __attribute__((ext_vector_type(4)));
typedef float f32x4 __attribute__((ext_vector_type(4)));
typedef short bf16x8 __attribute__((ext_vector_type(8)));
typedef GAS unsigned gu32;
typedef GAS unsigned long long gu64;
#define RLX_AGENT __ATOMIC_RELAXED, __HIP_MEMORY_SCOPE_AGENT
#define LDS_WAIT() asm volatile("s_waitcnt lgkmcnt(0)" ::: "memory")
#define VM_WAIT() asm volatile("s_waitcnt vmcnt(0)" ::: "memory")
__device__ __forceinline__ unsigned long long rt() { return __builtin_amdgcn_s_memrealtime(); }
__device__ __forceinline__ unsigned f2bf(float f) { unsigned u = __builtin_bit_cast(unsigned, f); return (u + 0x7fffu + ((u >> 16) & 1u)) >> 16; }
__device__ __forceinline__ unsigned pk2(float lo, float hi) { return f2bf(lo) | (f2bf(hi) << 16); }
constexpr size_t MiB = 1u << 20;
constexpr size_t WS_CTL = 0, CTL_ZERO_BYTES = 1 * MiB;
constexpr size_t WS_MOD = 1 * MiB, WS_COS = 1 * MiB + 512 * 1024, WS_SIN = 1 * MiB + 640 * 1024, WS_LBIAS = 1 * MiB + 768 * 1024;
constexpr size_t WS_WFI = 2 * MiB, WS_WFO = 174 * MiB, WS_WOUT = 260 * MiB, WS_WOR = 292 * MiB, WS_WOM = 308 * MiB;
constexpr size_t WS_WIN = 324 * MiB, WS_WUQ = 458 * MiB, WS_WUKV = 464 * MiB, WS_WLORA = 468 * MiB, WS_WG = 472 * MiB;
constexpr size_t WS_YS = 324 * MiB, WS_BON = 420 * MiB, WS_YB = 423 * MiB;
constexpr size_t WS_HB = 474 * MiB;
constexpr size_t WS_RKV = 570 * MiB, WS_GA = 714 * MiB, WS_GB = 810 * MiB;
constexpr size_t WS_MIXED = 570 * MiB, WS_ACT = 570 * MiB;
constexpr size_t WS_LWA = 906 * MiB, WS_LG = 918 * MiB;
constexpr size_t WS_QLAT = 930 * MiB, WS_KVLAT = 978 * MiB, WS_Q = 930 * MiB;
constexpr size_t WS_KPE = 1002 * MiB;
constexpr size_t WS_QN = 1005 * MiB, WS_CKVA = 1029 * MiB;
constexpr size_t WS_EW = 1043 * MiB, WS_AA = 1139 * MiB, WS_TMP = 1043 * MiB;
constexpr size_t WS_G = 1235 * MiB;
constexpr size_t WS_KV = 1283 * MiB, WS_YA = 1479 * MiB;
constexpr size_t WS_KP = 1395 * MiB;
constexpr size_t WS_END = 1527 * MiB;
static_assert(WS_WIN + (size_t)NIN * DM * 2 <= WS_WUQ && WS_WFI + (size_t)2 * DFF * DM * 2 <= WS_WFO && WS_WFO + (size_t)DM * DFF * 2 <= WS_WOUT, "weights map");
static_assert(WS_YS + (size_t)2 * T * DA * 2 <= WS_BON && WS_BON + (size_t)2 * T * 32 * 4 <= WS_YB && WS_YB + (size_t)T * DA * 2 <= WS_HB, "overlay map");
static_assert(WS_RKV + (size_t)T * 6144 * 2 <= WS_GA && WS_ACT + (size_t)T * DFF * 2 <= WS_LWA && WS_Q + (size_t)T * 3072 * 2 <= WS_KPE && WS_KV + (size_t)KVROWS * 4096 * 2 <= WS_KP && WS_KP + (size_t)KVROWS * 3072 * 2 <= WS_YA && WS_YA + (size_t)T * DA * 2 <= WS_END, "act map");
static_assert(WS_AA == WS_EW + (size_t)2 * T * DA * 2, "AA follows EW");
constexpr int CW_BAR = 4096;
constexpr size_t WS_CMAX = 64 * 1024;
constexpr size_t WS_ROWS = 256 * 1024;
constexpr size_t WS_CMAXG = 320 * 1024;
constexpr size_t WS_ROWS1 = 384 * 1024;
static_assert(WS_ROWS + 12288 * 4 <= WS_CMAXG && WS_CMAXG + 11776 * 4 <= WS_ROWS1 && WS_ROWS1 + 12288 * 4 <= CTL_ZERO_BYTES, "scale tables 2");
constexpr size_t WS_CMAXO = 448 * 1024, WS_CMAXR = 464 * 1024, WS_RMAXM = 480 * 1024, WS_ROWSYA = 528 * 1024, WS_ROWSM = 576 * 1024;
static_assert(WS_ROWS1 + 12288 * 4 <= WS_CMAXO && WS_ROWSM + 12288 * 4 <= CTL_ZERO_BYTES, "scale tables 3");
constexpr size_t WS_YB8 = 1395 * MiB;
constexpr size_t WS_ROWSYB = 640 * 1024, WS_CMAXM = 704 * 1024;
static_assert(WS_ROWSM + 12288 * 4 <= WS_ROWSYB && WS_ROWSYB + 12288 * 4 <= WS_CMAXM && WS_CMAXM + 4096 * 4 <= CTL_ZERO_BYTES, "scale tables 4");
constexpr size_t WS_ROWSQ = 720 * 1024, WS_ROWSKV = 768 * 1024, WS_CMAXUQ = 824 * 1024, WS_CMAXUKV = 836 * 1024;
static_assert(WS_CMAXM + 4096 * 4 <= WS_ROWSQ && WS_ROWSQ + 12288 * 4 <= WS_ROWSKV && WS_ROWSKV + 14336 * 4 <= WS_CMAXUQ && WS_CMAXUQ + 3072 * 4 <= WS_CMAXUKV && WS_CMAXUKV + 4096 * 4 <= CTL_ZERO_BYTES, "scale tables 5");
constexpr size_t WS_X1 = 324 * MiB;
constexpr size_t WS_MIX8 = 666 * MiB;
constexpr size_t WS_H1Q = 88 * MiB, WS_WGATE8 = 136 * MiB, WS_WING8 = 1139 * MiB;
static_assert(WS_WFI + (size_t)2 * DFF * DM <= WS_H1Q && WS_H1Q + (size_t)T * DM <= WS_WGATE8 && WS_WGATE8 + (size_t)8192 * DM <= WS_WFO, "int8 tail of the WFI region");
static_assert(WS_CMAX + 22016 * 4 <= WS_ROWS && WS_ROWS + 12288 * 4 <= CTL_ZERO_BYTES, "scale tables inside the control region");

constexpr int RING_OFF = 0, RING_BYTES = 131072;
constexpr int LDSCTL_OFF = RING_BYTES, MISC_OFF = LDSCTL_OFF + 320;
constexpr int LDS_BYTES = 147456;
constexpr int NWAVES = 8;

constexpr size_t OUT_YP = 0, OUT_YS = (size_t)T_P * DM, OUT_STATE = (size_t)T * DM, OUT_CKV = OUT_STATE + (size_t)32 * 2 * 32 * 64 * 64, OUT_KPE = OUT_CKV + (size_t)T_P * KVL;

typedef _Float16 f16;
typedef unsigned v2u __attribute__((ext_vector_type(2)));
typedef float f32x2 __attribute__((ext_vector_type(2)));
#define XB_TMO      128
#define XB_XCNT(j)  (256  + 64 * (j))
#define XB_XSUB(j)  (1280 + 64 * (j))
#define XB_XGEN(j)  (2304 + 64 * (j))
#define XB_TOP      3328
#define XB_TOPGEN   3392
#define XCD_BAR_WORDS 3456
#define XB_SPIN_CAP (1u << 18)

__device__ __forceinline__ unsigned xb_ld(unsigned* p)              { return __hip_atomic_load(p, __ATOMIC_RELAXED, __HIP_MEMORY_SCOPE_AGENT); }
__device__ __forceinline__ unsigned xb_add(unsigned* p, unsigned v) { return __hip_atomic_fetch_add(p, v, __ATOMIC_RELAXED, __HIP_MEMORY_SCOPE_AGENT); }
__device__ __forceinline__ unsigned xb_xcc_id() { return (unsigned)__builtin_amdgcn_s_getreg((3 << 11) | 20) & 0xFu; }
#define XB_SPIN(cond, bar) do { unsigned _sp = 0; while (cond) { __builtin_amdgcn_s_sleep(1); \
    if ((++_sp & 255u) == 0u) { if (xb_ld(&(bar)[XB_TMO])) break; if (_sp > XB_SPIN_CAP) { atomicAdd(&(bar)[XB_TMO], 1u); break; } } } } while (0)

struct XcdBarrier {
    unsigned* bar; unsigned x;
    volatile LAS unsigned* st;
};

__device__ __forceinline__ XcdBarrier xcd_barrier_post(unsigned* bar, volatile LAS unsigned* st) {
    XcdBarrier b; b.bar = bar; b.x = xb_xcc_id(); b.st = st;
    if (threadIdx.x == 0) (void)xb_add(&bar[XB_XCNT(b.x)], 1u);
    return b;
}
__device__ __forceinline__ void xcd_barrier_complete(unsigned* bar, unsigned x, unsigned& nloc, unsigned& nx) {
    const unsigned G = gridDim.x * gridDim.y * gridDim.z;
    unsigned sum, cnt, mine, sp = 0u;
    for (;;) {
        sum = 0u; cnt = 0u; mine = 0u;
#pragma unroll
        for (unsigned j = 0; j < 16; ++j) { const unsigned c = xb_ld(&bar[XB_XCNT(j)]); sum += c; cnt += (c > 0u) ? 1u : 0u; mine = (j == x) ? c : mine; }
        if (sum == G) break;
        __builtin_amdgcn_s_sleep(1);
        if ((++sp & 255u) == 0u) { if (xb_ld(&bar[XB_TMO])) break; if (sp > XB_SPIN_CAP) { atomicAdd(&bar[XB_TMO], 1u); break; } }
    }
    nloc = mine > 0u ? mine : 1u; nx = cnt > 0u ? cnt : 1u;
}

__device__ __forceinline__ void xcd_barrier(const XcdBarrier& b) {
    asm volatile("s_waitcnt vmcnt(0)" ::: "memory");
    __syncthreads();
    if (threadIdx.x == 0) {
        unsigned* bar = b.bar;
        __builtin_amdgcn_s_waitcnt(0);
        unsigned nloc = b.st[0], nx = b.st[1];
        if (nloc == 0u) { xcd_barrier_complete(bar, b.x, nloc, nx); b.st[0] = nloc; b.st[1] = nx; }
        const unsigned old = xb_add(&bar[XB_XSUB(b.x)], 1u);
        const unsigned gen = old / nloc;
        if (old + 1u == (gen + 1u) * nloc) {
            __builtin_amdgcn_fence(__ATOMIC_RELEASE, "agent");
            asm volatile("s_waitcnt vmcnt(0)" ::: "memory");
            const unsigned og = xb_add(&bar[XB_TOP], 1u);
            const unsigned tg = og / nx;
            if (og + 1u == (tg + 1u) * nx) xb_add(&bar[XB_TOPGEN], 1u);
            else XB_SPIN(xb_ld(&bar[XB_TOPGEN]) == tg, bar);
            __builtin_amdgcn_fence(__ATOMIC_ACQUIRE, "agent");
            xb_add(&bar[XB_XGEN(b.x)], 1u);
            asm volatile("s_waitcnt vmcnt(0)" ::: "memory");
        } else {
            XB_SPIN(xb_ld(&bar[XB_XGEN(b.x)]) == gen, bar);
            __builtin_amdgcn_fence(__ATOMIC_ACQUIRE, "agent");
            asm volatile("s_waitcnt vmcnt(0)" ::: "memory");
        }
    }
    __syncthreads();
}
struct Args { const float* in[33]; float* out; unsigned char* ws; int ph_lo, ph_hi; };
enum { I_XP = 0, I_XS, I_C, I_STATE, I_CCKV, I_CKPE, I_CCTX, I_WMOD, I_BMOD, I_NMIX, I_WIN, I_W0, I_WLB, I_A0, I_ALB, I_GLB, I_KK, I_KA, I_RK, I_LNW, I_LNB,
       I_QNW, I_WUQ, I_KVNW, I_WUKV, I_QHN, I_KHN, I_WOR, I_WOM, I_WOUT, I_NFFN, I_WFI, I_WFO };
struct Frame { LAS unsigned char* lds; volatile LAS unsigned* MISC; gu32* ctl; int tid, lane, wave, G, gw, ngw; };

__device__ __forceinline__ float wave_sum(float v) {
#pragma unroll
    for (int o = 1; o < 64; o <<= 1) v += __shfl_xor(v, o);
    return v;
}
__device__ __forceinline__ float dpp_f(float x, const int ctrl_sel) {
    const int xi = __builtin_bit_cast(int, x); int r;
    if (ctrl_sel == 0) r = __builtin_amdgcn_update_dpp(0, xi, 0xB1, 0xF, 0xF, true);
    else if (ctrl_sel == 1) r = __builtin_amdgcn_update_dpp(0, xi, 0x4E, 0xF, 0xF, true);
    else if (ctrl_sel == 2) r = __builtin_amdgcn_update_dpp(0, xi, 0x141, 0xF, 0xF, true);
    else r = __builtin_amdgcn_update_dpp(0, xi, 0x140, 0xF, 0xF, true);
    return __builtin_bit_cast(float, r);
}
__device__ __forceinline__ float row16_sum(float x) { x += dpp_f(x, 0); x += dpp_f(x, 1); x += dpp_f(x, 2); x += dpp_f(x, 3); return x; }
__device__ __forceinline__ float sigm(float x) { return pg8::sigm(x); }
__device__ __forceinline__ int mod_index(int row) { return row < T_P ? 0 : 1 + ((row - T_P) >> 10); }

__device__ __forceinline__ void p0_adaln(const Args& a, Frame& F) {
    LAS float* SC = (LAS float*)(F.lds);
    LAS float* RED = (LAS float*)(F.lds + 81920);
    const float* c = a.in[I_C]; const float* cctx = a.in[I_CCTX]; const float* wmod = a.in[I_WMOD]; const float* bmod = a.in[I_BMOD];
    float* MOD = (float*)(a.ws + WS_MOD);
    for (int i = F.tid; i < 5 * 4096; i += 512) { const int r = i >> 12, k = i & 4095; const float v = (r == 0) ? cctx[k] : c[(r - 1) * 4096 + k]; SC[i] = v * sigm(v); }
    __syncthreads();
    const int kk = F.lane / 24, cg = F.lane % 24;
    for (int cb = blockIdx.x; cb < 256; cb += F.G) {
        f32x4 acc[5];
#pragma unroll
        for (int r = 0; r < 5; ++r) acc[r] = (f32x4){0.f, 0.f, 0.f, 0.f};
        if (F.lane < 48) {
            const float* wp = wmod + (size_t)(512 * F.wave + kk) * NMOD + 96 * cb + 4 * cg;
            const LAS float* sp = SC + 512 * F.wave + kk;
#pragma unroll 16
            for (int k2 = 0; k2 < 512; k2 += 2) {
                const f32x4 w = *(const f32x4*)(wp + (size_t)k2 * NMOD);
#pragma unroll
                for (int r = 0; r < 5; ++r) acc[r] += w * sp[r * 4096 + k2];
            }
#pragma unroll
            for (int r = 0; r < 5; ++r) *(LAS f32x4*)(RED + ((F.wave * 2 + kk) * 5 + r) * 96 + 4 * cg) = acc[r];
        }
        __syncthreads();
        if (F.tid < 480) { const int r = F.tid / 96, col = F.tid % 96; float s = bmod[96 * cb + col];
#pragma unroll
            for (int p = 0; p < 16; ++p) s += RED[(p * 5 + r) * 96 + col];
            MOD[(size_t)r * NMOD + 96 * cb + col] = s; }
        __syncthreads();
    }
}

__device__ __forceinline__ void tr_item(const float* W, int ldw, int k0, int kvalid, int srcn0, bf16* WT, int ldt, int drow0, int dk0, LAS float* scr, int lane) {
    const int c = lane & 7;
    if (srcn0 < 0) {
#pragma unroll
        for (int j = 0; j < 4; ++j) { const int n = (lane >> 3) + 8 * j; *(GAS v4u*)(WT + (size_t)(drow0 + n) * ldt + dk0 + 8 * c) = (v4u){0u, 0u, 0u, 0u}; }
        return;
    }
#pragma unroll 32
    for (int i = 0; i < 32; ++i) { const int kk = 2 * i + (lane >> 5); scr[kk * 33 + (lane & 31)] = (kk < kvalid) ? W[(size_t)(k0 + kk) * ldw + srcn0 + (lane & 31)] : 0.f; }
    LDS_WAIT(); asm volatile("" ::: "memory");
#pragma unroll
    for (int j = 0; j < 4; ++j) { const int n = (lane >> 3) + 8 * j; const LAS float* s = scr + (8 * c) * 33 + n;
        v4u o; o.x = pg8::cvt_pk_bf16(s[0 * 33], s[1 * 33]); o.y = pg8::cvt_pk_bf16(s[2 * 33], s[3 * 33]); o.z = pg8::cvt_pk_bf16(s[4 * 33], s[5 * 33]); o.w = pg8::cvt_pk_bf16(s[6 * 33], s[7 * 33]);
        *(GAS v4u*)(WT + (size_t)(drow0 + n) * ldt + dk0 + 8 * c) = o; }
    LDS_WAIT(); asm volatile("" ::: "memory");
}
__device__ __forceinline__ void tr_item_f8(const float* W, int ldw, int k0, int srcn0, unsigned char* WT, int ldt, int drow0, int dk0, float scale, LAS float* scr, int lane) {
    const int c = lane & 7;
#pragma unroll 32
    for (int i = 0; i < 32; ++i) { const int kk = 2 * i + (lane >> 5); scr[kk * 33 + (lane & 31)] = W[(size_t)(k0 + kk) * ldw + srcn0 + (lane & 31)]; }
    LDS_WAIT(); asm volatile("" ::: "memory");
#pragma unroll
    for (int j = 0; j < 4; ++j) { const int n = (lane >> 3) + 8 * j; const LAS float* s = scr + (8 * c) * 33 + n;
        unsigned w0 = 0u, w1 = 0u;
        w0 = __builtin_amdgcn_cvt_pk_fp8_f32(s[0 * 33] * scale, s[1 * 33] * scale, w0, false); w0 = __builtin_amdgcn_cvt_pk_fp8_f32(s[2 * 33] * scale, s[3 * 33] * scale, w0, true);
        w1 = __builtin_amdgcn_cvt_pk_fp8_f32(s[4 * 33] * scale, s[5 * 33] * scale, w1, false); w1 = __builtin_amdgcn_cvt_pk_fp8_f32(s[6 * 33] * scale, s[7 * 33] * scale, w1, true);
        v2u o; o.x = w0; o.y = w1; *(GAS v2u*)(WT + (size_t)(drow0 + n) * ldt + dk0 + 8 * c) = o; }
    LDS_WAIT(); asm volatile("" ::: "memory");
}
__device__ __forceinline__ int q8(float x) { const int q = (int)__builtin_rintf(x); return (q < -127 ? -127 : (q > 127 ? 127 : q)) & 0xff; }
__device__ __forceinline__ void tr_item_i8(const float* W, int ldw, int k0, int srcn0, unsigned char* WT, int ldt, int drow0, int dk0, const unsigned* cmax  , LAS float* scr, int lane) {
    const int c = lane & 7;
    if (srcn0 < 0) {
#pragma unroll
        for (int j = 0; j < 4; ++j) { const int n = (lane >> 3) + 8 * j; v2u o; o.x = 0u; o.y = 0u; *(GAS v2u*)(WT + (size_t)(drow0 + n) * ldt + dk0 + 8 * c) = o; }
        return;
    }
#pragma unroll 32
    for (int i = 0; i < 32; ++i) { const int kk = 2 * i + (lane >> 5); scr[kk * 33 + (lane & 31)] = W[(size_t)(k0 + kk) * ldw + srcn0 + (lane & 31)]; }
    LDS_WAIT(); asm volatile("" ::: "memory");
#pragma unroll
    for (int j = 0; j < 4; ++j) { const int n = (lane >> 3) + 8 * j; const LAS float* s = scr + (8 * c) * 33 + n;
        const float mx = __builtin_bit_cast(float, cmax[n]); const float sc = mx > 0.f ? 127.0f / mx : 0.f;
        v2u o; o.x = (unsigned)q8(s[0 * 33] * sc) | ((unsigned)q8(s[1 * 33] * sc) << 8) | ((unsigned)q8(s[2 * 33] * sc) << 16) | ((unsigned)q8(s[3 * 33] * sc) << 24);
        o.y = (unsigned)q8(s[4 * 33] * sc) | ((unsigned)q8(s[5 * 33] * sc) << 8) | ((unsigned)q8(s[6 * 33] * sc) << 16) | ((unsigned)q8(s[7 * 33] * sc) << 24);
        *(GAS v2u*)(WT + (size_t)(drow0 + n) * ldt + dk0 + 8 * c) = o; }
    LDS_WAIT(); asm volatile("" ::: "memory");
}
__device__ __forceinline__ void colmax_pass(Frame& F, const float* W, int ld, int col0, int nblk, unsigned* cmax, int K = 4096) {
    const int r8 = F.lane >> 3, c4 = F.lane & 7;
    for (int task = F.gw; task < 4 * nblk; task += F.ngw) { const int kp = task / nblk, nb = task % nblk;
        const int rp = K >> 2; const float* p = W + (size_t)(rp * kp + r8) * ld + col0 + 32 * nb + 4 * c4; f32x4 mx = (f32x4){0.f, 0.f, 0.f, 0.f};
#pragma unroll 8
        for (int i = 0; i < (rp >> 3); ++i) { const f32x4 v = *(const GAS f32x4*)(p + (size_t)(8 * i) * ld); mx = __builtin_elementwise_max(mx, __builtin_elementwise_abs(v)); }
#pragma unroll
        for (int o = 8; o < 64; o <<= 1) { mx.x = fmaxf(mx.x, __shfl_xor(mx.x, o)); mx.y = fmaxf(mx.y, __shfl_xor(mx.y, o)); mx.z = fmaxf(mx.z, __shfl_xor(mx.z, o)); mx.w = fmaxf(mx.w, __shfl_xor(mx.w, o)); }
        if (r8 == 0) { unsigned* q = cmax + 32 * nb + 4 * c4; const float m0 = mx.x, m1 = mx.y, m2 = mx.z, m3 = mx.w;     atomicMax(q, __builtin_bit_cast(unsigned, m0)); atomicMax(q + 1, __builtin_bit_cast(unsigned, m1)); atomicMax(q + 2, __builtin_bit_cast(unsigned, m2)); atomicMax(q + 3, __builtin_bit_cast(unsigned, m3)); }
    }
}
#ifndef SIDE_IN_SCAN
#define SIDE_IN_SCAN 1
#endif
__device__ __forceinline__ void colmax_task(int lane, const float* W, int ld, int col, int row0, int rows, unsigned* cmax) {
    const int r8 = lane >> 3, c4 = lane & 7; const float* p = W + (size_t)(row0 + r8) * ld + col + 4 * c4; f32x4 mx = (f32x4){0.f, 0.f, 0.f, 0.f};
#pragma unroll 8
    for (int i = 0; i < (rows >> 3); ++i) { const f32x4 v = *(const GAS f32x4*)(p + (size_t)(8 * i) * ld); mx = __builtin_elementwise_max(mx, __builtin_elementwise_abs(v)); }
#pragma unroll
    for (int o = 8; o < 64; o <<= 1) { mx.x = fmaxf(mx.x, __shfl_xor(mx.x, o)); mx.y = fmaxf(mx.y, __shfl_xor(mx.y, o)); mx.z = fmaxf(mx.z, __shfl_xor(mx.z, o)); mx.w = fmaxf(mx.w, __shfl_xor(mx.w, o)); }
    if (r8 == 0) { unsigned* q = cmax + 4 * c4; const float m0 = mx.x, m1 = mx.y, m2 = mx.z, m3 = mx.w;
        atomicMax(q, __builtin_bit_cast(unsigned, m0)); atomicMax(q + 1, __builtin_bit_cast(unsigned, m1)); atomicMax(q + 2, __builtin_bit_cast(unsigned, m2)); atomicMax(q + 3, __builtin_bit_cast(unsigned, m3)); }
}
__device__ __forceinline__ void p0_colmax(const Args& a, Frame& F) {
#if SIDE_IN_SCAN
    constexpr int T_R = 64 * 8, T_LG = 15 * 8, T_Q = 32 * 8, T_UQ = 96 * 4, T_UKV = 128 * 4, T_ALL = T_R + T_LG + T_Q + T_UQ + T_UKV;
    unsigned* CG = (unsigned*)(a.ws + WS_CMAXG);
    for (int t = F.gw; t < T_ALL; t += F.ngw) {
        int u = t;
        if (u < T_R) { const int nb = u % 64, kp = u / 64; colmax_task(F.lane, a.in[I_WIN], 16928, 32 * nb, 512 * kp, 512, CG + 8192 + 32 * nb); continue; }
        u -= T_R;
        if (u < T_LG) { const int nb = u % 15, kp = u / 15; colmax_task(F.lane, a.in[I_WIN], 16928, 6656 + 32 * nb, 512 * kp, 512, CG + 10240 + 32 * nb); continue; }
        u -= T_LG;
        if (u < T_Q) { const int nb = u % 32, kp = u / 32; colmax_task(F.lane, a.in[I_WIN], 16928, 7136 + 32 * nb, 512 * kp, 512, CG + 10752 + 32 * nb); continue; }
        u -= T_Q;
        if (u < T_UQ) { const int nb = u % 96, kp = u / 96; colmax_task(F.lane, a.in[I_WUQ], 3072, 32 * nb, 256 * kp, 256, (unsigned*)(a.ws + WS_CMAXUQ) + 32 * nb); continue; }
        u -= T_UQ;
        { const int nb = u % 128, kp = u / 128; colmax_task(F.lane, a.in[I_WUKV], 4096, 32 * nb, 128 * kp, 128, (unsigned*)(a.ws + WS_CMAXUKV) + 32 * nb); }
    }
#else
#if !SIDE_IN_SCAN
    colmax_pass(F, a.in[I_WFI], 2 * DFF, 0, 2 * DFF / 32, (unsigned*)(a.ws + WS_CMAX));
#endif
#if !SIDE_IN_SCAN
    colmax_pass(F, a.in[I_WIN], 16928, 8736, 256, (unsigned*)(a.ws + WS_CMAXG));
#endif
    colmax_pass(F, a.in[I_WIN], 16928, 0, 64, (unsigned*)(a.ws + WS_CMAXG) + 8192);
    colmax_pass(F, a.in[I_WIN], 16928, 6656, 15, (unsigned*)(a.ws + WS_CMAXG) + 10240);
    colmax_pass(F, a.in[I_WIN], 16928, 7136, 32, (unsigned*)(a.ws + WS_CMAXG) + 10752);
    colmax_pass(F, a.in[I_WUQ], 3072, 0, 96, (unsigned*)(a.ws + WS_CMAXUQ), QL);
    colmax_pass(F, a.in[I_WUKV], 4096, 0, 128, (unsigned*)(a.ws + WS_CMAXUKV), KVL);
#if !SIDE_IN_SCAN
    colmax_pass(F, a.in[I_WOUT], DM, 0, 128, (unsigned*)(a.ws + WS_CMAXO));
    colmax_pass(F, a.in[I_WOR], DM, 0, 128, (unsigned*)(a.ws + WS_CMAXR), DA);
#endif
#endif
}
__device__ __forceinline__ void p1_weights_i8(const Args& a, Frame& F) {
    LAS float* scr = (LAS float*)(F.lds + F.wave * 16384);
#if !SIDE_IN_SCAN
    constexpr int I_FI = (2 * DFF / 32) * 64;
    for (int r = F.gw; r < I_FI; r += F.ngw) { const int nblk = 2 * DFF / 32, kb = r / nblk, nb = r % nblk, n0 = 32 * nb, pn = n0 >> 8, j = n0 & 255; const int src = (j < 128) ? 128 * pn + j : DFF + 128 * pn + (j - 128);
        tr_item_i8(a.in[I_WFI], 2 * DFF, 64 * kb, src, (unsigned char*)(a.ws + WS_WFI), DM, n0, 64 * kb, (const unsigned*)(a.ws + WS_CMAX) + src, scr, F.lane); }
    for (int r = F.gw; r < 128 * 64; r += F.ngw) { const int kb = r >> 7, nb = r & 127;
        tr_item_i8(a.in[I_WOUT], DM, 64 * kb, 32 * nb, (unsigned char*)(a.ws + WS_WOUT), DM, 32 * nb, 64 * kb, (const unsigned*)(a.ws + WS_CMAXO) + 32 * nb, scr, F.lane); }
    for (int r = F.gw; r < 128 * 32; r += F.ngw) { const int kb = r >> 7, nb = r & 127;
        tr_item_i8(a.in[I_WOR], DM, 64 * kb, 32 * nb, (unsigned char*)(a.ws + WS_WOR), DA, 32 * nb, 64 * kb, (const unsigned*)(a.ws + WS_CMAXR) + 32 * nb, scr, F.lane); }
#endif
    constexpr int NB0 = SIDE_IN_SCAN ? 256 : 0, NBN = 368 - NB0;
    for (int r = F.gw; r < NBN * 64; r += F.ngw) { const int kb = r / NBN, nb = NB0 + r % NBN;
        const int src = nb < 256 ? 8736 + 32 * nb : (nb < 320 ? 32 * (nb - 256) : (nb < 336 ? (nb < 335 ? 6656 + 32 * (nb - 320) : -1) : 7136 + 32 * (nb - 336)));
        tr_item_i8(a.in[I_WIN], 16928, 64 * kb, src, (unsigned char*)(a.ws + WS_WING8), DM, 32 * nb, 64 * kb, (const unsigned*)(a.ws + WS_CMAXG) + 32 * nb, scr, F.lane); }
    for (int r = F.gw; r < 96 * 16; r += F.ngw) { const int kb = r / 96, nb = r % 96;
        tr_item_i8(a.in[I_WUQ], 3072, 64 * kb, 32 * nb, (unsigned char*)(a.ws + WS_WUQ), QL, 32 * nb, 64 * kb, (const unsigned*)(a.ws + WS_CMAXUQ) + 32 * nb, scr, F.lane); }
    for (int r = F.gw; r < 128 * 8; r += F.ngw) { const int kb = r >> 7, nb = r & 127;
        tr_item_i8(a.in[I_WUKV], 4096, 64 * kb, 32 * nb, (unsigned char*)(a.ws + WS_WUKV), KVL, 32 * nb, 64 * kb, (const unsigned*)(a.ws + WS_CMAXUKV) + 32 * nb, scr, F.lane); }
}
constexpr int NIN16 = 5376;
__device__ __forceinline__ int map_in(int n0) {
    if (n0 < 4608) return 2048 + n0;
    if (n0 < 5120) return 8160 + (n0 - 4608);
    if (n0 < 5184) return 8672 + (n0 - 5120);
    return -1;
}
__device__ __forceinline__ void p0_weights(const Args& a, Frame& F) {
    LAS float* scr = (LAS float*)(F.lds + F.wave * 16384);
    constexpr int I_IN = (NIN16 / 32) * 64, I_FO = SIDE_IN_SCAN ? 0 : (DM / 32) * (DFF / 64), I_OM = SIDE_IN_SCAN ? 0 : 128 * 32, I_UQ = 0, I_UKV = 0  , I_LORA = 256 * 4, I_G = 64 * 8;
    constexpr int NITEMS = I_IN + I_FO + I_OM + I_UQ + I_UKV + I_LORA + I_G;
    unsigned char* ws = a.ws;
    for (int it = F.gw; it < NITEMS; it += F.ngw) {
        int r = it;
        if (r < I_IN) { const int nblk = NIN16 / 32, kb = r / nblk, nb = r % nblk; tr_item(a.in[I_WIN], 16928, 64 * kb, 64, map_in(32 * nb), (bf16*)(ws + WS_WIN), DM, 32 * nb, 64 * kb, scr, F.lane); continue; } r -= I_IN;
        if (r < I_FO) { const int nblk = DM / 32, kb = r / nblk, nb = r % nblk; tr_item_f8(a.in[I_WFO], DM, 64 * kb, 32 * nb, (unsigned char*)(ws + WS_WFO), DFF, 32 * nb, 64 * kb, 128.0f, scr, F.lane); continue; } r -= I_FO;
        if (r < I_OM) { const int nblk = 128, kb = r / nblk, nb = r % nblk; tr_item(a.in[I_WOM], DM, 64 * kb, 64, 32 * nb, (bf16*)(ws + WS_WOM), DA, 32 * nb, 64 * kb, scr, F.lane); continue; } r -= I_OM;
        if (r < I_UQ) { const int nblk = 96, kb = r / nblk, nb = r % nblk; tr_item(a.in[I_WUQ], 3072, 64 * kb, 64, 32 * nb, (bf16*)(ws + WS_WUQ), QL, 32 * nb, 64 * kb, scr, F.lane); continue; } r -= I_UQ;
        if (r < I_UKV) { const int nblk = 128, kb = r / nblk, nb = r % nblk; tr_item(a.in[I_WUKV], 4096, 64 * kb, 64, 32 * nb, (bf16*)(ws + WS_WUKV), KVL, 32 * nb, 64 * kb, scr, F.lane); continue; } r -= I_UKV;
        if (r < I_LORA) {
            const int nblk = 256, kb = r / nblk, nb = r % nblk, n0 = 32 * nb, dir = n0 >> 12, j = n0 & 4095; const bool isw = j < 2048; const bool live = isw ? (kb < 2) : (kb >= 2);
            const float* src = (isw ? a.in[I_WLB] : a.in[I_ALB]) + (size_t)dir * 128 * DA;
            tr_item(src, DA, 64 * (kb & 1), 64, live ? (isw ? j : j - 2048) : -1, (bf16*)(ws + WS_WLORA), 256, n0, 64 * kb, scr, F.lane); continue; } r -= I_LORA;
        { const int nblk = 64, kb = r / nblk, nb = r % nblk; const int kv = 480 - 64 * kb; tr_item(a.in[I_GLB], DA, 64 * kb, kv < 0 ? 0 : kv, 32 * nb, (bf16*)(ws + WS_WG), 512, 32 * nb, 64 * kb, scr, F.lane); }
    }
}

__device__ __forceinline__ void sincos_small(double x, double& s, double& c) {
    const double n = __builtin_rint(x * 0.63661977236758134308);
    double r = __builtin_fma(-n, 1.57079632679489655800e+00, x); r = __builtin_fma(-n, 6.12323399573676603587e-17, r);
    const double r2 = r * r;
    double sp = -7.6471637318198164759e-13; sp = sp * r2 + 1.6059043836821614599e-10; sp = sp * r2 - 2.5052108385441718775e-08; sp = sp * r2 + 2.7557319223985890653e-06;
    sp = sp * r2 - 1.9841269841269841270e-04; sp = sp * r2 + 8.3333333333333333333e-03; sp = sp * r2 - 1.6666666666666666667e-01; const double sr = r + r * r2 * sp;
    double cp = 4.7794773323873852974e-14; cp = cp * r2 - 1.1470745597729724714e-11; cp = cp * r2 + 2.0876756987868098979e-09; cp = cp * r2 - 2.7557319223985890653e-07;
    cp = cp * r2 + 2.4801587301587301587e-05; cp = cp * r2 - 1.3888888888888888889e-03; cp = cp * r2 + 4.1666666666666666667e-02; cp = cp * r2 - 0.5; const double cr = 1.0 + r2 * cp;
    const int q = ((int)n) & 3;
    s = (q == 0) ? sr : (q == 1) ? cr : (q == 2) ? -sr : -cr;
    c = (q == 0) ? cr : (q == 1) ? -sr : (q == 2) ? -cr : sr;
}
__device__ __forceinline__ double rope_inv(int j) {
    switch (j) { case 0: return 1.0; case 1: return 0.56234132519034908; case 2: return 0.31622776601683794; case 3: return 0.17782794100389229; case 4: return 0.1; case 5: return 0.056234132519034911;
        case 6: return 0.031622776601683791; case 7: return 0.017782794100389229; case 8: return 0.01; case 9: return 0.0056234132519034910; case 10: return 0.0031622776601683794; case 11: return 0.0017782794100389228;
        case 12: return 0.001; case 13: return 0.00056234132519034910; case 14: return 0.00031622776601683794; default: return 0.00017782794100389228; }
}
__device__ __forceinline__ void p0_rope(const Args& a, Frame& F) {
    float* COS = (float*)(a.ws + WS_COS); float* SIN = (float*)(a.ws + WS_SIN); float* LB = (float*)(a.ws + WS_LBIAS);
    for (int i = blockIdx.x * 512 + F.tid; i < 8192; i += F.G * 512) LB[i] = (i < 4096) ? a.in[I_W0][i] : a.in[I_A0][i - 4096];
    for (int i = blockIdx.x * 512 + F.tid; i < 1024 * 32; i += F.G * 512) { const int t = i >> 5, f = i & 31;
        const double pos = (f < 16) ? (double)(t >> 6) : (double)(t & 63); const double ang = pos * rope_inv(f & 15);
        double s, c; sincos_small(ang, s, c); COS[i] = (float)c; SIN[i] = (float)s; }
}

__device__ __forceinline__ void modnorm_rows(Frame& F, const float* x0, const float* x1, const float* nw, const float* MOD, int shift_slot, bf16* H) {
    for (int row = F.gw; row < T; row += F.ngw) {
        const float* xr = row < T_P ? x0 + (size_t)row * DM : x1 + (size_t)(row - T_P) * DM;
        const float* md = MOD + (size_t)mod_index(row) * NMOD + shift_slot * DM;
        f32x4 v[16]; float ss = 0.f;
#pragma unroll
        for (int j = 0; j < 16; ++j) { v[j] = *((const GAS f32x4*)xr + F.lane + 64 * j); ss += (v[j].x * v[j].x + v[j].y * v[j].y) + (v[j].z * v[j].z + v[j].w * v[j].w); }
        const float rstd = 1.0f / sqrtf(wave_sum(ss) * (1.0f / DM) + NORM_EPS);
#pragma unroll
        for (int j = 0; j < 16; ++j) { const int col = 4 * (F.lane + 64 * j);
            const f32x4 w = *(const f32x4*)(nw + col), sh = *(const f32x4*)(md + col), sc = *(const f32x4*)(md + DM + col);
            const f32x4 o = v[j] * rstd * w * (sc + 1.0f) + sh;
            v2u p; p.x = pg8::cvt_pk_bf16(o.x, o.y); p.y = pg8::cvt_pk_bf16(o.z, o.w); *(GAS v2u*)(H + (size_t)row * DM + col) = p; }
    }
}

__device__ __forceinline__ void modnorm_rows_dual(Frame& F, const float* x0, const float* x1, const float* nw, const float* MOD, int shift_slot, bf16* H, unsigned char* HQ, float* ROWS) {
    for (int row = F.gw; row < T; row += F.ngw) {
        const float* xr = row < T_P ? x0 + (size_t)row * DM : x1 + (size_t)(row - T_P) * DM;
        const float* md = MOD + (size_t)mod_index(row) * NMOD + shift_slot * DM;
        f32x4 v[16]; float ss = 0.f;
#pragma unroll
        for (int j = 0; j < 16; ++j) { v[j] = *((const GAS f32x4*)xr + F.lane + 64 * j); ss += (v[j].x * v[j].x + v[j].y * v[j].y) + (v[j].z * v[j].z + v[j].w * v[j].w); }
        const float rstd = 1.0f / sqrtf(wave_sum(ss) * (1.0f / DM) + NORM_EPS); float mx = 0.f;
#pragma unroll
        for (int jh = 0; jh < 16; jh += 4) {
#pragma unroll
            for (int j = jh; j < jh + 4; ++j) { const int col = 4 * (F.lane + 64 * j);
                const f32x4 w = *(const f32x4*)(nw + col), sh = *(const f32x4*)(md + col), sc = *(const f32x4*)(md + DM + col);
                v[j] = v[j] * rstd * w * (sc + 1.0f) + sh; mx = fmaxf(mx, fmaxf(fmaxf(fabsf(v[j].x), fabsf(v[j].y)), fmaxf(fabsf(v[j].z), fabsf(v[j].w)))); }
#pragma unroll
            for (int j = jh; j < jh + 4; ++j) { const int col = 4 * (F.lane + 64 * j);
                v2u p; p.x = pg8::cvt_pk_bf16(v[j].x, v[j].y); p.y = pg8::cvt_pk_bf16(v[j].z, v[j].w); *(GAS v2u*)(H + (size_t)row * DM + col) = p; }
        }
#pragma unroll
        for (int o = 1; o < 64; o <<= 1) mx = fmaxf(mx, __shfl_xor(mx, o));
        const float qs = mx > 0.f ? 127.0f / mx : 0.f;
        if (F.lane == 0) ROWS[row] = mx * (1.0f / 127.0f);
#pragma unroll
        for (int j = 0; j < 16; ++j) { const int col = 4 * (F.lane + 64 * j);
            *(GAS unsigned*)(HQ + (size_t)row * DM + col) = (unsigned)q8(v[j].x * qs) | ((unsigned)q8(v[j].y * qs) << 8) | ((unsigned)q8(v[j].z * qs) << 16) | ((unsigned)q8(v[j].w * qs) << 24); }
    }
}

__device__ __forceinline__ void modnorm_rows_i8(Frame& F, const bf16* X1, const float* nw, const float* MOD, int shift_slot, unsigned char* H, float* ROWS) {
    for (int row = F.gw; row < T; row += F.ngw) {
        const bf16* xr = X1 + (size_t)row * DM;
        const float* md = MOD + (size_t)mod_index(row) * NMOD + shift_slot * DM;
        f32x4 v[16]; float ss = 0.f;
#pragma unroll
        for (int j = 0; j < 16; ++j) { const v2u t = *((const GAS v2u*)xr + F.lane + 64 * j); v[j] = (f32x4){pg8::bflo(t.x), pg8::bfhi(t.x), pg8::bflo(t.y), pg8::bfhi(t.y)}; ss += (v[j].x * v[j].x + v[j].y * v[j].y) + (v[j].z * v[j].z + v[j].w * v[j].w); }
        const float rstd = 1.0f / sqrtf(wave_sum(ss) * (1.0f / DM) + NORM_EPS); float mx = 0.f;
#pragma unroll
        for (int j = 0; j < 16; ++j) { const int col = 4 * (F.lane + 64 * j);
            const f32x4 w = *(const f32x4*)(nw + col), sh = *(const f32x4*)(md + col), sc = *(const f32x4*)(md + DM + col);
            v[j] = v[j] * rstd * w * (sc + 1.0f) + sh; mx = fmaxf(mx, fmaxf(fmaxf(fabsf(v[j].x), fabsf(v[j].y)), fmaxf(fabsf(v[j].z), fabsf(v[j].w)))); }
#pragma unroll
        for (int o = 1; o < 64; o <<= 1) mx = fmaxf(mx, __shfl_xor(mx, o));
        const float qs = mx > 0.f ? 127.0f / mx : 0.f;
        if (F.lane == 0) ROWS[row] = mx * (1.0f / 127.0f);
#pragma unroll
        for (int j = 0; j < 16; ++j) { const int col = 4 * (F.lane + 64 * j);
            *(GAS unsigned*)(H + (size_t)row * DM + col) = (unsigned)q8(v[j].x * qs) | ((unsigned)q8(v[j].y * qs) << 8) | ((unsigned)q8(v[j].z * qs) << 16) | ((unsigned)q8(v[j].w * qs) << 24); }
    }
}

__device__ __forceinline__ void p8c_quant_mixed(const Args& a, Frame& F) {
    const bf16* MX = (const bf16*)(a.ws + WS_MIXED); unsigned char* Q = (unsigned char*)(a.ws + WS_MIX8); const unsigned* rmax = (const unsigned*)(a.ws + WS_RMAXM); float* ROWS = (float*)(a.ws + WS_ROWSM);
    for (int row = F.gw; row < T; row += F.ngw) { const float mx = __builtin_bit_cast(float, rmax[row]); const float qs = mx > 0.f ? 127.0f / mx : 0.f;
        if (F.lane == 0) ROWS[row] = mx * (1.0f / 127.0f);
        v4u wv[8];
#pragma unroll
        for (int j = 0; j < 8; ++j) wv[j] = *(const GAS v4u*)(MX + (size_t)row * DM + 8 * (F.lane + 64 * j));
#pragma unroll
        for (int j = 0; j < 8; ++j) { const int col = 8 * (F.lane + 64 * j); const v4u w = wv[j];
            v2u o; o.x = (unsigned)q8(pg8::bflo(w.x) * qs) | ((unsigned)q8(pg8::bfhi(w.x) * qs) << 8) | ((unsigned)q8(pg8::bflo(w.y) * qs) << 16) | ((unsigned)q8(pg8::bfhi(w.y) * qs) << 24);
            o.y = (unsigned)q8(pg8::bflo(w.z) * qs) | ((unsigned)q8(pg8::bfhi(w.z) * qs) << 8) | ((unsigned)q8(pg8::bflo(w.w) * qs) << 16) | ((unsigned)q8(pg8::bfhi(w.w) * qs) << 24);
            *(GAS v2u*)(Q + (size_t)row * DM + col) = o; } }
}

__device__ __forceinline__ int kv_row_of_token(int row) { return row < T_P ? row : T_P + ((row - T_P) >> 10) * 1536 + 512 + ((row - T_P) & 1023); }
__device__ __forceinline__ float h2f_(unsigned u) { return (float)__builtin_bit_cast(_Float16, (unsigned short)u); }
__device__ __forceinline__ unsigned q8x4(f32x4 o, float qs) { return (unsigned)q8(o.x * qs) | ((unsigned)q8(o.y * qs) << 8) | ((unsigned)q8(o.z * qs) << 16) | ((unsigned)q8(o.w * qs) << 24); }
__device__ __forceinline__ float absmax4(f32x4 o) { return fmaxf(fmaxf(fabsf(o.x), fabsf(o.y)), fmaxf(fabsf(o.z), fabsf(o.w))); }
__device__ __forceinline__ float wave_max(float v) {
#pragma unroll
    for (int o = 1; o < 64; o <<= 1) v = fmaxf(v, __shfl_xor(v, o));
    return v;
}
__device__ __forceinline__ float wave_sum_d(float x) { x = row16_sum(x); const int xi = __builtin_bit_cast(int, x);
    return (__builtin_bit_cast(float, __builtin_amdgcn_readlane(xi, 0)) + __builtin_bit_cast(float, __builtin_amdgcn_readlane(xi, 16))) + (__builtin_bit_cast(float, __builtin_amdgcn_readlane(xi, 32)) + __builtin_bit_cast(float, __builtin_amdgcn_readlane(xi, 48))); }
__device__ __forceinline__ float wave_max_d(float x) {
    x = fmaxf(x, dpp_f(x, 0)); x = fmaxf(x, dpp_f(x, 1)); x = fmaxf(x, dpp_f(x, 2)); x = fmaxf(x, dpp_f(x, 3)); const int xi = __builtin_bit_cast(int, x);
    return fmaxf(fmaxf(__builtin_bit_cast(float, __builtin_amdgcn_readlane(xi, 0)), __builtin_bit_cast(float, __builtin_amdgcn_readlane(xi, 16))), fmaxf(__builtin_bit_cast(float, __builtin_amdgcn_readlane(xi, 32)), __builtin_bit_cast(float, __builtin_amdgcn_readlane(xi, 48)))); }
__device__ __forceinline__ void p3_post(const Args& a, Frame& F) {
    const float* QLAT = (const float*)(a.ws + WS_QLAT); const float* KVLAT = (const float*)(a.ws + WS_KVLAT); const float* KPE = (const float*)(a.ws + WS_KPE);
    unsigned char* QN = (unsigned char*)(a.ws + WS_QN); unsigned char* CKVA = (unsigned char*)(a.ws + WS_CKVA); float* ROWSQ = (float*)(a.ws + WS_ROWSQ); float* ROWSKV = (float*)(a.ws + WS_ROWSKV);
    const float* qnw = a.in[I_QNW]; const float* kvnw = a.in[I_KVNW];
    for (int task = F.gw; task < T + 2048; task += F.ngw) {
        if (task < T) { const int row = task;
            v2u tq[4]; f32x4 vk[2], wq[4], wk[2];
#pragma unroll
            for (int j = 0; j < 4; ++j) { tq[j] = *((const GAS v2u*)((const unsigned short*)QLAT + (size_t)row * QL) + F.lane + 64 * j); wq[j] = *(const f32x4*)(qnw + 4 * (F.lane + 64 * j)); }
#pragma unroll
            for (int j = 0; j < 2; ++j) { vk[j] = *((const GAS f32x4*)(KVLAT + (size_t)row * KVL) + F.lane + 64 * j); wk[j] = *(const f32x4*)(kvnw + 4 * (F.lane + 64 * j)); }
            const float kpev = (row < T_P) ? KPE[(size_t)row * 64 + F.lane] : 0.f;
            f32x4 v[4]; float ss = 0.f;
#pragma unroll
            for (int j = 0; j < 4; ++j) { v[j] = (f32x4){h2f_(tq[j].x & 0xffff), h2f_(tq[j].x >> 16), h2f_(tq[j].y & 0xffff), h2f_(tq[j].y >> 16)}; ss += (v[j].x * v[j].x + v[j].y * v[j].y) + (v[j].z * v[j].z + v[j].w * v[j].w); }
            const float rstd = 1.0f / sqrtf(wave_sum_d(ss) * (1.0f / QL) + NORM_EPS); float mx = 0.f;
#pragma unroll
            for (int j = 0; j < 4; ++j) { v[j] = v[j] * rstd * wq[j]; mx = fmaxf(mx, absmax4(v[j])); }
            mx = wave_max_d(mx); const float qs = mx > 0.f ? 127.0f / mx : 0.f;
            float ss2 = 0.f;
#pragma unroll
            for (int j = 0; j < 2; ++j) ss2 += (vk[j].x * vk[j].x + vk[j].y * vk[j].y) + (vk[j].z * vk[j].z + vk[j].w * vk[j].w);
            const float rstd2 = 1.0f / sqrtf(wave_sum_d(ss2) * (1.0f / KVL) + NORM_EPS); const int kr = kv_row_of_token(row); float mx2 = 0.f;
#pragma unroll
            for (int j = 0; j < 2; ++j) { vk[j] = vk[j] * rstd2 * wk[j]; mx2 = fmaxf(mx2, absmax4(vk[j])); }
            mx2 = wave_max_d(mx2); const float qs2 = mx2 > 0.f ? 127.0f / mx2 : 0.f;
            if (F.lane == 0) { ROWSQ[row] = mx * (1.0f / 127.0f); ROWSKV[kr] = mx2 * (1.0f / 127.0f); }
#pragma unroll
            for (int j = 0; j < 4; ++j) *(GAS unsigned*)(QN + (size_t)row * QL + 4 * (F.lane + 64 * j)) = q8x4(v[j], qs);
#pragma unroll
            for (int j = 0; j < 2; ++j) { const int col = 4 * (F.lane + 64 * j); *(GAS unsigned*)(CKVA + (size_t)kr * KVL + col) = q8x4(vk[j], qs2);
                if (row < T_P) *(GAS f32x4*)(a.out + OUT_CKV + (size_t)row * KVL + col) = vk[j]; }
            if (row < T_P) a.out[OUT_KPE + (size_t)row * 64 + F.lane] = kpev;
        } else { const int idx = task - T, b = idx >> 9, p = idx & 511; const float* src = a.in[I_CCKV] + (size_t)idx * KVL; const int kr = T_P + b * 1536 + p;
            f32x4 v[2]; float mx = 0.f;
#pragma unroll
            for (int j = 0; j < 2; ++j) { v[j] = *(const GAS f32x4*)(src + 4 * (F.lane + 64 * j)); mx = fmaxf(mx, absmax4(v[j])); }
            mx = wave_max_d(mx); const float qs = mx > 0.f ? 127.0f / mx : 0.f; if (F.lane == 0) ROWSKV[kr] = mx * (1.0f / 127.0f);
#pragma unroll
            for (int j = 0; j < 2; ++j) { const int col = 4 * (F.lane + 64 * j); *(GAS unsigned*)(CKVA + (size_t)kr * KVL + col) = q8x4(v[j], qs); }
        }
    }
}
struct SidePair { int kind, first, last, cs; const float* src; unsigned char* dst; unsigned* cm; unsigned ld, ldt; };
constexpr int SIDE_PART_OFF = 98304;
static_assert(SIDE_PART_OFF + 1024 <= RING_BYTES, "side-work LDS");
__device__ __forceinline__ void side_pair_next(const Args& a, int b, int w, int p, SidePair& d) {
    const int s8p = b < 96 ? 80 : 72;
    if (p < s8p) {
        const int win = p >> 4, within = p & 15; const bool half = (win == 4 && b >= 48);
        const int wi = half ? (within & 7) : within, nsubp = half ? 4 : 8;
        if (wi != 0 && wi != nsubp) { const int subp = wi >= nsubp ? wi - nsubp : wi; d.src += (size_t)64 * d.ld; d.dst += 64; d.first = 0; d.last = subp == nsubp - 1; return; }
        int K, srcc;
        if (!half) { const int idx = b + 256 * win; K = DM;
            if (idx < 688) { const int n0 = 32 * idx, pn = n0 >> 8, j = n0 & 255; srcc = (j < 128) ? 128 * pn + j : DFF + 128 * pn + (j - 128);
                d.src = a.in[I_WFI]; d.ld = 2 * DFF; d.dst = a.ws + WS_WFI + (size_t)n0 * DM; d.cm = (unsigned*)(a.ws + WS_CMAX) + srcc; }
            else if (idx < 944) { const int nb = idx - 688; srcc = 8736 + 32 * nb; d.src = a.in[I_WIN]; d.ld = 16928; d.dst = a.ws + WS_WGATE8 + (size_t)(32 * nb) * DM; d.cm = (unsigned*)(a.ws + WS_CMAXG) + 32 * nb; }
            else { const int nb = idx - 944; srcc = 32 * nb; d.src = a.in[I_WOUT]; d.ld = DM; d.dst = a.ws + WS_WOUT + (size_t)(32 * nb) * DM; d.cm = (unsigned*)(a.ws + WS_CMAXO) + 32 * nb; }
        } else { K = DA; d.ld = DM;
            if ((within >> 3) == 0 && b < 176) { const int nb = b - 48; srcc = 32 * nb; d.src = a.in[I_WOR]; d.dst = a.ws + WS_WOR + (size_t)(32 * nb) * DA; d.cm = (unsigned*)(a.ws + WS_CMAXR) + 32 * nb; }
            else { const int nb = b >= 176 ? b - 176 : 80 + (b - 48); srcc = 32 * nb; d.src = a.in[I_WOM]; d.dst = a.ws + WS_WOM + (size_t)(32 * nb) * DA; d.cm = (unsigned*)(a.ws + WS_CMAXM) + 32 * nb; } }
        const int pass = wi >= nsubp ? 1 : 0, k0 = w * (K >> 3);
        d.kind = 1 + pass; d.first = 1; d.last = 0; d.ldt = (unsigned)K; d.cs = 3;
        d.src += (size_t)k0 * d.ld + srcc; d.dst += k0;
        return;
    }
    const int f = b + 256 * (p - s8p);
    d.first = 0; d.last = 0; d.ld = DM; d.cs = 4;
    if (f < 2752) { const int nbp = f & 63, k0 = 256 * (f >> 6) + 32 * w; d.kind = 3; d.src = a.in[I_WFO] + (size_t)k0 * DM + 64 * nbp; d.dst = a.ws + WS_WFO + (size_t)(64 * nbp) * DFF + k0; d.ldt = DFF; }
    else { d.kind = 0; d.src = a.in[I_WFI]; d.ld = 0; d.cs = 3; }
}
__device__ __forceinline__ const char* side_issue_addr(const SidePair& d, int lane) {
    const int g = lane >> d.cs, cg = lane & ((1 << d.cs) - 1);
    const unsigned loff = ((unsigned)(8 * g) * d.ld + (unsigned)(4 * cg)) * 4u;
    return (const char*)d.src + loff;
}
__device__ __forceinline__ f32x4 side_issue_one(const char* pa, unsigned ld, int j) { return *(const GAS f32x4*)(pa + (size_t)j * ld * 4u); }
__device__ __forceinline__ unsigned side_pack4(float a, float b, float c, float e, float sc) {
    const unsigned q0 = __builtin_bit_cast(unsigned, __builtin_fmaf(a, sc, 12582912.0f)), q1 = __builtin_bit_cast(unsigned, __builtin_fmaf(b, sc, 12582912.0f));
    const unsigned q2 = __builtin_bit_cast(unsigned, __builtin_fmaf(c, sc, 12582912.0f)), q3 = __builtin_bit_cast(unsigned, __builtin_fmaf(e, sc, 12582912.0f));
    return __builtin_amdgcn_perm(q1, q0, 0x0c0c0400u) | __builtin_amdgcn_perm(q3, q2, 0x04000c0cu);
}
#define SIDE_COL(c_, j_) (c_ == 0 ? R[j_].x : c_ == 1 ? R[j_].y : c_ == 2 ? R[j_].z : R[j_].w)
__device__ __forceinline__ void side_consume(const SidePair& d, int lane, int w, const f32x4 (&R)[8], float (&mx)[4], float (&sc)[4], LAS float* PART) {
    if (d.kind == 0) return;
    const int g = lane >> d.cs, cg = lane & ((1 << d.cs) - 1);
    if (d.kind == 1) {
        f32x4 m = d.first ? (f32x4){0.f, 0.f, 0.f, 0.f} : (f32x4){mx[0], mx[1], mx[2], mx[3]};
#pragma unroll
        for (int j = 0; j < 8; ++j) m = __builtin_elementwise_max(m, __builtin_elementwise_abs(R[j]));
        if (d.last) {
#pragma unroll
            for (int o = 8; o < 64; o <<= 1) { m.x = fmaxf(m.x, __shfl_xor(m.x, o)); m.y = fmaxf(m.y, __shfl_xor(m.y, o)); m.z = fmaxf(m.z, __shfl_xor(m.z, o)); m.w = fmaxf(m.w, __shfl_xor(m.w, o)); }
            if (lane < 8) *(LAS f32x4*)(PART + w * 32 + 4 * lane) = m;
        }
        mx[0] = m.x; mx[1] = m.y; mx[2] = m.z; mx[3] = m.w;
        return;
    }
    if (d.kind == 2) {
        if (d.first) { f32x4 m = *(const LAS f32x4*)(PART + 4 * cg);
#pragma unroll
            for (int r = 1; r < 8; ++r) m = __builtin_elementwise_max(m, *(const LAS f32x4*)(PART + r * 32 + 4 * cg));
            sc[0] = m.x > 0.f ? 127.0f / m.x : 0.f; sc[1] = m.y > 0.f ? 127.0f / m.y : 0.f; sc[2] = m.z > 0.f ? 127.0f / m.z : 0.f; sc[3] = m.w > 0.f ? 127.0f / m.w : 0.f;
            if (w == 0 && g == 0) { const float m0 = m.x, m1 = m.y, m2 = m.z, m3 = m.w; v4u o; o.x = __builtin_bit_cast(unsigned, m0); o.y = __builtin_bit_cast(unsigned, m1); o.z = __builtin_bit_cast(unsigned, m2); o.w = __builtin_bit_cast(unsigned, m3);
                *(GAS v4u*)(d.cm + 4 * cg) = o; } }
        unsigned char* q = d.dst + (size_t)(4 * cg) * d.ldt + 8 * g;
#pragma unroll
        for (int c = 0; c < 4; ++c) { v2u o; o.x = side_pack4(SIDE_COL(c, 0), SIDE_COL(c, 1), SIDE_COL(c, 2), SIDE_COL(c, 3), sc[c]); o.y = side_pack4(SIDE_COL(c, 4), SIDE_COL(c, 5), SIDE_COL(c, 6), SIDE_COL(c, 7), sc[c]);
            *(GAS v2u*)(q + (size_t)c * d.ldt) = o; }
        return;
    }
    if (d.kind == 3) {
        unsigned char* q = d.dst + (size_t)(4 * cg) * d.ldt + 8 * g;
#pragma unroll
        for (int c = 0; c < 4; ++c) { unsigned t0 = 0u, t1 = 0u;
            t0 = __builtin_amdgcn_cvt_pk_fp8_f32(SIDE_COL(c, 0) * 128.0f, SIDE_COL(c, 1) * 128.0f, t0, false); t0 = __builtin_amdgcn_cvt_pk_fp8_f32(SIDE_COL(c, 2) * 128.0f, SIDE_COL(c, 3) * 128.0f, t0, true);
            t1 = __builtin_amdgcn_cvt_pk_fp8_f32(SIDE_COL(c, 4) * 128.0f, SIDE_COL(c, 5) * 128.0f, t1, false); t1 = __builtin_amdgcn_cvt_pk_fp8_f32(SIDE_COL(c, 6) * 128.0f, SIDE_COL(c, 7) * 128.0f, t1, true);
            v2u o; o.x = t0; o.y = t1; *(GAS v2u*)(q + (size_t)c * d.ldt) = o; }
        return;
    }
    {
        unsigned char* q = d.dst + ((size_t)(4 * cg) * d.ldt + 8 * g) * 2;
#pragma unroll
        for (int c = 0; c < 4; ++c) { v4u o; o.x = pg8::cvt_pk_bf16(SIDE_COL(c, 0), SIDE_COL(c, 1)); o.y = pg8::cvt_pk_bf16(SIDE_COL(c, 2), SIDE_COL(c, 3)); o.z = pg8::cvt_pk_bf16(SIDE_COL(c, 4), SIDE_COL(c, 5)); o.w = pg8::cvt_pk_bf16(SIDE_COL(c, 6), SIDE_COL(c, 7));
            *(GAS v4u*)(q + (size_t)c * d.ldt * 2) = o; }
    }
}
constexpr int SC_TS = 16, SC_NCH = 96, SC_BUF_FLOATS = SC_TS * 6 * 64;
struct ScanChain { int row0, L, h, dir, b, is_sample; };
__device__ __forceinline__ ScanChain scan_chain(int gid, int idx) {
    ScanChain c; int code;
    if (gid < 256) { if (idx == 0) { code = gid; c.is_sample = 1; } else { code = 2 * gid + (idx - 1); c.is_sample = 0; } }
    else { code = 512 + 6 * (gid - 256) + idx; c.is_sample = 0; }
    c.b = code >> 6; c.h = (code >> 1) & 31; c.dir = code & 1;
    if (c.is_sample) { c.row0 = T_P + c.b * 1024; c.L = 1024; } else { c.row0 = c.b * 256; c.L = 256; }
    return c;
}
__device__ __forceinline__ void scan_locate(int gid, int ci, int& idx, int& chunk) {
    if (gid < 256) { if (ci < 64) { idx = 0; chunk = ci; } else { idx = 1 + ((ci - 64) >> 4); chunk = (ci - 64) & 15; } }
    else { idx = ci >> 4; chunk = ci & 15; }
}
struct ScanPref { unsigned short r[4], k[4], v[4], e[4], a[4]; float kk, ka, rk; };
__device__ __forceinline__ float h2f(unsigned short u) { return (float)__builtin_bit_cast(_Float16, u); }

__device__ __forceinline__ float fmul_s(float a, float b) { float r; asm("v_mul_f32_e32 %0, %1, %2" : "=v"(r) : "v"(a), "v"(b)); return r; }
__device__ __forceinline__ float ffma_s(float a, float b, float c) { float r; asm("v_fma_f32 %0, %1, %2, %3" : "=v"(r) : "v"(a), "v"(b), "v"(c)); return r; }
__device__ __forceinline__ void reduce2_oct(float& a, float& b) {
    asm("s_nop 1\n\t"
        "v_add_f32_dpp %0, %0, %0 quad_perm:[1,0,3,2] row_mask:0xf bank_mask:0xf bound_ctrl:1\n\t"
        "v_add_f32_dpp %1, %1, %1 quad_perm:[1,0,3,2] row_mask:0xf bank_mask:0xf bound_ctrl:1\n\t"
        "s_nop 0\n\t"
        "v_add_f32_dpp %0, %0, %0 quad_perm:[2,3,0,1] row_mask:0xf bank_mask:0xf bound_ctrl:1\n\t"
        "v_add_f32_dpp %1, %1, %1 quad_perm:[2,3,0,1] row_mask:0xf bank_mask:0xf bound_ctrl:1\n\t"
        "s_nop 0\n\t"
        "v_add_f32_dpp %0, %0, %0 row_half_mirror row_mask:0xf bank_mask:0xf bound_ctrl:1\n\t"
        "v_add_f32_dpp %1, %1, %1 row_half_mirror row_mask:0xf bank_mask:0xf bound_ctrl:1\n\t"
        : "+v"(a), "+v"(b));
}
__device__ __forceinline__ float wave_sum_u(float x) {
    x = row16_sum(x);
    const int xi = __builtin_bit_cast(int, x);
    const float s0 = __builtin_bit_cast(float, __builtin_amdgcn_readlane(xi, 0)), s1 = __builtin_bit_cast(float, __builtin_amdgcn_readlane(xi, 16)),
                s2 = __builtin_bit_cast(float, __builtin_amdgcn_readlane(xi, 32)), s3 = __builtin_bit_cast(float, __builtin_amdgcn_readlane(xi, 48));
    return (s0 + s1) + (s2 + s3);
}
template <int SIDE = 1> __device__ __forceinline__ void p5_scan(const Args& a, Frame& F) {
    const unsigned short* RKV = (const unsigned short*)(a.ws + WS_RKV); const unsigned char* EW = (const unsigned char*)(a.ws + WS_EW); const unsigned char* AA = EW + (size_t)2 * T * DA;
    _Float16* YS = (_Float16*)(a.ws + WS_YS); float* BON = (float*)(a.ws + WS_BON);
    const float* k_k = a.in[I_KK]; const float* k_a = a.in[I_KA]; const float* r_k = a.in[I_RK];
    const int grp = F.wave >> 2, wq = F.wave & 3, lane = F.lane, rp = lane >> 3, kq = lane & 7;
    LAS float* buf0 = (LAS float*)F.lds + (grp * 2) * SC_BUF_FLOATS;
    if (F.G != 256) return;
    const int gid = grp == 0 ? (int)blockIdx.x : 256 + (int)blockIdx.x;

    ScanPref P; float bonv[4];
#define SC_LOAD(ci_) do { const int cc_ = (ci_) < SC_NCH ? (ci_) : SC_NCH - 1; int idx_, ch_; scan_locate(gid, cc_, idx_, ch_); const ScanChain c_ = scan_chain(gid, idx_); \
        P.kk = k_k[c_.h * 64 + lane]; P.ka = k_a[c_.h * 64 + lane]; P.rk = r_k[c_.h * 64 + lane]; \
        _Pragma("unroll") for (int j = 0; j < 4; ++j) { const int s_ = ch_ * SC_TS + 4 * wq + j; const int t_ = c_.dir ? c_.L - 1 - s_ : s_; const size_t row_ = (size_t)(c_.row0 + t_); \
            const unsigned short* rp = RKV + row_ * 6144 + c_.h * 64 + lane; P.r[j] = rp[0]; P.k[j] = rp[2048]; P.v[j] = rp[4096]; \
            const size_t o_ = ((size_t)c_.dir * T + row_) * DA + c_.h * 64 + lane; P.e[j] = EW[o_]; P.a[j] = AA[o_]; } } while (0)
#define SC_STAGE(ci_, pb_) do { const int cc_ = (ci_) < SC_NCH ? (ci_) : SC_NCH - 1; int idx_, ch_; scan_locate(gid, cc_, idx_, ch_); const ScanChain c_ = scan_chain(gid, idx_); LAS float* B_ = buf0 + (pb_) * SC_BUF_FLOATS; \
        const float kkw = P.kk, kaw = P.ka, rkw = P.rk;     \
        _Pragma("unroll") for (int j = 0; j < 4; ++j) { const int i_ = 4 * wq + j; \
            const float r_ = h2f(P.r[j]), k_ = h2f(P.k[j]), v_ = h2f(P.v[j]), e_ = (float)P.e[j] * (0.60653065971263342f / 255.0f), a_ = (float)P.a[j] * (1.0f / 255.0f); \
            const float kr_ = k_ * kkw; const float kk_ = kr_ * __builtin_amdgcn_rsqf(wave_sum_u(kr_ * kr_) + 1e-12f); \
            const float kd_ = k_ * (1.0f + (a_ - 1.0f) * kaw); bonv[j] = wave_sum_u(r_ * kd_ * rkw); \
            LAS float* o_ = B_ + i_ * 6 * 64 + lane; o_[0] = -kk_; o_[64] = __expf(-e_); o_[128] = kk_ * a_; o_[192] = kd_; o_[256] = r_; o_[320] = v_; } } while (0)
#define SC_BON(ci_) do { if ((ci_) < SC_NCH && lane < 4) { int idx_, ch_; scan_locate(gid, (ci_), idx_, ch_); const ScanChain c_ = scan_chain(gid, idx_); \
            const int s_ = ch_ * SC_TS + 4 * wq + lane; const int t_ = c_.dir ? c_.L - 1 - s_ : s_; \
            const float bv_ = lane == 0 ? bonv[0] : lane == 1 ? bonv[1] : lane == 2 ? bonv[2] : bonv[3]; \
            BON[((size_t)c_.dir * T + (size_t)(c_.row0 + t_)) * 32 + c_.h] = bv_; } } while (0)

    SC_LOAD(0); SC_STAGE(0, 0); SC_BON(0); SC_LOAD(1);
    asm volatile("s_waitcnt lgkmcnt(0)" ::: "memory"); __syncthreads();

    float S[2][8];
#if SIDE_IN_SCAN
    f32x4 SR[8]; float smx[4] = {0.f, 0.f, 0.f, 0.f}, ssc[4] = {0.f, 0.f, 0.f, 0.f};
#pragma unroll
    for (int j = 0; j < 8; ++j) SR[j] = (f32x4){0.f, 0.f, 0.f, 0.f};
    LAS float* PART = (LAS float*)(F.lds + SIDE_PART_OFF);
    const char* spa = (const char*)a.in[I_WFI]; unsigned sld = 0;
    SidePair sd; sd.kind = 0; sd.first = 0; sd.last = 0; sd.src = a.in[I_WFI]; sd.dst = a.ws; sd.cm = (unsigned*)(a.ws + WS_CMAX); sd.ld = 0; sd.ldt = 0; sd.cs = 3;
#endif
    for (int ci = 0; ci < SC_NCH; ++ci) {
        int idx, chunk; scan_locate(gid, ci, idx, chunk); const ScanChain c = scan_chain(gid, idx);
        const size_t sbase = (size_t)((c.b * 2 + c.dir) * 32 + c.h) * 4096 + (size_t)(16 * wq + 2 * rp) * 64 + 8 * kq;
        if (chunk == 0) {
            if (c.is_sample) {
#pragma unroll
                for (int rr = 0; rr < 2; ++rr) { const f32x4 s0 = *(const f32x4*)(a.in[I_STATE] + sbase + rr * 64), s1 = *(const f32x4*)(a.in[I_STATE] + sbase + rr * 64 + 4);
                    S[rr][0] = s0.x; S[rr][1] = s0.y; S[rr][2] = s0.z; S[rr][3] = s0.w; S[rr][4] = s1.x; S[rr][5] = s1.y; S[rr][6] = s1.z; S[rr][7] = s1.w; }
#pragma unroll
                for (int rr = 0; rr < 2; ++rr)
#pragma unroll
                    for (int j = 0; j < 8; ++j) asm volatile("" : "+v"(S[rr][j]));
            } else {
#pragma unroll
                for (int rr = 0; rr < 2; ++rr)
#pragma unroll
                    for (int j = 0; j < 8; ++j) S[rr][j] = 0.f;
            }
        }
        const LAS float* B = buf0 + (ci & 1) * SC_BUF_FLOATS;
        _Float16* yout = YS + (size_t)c.dir * T * DA + c.h * 64 + 16 * wq + 2 * rp;
        unsigned ypk[SC_TS];
#define SC_RD8(dst, off) do { const f32x4 lo_ = *(const LAS f32x4*)(O + (off) + 8 * kq), hi_ = *(const LAS f32x4*)(O + (off) + 8 * kq + 4); \
                dst[0] = lo_.x; dst[1] = lo_.y; dst[2] = lo_.z; dst[3] = lo_.w; dst[4] = hi_.x; dst[5] = hi_.y; dst[6] = hi_.z; dst[7] = hi_.w; \
                _Pragma("unroll") for (int j = 0; j < 8; ++j) asm("" : "+v"(dst[j])); } while (0)
#define SC_STEP(i) do { \
            const LAS float* O = B + (i) * 6 * 64; \
            float av[8], wv[8], bv[8], kv[8], rv[8], vv[2]; \
            SC_RD8(av, 0); SC_RD8(wv, 64); SC_RD8(bv, 128); SC_RD8(kv, 192); SC_RD8(rv, 256); \
            { const f32x2 v2 = *(const LAS f32x2*)(O + 320 + 16 * wq + 2 * rp); vv[0] = v2.x; vv[1] = v2.y; asm("" : "+v"(vv[0])); asm("" : "+v"(vv[1])); } \
            float sa[2], y[2]; \
            _Pragma("unroll") for (int rr = 0; rr < 2; ++rr) { float t = S[rr][0] * av[0]; \
                _Pragma("unroll") for (int j = 1; j < 8; ++j) t = __builtin_fmaf(S[rr][j], av[j], t); \
                sa[rr] = t; } \
            reduce2_oct(sa[0], sa[1]); \
            _Pragma("unroll") for (int rr = 0; rr < 2; ++rr) { \
                _Pragma("unroll") for (int j = 0; j < 8; ++j) { S[rr][j] = __builtin_fmaf(vv[rr], kv[j], __builtin_fmaf(S[rr][j], wv[j], sa[rr] * bv[j])); asm("" : "+v"(S[rr][j])); } \
                float t = S[rr][0] * rv[0]; \
                _Pragma("unroll") for (int j = 1; j < 8; ++j) t = __builtin_fmaf(S[rr][j], rv[j], t); \
                y[rr] = t; } \
            reduce2_oct(y[0], y[1]); \
            ypk[i] = pg8::pk_f16(y[0], y[1]); } while (0)
        SC_STEP(0); SC_STEP(1); SC_STEP(2); SC_STEP(3); SC_STEP(4); SC_STEP(5); SC_STEP(6); SC_STEP(7);
        {
            SC_STAGE(ci + 1, (ci + 1) & 1);
            SC_BON(ci + 1);
#if SIDE_IN_SCAN
            if constexpr (SIDE != 0) {
            if constexpr (SIDE == 1) side_consume(sd, lane, F.wave, SR, smx, ssc, PART);
            else { _Pragma("unroll") for (int j = 0; j < 8; ++j) { asm volatile("" :: "v"(SR[j])); } }
            side_pair_next(a, (int)blockIdx.x, F.wave, ci, sd);
            spa = side_issue_addr(sd, lane); sld = sd.ld;
            }
#endif
            SC_LOAD(ci + 2);
        }
#if SIDE_IN_SCAN
#define SC_SIDE_LOAD(j) do { if constexpr (SIDE != 0) { SR[j] = side_issue_one(spa, sld, j); __builtin_amdgcn_sched_barrier(0x38F); } } while (0)
#else
#define SC_SIDE_LOAD(j) do { } while (0)
#endif
        SC_STEP(8); SC_SIDE_LOAD(0); SC_STEP(9); SC_SIDE_LOAD(1); SC_STEP(10); SC_SIDE_LOAD(2); SC_STEP(11); SC_SIDE_LOAD(3); SC_STEP(12); SC_SIDE_LOAD(4); SC_STEP(13); SC_SIDE_LOAD(5); SC_STEP(14); SC_SIDE_LOAD(6); SC_STEP(15); SC_SIDE_LOAD(7);
#undef SC_SIDE_LOAD
#undef SC_STEP
#undef SC_RD8
        if (kq == 0) {
#pragma unroll
            for (int i = 0; i < SC_TS; ++i) { const int s = chunk * SC_TS + i; const int t = c.dir ? c.L - 1 - s : s;
                *(GAS unsigned*)(yout + (size_t)(c.row0 + t) * DA) = ypk[i]; }
        }
        if (!c.is_sample && chunk == (c.L / SC_TS) - 1) {
#pragma unroll
            for (int rr = 0; rr < 2; ++rr) { *(GAS f32x4*)(a.out + OUT_STATE + sbase + rr * 64) = (f32x4){S[rr][0], S[rr][1], S[rr][2], S[rr][3]};
                *(GAS f32x4*)(a.out + OUT_STATE + sbase + rr * 64 + 4) = (f32x4){S[rr][4], S[rr][5], S[rr][6], S[rr][7]}; }
        }
        asm volatile("s_waitcnt lgkmcnt(0)\n\ts_barrier" ::: "memory");
    }
    asm volatile("s_waitcnt vmcnt(0) lgkmcnt(0)" ::: "memory");
#undef SC_LOAD
#undef SC_STAGE
#undef SC_BON
}
__device__ __forceinline__ float bf2f(bf16 b) { return __builtin_bit_cast(float, (unsigned)b << 16); }
__device__ __forceinline__ bf16 f2bf_rne(float f) { return (bf16)(pg8::cvt_pk_bf16(f, 0.f) & 0xffffu); }
struct P5Task { unsigned short r0[16], r1[16], r2[16]; float w0, w1, w2, cs, sn, kx2; int pos, isq; size_t orow; };
__device__ __forceinline__ void p5_issue(const Args& a, int task, int lane, P5Task& X) {
    const unsigned short* Q = (const unsigned short*)(a.ws + WS_Q); const unsigned short* KV = (const unsigned short*)(a.ws + WS_KV); const float* KPE = (const float*)(a.ws + WS_KPE);
    const float* COS = (const float*)(a.ws + WS_COS); const float* SIN = (const float*)(a.ws + WS_SIN);
    const bool isq = task < T; int pos = -1; const float* kpe = KPE; size_t qrow = 0, kvrow = 0;
    if (isq) { qrow = task; if (task >= T_P) pos = (task - T_P) & 1023; }
    else { kvrow = task - T;
        if (kvrow < (size_t)T_P) kpe = KPE + kvrow * 64;
        else { const int r = (int)kvrow - T_P, b = r / 1536, p = r % 1536;
            if (p < 512) kpe = a.in[I_CKPE] + (size_t)(b * 512 + p) * 64; else { pos = p - 512; kpe = KPE + (size_t)(T_P + b * 1024 + pos) * 64; } } }
    const float* hn = isq ? a.in[I_QHN] : a.in[I_KHN];
    X.w0 = hn[lane]; X.w1 = hn[64 + lane]; X.w2 = hn[128 + lane];
    X.cs = 1.f; X.sn = 0.f; if (pos >= 0) { X.cs = COS[pos * 32 + (lane & 31)]; X.sn = SIN[pos * 32 + (lane & 31)]; }
    X.kx2 = isq ? 0.f : kpe[lane]; X.pos = pos; X.isq = isq ? 1 : 0; X.orow = isq ? qrow : kvrow;
    if (isq) { const unsigned short* p = Q + qrow * 3072;
#pragma unroll
        for (int h = 0; h < 16; ++h) { X.r0[h] = p[h * 192 + lane]; X.r1[h] = p[h * 192 + 64 + lane]; X.r2[h] = p[h * 192 + 128 + lane]; } }
    else { const unsigned short* p = KV + kvrow * 4096;
#pragma unroll
        for (int h = 0; h < 16; ++h) { X.r0[h] = p[h * 256 + lane]; X.r1[h] = p[h * 256 + 64 + lane]; X.r2[h] = 0; } }
}
__device__ __forceinline__ void p5_qkprep(const Args& a, Frame& F) {
    unsigned short* Q = (unsigned short*)(a.ws + WS_Q); unsigned short* KP = (unsigned short*)(a.ws + WS_KP);
    const int lane = F.lane; constexpr int NTASK = T + KVROWS;
    P5Task A;
    if (F.gw < NTASK) p5_issue(a, F.gw, lane, A);
    for (int task = F.gw; task < NTASK; task += F.ngw) {
        P5Task B = A;
        if (task + F.ngw < NTASK) p5_issue(a, task + F.ngw, lane, B);
        unsigned short o0[16], o1[16], o2[16];
#pragma unroll
        for (int h = 0; h < 16; ++h) {
            const float x0 = bf2f((bf16)A.r0[h]), x1 = bf2f((bf16)A.r1[h]), x2 = A.isq ? bf2f((bf16)A.r2[h]) : A.kx2;
            const float rs = 1.0f / sqrtf(wave_sum_u(x0 * x0 + x1 * x1 + x2 * x2) * (1.0f / 192.0f) + NORM_EPS);
            const float y0 = x0 * rs * A.w0, y1 = x1 * rs * A.w1; float y2 = x2 * rs * A.w2;
            if (A.pos >= 0) { const float pr = __shfl_xor(y2, 32); y2 = (lane < 32) ? y2 * A.cs - pr * A.sn : pr * A.sn + y2 * A.cs; }
            o0[h] = (unsigned short)f2bf_rne(y0); o1[h] = (unsigned short)f2bf_rne(y1); o2[h] = (unsigned short)f2bf_rne(y2);
        }
        { unsigned short* o = (A.isq ? Q : KP) + A.orow * 3072;
#pragma unroll
            for (int h = 0; h < 16; ++h) { o[h * 192 + lane] = o0[h]; o[h * 192 + 64 + lane] = o1[h]; o[h * 192 + 128 + lane] = o2[h]; } }
        A = B;
    }
}

namespace attn {
using bf16x8 = __attribute__((ext_vector_type(8))) short;
using s16x4  = __attribute__((ext_vector_type(4))) short;
using f32x16 = __attribute__((ext_vector_type(16))) float;
using u32x4  = __attribute__((ext_vector_type(4))) unsigned;
constexpr int DQK = 192, DV = 128, NW = 8, QBLK = 32, KVBLK = 64;
constexpr int LDQ = 3072, LDK = 3072, LDV = 4096, LDO = 2048;
constexpr float SCALE = 0.07216878364870322f;
constexpr float THR = 8.f;
constexpr size_t SHM_V = KVBLK * DV * 2, SHM_K = KVBLK * DQK * 2, SHM_ATTN = 2 * SHM_V + 2 * SHM_K + NW * 64 * 4;
#define KSWZ(row, colB) ((row) * 384 + ((colB) ^ (((row) & 7) << 4)))
#define SBAR() __builtin_amdgcn_sched_barrier(0)
__device__ __forceinline__ int crow(int r, int hi) { return (r & 3) + 8 * (r >> 2) + 4 * hi; }
__device__ __forceinline__ unsigned cvtpk(float lo, float hi) { return pg8::cvt_pk_bf16(lo, hi); }

__device__ __forceinline__ void partialSM(f32x16& p0, f32x16& p1, float& m_reg, float& mn, float& alpha) {
  constexpr float C = SCALE * 1.4426950408889634f;
  float pmax = p0[0];
#pragma unroll
  for (int r = 1; r < 16; ++r) pmax = fmaxf(pmax, p0[r]);
#pragma unroll
  for (int r = 0; r < 16; ++r) pmax = fmaxf(pmax, p1[r]);
  { auto rr = __builtin_amdgcn_permlane32_swap(__float_as_uint(pmax), __float_as_uint(pmax), false, false);
    pmax = fmaxf(__uint_as_float(rr[0]), __uint_as_float(rr[1])); }
  if (__builtin_expect(__all(pmax - m_reg <= THR / SCALE), 1)) { mn = m_reg; alpha = 1.f; }
  else { mn = fmaxf(m_reg, pmax); alpha = __builtin_amdgcn_exp2f((m_reg - mn) * C); m_reg = mn; }
  float mnC = -mn * C;
#pragma unroll
  for (int r = 0; r < 16; ++r) p0[r] = fmaf(p0[r], C, mnC);
#pragma unroll
  for (int r = 0; r < 16; ++r) p1[r] = fmaf(p1[r], C, mnC);
#pragma unroll
  for (int r = 0; r < 16; ++r) p0[r] = __builtin_amdgcn_exp2f(p0[r]);
}
__device__ __forceinline__ void finishSM(f32x16& p0, f32x16& p1, float alpha, float& l_reg, bf16x8& pa0, bf16x8& pa1, bf16x8& pa2, bf16x8& pa3) {
#pragma unroll
  for (int r = 0; r < 16; ++r) p1[r] = __builtin_amdgcn_exp2f(p1[r]);
  float ps = 0;
#pragma unroll
  for (int r = 0; r < 16; ++r) ps += p0[r];
#pragma unroll
  for (int r = 0; r < 16; ++r) ps += p1[r];
  { auto rr = __builtin_amdgcn_permlane32_swap(__float_as_uint(ps), __float_as_uint(ps), false, false);
    ps = __uint_as_float(rr[0]) + __uint_as_float(rr[1]); }
  l_reg = l_reg * alpha + ps;
#define PK4(P, BASE, OUT) do { unsigned a0 = cvtpk(P[BASE + 0], P[BASE + 1]), a1 = cvtpk(P[BASE + 2], P[BASE + 3]);   \
    unsigned b0 = cvtpk(P[BASE + 4], P[BASE + 5]), b1 = cvtpk(P[BASE + 6], P[BASE + 7]);                              \
    auto r0 = __builtin_amdgcn_permlane32_swap(a0, b0, false, false); auto r1 = __builtin_amdgcn_permlane32_swap(a1, b1, false, false); \
    u32x4 w = {r0[0], r1[0], r0[1], r1[1]}; OUT = *reinterpret_cast<bf16x8*>(&w); } while (0)
  PK4(p0, 0, pa0); PK4(p0, 8, pa1); PK4(p1, 0, pa2); PK4(p1, 8, pa3);
#undef PK4
}
__device__ __forceinline__ void qkt(f32x16& p0, f32x16& p1, const char* Ks, const bf16x8* qr, int r32, int hi) {
  p0 = f32x16{}; p1 = f32x16{};
#pragma unroll
  for (int d0 = 0; d0 < 12; ++d0) { int cb = (d0 * 16 + hi * 8) * 2;
    bf16x8 b0 = *reinterpret_cast<const bf16x8*>(Ks + KSWZ(r32, cb));
    bf16x8 b1 = *reinterpret_cast<const bf16x8*>(Ks + KSWZ(32 + r32, cb));
    p0 = __builtin_amdgcn_mfma_f32_32x32x16_bf16(b0, qr[d0], p0, 0, 0, 0);
    p1 = __builtin_amdgcn_mfma_f32_32x32x16_bf16(b1, qr[d0], p1, 0, 0, 0); }
}
__device__ __forceinline__ int v_st(int k, int c) { const int kk = (k & ~0xC) | ((k & 4) << 1) | ((k & 8) >> 1); return ((kk >> 3) * 4 + (c >> 5)) * 512 + ((kk & 7) * 32 + (c & 31)) * 2; }
__device__ __forceinline__ int v_rd_base(int lane) { return ((lane & 3) << 3) | (((lane >> 2) & 3) << 6) | (((lane >> 4) & 1) << 5) | (((lane >> 5) & 1) << 8); }
constexpr int v_rd_off(int d0, int ks, int half) { return d0 * 512 + ks * 4096 + half * 2048; }
template <int OFF> __device__ __forceinline__ s16x4 tr_read(int vb) {
  s16x4 r; asm volatile("ds_read_b64_tr_b16 %0, %1 offset:%2" : "=&v"(r) : "v"(vb), "i"(OFF) : "memory"); return r;
}
template <int D0> __device__ __forceinline__ void pv_one(f32x16& od, int vb, bf16x8 pa0, bf16x8 pa1, bf16x8 pa2, bf16x8 pa3) {
#define PK(L, H) (bf16x8){L[0], L[1], L[2], L[3], H[0], H[1], H[2], H[3]}
  { const s16x4 l0 = tr_read<v_rd_off(D0, 0, 0)>(vb), h0 = tr_read<v_rd_off(D0, 0, 1)>(vb), l1 = tr_read<v_rd_off(D0, 1, 0)>(vb), h1 = tr_read<v_rd_off(D0, 1, 1)>(vb);
    asm volatile("s_waitcnt lgkmcnt(0)" ::: "memory"); SBAR();
    od = __builtin_amdgcn_mfma_f32_32x32x16_bf16(pa0, PK(l0, h0), od, 0, 0, 0);
    od = __builtin_amdgcn_mfma_f32_32x32x16_bf16(pa1, PK(l1, h1), od, 0, 0, 0); }
  { const s16x4 l2 = tr_read<v_rd_off(D0, 2, 0)>(vb), h2 = tr_read<v_rd_off(D0, 2, 1)>(vb), l3 = tr_read<v_rd_off(D0, 3, 0)>(vb), h3 = tr_read<v_rd_off(D0, 3, 1)>(vb);
    asm volatile("s_waitcnt lgkmcnt(0)" ::: "memory"); SBAR();
    od = __builtin_amdgcn_mfma_f32_32x32x16_bf16(pa2, PK(l2, h2), od, 0, 0, 0);
    od = __builtin_amdgcn_mfma_f32_32x32x16_bf16(pa3, PK(l3, h3), od, 0, 0, 0); }
#undef PK
}
__device__ __forceinline__ void pv_d0(f32x16* o, int vb, bf16x8 pa0, bf16x8 pa1, bf16x8 pa2, bf16x8 pa3) {
  pv_one<0>(o[0], vb, pa0, pa1, pa2, pa3); pv_one<1>(o[1], vb, pa0, pa1, pa2, pa3); pv_one<2>(o[2], vb, pa0, pa1, pa2, pa3); pv_one<3>(o[3], vb, pa0, pa1, pa2, pa3);
}

__device__ __forceinline__ void attn_dense_body(const bf16* __restrict__ Qb, const bf16* __restrict__ Kh, const bf16* __restrict__ Vh, bf16* __restrict__ Ob, int seq, char* lds) {
  int tid_ = threadIdx.x; asm volatile("" : "+v"(tid_));
  const int tid = tid_, wid = __builtin_amdgcn_readfirstlane(tid >> 6), lane = tid & 63, r32 = lane & 31, hi = lane >> 5;
  char* V_lds = lds; char* K_lds = lds + 2 * SHM_V;
  float* ws = (float*)(lds + 2 * SHM_V + 2 * SHM_K) + wid * 64; float* li_l = ws; float* al_l = ws + 32;
  float m_reg = -1e30f, l_reg = 0; f32x16 o[4] = {}; bf16x8 qr[12];
  const bf16* Qw = Qb + (long)(wid * QBLK + r32) * LDQ + hi * 8;
#pragma unroll
  for (int d0 = 0; d0 < 12; ++d0) qr[d0] = *reinterpret_cast<const bf16x8*>(Qw + d0 * 16);
  const int sr = tid >> 4, sc = (tid & 15) * 8, vst0 = v_st(sr, sc), vst1 = v_st(32 + sr, sc);
  const int kr2 = tid >> 3, kc2 = 128 + (tid & 7) * 8;
  const int vb0 = (int)(uintptr_t)V_lds + v_rd_base(lane);
  bf16x8 vs0, vs1, ks0, ks1, ks2;
  const unsigned ovs0 = (unsigned)(sr * LDV + sc) * 2u, ovs1 = (unsigned)((32 + sr) * LDV + sc) * 2u, oks0 = (unsigned)(sr * LDK + sc) * 2u, oks1 = (unsigned)((32 + sr) * LDK + sc) * 2u, oks2 = (unsigned)(kr2 * LDK + kc2) * 2u;
#define SLOAD(k0) do { const char* vt_ = (const char*)Vh + (size_t)(k0) * (LDV * 2); const char* kt_ = (const char*)Kh + (size_t)(k0) * (LDK * 2); \
    vs0 = *reinterpret_cast<const bf16x8*>(vt_ + ovs0); vs1 = *reinterpret_cast<const bf16x8*>(vt_ + ovs1); \
    ks0 = *reinterpret_cast<const bf16x8*>(kt_ + oks0); ks1 = *reinterpret_cast<const bf16x8*>(kt_ + oks1); ks2 = *reinterpret_cast<const bf16x8*>(kt_ + oks2); } while (0)
#define SWRITE(b) do { *(bf16x8*)(V_lds + (b) * SHM_V + vst0) = vs0; *(bf16x8*)(V_lds + (b) * SHM_V + vst1) = vs1; \
    *(bf16x8*)(K_lds + (b) * SHM_K + KSWZ(sr, sc * 2)) = ks0; *(bf16x8*)(K_lds + (b) * SHM_K + KSWZ(32 + sr, sc * 2)) = ks1; \
    *(bf16x8*)(K_lds + (b) * SHM_K + KSWZ(kr2, kc2 * 2)) = ks2; } while (0)
#define RESC(a) do { if (__any((a) < 1.f)) { if (hi == 0) al_l[r32] = (a); asm volatile("s_waitcnt lgkmcnt(0)" ::: "memory"); \
    _Pragma("unroll") for (int d = 0; d < 4; ++d) _Pragma("unroll") for (int r = 0; r < 16; ++r) o[d][r] *= al_l[crow(r, hi)]; } } while (0)
  f32x16 p0, p1; float mn, al; bf16x8 pa0, pa1, pa2, pa3; const int NT = seq / KVBLK;
  SLOAD(0); asm volatile("s_waitcnt vmcnt(0)" ::: "memory"); SWRITE(0); __syncthreads();
  SLOAD(KVBLK);
  for (int j = 0; j < NT; ++j) {
    const int bsel = j & 1;
    SBAR(); qkt(p0, p1, K_lds + bsel * SHM_K, qr, r32, hi);
    partialSM(p0, p1, m_reg, mn, al); finishSM(p0, p1, al, l_reg, pa0, pa1, pa2, pa3); SBAR();
    RESC(al);
    if (j + 1 < NT) { asm volatile("s_waitcnt vmcnt(0)" ::: "memory"); SWRITE(bsel ^ 1); }
    if (j + 2 < NT) SLOAD((j + 2) * KVBLK);
    SBAR(); pv_d0(o, vb0 + bsel * (int)SHM_V, pa0, pa1, pa2, pa3);
    __syncthreads();
  }
  if (hi == 0) li_l[r32] = l_reg; asm volatile("s_waitcnt lgkmcnt(0)" ::: "memory");
  float rli[16];
#pragma unroll
  for (int r = 0; r < 16; ++r) rli[r] = __builtin_amdgcn_rcpf(li_l[crow(r, hi)]);
  bf16* Ow = Ob + (long)(wid * QBLK) * LDO;
#pragma unroll
  for (int r = 0; r < 16; ++r) { int orow = crow(r, hi);
#pragma unroll
    for (int d0 = 0; d0 < 4; ++d0) Ow[(long)orow * LDO + d0 * 32 + r32] = (bf16)(cvtpk(o[d0][r] * rli[r], 0.f) & 0xffffu); }
  __syncthreads();
#undef SLOAD
#undef SWRITE
#undef RESC
}
#undef KSWZ
#undef SBAR
}

__device__ __forceinline__ void p6_attention(const Args& a, Frame& F) {
    const bf16* QP = (const bf16*)(a.ws + WS_Q); const bf16* KP = (const bf16*)(a.ws + WS_KP); const bf16* KV = (const bf16*)(a.ws + WS_KV); bf16* YB = (bf16*)(a.ws + WS_YB);
    char* lds = (char*)(unsigned char*)F.lds;
    for (int u = blockIdx.x; u < 256; u += F.G) {
        const int b = u >> 6, h = (u >> 2) & 15, qb = u & 3; const size_t row0 = (size_t)T_P + b * 1024 + qb * 256, kv0 = (size_t)T_P + b * 1536;
        attn::attn_dense_body(QP + row0 * 3072 + h * 192, KP + kv0 * 3072 + h * 192, KV + kv0 * 4096 + h * 256 + 128, YB + row0 * 2048 + h * 128, 1536, lds);
    }
    for (int u = blockIdx.x; u < 512; u += F.G) {
        const int b = u >> 4, h = u & 15; const size_t row0 = (size_t)b * 256;
        attn::attn_dense_body(QP + row0 * 3072 + h * 192, KP + row0 * 3072 + h * 192, KV + row0 * 4096 + h * 256 + 128, YB + row0 * 2048 + h * 128, 256, lds);
    }
}

__device__ __forceinline__ float grp16_sum(float v) { v += __shfl_xor(v, 1); v += __shfl_xor(v, 2); v += __shfl_xor(v, 4); v += __shfl_xor(v, 8); return v; }
#ifndef P7_NOLN
#define P7_NOLN 0
#endif
#ifndef P7_TRIVIAL
#define P7_TRIVIAL 0
#endif
__device__ __forceinline__ void p7_postscan(const Args& a, Frame& F) {
    const unsigned short* YS = (const unsigned short*)(a.ws + WS_YS); const float* BON = (const float*)(a.ws + WS_BON); const unsigned short* RKV = (const unsigned short*)(a.ws + WS_RKV);
    const bf16* G = (const bf16*)(a.ws + WS_G); unsigned char* YA = (unsigned char*)(a.ws + WS_YA); float* ROWS = (float*)(a.ws + WS_ROWSYA); const float* lnw = a.in[I_LNW]; const float* lnb = a.in[I_LNB];
    for (int row = F.gw; row < T; row += F.ngw) {
        v2u ybw[8];
#pragma unroll
        for (int p = 0; p < 8; ++p) ybw[p] = *(const GAS v2u*)((const unsigned short*)(a.ws + WS_YB) + (size_t)row * DA + p * 256 + F.lane * 4);
        float ov[8][4]; float mx = 0.f;
#pragma unroll
        for (int p = 0; p < 8; ++p) { const int c = p * 256 + F.lane * 4, h = c >> 6;
            const v2u yf = *(const GAS v2u*)(YS + (size_t)row * DA + c), yb = *(const GAS v2u*)(YS + ((size_t)T + row) * DA + c), vv = *(const GAS v2u*)(RKV + (size_t)row * 6144 + 4096 + c), gg = *(const GAS v2u*)(G + (size_t)row * DA + c);
            const float bon = BON[(size_t)row * 32 + h] + BON[((size_t)T + row) * 32 + h];
            float y[4], v[4], g[4];
            y[0] = h2f(yf.x & 0xffff) + h2f(yb.x & 0xffff); y[1] = h2f(yf.x >> 16) + h2f(yb.x >> 16); y[2] = h2f(yf.y & 0xffff) + h2f(yb.y & 0xffff); y[3] = h2f(yf.y >> 16) + h2f(yb.y >> 16);
            v[0] = h2f(vv.x & 0xffff); v[1] = h2f(vv.x >> 16); v[2] = h2f(vv.y & 0xffff); v[3] = h2f(vv.y >> 16);
            g[0] = pg8::bflo(gg.x); g[1] = pg8::bfhi(gg.x); g[2] = pg8::bflo(gg.y); g[3] = pg8::bfhi(gg.y);
            const float mu = row16_sum((y[0] + y[1]) + (y[2] + y[3])) * (1.0f / 64.0f);
            float d[4]; float q = 0.f;
#pragma unroll
            for (int i = 0; i < 4; ++i) { d[i] = y[i] - mu; q += d[i] * d[i]; }
            const float rstd = 1.0f / sqrtf(row16_sum(q) * (1.0f / 64.0f) + 64e-5f);
            const f32x4 w4 = *(const f32x4*)(lnw + c), b4 = *(const f32x4*)(lnb + c);
#pragma unroll
            for (int i = 0; i < 4; ++i) { ov[p][i] = (d[i] * rstd * w4[i] + b4[i] + bon * v[i]) * g[i]; mx = fmaxf(mx, fabsf(ov[p][i])); } }
        mx = wave_max_d(mx);
        const float qs = mx > 0.f ? 127.0f / mx : 0.f;
        if (F.lane == 0) ROWS[row] = mx * (1.0f / 127.0f);
#pragma unroll
        for (int p = 0; p < 8; ++p) { const int c = p * 256 + F.lane * 4;
            *(GAS unsigned*)(YA + (size_t)row * DA + c) = (unsigned)q8(ov[p][0] * qs) | ((unsigned)q8(ov[p][1] * qs) << 8) | ((unsigned)q8(ov[p][2] * qs) << 16) | ((unsigned)q8(ov[p][3] * qs) << 24); }
        {
            const unsigned short* YBr = (const unsigned short*)(a.ws + WS_YB) + (size_t)row * DA; unsigned char* YB8 = (unsigned char*)(a.ws + WS_YB8) + (size_t)row * DA;
            float yv[8][4]; float mb = 0.f;
#pragma unroll
            for (int p = 0; p < 8; ++p) { const v2u t = ybw[p];
                yv[p][0] = pg8::bflo(t.x); yv[p][1] = pg8::bfhi(t.x); yv[p][2] = pg8::bflo(t.y); yv[p][3] = pg8::bfhi(t.y);
                mb = fmaxf(mb, fmaxf(fmaxf(fabsf(yv[p][0]), fabsf(yv[p][1])), fmaxf(fabsf(yv[p][2]), fabsf(yv[p][3])))); }
            mb = wave_max_d(mb);
            const float qb = mb > 0.f ? 127.0f / mb : 0.f;
            if (F.lane == 0) ((float*)(a.ws + WS_ROWSYB))[row] = mb * (1.0f / 127.0f);
#pragma unroll
            for (int p = 0; p < 8; ++p)
                *(GAS unsigned*)(YB8 + p * 256 + F.lane * 4) = (unsigned)q8(yv[p][0] * qb) | ((unsigned)q8(yv[p][1] * qb) << 8) | ((unsigned)q8(yv[p][2] * qb) << 16) | ((unsigned)q8(yv[p][3] * qb) << 24);
        }
    }
}
#ifndef MK_PER_PHASE
#define MK_PER_PHASE 0
#endif
constexpr int N_PHASES = 14;
__global__ void __launch_bounds__(NWAVES * 64, 2) fwd_kernel(Args args) {
    extern __shared__ __attribute__((aligned(16))) unsigned char lds[];
    Frame F;
    F.lds = (LAS unsigned char*)lds; F.MISC = (volatile LAS unsigned*)(F.lds + MISC_OFF);
    F.tid = threadIdx.x; F.lane = F.tid & 63; F.wave = __builtin_amdgcn_readfirstlane(F.tid >> 6);
    F.G = gridDim.x; F.gw = blockIdx.x * NWAVES + F.wave; F.ngw = F.G * NWAVES;
    unsigned char* ws = args.ws; F.ctl = (gu32*)(ws + WS_CTL);
    for (int u = F.tid; u < (LDS_BYTES - LDSCTL_OFF) / 4; u += NWAVES * 64) ((LAS unsigned*)(F.lds + LDSCTL_OFF))[u] = 0u;
    __syncthreads();
    const int lo = args.ph_lo, hi = args.ph_hi;
    XcdBarrier bar; bar.bar = (unsigned*)(F.ctl + CW_BAR); bar.x = 0; bar.st = nullptr;
    if (hi - lo > 1) bar = xcd_barrier_post((unsigned*)(F.ctl + CW_BAR), F.MISC + 8);
#ifndef P4_MASK
#define P4_MASK 15
#endif
#ifndef PH_MASK
#define PH_MASK 0xFFFFFFFFu
#endif
#define IN(k) (((PH_MASK >> (k)) & 1u) && lo <= (k) && (k) < hi)
#define SEAM(k) do { if (IN(k) && IN((k) + 1)) xcd_barrier(bar); } while (0)
    LAS unsigned char* ring = F.lds + RING_OFF;
    float* MOD = (float*)(ws + WS_MOD);

    if (IN(0)) { p0_adaln(args, F); p0_colmax(args, F); p0_weights(args, F); p0_rope(args, F); }
    SEAM(0);
    if (IN(1)) {
        Frame F2 = F; F2.gw = (int)blockIdx.x * 4 + (F.wave & 3); F2.ngw = F.G * 4;
        if (F.wave < 4) modnorm_rows_dual(F2, args.in[I_XP], args.in[I_XS], args.in[I_NMIX], MOD, 0, (bf16*)(ws + WS_HB), (unsigned char*)(ws + WS_H1Q), (float*)(ws + WS_ROWS1));
        else p1_weights_i8(args, F2); }
    SEAM(1);
    if (IN(2)) {
        {
            int k8 = DM / 2; asm volatile("" : "+s"(k8));
            pg8::Gemm g{(const pg8::bf16_t*)(ws + WS_H1Q), (const pg8::bf16_t*)(ws + WS_WING8 + (size_t)8192 * DM), T, 3584, k8}; pg8::StaticOrder S; S.init(T, 3584, F.G, (int)blockIdx.x);
            pg8::EpiGate8 E{(unsigned char*)(ws + WS_GA), (unsigned char*)(ws + WS_GB), (const float*)(ws + WS_ROWS1), (const unsigned*)(ws + WS_CMAXG), (pg8::f16_t*)(ws + WS_RKV), (pg8::bf16_t*)(ws + WS_LG), (float*)(ws + WS_QLAT), 32};
            pg8::gemm_phase<pg8::EpiGate8, pg8::StaticOrder, true, true, 2>(ring, g, S, E); }
        {
            pg8::Gemm g{(const pg8::bf16_t*)(ws + WS_HB), (const pg8::bf16_t*)(ws + WS_WIN), T, NIN16, DM}; pg8::StaticOrder S; S.init(T, NIN16, F.G, (int)blockIdx.x);
            pg8::EpiIn E{(pg8::f16_t*)(ws + WS_RKV), (pg8::bf16_t*)(ws + WS_LWA), (pg8::bf16_t*)(ws + WS_LG), (float*)(ws + WS_QLAT), (float*)(ws + WS_KVLAT), (float*)(ws + WS_KPE), (pg8::bf16_t*)(ws + WS_GA), (pg8::bf16_t*)(ws + WS_GB)};
            pg8::gemm_phase<pg8::EpiIn, pg8::StaticOrder, true, true>(ring, g, S, E); }
    }
    SEAM(2);
    if (IN(3)) { p3_post(args, F); }
    SEAM(3);
    if (IN(4)) {
        if (P4_MASK & 1) { int kl = 256; asm volatile("" : "+s"(kl));
          pg8::Gemm g{(const pg8::bf16_t*)(ws + WS_LWA), (const pg8::bf16_t*)(ws + WS_WLORA), 2 * T, 8192, kl}; pg8::BatchedOrder S; S.init(T / 256, 16, 2, F.G, (int)blockIdx.x);
          pg8::EpiLora E{(unsigned char*)(ws + WS_EW), (const float*)(ws + WS_LBIAS)};
          pg8::gemm_phase<pg8::EpiLora, pg8::BatchedOrder, true, true>(ring, g, S, E); }
        if (P4_MASK & 2) { int kg = 512; asm volatile("" : "+s"(kg));
          pg8::Gemm g{(const pg8::bf16_t*)(ws + WS_LG), (const pg8::bf16_t*)(ws + WS_WG), T, DA, kg}; pg8::StaticOrder S; S.init(T, DA, F.G, (int)blockIdx.x);
          pg8::EpiPlain E{(pg8::bf16_t*)(ws + WS_G), DA};
          pg8::gemm_phase<pg8::EpiPlain, pg8::StaticOrder, true, true>(ring, g, S, E); }
        if (P4_MASK & 4) { int kq = QL / 2; asm volatile("" : "+s"(kq));
          pg8::Gemm g{(const pg8::bf16_t*)(ws + WS_QN), (const pg8::bf16_t*)(ws + WS_WUQ), T, 3072, kq}; pg8::StaticOrder S; S.init(T, 3072, F.G, (int)blockIdx.x, 128);
          pg8::EpiPlainI8 E{(pg8::bf16_t*)(ws + WS_Q), 3072, (const float*)(ws + WS_ROWSQ), (const unsigned*)(ws + WS_CMAXUQ)};
          pg8::gemm_phase<pg8::EpiPlainI8, pg8::StaticOrder, true, true, 2>(ring, g, S, E); }
        if (P4_MASK & 8) { int kk = KVL / 2; asm volatile("" : "+s"(kk));
          pg8::Gemm g{(const pg8::bf16_t*)(ws + WS_CKVA), (const pg8::bf16_t*)(ws + WS_WUKV), KVROWS, 4096, kk}; pg8::StaticOrder S; S.init(KVROWS, 4096, F.G, (int)blockIdx.x, 64);
          pg8::EpiPlainI8 E{(pg8::bf16_t*)(ws + WS_KV), 4096, (const float*)(ws + WS_ROWSKV), (const unsigned*)(ws + WS_CMAXUKV)};
          pg8::gemm_phase<pg8::EpiPlainI8, pg8::StaticOrder, true, true, 2>(ring, g, S, E); }
    }
    SEAM(4);
    if (IN(5)) { p5_qkprep(args, F); }
    SEAM(5);
    if (IN(6)) { p5_scan(args, F); __syncthreads(); p6_attention(args, F); }
    SEAM(6);
    if (IN(7)) { p7_postscan(args, F); }
    SEAM(7);
    if (IN(8)) {
#pragma unroll
        for (int gb = 0; gb < 2; ++gb) {
            int k8 = DM / 2; asm volatile("" : "+s"(k8));
            pg8::Gemm g{(const pg8::bf16_t*)(ws + WS_H1Q), (const pg8::bf16_t*)(ws + WS_WGATE8 + (size_t)gb * 4096 * DM), T, DM, k8}; pg8::StaticOrder S; S.init(T, DM, F.G, (int)blockIdx.x);
            pg8::EpiGate8 E{(unsigned char*)(ws + WS_GA), (unsigned char*)(ws + WS_GB), (const float*)(ws + WS_ROWS1), (const unsigned*)(ws + WS_CMAXG), (pg8::f16_t*)(ws + WS_RKV), (pg8::bf16_t*)(ws + WS_LG), (float*)(ws + WS_QLAT), 16 * gb};
            pg8::gemm_phase<pg8::EpiGate8, pg8::StaticOrder, true, true, 2>(ring, g, S, E); }
        asm volatile("s_waitcnt vmcnt(0)" ::: "memory"); __syncthreads();
        { int k8 = DA / 2; asm volatile("" : "+s"(k8));
          pg8::Gemm g{(const pg8::bf16_t*)(ws + WS_YA), (const pg8::bf16_t*)(ws + WS_WOR), T, DM, k8}; pg8::StaticOrder S; S.init(T, DM, F.G, (int)blockIdx.x);
          pg8::EpiMix1I8 E{(const unsigned char*)(ws + WS_GA), (pg8::bf16_t*)(ws + WS_TMP), (const float*)(ws + WS_ROWSYA), (const unsigned*)(ws + WS_CMAXR)};
          pg8::gemm_phase<pg8::EpiMix1I8, pg8::StaticOrder, true, true, 2>(ring, g, S, E); }
        { int k8 = DA / 2; asm volatile("" : "+s"(k8));
          pg8::Gemm g{(const pg8::bf16_t*)(ws + WS_YB8), (const pg8::bf16_t*)(ws + WS_WOM), T, DM, k8}; pg8::StaticOrder S; S.init(T, DM, F.G, (int)blockIdx.x);
          pg8::EpiMix2I8 E{(const unsigned char*)(ws + WS_GB), (const pg8::bf16_t*)(ws + WS_TMP), (pg8::bf16_t*)(ws + WS_MIXED), (unsigned*)(ws + WS_RMAXM), (const float*)(ws + WS_ROWSYB), (const unsigned*)(ws + WS_CMAXM)};
          pg8::gemm_phase<pg8::EpiMix2I8, pg8::StaticOrder, true, true, 2>(ring, g, S, E); }
    }
    SEAM(8);
    if (IN(9)) { p8c_quant_mixed(args, F); }
    SEAM(9);
    if (IN(10)) {
        int k8 = DM / 2; asm volatile("" : "+s"(k8));
        pg8::Gemm g{(const pg8::bf16_t*)(ws + WS_MIX8), (const pg8::bf16_t*)(ws + WS_WOUT), T, DM, k8}; pg8::StaticOrder S; S.init(T, DM, F.G, (int)blockIdx.x);
        pg8::EpiResI8 E{args.in[I_XP], args.in[I_XS], (pg8::bf16_t*)(ws + WS_X1), MOD + 2 * DM, (const float*)(ws + WS_ROWSM), (const unsigned*)(ws + WS_CMAXO)};
        pg8::gemm_phase<pg8::EpiResI8, pg8::StaticOrder, true, true, 2>(ring, g, S, E);
    }
    SEAM(10);
    if (IN(11)) { modnorm_rows_i8(F, (const bf16*)(ws + WS_X1), args.in[I_NFFN], MOD, 3, (unsigned char*)(ws + WS_HB), (float*)(ws + WS_ROWS)); }
    SEAM(11);
    if (IN(12)) {
        int k8 = DM / 2; asm volatile("" : "+s"(k8));
        pg8::Gemm g{(const pg8::bf16_t*)(ws + WS_HB), (const pg8::bf16_t*)(ws + WS_WFI), T, 2 * DFF, k8}; pg8::StaticOrder S; S.init(T, 2 * DFF, F.G, (int)blockIdx.x);
        pg8::EpiSwigluI8 E{(unsigned char*)(ws + WS_ACT), (const float*)(ws + WS_ROWS), (const unsigned*)(ws + WS_CMAX)};
        pg8::gemm_phase<pg8::EpiSwigluI8, pg8::StaticOrder, true, true, 2>(ring, g, S, E);
    }
    SEAM(12);
    if (IN(13)) {
        int k8 = DFF / 2; asm volatile("" : "+s"(k8));
        pg8::Gemm g{(const pg8::bf16_t*)(ws + WS_ACT), (const pg8::bf16_t*)(ws + WS_WFO), T, DM, k8}; pg8::StaticOrder S; S.init(T, DM, F.G, (int)blockIdx.x);
        pg8::EpiRes E{(const pg8::bf16_t*)(ws + WS_X1), args.out, MOD + 5 * DM, 0.0078125f};
        pg8::gemm_phase<pg8::EpiRes, pg8::StaticOrder, true, true, 1>(ring, g, S, E);
    }
#undef IN
#undef SEAM
}

extern "C" void kernel_launch(void* const* d_in, const int* in_sizes, int n_in, void* d_out, int out_size, void* d_ws, size_t ws_size, hipStream_t stream) {
    static int grid = 0;
    if (grid == 0) {
        if (n_in != 33 || ws_size < WS_END) { fprintf(stderr, "kernel_launch: n_in %d ws %zu (need 33 inputs, >= %zu bytes)\n", n_in, ws_size, (size_t)WS_END); grid = -1; return; }
        if (hipFuncSetAttribute((const void*)fwd_kernel, hipFuncAttributeMaxDynamicSharedMemorySize, LDS_BYTES) != hipSuccess) { fprintf(stderr, "kernel_launch: hipFuncSetAttribute failed\n"); grid = -1; return; }
        int per_cu = 0;
        if (hipOccupancyMaxActiveBlocksPerMultiprocessor(&per_cu, (const void*)fwd_kernel, NWAVES * 64, LDS_BYTES) != hipSuccess || per_cu < 1) fprintf(stderr, "kernel_launch: occupancy query reports %d\n", per_cu);
        (void)hipGetLastError();
        grid = 256;
    }
    if (grid < 0) return;
    if (hipMemsetAsync((char*)d_ws + WS_CTL, 0, CTL_ZERO_BYTES, stream) != hipSuccess) return;
    Args a{};
    for (int i = 0; i < 33; ++i) a.in[i] = (const float*)d_in[i];
    a.out = (float*)d_out; a.ws = (unsigned char*)d_ws;
#if MK_PER_PHASE
    for (int p = 0; p < N_PHASES; ++p) { a.ph_lo = p; a.ph_hi = p + 1; hipLaunchKernelGGL(fwd_kernel, dim3(grid), dim3(NWAVES * 64), LDS_BYTES, stream, a); }
#else
    a.ph_lo = 0; a.ph_hi = N_PHASES; hipLaunchKernelGGL(fwd_kernel, dim3(grid), dim3(NWAVES * 64), LDS_BYTES, stream, a);
#endif
    const hipError_t le = hipPeekAtLastError();
    if (le != hipSuccess) fprintf(stderr, "kernel_launch: launch failed: %s\n", hipGetErrorName(le));
}
```

```cpp
#include <hip/hip_runtime.h>
#include <cstdio>
#include <cstdint>
namespace pg8 {
#define PG8_LAS __attribute__((address_space(3)))
typedef unsigned short bf16_t;
typedef short bf16x8 __attribute__((ext_vector_type(8)));
typedef float f32x4 __attribute__((ext_vector_type(4)));
typedef unsigned u32x4 __attribute__((ext_vector_type(4)));
constexpr int BM = 256, BK = 64, HALF = 128, HTB = HALF * BK * 2  , STAGE_BYTES = 8 * HTB, NXCD = 8, WGM = 8;

__host__ __device__ __forceinline__ int lds_byte(int r, int c) { const int st = (r >> 4) * 2 + (c >> 5), rr = r & 15, cc = c & 31, ob = rr * 64 + cc * 2; return st * 1024 + (ob ^ (((ob >> 9) & 1) << 5)); }
__host__ __device__ __forceinline__ void stage_rc(int b, int& R, int& C) { const int st = b / 1024, sb = b % 1024, swz = sb ^ (((sb >> 9) & 1) << 5); R = (st >> 1) * 16 + swz / 64; C = (st & 1) * 32 + (swz % 64) / 2; }
__host__ __device__ __forceinline__ int perm32(int rho) { const int n = rho >> 4, i = rho & 15; return 8 * (i >> 2) + 4 * n + (i & 3); }

struct Unit { int pm, pn; };
struct Gemm { const bf16_t* A; const bf16_t* Bt; int M, N, K; };

struct StaticOrder {
    int nM, nN, nwg, G, c;
    __host__ __device__ void init(int M, int N, int G_, int c_, int rot = 0) { nM = M / BM; nN = N / BM; nwg = nM * nN; G = G_; c = (c_ + rot) % G_; }
    __host__ __device__ bool next(int i, Unit& u) const {
        const long L = (long)i * G + c; if (L >= nwg) return false;
        int wgid = (int)L; { const int q = nwg / NXCD, r = nwg % NXCD, xcd = wgid % NXCD, off = wgid / NXCD; wgid = (xcd < r ? xcd * (q + 1) : r * (q + 1) + (xcd - r) * q) + off; }
        const int nig = WGM * nN, gid = wgid / nig, fm = gid * WGM, gsz = (nM - fm) < WGM ? (nM - fm) : WGM;
        u.pm = fm + ((wgid % nig) % gsz); u.pn = (wgid % nig) / gsz; return true;
    }
    __device__ __forceinline__ void a_ready(const Unit&) const {}
    __device__ __forceinline__ void done(const Unit&) const {}
};

typedef float cvt_f32x2_t __attribute__((ext_vector_type(2)));
typedef __bf16 cvt_bf16x2_t __attribute__((ext_vector_type(2)));
__device__ __forceinline__ unsigned cvt_pk_bf16(float lo, float hi) { cvt_f32x2_t v = {lo, hi}; cvt_bf16x2_t b = __builtin_convertvector(v, cvt_bf16x2_t); return __builtin_bit_cast(unsigned, b); }
typedef float f32x2 __attribute__((ext_vector_type(2)));
template <class Epi, class Sched, bool ALIGN_EPI = false, bool SP2 = false, int MODE = 0>
__device__ __forceinline__ void gemm_phase(PG8_LAS unsigned char* lds, const Gemm g, const Sched& S, const Epi& E) {
    int tid_o = threadIdx.x; asm volatile("" : "+v"(tid_o));
    const int tid = tid_o, wid = __builtin_amdgcn_readfirstlane(tid >> 6), lane = tid & 63, wr = wid >> 2, wc = wid & 3, fr = lane & 15, fq = lane >> 4;
    const int K = g.K, nt = K / BK;
    unsigned voffA[2], voffB[2];
#pragma unroll
    for (int i = 0; i < 2; ++i) { int R, C; stage_rc(tid * 16 + i * 8192, R, C); const int Rb = Epi::PERM ? ((R & ~31) + perm32(R & 31)) : R;
        voffA[i] = (unsigned)(R * K + C) * 2u; voffB[i] = (unsigned)(Rb * K + C) * 2u; }
    const size_t kstep = (size_t)(BK * 2);
    const size_t hstep = (size_t)HALF * K * 2;
    const size_t tstep = 2 * hstep;
    const unsigned ldsw = (unsigned)wid * 1024u;
    const int aoff = lds_byte(wr * 64 + fr, fq * 8), boff = lds_byte(wc * 32 + fr, fq * 8);
#define PG8_SA(b, h) (((b) * 2 + (h)) * HTB)
#define PG8_SB(b, h) ((4 + (b) * 2 + (h)) * HTB)
#define PG8_STAGE(bufoff, gbase, voff) do { _Pragma("unroll") for (int _i = 0; _i < 2; ++_i) \
        __builtin_amdgcn_global_load_lds((const unsigned*)((const char*)(gbase) + (voff)[_i]), (PG8_LAS unsigned*)(lds + (bufoff) + ldsw + _i * 8192), 16, 0, 0); } while (0)
#define PG8_LDA(dst, b, h) do { _Pragma("unroll") for (int m = 0; m < 4; ++m) { dst[m].lo = *(const PG8_LAS bf16x8*)(lds + PG8_SA(b, h) + aoff + m * 2048); dst[m].hi = *(const PG8_LAS bf16x8*)(lds + PG8_SA(b, h) + aoff + m * 2048 + 1024); } } while (0)
#define PG8_LDB(dst, b, h) do { _Pragma("unroll") for (int n = 0; n < 2; ++n) { dst[n].lo = *(const PG8_LAS bf16x8*)(lds + PG8_SB(b, h) + boff + n * 2048); dst[n].hi = *(const PG8_LAS bf16x8*)(lds + PG8_SB(b, h) + boff + n * 2048 + 1024); } } while (0)
#define PG8_MMA(ai, bj, At, Bt) do { __builtin_amdgcn_s_setprio(1); _Pragma("unroll") for (int m = 0; m < 4; ++m) _Pragma("unroll") for (int n = 0; n < 2; ++n) { \
        if constexpr (MODE == 1) { typedef int v8i_t __attribute__((ext_vector_type(8))); \
            asm("v_mfma_scale_f32_16x16x128_f8f6f4 %0, %1, %2, %0, %3, %3 op_sel_hi:[0,0,0]" : "+v"(acc[ai][bj][m][n]) : "v"(__builtin_bit_cast(v8i_t, Bt[n])), "v"(__builtin_bit_cast(v8i_t, At[m])), "v"(f8_unit_scale)); } \
        else if constexpr (MODE == 2) { typedef int v4i_t __attribute__((ext_vector_type(4))); \
            v4i_t c_ = __builtin_bit_cast(v4i_t, acc[ai][bj][m][n]); \
            const bf16x8 bl_ = Bt[n].lo, bh_ = Bt[n].hi, al_ = At[m].lo, ah_ = At[m].hi;     \
            c_ = __builtin_amdgcn_mfma_i32_16x16x64_i8(__builtin_bit_cast(v4i_t, bl_), __builtin_bit_cast(v4i_t, al_), c_, 0, 0, 0); \
            c_ = __builtin_amdgcn_mfma_i32_16x16x64_i8(__builtin_bit_cast(v4i_t, bh_), __builtin_bit_cast(v4i_t, ah_), c_, 0, 0, 0); \
            acc[ai][bj][m][n] = __builtin_bit_cast(f32x4, c_); } \
        else { acc[ai][bj][m][n] = __builtin_amdgcn_mfma_f32_16x16x32_bf16(Bt[n].lo, At[m].lo, acc[ai][bj][m][n], 0, 0, 0); \
               acc[ai][bj][m][n] = __builtin_amdgcn_mfma_f32_16x16x32_bf16(Bt[n].hi, At[m].hi, acc[ai][bj][m][n], 0, 0, 0); } } \
        __builtin_amdgcn_s_setprio(0); } while (0)
#define PG8_WAIT_V(n) asm volatile("s_waitcnt vmcnt(" #n ")" ::: "memory")
#define PG8_WAIT_L(n) asm volatile("s_waitcnt lgkmcnt(" #n ")" ::: "memory")
#define PG8_BAR __builtin_amdgcn_s_barrier()
#define PG8_SCHED __builtin_amdgcn_sched_barrier(0)
    Unit cur, nxt; int ui = 0;
    if (!S.next(0, cur)) return;
    f32x4 acc[2][2][4][2];
#pragma unroll
    for (int a = 0; a < 2; ++a)
#pragma unroll
        for (int b = 0; b < 2; ++b)
#pragma unroll
            for (int m = 0; m < 4; ++m)
#pragma unroll
                for (int n = 0; n < 2; ++n) acc[a][b][m][n] = (f32x4){0.f, 0.f, 0.f, 0.f};
    const int f8_unit_scale = 0x7F7F7F7F;
    typedef short bf16x16 __attribute__((ext_vector_type(16)));
    bf16x16 At[4], B0[2], B1[2];
    const char* cA = (const char*)g.A + (size_t)cur.pm * tstep; const char* cB = (const char*)g.Bt + (size_t)cur.pn * tstep;
    S.a_ready(cur);
    if constexpr (SP2) {
        PG8_STAGE(PG8_SB(0, 0), cB, voffB); PG8_STAGE(PG8_SB(0, 1), cB + hstep, voffB); PG8_STAGE(PG8_SA(0, 0), cA, voffA); PG8_STAGE(PG8_SA(0, 1), cA + hstep, voffA);
        if (wr == 1) PG8_BAR;
        PG8_WAIT_V(2); PG8_BAR;
        PG8_STAGE(PG8_SB(1, 0), cB + kstep, voffB); PG8_STAGE(PG8_SA(1, 0), cA + kstep, voffA); PG8_STAGE(PG8_SB(1, 1), cB + hstep + kstep, voffB);
        PG8_WAIT_V(6); PG8_BAR;
    } else {
        PG8_STAGE(PG8_SB(0, 0), cB, voffB); PG8_STAGE(PG8_SA(0, 0), cA, voffA); PG8_STAGE(PG8_SB(0, 1), cB + hstep, voffB); PG8_STAGE(PG8_SA(0, 1), cA + hstep, voffA);
        if (wr == 1) PG8_BAR;
        PG8_WAIT_V(4); PG8_BAR;
        PG8_STAGE(PG8_SB(1, 0), cB + kstep, voffB); PG8_STAGE(PG8_SA(1, 0), cA + kstep, voffA); PG8_STAGE(PG8_SB(1, 1), cB + hstep + kstep, voffB);
        PG8_WAIT_V(6); PG8_BAR;
    }
    for (;;) {
        const bool has_next = S.next(ui + 1, nxt);
        const char* nA = has_next ? (const char*)g.A + (size_t)nxt.pm * tstep : cA; const char* nB = has_next ? (const char*)g.Bt + (size_t)nxt.pn * tstep : cB;
        for (int t = 0; t < nt; t += 2) {
            const bool last = (t == nt - 2);
            const char* a1 = cA + (size_t)(t + 1) * kstep;
            const char* a2 = last ? nA : cA + (size_t)(t + 2) * kstep; const char* b2 = last ? nB : cB + (size_t)(t + 2) * kstep;
            const char* a3 = a2 + kstep; const char* b3 = b2 + kstep;
            if (last && has_next) S.a_ready(nxt);
            if constexpr (SP2) {
            PG8_LDB(B0, 0, 0); PG8_LDB(B1, 0, 1); PG8_SCHED; PG8_LDA(At, 0, 0); PG8_STAGE(PG8_SA(1, 1), a1 + hstep, voffA);
            PG8_WAIT_V(8); PG8_WAIT_L(0); PG8_BAR; PG8_MMA(0, 0, At, B0); PG8_MMA(0, 1, At, B1); PG8_BAR; PG8_SCHED;
            PG8_LDA(At, 0, 1); PG8_STAGE(PG8_SB(0, 0), b2, voffB); PG8_STAGE(PG8_SB(0, 1), b2 + hstep, voffB); PG8_STAGE(PG8_SA(0, 0), a2, voffA);
            PG8_WAIT_V(8); PG8_WAIT_L(0); PG8_BAR; PG8_MMA(1, 0, At, B0); PG8_MMA(1, 1, At, B1); PG8_BAR; PG8_SCHED;
            PG8_LDB(B0, 1, 0); PG8_LDB(B1, 1, 1); PG8_SCHED; PG8_LDA(At, 1, 0); PG8_STAGE(PG8_SA(0, 1), a2 + hstep, voffA);
            PG8_WAIT_V(8); PG8_WAIT_L(0); PG8_BAR; PG8_MMA(0, 0, At, B0); PG8_MMA(0, 1, At, B1); PG8_BAR; PG8_SCHED;
            PG8_LDA(At, 1, 1); PG8_STAGE(PG8_SB(1, 0), b3, voffB); PG8_STAGE(PG8_SB(1, 1), b3 + hstep, voffB); PG8_STAGE(PG8_SA(1, 0), a3, voffA);
            PG8_WAIT_V(8); PG8_WAIT_L(0); PG8_BAR; PG8_MMA(1, 0, At, B0); PG8_MMA(1, 1, At, B1); PG8_BAR; PG8_SCHED;
            } else {
            PG8_LDB(B0, 0, 0); PG8_SCHED; PG8_LDA(At, 0, 0); PG8_STAGE(PG8_SA(1, 1), a1 + hstep, voffA);
            PG8_WAIT_L(8); PG8_BAR; PG8_WAIT_L(0); PG8_MMA(0, 0, At, B0); PG8_BAR; PG8_SCHED;
            PG8_LDB(B1, 0, 1); PG8_STAGE(PG8_SB(0, 0), b2, voffB);
            PG8_BAR; PG8_WAIT_L(0); PG8_MMA(0, 1, At, B1); PG8_BAR;
            PG8_LDA(At, 0, 1); PG8_STAGE(PG8_SA(0, 0), a2, voffA);
            PG8_BAR; PG8_WAIT_L(0); PG8_MMA(1, 0, At, B0); PG8_BAR; PG8_SCHED;
            PG8_STAGE(PG8_SB(0, 1), b2 + hstep, voffB);
            PG8_WAIT_V(6); PG8_BAR; PG8_MMA(1, 1, At, B1); PG8_BAR;
            PG8_LDB(B0, 1, 0); PG8_SCHED; PG8_LDA(At, 1, 0); PG8_STAGE(PG8_SA(0, 1), a2 + hstep, voffA);
            PG8_WAIT_L(8); PG8_BAR; PG8_WAIT_L(0); PG8_MMA(0, 0, At, B0); PG8_BAR; PG8_SCHED;
            PG8_LDB(B1, 1, 1); PG8_STAGE(PG8_SB(1, 0), b3, voffB);
            PG8_BAR; PG8_WAIT_L(0); PG8_MMA(0, 1, At, B1); PG8_BAR;
            PG8_LDA(At, 1, 1); PG8_STAGE(PG8_SA(1, 0), a3, voffA);
            PG8_BAR; PG8_WAIT_L(0); PG8_MMA(1, 0, At, B0); PG8_BAR; PG8_SCHED;
            PG8_STAGE(PG8_SB(1, 1), b3 + hstep, voffB);
            PG8_WAIT_V(6); PG8_BAR; PG8_MMA(1, 1, At, B1); PG8_BAR;
            }
        }
        if constexpr (MODE == 1) asm volatile("s_nop 15\n\ts_nop 15" ::: "memory");
        if constexpr (ALIGN_EPI) { if (wr == 0) PG8_BAR; }
        if constexpr (!Epi::AFTER_DRAIN) { E(acc, cur, wr, wc, fr, fq); S.done(cur); }
        if (!has_next) break;
#pragma unroll
        for (int a = 0; a < 2; ++a)
#pragma unroll
            for (int b = 0; b < 2; ++b)
#pragma unroll
                for (int m = 0; m < 4; ++m)
#pragma unroll
                    for (int n = 0; n < 2; ++n) acc[a][b][m][n] = (f32x4){0.f, 0.f, 0.f, 0.f};
        cur = nxt; cA = nA; cB = nB; ++ui;
        if constexpr (ALIGN_EPI) { if (wr == 1) PG8_BAR; }
    }
    PG8_WAIT_V(0);
    if constexpr (!ALIGN_EPI) { if (wr == 0) PG8_BAR; }
    PG8_BAR;
    if constexpr (Epi::AFTER_DRAIN) { E.fused(acc, cur, wr, wc, fr, fq, lds, wid, lane); S.done(cur); }
#undef PG8_SA
#undef PG8_SB
#undef PG8_STAGE
#undef PG8_LDA
#undef PG8_LDB
#undef PG8_MMA
#undef PG8_WAIT_V
#undef PG8_WAIT_L
#undef PG8_BAR
#undef PG8_SCHED
}
}
constexpr int T_P = 8192, T_S = 4096, T = T_P + T_S;
constexpr int DM = 4096, DA = 2048, DFF = 11008, NIN = 17152  , KVROWS = 14336;
constexpr int QL = 1024, KVL = 512, NMOD = 6 * DM;
constexpr float NORM_EPS = 1e-6f;

namespace pg8 {
typedef _Float16 f16_t;
typedef _Float16 f16x2 __attribute__((ext_vector_type(2)));
typedef unsigned u32x2 __attribute__((ext_vector_type(2)));
__device__ __forceinline__ float ubf(unsigned u) { return __builtin_bit_cast(float, u); }
__device__ __forceinline__ float sigm(float x) { return __builtin_amdgcn_rcpf(1.0f + __builtin_amdgcn_exp2f(-1.4426950408889634f * x)); }
__device__ __forceinline__ f32x4 sigm4(f32x4 v) { return (f32x4){sigm(v[0]), sigm(v[1]), sigm(v[2]), sigm(v[3])}; }
__device__ __forceinline__ unsigned pk_f16(float lo, float hi) { f16x2 h = {(f16_t)lo, (f16_t)hi}; return __builtin_bit_cast(unsigned, h); }
__device__ __forceinline__ u32x4 pack_bf16x8(f32x4 a, f32x4 b) { u32x4 w; w.x = cvt_pk_bf16(a[0], a[1]); w.y = cvt_pk_bf16(a[2], a[3]); w.z = cvt_pk_bf16(b[0], b[1]); w.w = cvt_pk_bf16(b[2], b[3]); return w; }
__device__ __forceinline__ u32x4 pack_f16x8(f32x4 a, f32x4 b) { u32x4 w; w.x = pk_f16(a[0], a[1]); w.y = pk_f16(a[2], a[3]); w.z = pk_f16(b[0], b[1]); w.w = pk_f16(b[2], b[3]); return w; }
__device__ __forceinline__ unsigned pack_u8x4(f32x4 v, float sc) {
    const unsigned q0 = __builtin_bit_cast(unsigned, __builtin_fmaf(v[0], sc, 12582912.0f)), q1 = __builtin_bit_cast(unsigned, __builtin_fmaf(v[1], sc, 12582912.0f));
    const unsigned q2 = __builtin_bit_cast(unsigned, __builtin_fmaf(v[2], sc, 12582912.0f)), q3 = __builtin_bit_cast(unsigned, __builtin_fmaf(v[3], sc, 12582912.0f));
    return __builtin_amdgcn_perm(q1, q0, 0x0c0c0400u) | __builtin_amdgcn_perm(q3, q2, 0x04000c0cu); }
__device__ __forceinline__ f32x4 unpack_u8x4(unsigned w) { return (f32x4){(float)(w & 0xffu), (float)((w >> 8) & 0xffu), (float)((w >> 16) & 0xffu), (float)(w >> 24)}; }
__device__ __forceinline__ float bflo(unsigned w) { return __builtin_bit_cast(float, w << 16); }
__device__ __forceinline__ float bfhi(unsigned w) { return __builtin_bit_cast(float, w & 0xffff0000u); }
__device__ __forceinline__ void unpack_bf16x8(u32x4 w, f32x4& a, f32x4& b) { a = (f32x4){bflo(w.x), bfhi(w.x), bflo(w.y), bfhi(w.y)}; b = (f32x4){bflo(w.z), bfhi(w.z), bflo(w.w), bfhi(w.w)}; }

struct BatchedOrder {
    int nM, nN, nb, G, c;
    __device__ void init(int nM_, int nN_, int nb_, int G_, int c_) { nM = nM_; nN = nN_; nb = nb_; G = G_; c = c_; }
    __device__ bool next(int i, Unit& u) const {
        const int L = i * G + c; const int per = nM * nN; if (L >= per * nb) return false;
        const int b = L / per, l = L - b * per;
        u.pm = b * nM + (l % nM); u.pn = b * nN + (l / nM); return true;
    }
    __device__ __forceinline__ void a_ready(const Unit&) const {}
    __device__ __forceinline__ void done(const Unit&) const {}
};

#define EPI_LANE() int tid_ = (int)threadIdx.x; asm volatile("" : "+v"(tid_)); const int fr_ = tid_ & 15, fq_ = (tid_ >> 4) & 3
#define EPI_LOOP(...) \
    _Pragma("unroll") for (int ai = 0; ai < 2; ++ai) _Pragma("unroll") for (int m = 0; m < 4; ++m) { const int row = row0 + ai * HALF + m * 16; \
    _Pragma("unroll") for (int bj = 0; bj < 2; ++bj) { const f32x4 v0 = acc[ai][bj][m][0], v1 = acc[ai][bj][m][1]; const int colt = bj * HALF + cl; __VA_ARGS__ } }

struct EpiIn {
    static constexpr bool PERM = true, AFTER_DRAIN = false;
    f16_t* RKV; bf16_t* LWA; bf16_t* LG; float* QLAT; float* KVLAT; float* KPE; bf16_t* GA; bf16_t* GB;
    __device__ __forceinline__ void operator()(const f32x4 (&acc)[2][2][4][2], const Unit& u, int wr, int wc, int fr, int fq) const {
        EPI_LANE(); const int pn = u.pn < 16 ? 8 + u.pn : (u.pn < 18 ? 8 + u.pn : 14 + u.pn);
        const int row0 = u.pm * BM + wr * 64 + fr_, cl = wc * 32 + 8 * fq_;
        if (pn < 24) {
            EPI_LOOP( *(u32x4*)(RKV + (size_t)row * 6144 + pn * 256 + colt) = pack_f16x8(v0, v1); )
        } else if (pn == 24) {
            EPI_LOOP( f32x4 a = sigm4(v0 * 2.0f) * 2.0f - 1.0f, b = sigm4(v1 * 2.0f) * 2.0f - 1.0f; *(u32x4*)(LWA + ((size_t)bj * T + row) * 256 + cl) = pack_bf16x8(a, b); )
        } else if (pn == 25) {
            EPI_LOOP( *(u32x4*)(LWA + ((size_t)bj * T + row) * 256 + 128 + cl) = pack_bf16x8(v0, v1); )
        } else if (pn < 28) {
            EPI_LOOP( *(u32x4*)(LG + (size_t)row * 512 + (pn - 26) * 256 + colt) = pack_bf16x8(sigm4(v0), sigm4(v1)); )
        } else if (pn < 32) {
            EPI_LOOP( float* p = QLAT + (size_t)row * QL + (pn - 28) * 256 + colt; *(f32x4*)p = v0; *(f32x4*)(p + 4) = v1; )
        } else if (pn < 34) {
            EPI_LOOP( float* p = KVLAT + (size_t)row * KVL + (pn - 32) * 256 + colt; *(f32x4*)p = v0; *(f32x4*)(p + 4) = v1; )
        } else if (pn == 34) {
            EPI_LOOP( if (colt < 64) { float* p = KPE + (size_t)row * 64 + colt; *(f32x4*)p = v0; *(f32x4*)(p + 4) = v1; } )
        } else if (pn < 51) {
            EPI_LOOP( *(u32x4*)(GA + (size_t)row * DM + (pn - 35) * 256 + colt) = pack_bf16x8(sigm4(v0), sigm4(v1)); )
        } else {
            EPI_LOOP( *(u32x4*)(GB + (size_t)row * DM + (pn - 51) * 256 + colt) = pack_bf16x8(sigm4(v0), sigm4(v1)); )
        }
    }
};

struct EpiLora {
    static constexpr bool PERM = true, AFTER_DRAIN = false;
    unsigned char* EWAA; const float* lbias;
    __device__ __forceinline__ void operator()(const f32x4 (&acc)[2][2][4][2], const Unit& u, int wr, int wc, int fr, int fq) const {
        EPI_LANE(); const int dir = u.pn >> 4, jn = u.pn & 15, row0 = (u.pm - dir * (T / BM)) * BM + wr * 64 + fr_, cl = wc * 32 + 8 * fq_;
        const int isa = jn >> 3;
        const float* bias = lbias + isa * (2 * DA) + dir * DA + (jn & 7) * 256; unsigned char* O = EWAA + (size_t)(isa * 2 + dir) * T * DA + (jn & 7) * 256;
        f32x4 bv[2][2];
#pragma unroll
        for (int bj = 0; bj < 2; ++bj) { bv[bj][0] = *(const f32x4*)(bias + bj * HALF + cl); bv[bj][1] = *(const f32x4*)(bias + bj * HALF + cl + 4); }
        EPI_LOOP( u32x2 w; w.x = pack_u8x4(sigm4(v0 + bv[bj][0]), 255.0f); w.y = pack_u8x4(sigm4(v1 + bv[bj][1]), 255.0f); *(u32x2*)(O + (size_t)row * DA + colt) = w; )
    }
};

struct EpiPlain {
    static constexpr bool PERM = true, AFTER_DRAIN = false;
    bf16_t* O; int ldc;
    __device__ __forceinline__ void operator()(const f32x4 (&acc)[2][2][4][2], const Unit& u, int wr, int wc, int fr, int fq) const {
        EPI_LANE(); const int row0 = u.pm * BM + wr * 64 + fr_, cl = wc * 32 + 8 * fq_;
        EPI_LOOP( *(u32x4*)(O + (size_t)row * ldc + u.pn * 256 + colt) = pack_bf16x8(v0, v1); )
    }
};

struct EpiPlainI8 {
    static constexpr bool PERM = true, AFTER_DRAIN = false;
    bf16_t* O; int ldc; const float* rows; const unsigned* cmax;
    __device__ __forceinline__ void operator()(const f32x4 (&acc)[2][2][4][2], const Unit& u, int wr, int wc, int fr, int fq) const {
        typedef int v4i_t __attribute__((ext_vector_type(4)));
        EPI_LANE(); const int row0 = u.pm * BM + wr * 64 + fr_, cl = wc * 32 + 8 * fq_;
        f32x4 cs[2][2];
#pragma unroll
        for (int bj = 0; bj < 2; ++bj)
#pragma unroll
            for (int n = 0; n < 2; ++n) { const u32x4 m4 = *(const u32x4*)(cmax + u.pn * 256 + bj * HALF + cl + 4 * n);
                cs[bj][n] = (f32x4){ubf(m4.x), ubf(m4.y), ubf(m4.z), ubf(m4.w)} * (1.0f / 127.0f); }
        float rs8[2][4];
#pragma unroll
        for (int ai = 0; ai < 2; ++ai)
#pragma unroll
            for (int m = 0; m < 4; ++m) rs8[ai][m] = rows[row0 + ai * HALF + m * 16];
#pragma unroll
        for (int ai = 0; ai < 2; ++ai)
#pragma unroll
            for (int m = 0; m < 4; ++m) { const int row = row0 + ai * HALF + m * 16; const float rs = rs8[ai][m];
#pragma unroll
                for (int bj = 0; bj < 2; ++bj) { const v4i_t c0 = __builtin_bit_cast(v4i_t, acc[ai][bj][m][0]), c1 = __builtin_bit_cast(v4i_t, acc[ai][bj][m][1]);
                    const f32x4 v0 = (f32x4){(float)c0[0], (float)c0[1], (float)c0[2], (float)c0[3]} * cs[bj][0] * rs, v1 = (f32x4){(float)c1[0], (float)c1[1], (float)c1[2], (float)c1[3]} * cs[bj][1] * rs;
                    *(u32x4*)(O + (size_t)row * ldc + u.pn * 256 + bj * HALF + cl) = pack_bf16x8(v0, v1); } }
    }
};
struct EpiMix1 {
    static constexpr bool PERM = true, AFTER_DRAIN = false;
    const bf16_t* GA; float* TMP;
    __device__ __forceinline__ void operator()(const f32x4 (&acc)[2][2][4][2], const Unit& u, int wr, int wc, int fr, int fq) const {
        EPI_LANE(); const int row0 = u.pm * BM + wr * 64 + fr_, cl = wc * 32 + 8 * fq_;
        EPI_LOOP( const size_t o = (size_t)row * DM + u.pn * 256 + colt; f32x4 g0, g1; unpack_bf16x8(*(const u32x4*)(GA + o), g0, g1); *(f32x4*)(TMP + o) = g0 * v0; *(f32x4*)(TMP + o + 4) = g1 * v1; )
    }
};
struct EpiMix2 {
    static constexpr bool PERM = true, AFTER_DRAIN = false;
    const bf16_t* GB; const float* TMP; bf16_t* MIXED; unsigned* rmax;
    __device__ __forceinline__ void operator()(const f32x4 (&acc)[2][2][4][2], const Unit& u, int wr, int wc, int fr, int fq) const {
        EPI_LANE(); const int row0 = u.pm * BM + wr * 64 + fr_, cl = wc * 32 + 8 * fq_;
#pragma unroll
        for (int ai = 0; ai < 2; ++ai)
#pragma unroll
            for (int m = 0; m < 4; ++m) { const int row = row0 + ai * HALF + m * 16; float mx = 0.f;
#pragma unroll
                for (int bj = 0; bj < 2; ++bj) { const f32x4 v0 = acc[ai][bj][m][0], v1 = acc[ai][bj][m][1]; const size_t o = (size_t)row * DM + u.pn * 256 + bj * HALF + cl;
                    f32x4 g0, g1; unpack_bf16x8(*(const u32x4*)(GB + o), g0, g1); const f32x4 t0 = *(const f32x4*)(TMP + o) + g0 * v0, t1 = *(const f32x4*)(TMP + o + 4) + g1 * v1;
                    *(u32x4*)(MIXED + o) = pack_bf16x8(t0, t1);
                    const f32x4 a0 = __builtin_elementwise_abs(t0), a1 = __builtin_elementwise_abs(t1); mx = fmaxf(mx, fmaxf(fmaxf(fmaxf(a0[0], a0[1]), fmaxf(a0[2], a0[3])), fmaxf(fmaxf(a1[0], a1[1]), fmaxf(a1[2], a1[3])))); }
                mx = fmaxf(mx, __shfl_xor(mx, 16)); mx = fmaxf(mx, __shfl_xor(mx, 32));
                if (fq_ == 0) atomicMax(rmax + row, __builtin_bit_cast(unsigned, mx)); }
    }
};
struct EpiRes {
    static constexpr bool PERM = true, AFTER_DRAIN = false;
    const bf16_t* x1; float* out; const float* gate; float accs;
    __device__ __forceinline__ void operator()(const f32x4 (&acc)[2][2][4][2], const Unit& u, int wr, int wc, int fr, int fq) const {
        EPI_LANE(); const int row0 = u.pm * BM + wr * 64 + fr_, cl = wc * 32 + 8 * fq_;
        const int rbase = u.pm * BM, mi = rbase < T_P ? 0 : 1 + ((rbase - T_P) >> 10);
        const float* gp = gate + (size_t)mi * NMOD + u.pn * 256;
        f32x4 gv[2][2];
#pragma unroll
        for (int bj = 0; bj < 2; ++bj) { gv[bj][0] = *(const f32x4*)(gp + bj * HALF + cl) * accs; gv[bj][1] = *(const f32x4*)(gp + bj * HALF + cl + 4) * accs; }
        EPI_LOOP( const size_t o = (size_t)row * DM + u.pn * 256 + colt; f32x4 b0, b1; unpack_bf16x8(*(const u32x4*)(x1 + o), b0, b1);
                  __builtin_nontemporal_store(b0 + gv[bj][0] * v0, (f32x4*)(out + o)); __builtin_nontemporal_store(b1 + gv[bj][1] * v1, (f32x4*)(out + o + 4)); )
    }
};
struct EpiSwiglu {
    static constexpr bool PERM = true, AFTER_DRAIN = false;
    unsigned char* ACT;
    __device__ __forceinline__ void operator()(const f32x4 (&acc)[2][2][4][2], const Unit& u, int wr, int wc, int fr, int fq) const {
        EPI_LANE(); const int row0 = u.pm * BM + wr * 64 + fr_, cl = wc * 32 + 8 * fq_;
#pragma unroll
        for (int ai = 0; ai < 2; ++ai)
#pragma unroll
            for (int m = 0; m < 4; ++m) { const int row = row0 + ai * HALF + m * 16;
                const f32x4 g0 = acc[ai][0][m][0], g1 = acc[ai][0][m][1], u0 = acc[ai][1][m][0], u1 = acc[ai][1][m][1];
                const f32x4 a0 = g0 * sigm4(g0) * u0, a1 = g1 * sigm4(g1) * u1;
                unsigned w0 = 0u, w1 = 0u;
                w0 = __builtin_amdgcn_cvt_pk_fp8_f32(a0[0], a0[1], w0, false); w0 = __builtin_amdgcn_cvt_pk_fp8_f32(a0[2], a0[3], w0, true);
                w1 = __builtin_amdgcn_cvt_pk_fp8_f32(a1[0], a1[1], w1, false); w1 = __builtin_amdgcn_cvt_pk_fp8_f32(a1[2], a1[3], w1, true);
                u32x2 pk; pk.x = w0; pk.y = w1; *(u32x2*)(ACT + (size_t)row * DFF + u.pn * 128 + cl) = pk; }
    }
};
struct EpiSwigluI8 {
    static constexpr bool PERM = true, AFTER_DRAIN = false;
    unsigned char* ACT; const float* rows; const unsigned* cmax;
    __device__ __forceinline__ void operator()(const f32x4 (&acc)[2][2][4][2], const Unit& u, int wr, int wc, int fr, int fq) const {
        typedef int v4i_t __attribute__((ext_vector_type(4)));
        EPI_LANE(); const int row0 = u.pm * BM + wr * 64 + fr_, cl = wc * 32 + 8 * fq_;
        f32x4 cs[2][2];
#pragma unroll
        for (int bj = 0; bj < 2; ++bj)
#pragma unroll
            for (int n = 0; n < 2; ++n) { const u32x4 m4 = *(const u32x4*)(cmax + bj * DFF + u.pn * 128 + cl + 4 * n);
                cs[bj][n] = (f32x4){ubf(m4.x), ubf(m4.y), ubf(m4.z), ubf(m4.w)} * (1.0f / 127.0f); }
        float rs8[2][4];
#pragma unroll
        for (int ai = 0; ai < 2; ++ai)
#pragma unroll
            for (int m = 0; m < 4; ++m) rs8[ai][m] = rows[row0 + ai * HALF + m * 16];
#pragma unroll
        for (int ai = 0; ai < 2; ++ai)
#pragma unroll
            for (int m = 0; m < 4; ++m) { const int row = row0 + ai * HALF + m * 16; const float rs = rs8[ai][m];
                f32x4 v[2][2];
#pragma unroll
                for (int bj = 0; bj < 2; ++bj)
#pragma unroll
                    for (int n = 0; n < 2; ++n) { const v4i_t c = __builtin_bit_cast(v4i_t, acc[ai][bj][m][n]); v[bj][n] = (f32x4){(float)c[0], (float)c[1], (float)c[2], (float)c[3]} * cs[bj][n] * rs; }
                const f32x4 a0 = v[0][0] * sigm4(v[0][0]) * v[1][0], a1 = v[0][1] * sigm4(v[0][1]) * v[1][1];
                unsigned w0 = 0u, w1 = 0u;
                w0 = __builtin_amdgcn_cvt_pk_fp8_f32(a0[0], a0[1], w0, false); w0 = __builtin_amdgcn_cvt_pk_fp8_f32(a0[2], a0[3], w0, true);
                w1 = __builtin_amdgcn_cvt_pk_fp8_f32(a1[0], a1[1], w1, false); w1 = __builtin_amdgcn_cvt_pk_fp8_f32(a1[2], a1[3], w1, true);
                u32x2 pk; pk.x = w0; pk.y = w1; *(u32x2*)(ACT + (size_t)row * DFF + u.pn * 128 + cl) = pk; }
    }
};
struct EpiGate8 {
    static constexpr bool PERM = true, AFTER_DRAIN = false;
    unsigned char* GA; unsigned char* GB; const float* rows;     const unsigned* cmax; f16_t* RKV; bf16_t* LG; float* QLAT; int pn0;
    __device__ __forceinline__ void operator()(const f32x4 (&acc)[2][2][4][2], const Unit& u, int wr, int wc, int fr, int fq) const {
        typedef int v4i_t __attribute__((ext_vector_type(4)));
        EPI_LANE(); const int row0 = u.pm * BM + wr * 64 + fr_, cl = wc * 32 + 8 * fq_, pn = u.pn + pn0;
        f32x4 cs[2][2];
#pragma unroll
        for (int bj = 0; bj < 2; ++bj)
#pragma unroll
            for (int n = 0; n < 2; ++n) { const u32x4 m4 = *(const u32x4*)(cmax + pn * 256 + bj * HALF + cl + 4 * n);
                cs[bj][n] = (f32x4){ubf(m4.x), ubf(m4.y), ubf(m4.z), ubf(m4.w)} * (1.0f / 127.0f); }
        float rs8[2][4];
#pragma unroll
        for (int ai = 0; ai < 2; ++ai)
#pragma unroll
            for (int m = 0; m < 4; ++m) rs8[ai][m] = rows[row0 + ai * HALF + m * 16];
#pragma unroll
        for (int ai = 0; ai < 2; ++ai)
#pragma unroll
            for (int m = 0; m < 4; ++m) { const int row = row0 + ai * HALF + m * 16; const float rs = rs8[ai][m];
#pragma unroll
                for (int bj = 0; bj < 2; ++bj) { const v4i_t c0 = __builtin_bit_cast(v4i_t, acc[ai][bj][m][0]), c1 = __builtin_bit_cast(v4i_t, acc[ai][bj][m][1]);
                    const f32x4 v0 = (f32x4){(float)c0[0], (float)c0[1], (float)c0[2], (float)c0[3]} * cs[bj][0] * rs, v1 = (f32x4){(float)c1[0], (float)c1[1], (float)c1[2], (float)c1[3]} * cs[bj][1] * rs;
                    const int colt = bj * HALF + cl;
                    if (pn < 32) { unsigned char* O = (pn < 16 ? GA : GB - (size_t)16 * 256) + pn * 256; u32x2 w; w.x = pack_u8x4(sigm4(v0), 255.0f); w.y = pack_u8x4(sigm4(v1), 255.0f); *(u32x2*)(O + (size_t)row * DM + colt) = w; }
                    else if (pn < 40) { *(u32x4*)(RKV + (size_t)row * 6144 + (pn - 32) * 256 + colt) = pack_f16x8(v0, v1); }
                    else if (pn < 42) { *(u32x4*)(LG + (size_t)row * 512 + (pn - 40) * 256 + colt) = pack_bf16x8(sigm4(v0), sigm4(v1)); }
                    else { *(u32x4*)((f16_t*)QLAT + (size_t)row * QL + (pn - 42) * 256 + colt) = pack_f16x8(v0, v1); } } }
    }
};
struct EpiMix1I8 {
    static constexpr bool PERM = true, AFTER_DRAIN = false;
    const unsigned char* GA; bf16_t* TMP;     const float* rows; const unsigned* cmax;
    __device__ __forceinline__ void operator()(const f32x4 (&acc)[2][2][4][2], const Unit& u, int wr, int wc, int fr, int fq) const {
        typedef int v4i_t __attribute__((ext_vector_type(4)));
        EPI_LANE(); const int row0 = u.pm * BM + wr * 64 + fr_, cl = wc * 32 + 8 * fq_;
        f32x4 cs[2][2];
#pragma unroll
        for (int bj = 0; bj < 2; ++bj)
#pragma unroll
            for (int n = 0; n < 2; ++n) { const u32x4 m4 = *(const u32x4*)(cmax + u.pn * 256 + bj * HALF + cl + 4 * n);
                cs[bj][n] = (f32x4){ubf(m4.x), ubf(m4.y), ubf(m4.z), ubf(m4.w)} * (1.0f / 127.0f); }
        float rs8[2][4];
#pragma unroll
        for (int ai = 0; ai < 2; ++ai)
#pragma unroll
            for (int m = 0; m < 4; ++m) rs8[ai][m] = rows[row0 + ai * HALF + m * 16];
#pragma unroll
        for (int ai = 0; ai < 2; ++ai)
#pragma unroll
            for (int m = 0; m < 4; ++m) { const int row = row0 + ai * HALF + m * 16; const float rs = rs8[ai][m];
#pragma unroll
                for (int bj = 0; bj < 2; ++bj) { const v4i_t c0 = __builtin_bit_cast(v4i_t, acc[ai][bj][m][0]), c1 = __builtin_bit_cast(v4i_t, acc[ai][bj][m][1]);
                    const f32x4 v0 = (f32x4){(float)c0[0], (float)c0[1], (float)c0[2], (float)c0[3]} * cs[bj][0] * rs, v1 = (f32x4){(float)c1[0], (float)c1[1], (float)c1[2], (float)c1[3]} * cs[bj][1] * rs;
                    const size_t o = (size_t)row * DM + u.pn * 256 + bj * HALF + cl; const u32x2 gw = *(const u32x2*)(GA + o); const f32x4 g0 = unpack_u8x4(gw.x) * (1.0f / 255.0f), g1 = unpack_u8x4(gw.y) * (1.0f / 255.0f);
                    *(u32x4*)(TMP + o) = pack_bf16x8(g0 * v0, g1 * v1); } }
    }
};
struct EpiMix2I8 {
    static constexpr bool PERM = true, AFTER_DRAIN = false;
    const unsigned char* GB; const bf16_t* TMP; bf16_t* MIXED; unsigned* rmax; const float* rows; const unsigned* cmax;
    __device__ __forceinline__ void operator()(const f32x4 (&acc)[2][2][4][2], const Unit& u, int wr, int wc, int fr, int fq) const {
        typedef int v4i_t __attribute__((ext_vector_type(4)));
        EPI_LANE(); const int row0 = u.pm * BM + wr * 64 + fr_, cl = wc * 32 + 8 * fq_;
        f32x4 cs[2][2];
#pragma unroll
        for (int bj = 0; bj < 2; ++bj)
#pragma unroll
            for (int n = 0; n < 2; ++n) { const u32x4 m4 = *(const u32x4*)(cmax + u.pn * 256 + bj * HALF + cl + 4 * n);
                cs[bj][n] = (f32x4){ubf(m4.x), ubf(m4.y), ubf(m4.z), ubf(m4.w)} * (1.0f / 127.0f); }
        float rs8[2][4];
#pragma unroll
        for (int ai = 0; ai < 2; ++ai)
#pragma unroll
            for (int m = 0; m < 4; ++m) rs8[ai][m] = rows[row0 + ai * HALF + m * 16];
#pragma unroll
        for (int ai = 0; ai < 2; ++ai)
#pragma unroll
            for (int m = 0; m < 4; ++m) { const int row = row0 + ai * HALF + m * 16; const float rs = rs8[ai][m]; float mx = 0.f;
#pragma unroll
                for (int bj = 0; bj < 2; ++bj) { const v4i_t c0 = __builtin_bit_cast(v4i_t, acc[ai][bj][m][0]), c1 = __builtin_bit_cast(v4i_t, acc[ai][bj][m][1]);
                    const f32x4 v0 = (f32x4){(float)c0[0], (float)c0[1], (float)c0[2], (float)c0[3]} * cs[bj][0] * rs, v1 = (f32x4){(float)c1[0], (float)c1[1], (float)c1[2], (float)c1[3]} * cs[bj][1] * rs;
                    const size_t o = (size_t)row * DM + u.pn * 256 + bj * HALF + cl;
                    const u32x2 gw = *(const u32x2*)(GB + o); const f32x4 g0 = unpack_u8x4(gw.x) * (1.0f / 255.0f), g1 = unpack_u8x4(gw.y) * (1.0f / 255.0f); f32x4 p0, p1; unpack_bf16x8(*(const u32x4*)(TMP + o), p0, p1); const f32x4 t0 = p0 + g0 * v0, t1 = p1 + g1 * v1;
                    *(u32x4*)(MIXED + o) = pack_bf16x8(t0, t1);
                    const f32x4 a0 = __builtin_elementwise_abs(t0), a1 = __builtin_elementwise_abs(t1); mx = fmaxf(mx, fmaxf(fmaxf(fmaxf(a0[0], a0[1]), fmaxf(a0[2], a0[3])), fmaxf(fmaxf(a1[0], a1[1]), fmaxf(a1[2], a1[3])))); }
                mx = fmaxf(mx, __shfl_xor(mx, 16)); mx = fmaxf(mx, __shfl_xor(mx, 32));
                if (fq_ == 0) atomicMax(rmax + row, __builtin_bit_cast(unsigned, mx)); }
    }
};
struct EpiResI8 {
    static constexpr bool PERM = true, AFTER_DRAIN = false;
    const float* xp; const float* xs; bf16_t* x1; const float* gate; const float* rows; const unsigned* cmax;
    __device__ __forceinline__ void operator()(const f32x4 (&acc)[2][2][4][2], const Unit& u, int wr, int wc, int fr, int fq) const {
        typedef int v4i_t __attribute__((ext_vector_type(4)));
        EPI_LANE(); const int row0 = u.pm * BM + wr * 64 + fr_, cl = wc * 32 + 8 * fq_;
        const int rbase = u.pm * BM, mi = rbase < T_P ? 0 : 1 + ((rbase - T_P) >> 10);
        const float* gp = gate + (size_t)mi * NMOD + u.pn * 256;
        const float* base = rbase < T_P ? xp : xs - (size_t)T_P * DM;
        f32x4 gv[2][2];
#pragma unroll
        for (int bj = 0; bj < 2; ++bj)
#pragma unroll
            for (int n = 0; n < 2; ++n) { const u32x4 m4 = *(const u32x4*)(cmax + u.pn * 256 + bj * HALF + cl + 4 * n);
                gv[bj][n] = *(const f32x4*)(gp + bj * HALF + cl + 4 * n) * ((f32x4){ubf(m4.x), ubf(m4.y), ubf(m4.z), ubf(m4.w)} * (1.0f / 127.0f)); }
        float rs8[2][4];
#pragma unroll
        for (int ai = 0; ai < 2; ++ai)
#pragma unroll
            for (int m = 0; m < 4; ++m) rs8[ai][m] = rows[row0 + ai * HALF + m * 16];
#pragma unroll
        for (int ai = 0; ai < 2; ++ai)
#pragma unroll
            for (int m = 0; m < 4; ++m) { const int row = row0 + ai * HALF + m * 16; const float rs = rs8[ai][m];
#pragma unroll
                for (int bj = 0; bj < 2; ++bj) { const v4i_t c0 = __builtin_bit_cast(v4i_t, acc[ai][bj][m][0]), c1 = __builtin_bit_cast(v4i_t, acc[ai][bj][m][1]);
                    const f32x4 v0 = (f32x4){(float)c0[0], (float)c0[1], (float)c0[2], (float)c0[3]} * rs, v1 = (f32x4){(float)c1[0], (float)c1[1], (float)c1[2], (float)c1[3]} * rs;
                    const size_t o = (size_t)row * DM + u.pn * 256 + bj * HALF + cl; const f32x4 b0 = *(const f32x4*)(base + o), b1 = *(const f32x4*)(base + o + 4);
                    *(u32x4*)(x1 + o) = pack_bf16x8(b0 + gv[bj][0] * v0, b1 + gv[bj][1] * v1); } }
    }
};
#undef EPI_LOOP
}
#define GAS __attribute__((address_space(1)))
#define LAS __attribute__((address_space(3)))
typedef unsigned short bf16;
typedef unsigned v4u __attribute__((ext_vector_type(4)));
typedef float f32x4 __attribute__((ext_vector_type(4)));
typedef short bf16x8 __attribute__((ext_vector_type(8)));
typedef GAS unsigned gu32;
typedef GAS unsigned long long gu64;
#define RLX_AGENT __ATOMIC_RELAXED, __HIP_MEMORY_SCOPE_AGENT
#define LDS_WAIT() asm volatile("s_waitcnt lgkmcnt(0)" ::: "memory")
#define VM_WAIT() asm volatile("s_waitcnt vmcnt(0)" ::: "memory")
__device__ __forceinline__ unsigned long long rt() { return __builtin_amdgcn_s_memrealtime(); }
__device__ __forceinline__ unsigned f2bf(float f) { unsigned u = __builtin_bit_cast(unsigned, f); return (u + 0x7fffu + ((u >> 16) & 1u)) >> 16; }
__device__ __forceinline__ unsigned pk2(float lo, float hi) { return f2bf(lo) | (f2bf(hi) << 16); }
constexpr size_t MiB = 1u << 20;
constexpr size_t WS_CTL = 0, CTL_ZERO_BYTES = 1 * MiB;
constexpr size_t WS_MOD = 1 * MiB, WS_COS = 1 * MiB + 512 * 1024, WS_SIN = 1 * MiB + 640 * 1024, WS_LBIAS = 1 * MiB + 768 * 1024;
constexpr size_t WS_WFI = 2 * MiB, WS_WFO = 174 * MiB, WS_WOUT = 260 * MiB, WS_WOR = 292 * MiB, WS_WOM = 308 * MiB;
constexpr size_t WS_WIN = 324 * MiB, WS_WUQ = 458 * MiB, WS_WUKV = 464 * MiB, WS_WLORA = 468 * MiB, WS_WG = 472 * MiB;
constexpr size_t WS_YS = 324 * MiB, WS_BON = 420 * MiB, WS_YB = 423 * MiB;
constexpr size_t WS_HB = 474 * MiB;
constexpr size_t WS_RKV = 570 * MiB, WS_GA = 714 * MiB, WS_GB = 810 * MiB;
constexpr size_t WS_MIXED = 570 * MiB, WS_ACT = 570 * MiB;
constexpr size_t WS_LWA = 906 * MiB, WS_LG = 918 * MiB;
constexpr size_t WS_QLAT = 930 * MiB, WS_KVLAT = 978 * MiB, WS_Q = 930 * MiB;
constexpr size_t WS_KPE = 1002 * MiB;
constexpr size_t WS_QN = 1005 * MiB, WS_CKVA = 1029 * MiB;
constexpr size_t WS_EW = 1043 * MiB, WS_AA = 1139 * MiB, WS_TMP = 1043 * MiB;
constexpr size_t WS_G = 1235 * MiB;
constexpr size_t WS_KV = 1283 * MiB, WS_YA = 1479 * MiB;
constexpr size_t WS_KP = 1395 * MiB;
constexpr size_t WS_END = 1527 * MiB;
static_assert(WS_WIN + (size_t)NIN * DM * 2 <= WS_WUQ && WS_WFI + (size_t)2 * DFF * DM * 2 <= WS_WFO && WS_WFO + (size_t)DM * DFF * 2 <= WS_WOUT, "weights map");
static_assert(WS_YS + (size_t)2 * T * DA * 2 <= WS_BON && WS_BON + (size_t)2 * T * 32 * 4 <= WS_YB && WS_YB + (size_t)T * DA * 2 <= WS_HB, "overlay map");
static_assert(WS_RKV + (size_t)T * 6144 * 2 <= WS_GA && WS_ACT + (size_t)T * DFF * 2 <= WS_LWA && WS_Q + (size_t)T * 3072 * 2 <= WS_KPE && WS_KV + (size_t)KVROWS * 4096 * 2 <= WS_KP && WS_KP + (size_t)KVROWS * 3072 * 2 <= WS_YA && WS_YA + (size_t)T * DA * 2 <= WS_END, "act map");
static_assert(WS_AA == WS_EW + (size_t)2 * T * DA * 2, "AA follows EW");
constexpr int CW_BAR = 4096;
constexpr size_t WS_CMAX = 64 * 1024;
constexpr size_t WS_ROWS = 256 * 1024;
constexpr size_t WS_CMAXG = 320 * 1024;
constexpr size_t WS_ROWS1 = 384 * 1024;
static_assert(WS_ROWS + 12288 * 4 <= WS_CMAXG && WS_CMAXG + 11776 * 4 <= WS_ROWS1 && WS_ROWS1 + 12288 * 4 <= CTL_ZERO_BYTES, "scale tables 2");
constexpr size_t WS_CMAXO = 448 * 1024, WS_CMAXR = 464 * 1024, WS_RMAXM = 480 * 1024, WS_ROWSYA = 528 * 1024, WS_ROWSM = 576 * 1024;
static_assert(WS_ROWS1 + 12288 * 4 <= WS_CMAXO && WS_ROWSM + 12288 * 4 <= CTL_ZERO_BYTES, "scale tables 3");
constexpr size_t WS_YB8 = 1395 * MiB;
constexpr size_t WS_ROWSYB = 640 * 1024, WS_CMAXM = 704 * 1024;
static_assert(WS_ROWSM + 12288 * 4 <= WS_ROWSYB && WS_ROWSYB + 12288 * 4 <= WS_CMAXM && WS_CMAXM + 4096 * 4 <= CTL_ZERO_BYTES, "scale tables 4");
constexpr size_t WS_ROWSQ = 720 * 1024, WS_ROWSKV = 768 * 1024, WS_CMAXUQ = 824 * 1024, WS_CMAXUKV = 836 * 1024;
static_assert(WS_CMAXM + 4096 * 4 <= WS_ROWSQ && WS_ROWSQ + 12288 * 4 <= WS_ROWSKV && WS_ROWSKV + 14336 * 4 <= WS_CMAXUQ && WS_CMAXUQ + 3072 * 4 <= WS_CMAXUKV && WS_CMAXUKV + 4096 * 4 <= CTL_ZERO_BYTES, "scale tables 5");
constexpr size_t WS_X1 = 324 * MiB;
constexpr size_t WS_MIX8 = 666 * MiB;
constexpr size_t WS_H1Q = 88 * MiB, WS_WGATE8 = 136 * MiB, WS_WING8 = 1139 * MiB;
static_assert(WS_WFI + (size_t)2 * DFF * DM <= WS_H1Q && WS_H1Q + (size_t)T * DM <= WS_WGATE8 && WS_WGATE8 + (size_t)8192 * DM <= WS_WFO, "int8 tail of the WFI region");
static_assert(WS_CMAX + 22016 * 4 <= WS_ROWS && WS_ROWS + 12288 * 4 <= CTL_ZERO_BYTES, "scale tables inside the control region");

constexpr int RING_OFF = 0, RING_BYTES = 131072;
constexpr int LDSCTL_OFF = RING_BYTES, MISC_OFF = LDSCTL_OFF + 320;
constexpr int LDS_BYTES = 147456;
constexpr int NWAVES = 8;

constexpr size_t OUT_YP = 0, OUT_YS = (size_t)T_P * DM, OUT_STATE = (size_t)T * DM, OUT_CKV = OUT_STATE + (size_t)32 * 2 * 32 * 64 * 64, OUT_KPE = OUT_CKV + (size_t)T_P * KVL;

typedef _Float16 f16;
typedef unsigned v2u __attribute__((ext_vector_type(2)));
typedef float f32x2 __attribute__((ext_vector_type(2)));
#define XB_TMO      128
#define XB_XCNT(j)  (256  + 64 * (j))
#define XB_XSUB(j)  (1280 + 64 * (j))
#define XB_XGEN(j)  (2304 + 64 * (j))
#define XB_TOP      3328
#define XB_TOPGEN   3392
#define XCD_BAR_WORDS 3456
#define XB_SPIN_CAP (1u << 18)

__device__ __forceinline__ unsigned xb_ld(unsigned* p)              { return __hip_atomic_load(p, __ATOMIC_RELAXED, __HIP_MEMORY_SCOPE_AGENT); }
__device__ __forceinline__ unsigned xb_add(unsigned* p, unsigned v) { return __hip_atomic_fetch_add(p, v, __ATOMIC_RELAXED, __HIP_MEMORY_SCOPE_AGENT); }
__device__ __forceinline__ unsigned xb_xcc_id() { return (unsigned)__builtin_amdgcn_s_getreg((3 << 11) | 20) & 0xFu; }
#define XB_SPIN(cond, bar) do { unsigned _sp = 0; while (cond) { __builtin_amdgcn_s_sleep(1); \
    if ((++_sp & 255u) == 0u) { if (xb_ld(&(bar)[XB_TMO])) break; if (_sp > XB_SPIN_CAP) { atomicAdd(&(bar)[XB_TMO], 1u); break; } } } } while (0)

struct XcdBarrier {
    unsigned* bar; unsigned x;
    volatile LAS unsigned* st;
};

__device__ __forceinline__ XcdBarrier xcd_barrier_post(unsigned* bar, volatile LAS unsigned* st) {
    XcdBarrier b; b.bar = bar; b.x = xb_xcc_id(); b.st = st;
    if (threadIdx.x == 0) (void)xb_add(&bar[XB_XCNT(b.x)], 1u);
    return b;
}
__device__ __forceinline__ void xcd_barrier_complete(unsigned* bar, unsigned x, unsigned& nloc, unsigned& nx) {
    const unsigned G = gridDim.x * gridDim.y * gridDim.z;
    unsigned sum, cnt, mine, sp = 0u;
    for (;;) {
        sum = 0u; cnt = 0u; mine = 0u;
#pragma unroll
        for (unsigned j = 0; j < 16; ++j) { const unsigned c = xb_ld(&bar[XB_XCNT(j)]); sum += c; cnt += (c > 0u) ? 1u : 0u; mine = (j == x) ? c : mine; }
        if (sum == G) break;
        __builtin_amdgcn_s_sleep(1);
        if ((++sp & 255u) == 0u) { if (xb_ld(&bar[XB_TMO])) break; if (sp > XB_SPIN_CAP) { atomicAdd(&bar[XB_TMO], 1u); break; } }
    }
    nloc = mine > 0u ? mine : 1u; nx = cnt > 0u ? cnt : 1u;
}

__device__ __forceinline__ void xcd_barrier(const XcdBarrier& b) {
    asm volatile("s_waitcnt vmcnt(0)" ::: "memory");
    __syncthreads();
    if (threadIdx.x == 0) {
        unsigned* bar = b.bar;
        __builtin_amdgcn_s_waitcnt(0);
        unsigned nloc = b.st[0], nx = b.st[1];
        if (nloc == 0u) { xcd_barrier_complete(bar, b.x, nloc, nx); b.st[0] = nloc; b.st[1] = nx; }
        const unsigned old = xb_add(&bar[XB_XSUB(b.x)], 1u);
        const unsigned gen = old / nloc;
        if (old + 1u == (gen + 1u) * nloc) {
            __builtin_amdgcn_fence(__ATOMIC_RELEASE, "agent");
            asm volatile("s_waitcnt vmcnt(0)" ::: "memory");
            const unsigned og = xb_add(&bar[XB_TOP], 1u);
            const unsigned tg = og / nx;
            if (og + 1u == (tg + 1u) * nx) xb_add(&bar[XB_TOPGEN], 1u);
            else XB_SPIN(xb_ld(&bar[XB_TOPGEN]) == tg, bar);
            __builtin_amdgcn_fence(__ATOMIC_ACQUIRE, "agent");
            xb_add(&bar[XB_XGEN(b.x)], 1u);
            asm volatile("s_waitcnt vmcnt(0)" ::: "memory");
        } else {
            XB_SPIN(xb_ld(&bar[XB_XGEN(b.x)]) == gen, bar);
            __builtin_amdgcn_fence(__ATOMIC_ACQUIRE, "agent");
            asm volatile("s_waitcnt vmcnt(0)" ::: "memory");
        }
    }
    __syncthreads();
}
struct Args { const float* in[33]; float* out; unsigned char* ws; int ph_lo, ph_hi; };
enum { I_XP = 0, I_XS, I_C, I_STATE, I_CCKV, I_CKPE, I_CCTX, I_WMOD, I_BMOD, I_NMIX, I_WIN, I_W0, I_WLB, I_A0, I_ALB, I_GLB, I_KK, I_KA, I_RK, I_LNW, I_LNB,
       I_QNW, I_WUQ, I_KVNW, I_WUKV, I_QHN, I_KHN, I_WOR, I_WOM, I_WOUT, I_NFFN, I_WFI, I_WFO };
struct Frame { LAS unsigned char* lds; volatile LAS unsigned* MISC; gu32* ctl; int tid, lane, wave, G, gw, ngw; };

__device__ __forceinline__ float wave_sum(float v) {
#pragma unroll
    for (int o = 1; o < 64; o <<= 1) v += __shfl_xor(v, o);
    return v;
}
__device__ __forceinline__ float dpp_f(float x, const int ctrl_sel) {
    const int xi = __builtin_bit_cast(int, x); int r;
    if (ctrl_sel == 0) r = __builtin_amdgcn_update_dpp(0, xi, 0xB1, 0xF, 0xF, true);
    else if (ctrl_sel == 1) r = __builtin_amdgcn_update_dpp(0, xi, 0x4E, 0xF, 0xF, true);
    else if (ctrl_sel == 2) r = __builtin_amdgcn_update_dpp(0, xi, 0x141, 0xF, 0xF, true);
    else r = __builtin_amdgcn_update_dpp(0, xi, 0x140, 0xF, 0xF, true);
    return __builtin_bit_cast(float, r);
}
__device__ __forceinline__ float row16_sum(float x) { x += dpp_f(x, 0); x += dpp_f(x, 1); x += dpp_f(x, 2); x += dpp_f(x, 3); return x; }
__device__ __forceinline__ float sigm(float x) { return pg8::sigm(x); }
__device__ __forceinline__ int mod_index(int row) { return row < T_P ? 0 : 1 + ((row - T_P) >> 10); }

__device__ __forceinline__ void p0_adaln(const Args& a, Frame& F) {
    LAS float* SC = (LAS float*)(F.lds);
    LAS float* RED = (LAS float*)(F.lds + 81920);
    const float* c = a.in[I_C]; const float* cctx = a.in[I_CCTX]; const float* wmod = a.in[I_WMOD]; const float* bmod = a.in[I_BMOD];
    float* MOD = (float*)(a.ws + WS_MOD);
#pragma unroll
    for (int it = 0; it < 40; ++it) { const int i = F.tid + 512 * it; const int r = i >> 12, k = i & 4095; const float v = (r == 0) ? cctx[k] : c[(r - 1) * 4096 + k]; SC[i] = v * sigm(v); }
    __syncthreads();
    const int kk = F.lane / 24, cg = F.lane % 24;
    for (int cb = blockIdx.x; cb < 256; cb += F.G) {
        f32x4 acc[5];
#pragma unroll
        for (int r = 0; r < 5; ++r) acc[r] = (f32x4){0.f, 0.f, 0.f, 0.f};
        if (F.lane < 48) {
            const float* wp = wmod + (size_t)(512 * F.wave + kk) * NMOD + 96 * cb + 4 * cg;
            const LAS float* sp = SC + 512 * F.wave + kk;
#pragma unroll 16
            for (int k2 = 0; k2 < 512; k2 += 2) {
                const f32x4 w = *(const f32x4*)(wp + (size_t)k2 * NMOD);
#pragma unroll
                for (int r = 0; r < 5; ++r) acc[r] += w * sp[r * 4096 + k2];
            }
#pragma unroll
            for (int r = 0; r < 5; ++r) *(LAS f32x4*)(RED + ((F.wave * 2 + kk) * 5 + r) * 96 + 4 * cg) = acc[r];
        }
        __syncthreads();
        if (F.tid < 480) { const int r = F.tid / 96, col = F.tid % 96; float s = bmod[96 * cb + col];
#pragma unroll
            for (int p = 0; p < 16; ++p) s += RED[(p * 5 + r) * 96 + col];
            MOD[(size_t)r * NMOD + 96 * cb + col] = s; }
        __syncthreads();
    }
}

__device__ __forceinline__ void tr_item(const float* W, int ldw, int k0, int kvalid, int srcn0, bf16* WT, int ldt, int drow0, int dk0, LAS float* scr, int lane) {
    const int c = lane & 7;
    if (srcn0 < 0) {
#pragma unroll
        for (int j = 0; j < 4; ++j) { const int n = (lane >> 3) + 8 * j; *(GAS v4u*)(WT + (size_t)(drow0 + n) * ldt + dk0 + 8 * c) = (v4u){0u, 0u, 0u, 0u}; }
        return;
    }
#pragma unroll 8
    for (int i = 0; i < 32; ++i) { const int kk = 2 * i + (lane >> 5); scr[kk * 33 + (lane & 31)] = (kk < kvalid) ? W[(size_t)(k0 + kk) * ldw + srcn0 + (lane & 31)] : 0.f; }
    LDS_WAIT(); asm volatile("" ::: "memory");
#pragma unroll
    for (int j = 0; j < 4; ++j) { const int n = (lane >> 3) + 8 * j; const LAS float* s = scr + (8 * c) * 33 + n;
        v4u o; o.x = pg8::cvt_pk_bf16(s[0 * 33], s[1 * 33]); o.y = pg8::cvt_pk_bf16(s[2 * 33], s[3 * 33]); o.z = pg8::cvt_pk_bf16(s[4 * 33], s[5 * 33]); o.w = pg8::cvt_pk_bf16(s[6 * 33], s[7 * 33]);
        *(GAS v4u*)(WT + (size_t)(drow0 + n) * ldt + dk0 + 8 * c) = o; }
    LDS_WAIT(); asm volatile("" ::: "memory");
}
__device__ __forceinline__ void tr_item_f8(const float* W, int ldw, int k0, int srcn0, unsigned char* WT, int ldt, int drow0, int dk0, float scale, LAS float* scr, int lane) {
    const int c = lane & 7;
#pragma unroll 8
    for (int i = 0; i < 32; ++i) { const int kk = 2 * i + (lane >> 5); scr[kk * 33 + (lane & 31)] = W[(size_t)(k0 + kk) * ldw + srcn0 + (lane & 31)]; }
    LDS_WAIT(); asm volatile("" ::: "memory");
#pragma unroll
    for (int j = 0; j < 4; ++j) { const int n = (lane >> 3) + 8 * j; const LAS float* s = scr + (8 * c) * 33 + n;
        unsigned w0 = 0u, w1 = 0u;
        w0 = __builtin_amdgcn_cvt_pk_fp8_f32(s[0 * 33] * scale, s[1 * 33] * scale, w0, false); w0 = __builtin_amdgcn_cvt_pk_fp8_f32(s[2 * 33] * scale, s[3 * 33] * scale, w0, true);
        w1 = __builtin_amdgcn_cvt_pk_fp8_f32(s[4 * 33] * scale, s[5 * 33] * scale, w1, false); w1 = __builtin_amdgcn_cvt_pk_fp8_f32(s[6 * 33] * scale, s[7 * 33] * scale, w1, true);
        v2u o; o.x = w0; o.y = w1; *(GAS v2u*)(WT + (size_t)(drow0 + n) * ldt + dk0 + 8 * c) = o; }
    LDS_WAIT(); asm volatile("" ::: "memory");
}
__device__ __forceinline__ int q8(float x) { const int q = (int)__builtin_rintf(x); return (q < -127 ? -127 : (q > 127 ? 127 : q)) & 0xff; }
__device__ __forceinline__ void tr_item_i8(const float* W, int ldw, int k0, int srcn0, unsigned char* WT, int ldt, int drow0, int dk0, const unsigned* cmax  , LAS float* scr, int lane) {
    const int c = lane & 7;
    if (srcn0 < 0) {
#pragma unroll
        for (int j = 0; j < 4; ++j) { const int n = (lane >> 3) + 8 * j; v2u o; o.x = 0u; o.y = 0u; *(GAS v2u*)(WT + (size_t)(drow0 + n) * ldt + dk0 + 8 * c) = o; }
        return;
    }
#pragma unroll 8
    for (int i = 0; i < 32; ++i) { const int kk = 2 * i + (lane >> 5); scr[kk * 33 + (lane & 31)] = W[(size_t)(k0 + kk) * ldw + srcn0 + (lane & 31)]; }
    LDS_WAIT(); asm volatile("" ::: "memory");
#pragma unroll
    for (int j = 0; j < 4; ++j) { const int n = (lane >> 3) + 8 * j; const LAS float* s = scr + (8 * c) * 33 + n;
        const float mx = __builtin_bit_cast(float, cmax[n]); const float sc = mx > 0.f ? 127.0f / mx : 0.f;
        v2u o; o.x = (unsigned)q8(s[0 * 33] * sc) | ((unsigned)q8(s[1 * 33] * sc) << 8) | ((unsigned)q8(s[2 * 33] * sc) << 16) | ((unsigned)q8(s[3 * 33] * sc) << 24);
        o.y = (unsigned)q8(s[4 * 33] * sc) | ((unsigned)q8(s[5 * 33] * sc) << 8) | ((unsigned)q8(s[6 * 33] * sc) << 16) | ((unsigned)q8(s[7 * 33] * sc) << 24);
        *(GAS v2u*)(WT + (size_t)(drow0 + n) * ldt + dk0 + 8 * c) = o; }
    LDS_WAIT(); asm volatile("" ::: "memory");
}
__device__ __forceinline__ void colmax_pass(Frame& F, const float* W, int ld, int col0, int nblk, unsigned* cmax, int K = 4096) {
    const int r8 = F.lane >> 3, c4 = F.lane & 7;
    for (int task = F.gw; task < 4 * nblk; task += F.ngw) { const int kp = task / nblk, nb = task % nblk;
        const int rp = K >> 2; const float* p = W + (size_t)(rp * kp + r8) * ld + col0 + 32 * nb + 4 * c4; f32x4 mx = (f32x4){0.f, 0.f, 0.f, 0.f};
#pragma unroll 8
        for (int i = 0; i < (rp >> 3); ++i) { const f32x4 v = *(const GAS f32x4*)(p + (size_t)(8 * i) * ld); mx = __builtin_elementwise_max(mx, __builtin_elementwise_abs(v)); }
#pragma unroll
        for (int o = 8; o < 64; o <<= 1) { mx.x = fmaxf(mx.x, __shfl_xor(mx.x, o)); mx.y = fmaxf(mx.y, __shfl_xor(mx.y, o)); mx.z = fmaxf(mx.z, __shfl_xor(mx.z, o)); mx.w = fmaxf(mx.w, __shfl_xor(mx.w, o)); }
        if (r8 == 0) { unsigned* q = cmax + 32 * nb + 4 * c4; const float m0 = mx.x, m1 = mx.y, m2 = mx.z, m3 = mx.w;     atomicMax(q, __builtin_bit_cast(unsigned, m0)); atomicMax(q + 1, __builtin_bit_cast(unsigned, m1)); atomicMax(q + 2, __builtin_bit_cast(unsigned, m2)); atomicMax(q + 3, __builtin_bit_cast(unsigned, m3)); }
    }
}
#ifndef SIDE_IN_SCAN
#define SIDE_IN_SCAN 1
#endif
__device__ __forceinline__ void colmax_task(int lane, const float* W, int ld, int col, int row0, int rows, unsigned* cmax) {
    const int r8 = lane >> 3, c4 = lane & 7; const float* p = W + (size_t)(row0 + r8) * ld + col + 4 * c4; f32x4 mx = (f32x4){0.f, 0.f, 0.f, 0.f};
#pragma unroll 8
    for (int i = 0; i < (rows >> 3); ++i) { const f32x4 v = *(const GAS f32x4*)(p + (size_t)(8 * i) * ld); mx = __builtin_elementwise_max(mx, __builtin_elementwise_abs(v)); }
#pragma unroll
    for (int o = 8; o < 64; o <<= 1) { mx.x = fmaxf(mx.x, __shfl_xor(mx.x, o)); mx.y = fmaxf(mx.y, __shfl_xor(mx.y, o)); mx.z = fmaxf(mx.z, __shfl_xor(mx.z, o)); mx.w = fmaxf(mx.w, __shfl_xor(mx.w, o)); }
    if (r8 == 0) { unsigned* q = cmax + 4 * c4; const float m0 = mx.x, m1 = mx.y, m2 = mx.z, m3 = mx.w;
        atomicMax(q, __builtin_bit_cast(unsigned, m0)); atomicMax(q + 1, __builtin_bit_cast(unsigned, m1)); atomicMax(q + 2, __builtin_bit_cast(unsigned, m2)); atomicMax(q + 3, __builtin_bit_cast(unsigned, m3)); }
}
__device__ __forceinline__ void p0_colmax(const Args& a, Frame& F) {
#if SIDE_IN_SCAN
    constexpr int T_R = 64 * 8, T_LG = 15 * 8, T_Q = 32 * 8, T_UQ = 96 * 4, T_UKV = 128 * 4, T_ALL = T_R + T_LG + T_Q + T_UQ + T_UKV;
    unsigned* CG = (unsigned*)(a.ws + WS_CMAXG);
    for (int t = F.gw; t < T_ALL; t += F.ngw) {
        int u = t;
        if (u < T_R) { const int nb = u % 64, kp = u / 64; colmax_task(F.lane, a.in[I_WIN], 16928, 32 * nb, 512 * kp, 512, CG + 8192 + 32 * nb); continue; }
        u -= T_R;
        if (u < T_LG) { const int nb = u % 15, kp = u / 15; colmax_task(F.lane, a.in[I_WIN], 16928, 6656 + 32 * nb, 512 * kp, 512, CG + 10240 + 32 * nb); continue; }
        u -= T_LG;
        if (u < T_Q) { const int nb = u % 32, kp = u / 32; colmax_task(F.lane, a.in[I_WIN], 16928, 7136 + 32 * nb, 512 * kp, 512, CG + 10752 + 32 * nb); continue; }
        u -= T_Q;
        if (u < T_UQ) { const int nb = u % 96, kp = u / 96; colmax_task(F.lane, a.in[I_WUQ], 3072, 32 * nb, 256 * kp, 256, (unsigned*)(a.ws + WS_CMAXUQ) + 32 * nb); continue; }
        u -= T_UQ;
        { const int nb = u % 128, kp = u / 128; colmax_task(F.lane, a.in[I_WUKV], 4096, 32 * nb, 128 * kp, 128, (unsigned*)(a.ws + WS_CMAXUKV) + 32 * nb); }
    }
#else
#if !SIDE_IN_SCAN
    colmax_pass(F, a.in[I_WFI], 2 * DFF, 0, 2 * DFF / 32, (unsigned*)(a.ws + WS_CMAX));
#endif
#if !SIDE_IN_SCAN
    colmax_pass(F, a.in[I_WIN], 16928, 8736, 256, (unsigned*)(a.ws + WS_CMAXG));
#endif
    colmax_pass(F, a.in[I_WIN], 16928, 0, 64, (unsigned*)(a.ws + WS_CMAXG) + 8192);
    colmax_pass(F, a.in[I_WIN], 16928, 6656, 15, (unsigned*)(a.ws + WS_CMAXG) + 10240);
    colmax_pass(F, a.in[I_WIN], 16928, 7136, 32, (unsigned*)(a.ws + WS_CMAXG) + 10752);
    colmax_pass(F, a.in[I_WUQ], 3072, 0, 96, (unsigned*)(a.ws + WS_CMAXUQ), QL);
    colmax_pass(F, a.in[I_WUKV], 4096, 0, 128, (unsigned*)(a.ws + WS_CMAXUKV), KVL);
#if !SIDE_IN_SCAN
    colmax_pass(F, a.in[I_WOUT], DM, 0, 128, (unsigned*)(a.ws + WS_CMAXO));
    colmax_pass(F, a.in[I_WOR], DM, 0, 128, (unsigned*)(a.ws + WS_CMAXR), DA);
#endif
#endif
}
__device__ __forceinline__ void p1_weights_i8(const Args& a, Frame& F) {
    LAS float* scr = (LAS float*)(F.lds + F.wave * 16384);
#if !SIDE_IN_SCAN
    constexpr int I_FI = (2 * DFF / 32) * 64;
    for (int r = F.gw; r < I_FI; r += F.ngw) { const int nblk = 2 * DFF / 32, kb = r / nblk, nb = r % nblk, n0 = 32 * nb, pn = n0 >> 8, j = n0 & 255; const int src = (j < 128) ? 128 * pn + j : DFF + 128 * pn + (j - 128);
        tr_item_i8(a.in[I_WFI], 2 * DFF, 64 * kb, src, (unsigned char*)(a.ws + WS_WFI), DM, n0, 64 * kb, (const unsigned*)(a.ws + WS_CMAX) + src, scr, F.lane); }
    for (int r = F.gw; r < 128 * 64; r += F.ngw) { const int kb = r >> 7, nb = r & 127;
        tr_item_i8(a.in[I_WOUT], DM, 64 * kb, 32 * nb, (unsigned char*)(a.ws + WS_WOUT), DM, 32 * nb, 64 * kb, (const unsigned*)(a.ws + WS_CMAXO) + 32 * nb, scr, F.lane); }
    for (int r = F.gw; r < 128 * 32; r += F.ngw) { const int kb = r >> 7, nb = r & 127;
        tr_item_i8(a.in[I_WOR], DM, 64 * kb, 32 * nb, (unsigned char*)(a.ws + WS_WOR), DA, 32 * nb, 64 * kb, (const unsigned*)(a.ws + WS_CMAXR) + 32 * nb, scr, F.lane); }
#endif
    constexpr int NB0 = SIDE_IN_SCAN ? 256 : 0, NBN = 368 - NB0;
    for (int r = F.gw; r < NBN * 64; r += F.ngw) { const int kb = r / NBN, nb = NB0 + r % NBN;
        const int src = nb < 256 ? 8736 + 32 * nb : (nb < 320 ? 32 * (nb - 256) : (nb < 336 ? (nb < 335 ? 6656 + 32 * (nb - 320) : -1) : 7136 + 32 * (nb - 336)));
        tr_item_i8(a.in[I_WIN], 16928, 64 * kb, src, (unsigned char*)(a.ws + WS_WING8), DM, 32 * nb, 64 * kb, (const unsigned*)(a.ws + WS_CMAXG) + 32 * nb, scr, F.lane); }
    for (int r = F.gw; r < 96 * 16; r += F.ngw) { const int kb = r / 96, nb = r % 96;
        tr_item_i8(a.in[I_WUQ], 3072, 64 * kb, 32 * nb, (unsigned char*)(a.ws + WS_WUQ), QL, 32 * nb, 64 * kb, (const unsigned*)(a.ws + WS_CMAXUQ) + 32 * nb, scr, F.lane); }
    for (int r = F.gw; r < 128 * 8; r += F.ngw) { const int kb = r >> 7, nb = r & 127;
        tr_item_i8(a.in[I_WUKV], 4096, 64 * kb, 32 * nb, (unsigned char*)(a.ws + WS_WUKV), KVL, 32 * nb, 64 * kb, (const unsigned*)(a.ws + WS_CMAXUKV) + 32 * nb, scr, F.lane); }
}
constexpr int NIN16 = 5376;
__device__ __forceinline__ int map_in(int n0) {
    if (n0 < 4608) return 2048 + n0;
    if (n0 < 5120) return 8160 + (n0 - 4608);
    if (n0 < 5184) return 8672 + (n0 - 5120);
    return -1;
}
__device__ __forceinline__ void p0_weights(const Args& a, Frame& F) {
    LAS float* scr = (LAS float*)(F.lds + F.wave * 16384);
    constexpr int I_IN = (NIN16 / 32) * 64, I_FO = SIDE_IN_SCAN ? 0 : (DM / 32) * (DFF / 64), I_OM = SIDE_IN_SCAN ? 0 : 128 * 32, I_UQ = 0, I_UKV = 0  , I_LORA = 256 * 4, I_G = 64 * 8;
    constexpr int NITEMS = I_IN + I_FO + I_OM + I_UQ + I_UKV + I_LORA + I_G;
    unsigned char* ws = a.ws;
    for (int it = F.gw; it < NITEMS; it += F.ngw) {
        int r = it;
        if (r < I_IN) { const int nblk = NIN16 / 32, kb = r / nblk, nb = r % nblk; tr_item(a.in[I_WIN], 16928, 64 * kb, 64, map_in(32 * nb), (bf16*)(ws + WS_WIN), DM, 32 * nb, 64 * kb, scr, F.lane); continue; } r -= I_IN;
        if (r < I_FO) { const int nblk = DM / 32, kb = r / nblk, nb = r % nblk; tr_item_f8(a.in[I_WFO], DM, 64 * kb, 32 * nb, (unsigned char*)(ws + WS_WFO), DFF, 32 * nb, 64 * kb, 128.0f, scr, F.lane); continue; } r -= I_FO;
        if (r < I_OM) { const int nblk = 128, kb = r / nblk, nb = r % nblk; tr_item(a.in[I_WOM], DM, 64 * kb, 64, 32 * nb, (bf16*)(ws + WS_WOM), DA, 32 * nb, 64 * kb, scr, F.lane); continue; } r -= I_OM;
        if (r < I_UQ) { const int nblk = 96, kb = r / nblk, nb = r % nblk; tr_item(a.in[I_WUQ], 3072, 64 * kb, 64, 32 * nb, (bf16*)(ws + WS_WUQ), QL, 32 * nb, 64 * kb, scr, F.lane); continue; } r -= I_UQ;
        if (r < I_UKV) { const int nblk = 128, kb = r / nblk, nb = r % nblk; tr_item(a.in[I_WUKV], 4096, 64 * kb, 64, 32 * nb, (bf16*)(ws + WS_WUKV), KVL, 32 * nb, 64 * kb, scr, F.lane); continue; } r -= I_UKV;
        if (r < I_LORA) {
            const int nblk = 256, kb = r / nblk, nb = r % nblk, n0 = 32 * nb, dir = n0 >> 12, j = n0 & 4095; const bool isw = j < 2048; const bool live = isw ? (kb < 2) : (kb >= 2);
            const float* src = (isw ? a.in[I_WLB] : a.in[I_ALB]) + (size_t)dir * 128 * DA;
            tr_item(src, DA, 64 * (kb & 1), 64, live ? (isw ? j : j - 2048) : -1, (bf16*)(ws + WS_WLORA), 256, n0, 64 * kb, scr, F.lane); continue; } r -= I_LORA;
        { const int nblk = 64, kb = r / nblk, nb = r % nblk; const int kv = 480 - 64 * kb; tr_item(a.in[I_GLB], DA, 64 * kb, kv < 0 ? 0 : kv, 32 * nb, (bf16*)(ws + WS_WG), 512, 32 * nb, 64 * kb, scr, F.lane); }
    }
}

__device__ __forceinline__ void sincos_small(double x, double& s, double& c) {
    const double n = __builtin_rint(x * 0.63661977236758134308);
    double r = __builtin_fma(-n, 1.57079632679489655800e+00, x); r = __builtin_fma(-n, 6.12323399573676603587e-17, r);
    const double r2 = r * r;
    double sp = -7.6471637318198164759e-13; sp = sp * r2 + 1.6059043836821614599e-10; sp = sp * r2 - 2.5052108385441718775e-08; sp = sp * r2 + 2.7557319223985890653e-06;
    sp = sp * r2 - 1.9841269841269841270e-04; sp = sp * r2 + 8.3333333333333333333e-03; sp = sp * r2 - 1.6666666666666666667e-01; const double sr = r + r * r2 * sp;
    double cp = 4.7794773323873852974e-14; cp = cp * r2 - 1.1470745597729724714e-11; cp = cp * r2 + 2.0876756987868098979e-09; cp = cp * r2 - 2.7557319223985890653e-07;
    cp = cp * r2 + 2.4801587301587301587e-05; cp = cp * r2 - 1.3888888888888888889e-03; cp = cp * r2 + 4.1666666666666666667e-02; cp = cp * r2 - 0.5; const double cr = 1.0 + r2 * cp;
    const int q = ((int)n) & 3;
    s = (q == 0) ? sr : (q == 1) ? cr : (q == 2) ? -sr : -cr;
    c = (q == 0) ? cr : (q == 1) ? -sr : (q == 2) ? -cr : sr;
}
__device__ __forceinline__ double rope_inv(int j) {
    switch (j) { case 0: return 1.0; case 1: return 0.56234132519034908; case 2: return 0.31622776601683794; case 3: return 0.17782794100389229; case 4: return 0.1; case 5: return 0.056234132519034911;
        case 6: return 0.031622776601683791; case 7: return 0.017782794100389229; case 8: return 0.01; case 9: return 0.0056234132519034910; case 10: return 0.0031622776601683794; case 11: return 0.0017782794100389228;
        case 12: return 0.001; case 13: return 0.00056234132519034910; case 14: return 0.00031622776601683794; default: return 0.00017782794100389228; }
}
__device__ __forceinline__ void p0_rope(const Args& a, Frame& F) {
    float* COS = (float*)(a.ws + WS_COS); float* SIN = (float*)(a.ws + WS_SIN); float* LB = (float*)(a.ws + WS_LBIAS);
    for (int i = blockIdx.x * 512 + F.tid; i < 8192; i += F.G * 512) LB[i] = (i < 4096) ? a.in[I_W0][i] : a.in[I_A0][i - 4096];
    for (int i = blockIdx.x * 512 + F.tid; i < 1024 * 32; i += F.G * 512) { const int t = i >> 5, f = i & 31;
        const double pos = (f < 16) ? (double)(t >> 6) : (double)(t & 63); const double ang = pos * rope_inv(f & 15);
        double s, c; sincos_small(ang, s, c); COS[i] = (float)c; SIN[i] = (float)s; }
}

__device__ __forceinline__ void modnorm_rows(Frame& F, const float* x0, const float* x1, const float* nw, const float* MOD, int shift_slot, bf16* H) {
    for (int row = F.gw; row < T; row += F.ngw) {
        const float* xr = row < T_P ? x0 + (size_t)row * DM : x1 + (size_t)(row - T_P) * DM;
        const float* md = MOD + (size_t)mod_index(row) * NMOD + shift_slot * DM;
        f32x4 v[16]; float ss = 0.f;
#pragma unroll
        for (int j = 0; j < 16; ++j) { v[j] = *((const GAS f32x4*)xr + F.lane + 64 * j); ss += (v[j].x * v[j].x + v[j].y * v[j].y) + (v[j].z * v[j].z + v[j].w * v[j].w); }
        const float rstd = 1.0f / sqrtf(wave_sum(ss) * (1.0f / DM) + NORM_EPS);
#pragma unroll
        for (int j = 0; j < 16; ++j) { const int col = 4 * (F.lane + 64 * j);
            const f32x4 w = *(const f32x4*)(nw + col), sh = *(const f32x4*)(md + col), sc = *(const f32x4*)(md + DM + col);
            const f32x4 o = v[j] * rstd * w * (sc + 1.0f) + sh;
            v2u p; p.x = pg8::cvt_pk_bf16(o.x, o.y); p.y = pg8::cvt_pk_bf16(o.z, o.w); *(GAS v2u*)(H + (size_t)row * DM + col) = p; }
    }
}

__device__ __forceinline__ void modnorm_rows_dual(Frame& F, const float* x0, const float* x1, const float* nw, const float* MOD, int shift_slot, bf16* H, unsigned char* HQ, float* ROWS) {
    for (int row = F.gw; row < T; row += F.ngw) {
        const float* xr = row < T_P ? x0 + (size_t)row * DM : x1 + (size_t)(row - T_P) * DM;
        const float* md = MOD + (size_t)mod_index(row) * NMOD + shift_slot * DM;
        f32x4 v[16]; float ss = 0.f;
#pragma unroll
        for (int j = 0; j < 16; ++j) { v[j] = *((const GAS f32x4*)xr + F.lane + 64 * j); ss += (v[j].x * v[j].x + v[j].y * v[j].y) + (v[j].z * v[j].z + v[j].w * v[j].w); }
        const float rstd = 1.0f / sqrtf(wave_sum(ss) * (1.0f / DM) + NORM_EPS); float mx = 0.f;
#pragma unroll
        for (int jh = 0; jh < 16; jh += 4) {
#pragma unroll
            for (int j = jh; j < jh + 4; ++j) { const int col = 4 * (F.lane + 64 * j);
                const f32x4 w = *(const f32x4*)(nw + col), sh = *(const f32x4*)(md + col), sc = *(const f32x4*)(md + DM + col);
                v[j] = v[j] * rstd * w * (sc + 1.0f) + sh; mx = fmaxf(mx, fmaxf(fmaxf(fabsf(v[j].x), fabsf(v[j].y)), fmaxf(fabsf(v[j].z), fabsf(v[j].w)))); }
#pragma unroll
            for (int j = jh; j < jh + 4; ++j) { const int col = 4 * (F.lane + 64 * j);
                v2u p; p.x = pg8::cvt_pk_bf16(v[j].x, v[j].y); p.y = pg8::cvt_pk_bf16(v[j].z, v[j].w); *(GAS v2u*)(H + (size_t)row * DM + col) = p; }
        }
#pragma unroll
        for (int o = 1; o < 64; o <<= 1) mx = fmaxf(mx, __shfl_xor(mx, o));
        const float qs = mx > 0.f ? 127.0f / mx : 0.f;
        if (F.lane == 0) ROWS[row] = mx * (1.0f / 127.0f);
#pragma unroll
        for (int j = 0; j < 16; ++j) { const int col = 4 * (F.lane + 64 * j);
            *(GAS unsigned*)(HQ + (size_t)row * DM + col) = (unsigned)q8(v[j].x * qs) | ((unsigned)q8(v[j].y * qs) << 8) | ((unsigned)q8(v[j].z * qs) << 16) | ((unsigned)q8(v[j].w * qs) << 24); }
    }
}

__device__ __forceinline__ void modnorm_rows_i8(Frame& F, const bf16* X1, const float* nw, const float* MOD, int shift_slot, unsigned char* H, float* ROWS) {
    for (int row = F.gw; row < T; row += F.ngw) {
        const bf16* xr = X1 + (size_t)row * DM;
        const float* md = MOD + (size_t)mod_index(row) * NMOD + shift_slot * DM;
        f32x4 v[16]; float ss = 0.f;
#pragma unroll
        for (int j = 0; j < 16; ++j) { const v2u t = *((const GAS v2u*)xr + F.lane + 64 * j); v[j] = (f32x4){pg8::bflo(t.x), pg8::bfhi(t.x), pg8::bflo(t.y), pg8::bfhi(t.y)}; ss += (v[j].x * v[j].x + v[j].y * v[j].y) + (v[j].z * v[j].z + v[j].w * v[j].w); }
        const float rstd = 1.0f / sqrtf(wave_sum(ss) * (1.0f / DM) + NORM_EPS); float mx = 0.f;
#pragma unroll
        for (int j = 0; j < 16; ++j) { const int col = 4 * (F.lane + 64 * j);
            const f32x4 w = *(const f32x4*)(nw + col), sh = *(const f32x4*)(md + col), sc = *(const f32x4*)(md + DM + col);
            v[j] = v[j] * rstd * w * (sc + 1.0f) + sh; mx = fmaxf(mx, fmaxf(fmaxf(fabsf(v[j].x), fabsf(v[j].y)), fmaxf(fabsf(v[j].z), fabsf(v[j].w)))); }
#pragma unroll
        for (int o = 1; o < 64; o <<= 1) mx = fmaxf(mx, __shfl_xor(mx, o));
        const float qs = mx > 0.f ? 127.0f / mx : 0.f;
        if (F.lane == 0) ROWS[row] = mx * (1.0f / 127.0f);
#pragma unroll
        for (int j = 0; j < 16; ++j) { const int col = 4 * (F.lane + 64 * j);
            *(GAS unsigned*)(H + (size_t)row * DM + col) = (unsigned)q8(v[j].x * qs) | ((unsigned)q8(v[j].y * qs) << 8) | ((unsigned)q8(v[j].z * qs) << 16) | ((unsigned)q8(v[j].w * qs) << 24); }
    }
}

__device__ __forceinline__ void p8c_quant_mixed(const Args& a, Frame& F) {
    const bf16* MX = (const bf16*)(a.ws + WS_MIXED); unsigned char* Q = (unsigned char*)(a.ws + WS_MIX8); const unsigned* rmax = (const unsigned*)(a.ws + WS_RMAXM); float* ROWS = (float*)(a.ws + WS_ROWSM);
    for (int row = F.gw; row < T; row += F.ngw) { const float mx = __builtin_bit_cast(float, rmax[row]); const float qs = mx > 0.f ? 127.0f / mx : 0.f;
        if (F.lane == 0) ROWS[row] = mx * (1.0f / 127.0f);
        v4u wv[8];
#pragma unroll
        for (int j = 0; j < 8; ++j) wv[j] = *(const GAS v4u*)(MX + (size_t)row * DM + 8 * (F.lane + 64 * j));
#pragma unroll
        for (int j = 0; j < 8; ++j) { const int col = 8 * (F.lane + 64 * j); const v4u w = wv[j];
            v2u o; o.x = (unsigned)q8(pg8::bflo(w.x) * qs) | ((unsigned)q8(pg8::bfhi(w.x) * qs) << 8) | ((unsigned)q8(pg8::bflo(w.y) * qs) << 16) | ((unsigned)q8(pg8::bfhi(w.y) * qs) << 24);
            o.y = (unsigned)q8(pg8::bflo(w.z) * qs) | ((unsigned)q8(pg8::bfhi(w.z) * qs) << 8) | ((unsigned)q8(pg8::bflo(w.w) * qs) << 16) | ((unsigned)q8(pg8::bfhi(w.w) * qs) << 24);
            *(GAS v2u*)(Q + (size_t)row * DM + col) = o; } }
}

__device__ __forceinline__ int kv_row_of_token(int row) { return row < T_P ? row : T_P + ((row - T_P) >> 10) * 1536 + 512 + ((row - T_P) & 1023); }
__device__ __forceinline__ float h2f_(unsigned u) { return (float)__builtin_bit_cast(_Float16, (unsigned short)u); }
__device__ __forceinline__ unsigned q8x4(f32x4 o, float qs) { return (unsigned)q8(o.x * qs) | ((unsigned)q8(o.y * qs) << 8) | ((unsigned)q8(o.z * qs) << 16) | ((unsigned)q8(o.w * qs) << 24); }
__device__ __forceinline__ float absmax4(f32x4 o) { return fmaxf(fmaxf(fabsf(o.x), fabsf(o.y)), fmaxf(fabsf(o.z), fabsf(o.w))); }
__device__ __forceinline__ float wave_max(float v) {
#pragma unroll
    for (int o = 1; o < 64; o <<= 1) v = fmaxf(v, __shfl_xor(v, o));
    return v;
}
__device__ __forceinline__ float wave_sum_d(float x) { x = row16_sum(x); const int xi = __builtin_bit_cast(int, x);
    return (__builtin_bit_cast(float, __builtin_amdgcn_readlane(xi, 0)) + __builtin_bit_cast(float, __builtin_amdgcn_readlane(xi, 16))) + (__builtin_bit_cast(float, __builtin_amdgcn_readlane(xi, 32)) + __builtin_bit_cast(float, __builtin_amdgcn_readlane(xi, 48))); }
__device__ __forceinline__ float wave_max_d(float x) {
    x = fmaxf(x, dpp_f(x, 0)); x = fmaxf(x, dpp_f(x, 1)); x = fmaxf(x, dpp_f(x, 2)); x = fmaxf(x, dpp_f(x, 3)); const int xi = __builtin_bit_cast(int, x);
    return fmaxf(fmaxf(__builtin_bit_cast(float, __builtin_amdgcn_readlane(xi, 0)), __builtin_bit_cast(float, __builtin_amdgcn_readlane(xi, 16))), fmaxf(__builtin_bit_cast(float, __builtin_amdgcn_readlane(xi, 32)), __builtin_bit_cast(float, __builtin_amdgcn_readlane(xi, 48)))); }
__device__ __forceinline__ void p3_post(const Args& a, Frame& F) {
    const float* QLAT = (const float*)(a.ws + WS_QLAT); const float* KVLAT = (const float*)(a.ws + WS_KVLAT); const float* KPE = (const float*)(a.ws + WS_KPE);
    unsigned char* QN = (unsigned char*)(a.ws + WS_QN); unsigned char* CKVA = (unsigned char*)(a.ws + WS_CKVA); float* ROWSQ = (float*)(a.ws + WS_ROWSQ); float* ROWSKV = (float*)(a.ws + WS_ROWSKV);
    const float* qnw = a.in[I_QNW]; const float* kvnw = a.in[I_KVNW];
    for (int task = F.gw; task < T + 2048; task += F.ngw) {
        if (task < T) { const int row = task;
            v2u tq[4]; f32x4 vk[2], wq[4], wk[2];
#pragma unroll
            for (int j = 0; j < 4; ++j) { tq[j] = *((const GAS v2u*)((const unsigned short*)QLAT + (size_t)row * QL) + F.lane + 64 * j); wq[j] = *(const f32x4*)(qnw + 4 * (F.lane + 64 * j)); }
#pragma unroll
            for (int j = 0; j < 2; ++j) { vk[j] = *((const GAS f32x4*)(KVLAT + (size_t)row * KVL) + F.lane + 64 * j); wk[j] = *(const f32x4*)(kvnw + 4 * (F.lane + 64 * j)); }
            const float kpev = (row < T_P) ? KPE[(size_t)row * 64 + F.lane] : 0.f;
            f32x4 v[4]; float ss = 0.f;
#pragma unroll
            for (int j = 0; j < 4; ++j) { v[j] = (f32x4){h2f_(tq[j].x & 0xffff), h2f_(tq[j].x >> 16), h2f_(tq[j].y & 0xffff), h2f_(tq[j].y >> 16)}; ss += (v[j].x * v[j].x + v[j].y * v[j].y) + (v[j].z * v[j].z + v[j].w * v[j].w); }
            const float rstd = 1.0f / sqrtf(wave_sum_d(ss) * (1.0f / QL) + NORM_EPS); float mx = 0.f;
#pragma unroll
            for (int j = 0; j < 4; ++j) { v[j] = v[j] * rstd * wq[j]; mx = fmaxf(mx, absmax4(v[j])); }
            mx = wave_max_d(mx); const float qs = mx > 0.f ? 127.0f / mx : 0.f;
            float ss2 = 0.f;
#pragma unroll
            for (int j = 0; j < 2; ++j) ss2 += (vk[j].x * vk[j].x + vk[j].y * vk[j].y) + (vk[j].z * vk[j].z + vk[j].w * vk[j].w);
            const float rstd2 = 1.0f / sqrtf(wave_sum_d(ss2) * (1.0f / KVL) + NORM_EPS); const int kr = kv_row_of_token(row); float mx2 = 0.f;
#pragma unroll
            for (int j = 0; j < 2; ++j) { vk[j] = vk[j] * rstd2 * wk[j]; mx2 = fmaxf(mx2, absmax4(vk[j])); }
            mx2 = wave_max_d(mx2); const float qs2 = mx2 > 0.f ? 127.0f / mx2 : 0.f;
            if (F.lane == 0) { ROWSQ[row] = mx * (1.0f / 127.0f); ROWSKV[kr] = mx2 * (1.0f / 127.0f); }
#pragma unroll
            for (int j = 0; j < 4; ++j) *(GAS unsigned*)(QN + (size_t)row * QL + 4 * (F.lane + 64 * j)) = q8x4(v[j], qs);
#pragma unroll
            for (int j = 0; j < 2; ++j) { const int col = 4 * (F.lane + 64 * j); *(GAS unsigned*)(CKVA + (size_t)kr * KVL + col) = q8x4(vk[j], qs2);
                if (row < T_P) *(GAS f32x4*)(a.out + OUT_CKV + (size_t)row * KVL + col) = vk[j]; }
            if (row < T_P) a.out[OUT_KPE + (size_t)row * 64 + F.lane] = kpev;
        } else { const int idx = task - T, b = idx >> 9, p = idx & 511; const float* src = a.in[I_CCKV] + (size_t)idx * KVL; const int kr = T_P + b * 1536 + p;
            f32x4 v[2]; float mx = 0.f;
#pragma unroll
            for (int j = 0; j < 2; ++j) { v[j] = *(const GAS f32x4*)(src + 4 * (F.lane + 64 * j)); mx = fmaxf(mx, absmax4(v[j])); }
            mx = wave_max_d(mx); const float qs = mx > 0.f ? 127.0f / mx : 0.f; if (F.lane == 0) ROWSKV[kr] = mx * (1.0f / 127.0f);
#pragma unroll
            for (int j = 0; j < 2; ++j) { const int col = 4 * (F.lane + 64 * j); *(GAS unsigned*)(CKVA + (size_t)kr * KVL + col) = q8x4(v[j], qs); }
        }
    }
}
struct SidePair { int kind, first, last, cs; const float* src; unsigned char* dst; unsigned* cm; unsigned ld, ldt; };
constexpr int SIDE_PART_OFF = 98304;
static_assert(SIDE_PART_OFF + 1024 <= RING_BYTES, "side-work LDS");
__device__ __forceinline__ void side_pair_next(const Args& a, int b, int w, int p, SidePair& d) {
    const int s8p = b < 96 ? 80 : 72;
    if (p < s8p) {
        const int win = p >> 4, within = p & 15; const bool half = (win == 4 && b >= 48);
        const int wi = half ? (within & 7) : within, nsubp = half ? 4 : 8;
        if (wi != 0 && wi != nsubp) { const int subp = wi >= nsubp ? wi - nsubp : wi; d.src += (size_t)64 * d.ld; d.dst += 64; d.first = 0; d.last = subp == nsubp - 1; return; }
        int K, srcc;
        if (!half) { const int idx = b + 256 * win; K = DM;
            if (idx < 688) { const int n0 = 32 * idx, pn = n0 >> 8, j = n0 & 255; srcc = (j < 128) ? 128 * pn + j : DFF + 128 * pn + (j - 128);
                d.src = a.in[I_WFI]; d.ld = 2 * DFF; d.dst = a.ws + WS_WFI + (size_t)n0 * DM; d.cm = (unsigned*)(a.ws + WS_CMAX) + srcc; }
            else if (idx < 944) { const int nb = idx - 688; srcc = 8736 + 32 * nb; d.src = a.in[I_WIN]; d.ld = 16928; d.dst = a.ws + WS_WGATE8 + (size_t)(32 * nb) * DM; d.cm = (unsigned*)(a.ws + WS_CMAXG) + 32 * nb; }
            else { const int nb = idx - 944; srcc = 32 * nb; d.src = a.in[I_WOUT]; d.ld = DM; d.dst = a.ws + WS_WOUT + (size_t)(32 * nb) * DM; d.cm = (unsigned*)(a.ws + WS_CMAXO) + 32 * nb; }
        } else { K = DA; d.ld = DM;
            if ((within >> 3) == 0 && b < 176) { const int nb = b - 48; srcc = 32 * nb; d.src = a.in[I_WOR]; d.dst = a.ws + WS_WOR + (size_t)(32 * nb) * DA; d.cm = (unsigned*)(a.ws + WS_CMAXR) + 32 * nb; }
            else { const int nb = b >= 176 ? b - 176 : 80 + (b - 48); srcc = 32 * nb; d.src = a.in[I_WOM]; d.dst = a.ws + WS_WOM + (size_t)(32 * nb) * DA; d.cm = (unsigned*)(a.ws + WS_CMAXM) + 32 * nb; } }
        const int pass = wi >= nsubp ? 1 : 0, k0 = w * (K >> 3);
        d.kind = 1 + pass; d.first = 1; d.last = 0; d.ldt = (unsigned)K; d.cs = 3;
        d.src += (size_t)k0 * d.ld + srcc; d.dst += k0;
        return;
    }
    const int f = b + 256 * (p - s8p);
    d.first = 0; d.last = 0; d.ld = DM; d.cs = 4;
    if (f < 2752) { const int nbp = f & 63, k0 = 256 * (f >> 6) + 32 * w; d.kind = 3; d.src = a.in[I_WFO] + (size_t)k0 * DM + 64 * nbp; d.dst = a.ws + WS_WFO + (size_t)(64 * nbp) * DFF + k0; d.ldt = DFF; }
    else { d.kind = 0; d.src = a.in[I_WFI]; d.ld = 0; d.cs = 3; }
}
__device__ __forceinline__ const char* side_issue_addr(const SidePair& d, int lane) {
    const int g = lane >> d.cs, cg = lane & ((1 << d.cs) - 1);
    const unsigned loff = ((unsigned)(8 * g) * d.ld + (unsigned)(4 * cg)) * 4u;
    return (const char*)d.src + loff;
}
__device__ __forceinline__ f32x4 side_issue_one(const char* pa, unsigned ld, int j) { return *(const GAS f32x4*)(pa + (size_t)j * ld * 4u); }
__device__ __forceinline__ unsigned side_pack4(float a, float b, float c, float e, float sc) {
    const unsigned q0 = __builtin_bit_cast(unsigned, __builtin_fmaf(a, sc, 12582912.0f)), q1 = __builtin_bit_cast(unsigned, __builtin_fmaf(b, sc, 12582912.0f));
    const unsigned q2 = __builtin_bit_cast(unsigned, __builtin_fmaf(c, sc, 12582912.0f)), q3 = __builtin_bit_cast(unsigned, __builtin_fmaf(e, sc, 12582912.0f));
    return __builtin_amdgcn_perm(q1, q0, 0x0c0c0400u) | __builtin_amdgcn_perm(q3, q2, 0x04000c0cu);
}
#define SIDE_COL(c_, j_) (c_ == 0 ? R[j_].x : c_ == 1 ? R[j_].y : c_ == 2 ? R[j_].z : R[j_].w)
__device__ __forceinline__ void side_consume(const SidePair& d, int lane, int w, const f32x4 (&R)[8], float (&mx)[4], float (&sc)[4], LAS float* PART) {
    if (d.kind == 0) return;
    const int g = lane >> d.cs, cg = lane & ((1 << d.cs) - 1);
    if (d.kind == 1) {
        f32x4 m = d.first ? (f32x4){0.f, 0.f, 0.f, 0.f} : (f32x4){mx[0], mx[1], mx[2], mx[3]};
#pragma unroll
        for (int j = 0; j < 8; ++j) m = __builtin_elementwise_max(m, __builtin_elementwise_abs(R[j]));
        if (d.last) {
#pragma unroll
            for (int o = 8; o < 64; o <<= 1) { m.x = fmaxf(m.x, __shfl_xor(m.x, o)); m.y = fmaxf(m.y, __shfl_xor(m.y, o)); m.z = fmaxf(m.z, __shfl_xor(m.z, o)); m.w = fmaxf(m.w, __shfl_xor(m.w, o)); }
            if (lane < 8) *(LAS f32x4*)(PART + w * 32 + 4 * lane) = m;
        }
        mx[0] = m.x; mx[1] = m.y; mx[2] = m.z; mx[3] = m.w;
        return;
    }
    if (d.kind == 2) {
        if (d.first) { f32x4 m = *(const LAS f32x4*)(PART + 4 * cg);
#pragma unroll
            for (int r = 1; r < 8; ++r) m = __builtin_elementwise_max(m, *(const LAS f32x4*)(PART + r * 32 + 4 * cg));
            sc[0] = m.x > 0.f ? 127.0f / m.x : 0.f; sc[1] = m.y > 0.f ? 127.0f / m.y : 0.f; sc[2] = m.z > 0.f ? 127.0f / m.z : 0.f; sc[3] = m.w > 0.f ? 127.0f / m.w : 0.f;
            if (w == 0 && g == 0) { const float m0 = m.x, m1 = m.y, m2 = m.z, m3 = m.w; v4u o; o.x = __builtin_bit_cast(unsigned, m0); o.y = __builtin_bit_cast(unsigned, m1); o.z = __builtin_bit_cast(unsigned, m2); o.w = __builtin_bit_cast(unsigned, m3);
                *(GAS v4u*)(d.cm + 4 * cg) = o; } }
        unsigned char* q = d.dst + (size_t)(4 * cg) * d.ldt + 8 * g;
#pragma unroll
        for (int c = 0; c < 4; ++c) { v2u o; o.x = side_pack4(SIDE_COL(c, 0), SIDE_COL(c, 1), SIDE_COL(c, 2), SIDE_COL(c, 3), sc[c]); o.y = side_pack4(SIDE_COL(c, 4), SIDE_COL(c, 5), SIDE_COL(c, 6), SIDE_COL(c, 7), sc[c]);
            *(GAS v2u*)(q + (size_t)c * d.ldt) = o; }
        return;
    }
    if (d.kind == 3) {
        unsigned char* q = d.dst + (size_t)(4 * cg) * d.ldt + 8 * g;
#pragma unroll
        for (int c = 0; c < 4; ++c) { unsigned t0 = 0u, t1 = 0u;
            t0 = __builtin_amdgcn_cvt_pk_fp8_f32(SIDE_COL(c, 0) * 128.0f, SIDE_COL(c, 1) * 128.0f, t0, false); t0 = __builtin_amdgcn_cvt_pk_fp8_f32(SIDE_COL(c, 2) * 128.0f, SIDE_COL(c, 3) * 128.0f, t0, true);
            t1 = __builtin_amdgcn_cvt_pk_fp8_f32(SIDE_COL(c, 4) * 128.0f, SIDE_COL(c, 5) * 128.0f, t1, false); t1 = __builtin_amdgcn_cvt_pk_fp8_f32(SIDE_COL(c, 6) * 128.0f, SIDE_COL(c, 7) * 128.0f, t1, true);
            v2u o; o.x = t0; o.y = t1; *(GAS v2u*)(q + (size_t)c * d.ldt) = o; }
        return;
    }
    {
        unsigned char* q = d.dst + ((size_t)(4 * cg) * d.ldt + 8 * g) * 2;
#pragma unroll
        for (int c = 0; c < 4; ++c) { v4u o; o.x = pg8::cvt_pk_bf16(SIDE_COL(c, 0), SIDE_COL(c, 1)); o.y = pg8::cvt_pk_bf16(SIDE_COL(c, 2), SIDE_COL(c, 3)); o.z = pg8::cvt_pk_bf16(SIDE_COL(c, 4), SIDE_COL(c, 5)); o.w = pg8::cvt_pk_bf16(SIDE_COL(c, 6), SIDE_COL(c, 7));
            *(GAS v4u*)(q + (size_t)c * d.ldt * 2) = o; }
    }
}
constexpr int SC_TS = 16, SC_NCH = 96, SC_BUF_FLOATS = SC_TS * 6 * 64;
struct ScanChain { int row0, L, h, dir, b, is_sample; };
__device__ __forceinline__ ScanChain scan_chain(int gid, int idx) {
    ScanChain c; int code;
    if (gid < 256) { if (idx == 0) { code = gid; c.is_sample = 1; } else { code = 2 * gid + (idx - 1); c.is_sample = 0; } }
    else { code = 512 + 6 * (gid - 256) + idx; c.is_sample = 0; }
    c.b = code >> 6; c.h = (code >> 1) & 31; c.dir = code & 1;
    if (c.is_sample) { c.row0 = T_P + c.b * 1024; c.L = 1024; } else { c.row0 = c.b * 256; c.L = 256; }
    return c;
}
__device__ __forceinline__ void scan_locate(int gid, int ci, int& idx, int& chunk) {
    if (gid < 256) { if (ci < 64) { idx = 0; chunk = ci; } else { idx = 1 + ((ci - 64) >> 4); chunk = (ci - 64) & 15; } }
    else { idx = ci >> 4; chunk = ci & 15; }
}
struct ScanPref { unsigned short r[4], k[4], v[4], e[4], a[4]; float kk, ka, rk; };
__device__ __forceinline__ float h2f(unsigned short u) { return (float)__builtin_bit_cast(_Float16, u); }

__device__ __forceinline__ float fmul_s(float a, float b) { float r; asm("v_mul_f32_e32 %0, %1, %2" : "=v"(r) : "v"(a), "v"(b)); return r; }
__device__ __forceinline__ float ffma_s(float a, float b, float c) { float r; asm("v_fma_f32 %0, %1, %2, %3" : "=v"(r) : "v"(a), "v"(b), "v"(c)); return r; }
__device__ __forceinline__ void reduce2_oct(float& a, float& b) {
    asm("s_nop 1\n\t"
        "v_add_f32_dpp %0, %0, %0 quad_perm:[1,0,3,2] row_mask:0xf bank_mask:0xf bound_ctrl:1\n\t"
        "v_add_f32_dpp %1, %1, %1 quad_perm:[1,0,3,2] row_mask:0xf bank_mask:0xf bound_ctrl:1\n\t"
        "s_nop 0\n\t"
        "v_add_f32_dpp %0, %0, %0 quad_perm:[2,3,0,1] row_mask:0xf bank_mask:0xf bound_ctrl:1\n\t"
        "v_add_f32_dpp %1, %1, %1 quad_perm:[2,3,0,1] row_mask:0xf bank_mask:0xf bound_ctrl:1\n\t"
        "s_nop 0\n\t"
        "v_add_f32_dpp %0, %0, %0 row_half_mirror row_mask:0xf bank_mask:0xf bound_ctrl:1\n\t"
        "v_add_f32_dpp %1, %1, %1 row_half_mirror row_mask:0xf bank_mask:0xf bound_ctrl:1\n\t"
        : "+v"(a), "+v"(b));
}
__device__ __forceinline__ float wave_sum_u(float x) {
    x = row16_sum(x);
    const int xi = __builtin_bit_cast(int, x);
    const float s0 = __builtin_bit_cast(float, __builtin_amdgcn_readlane(xi, 0)), s1 = __builtin_bit_cast(float, __builtin_amdgcn_readlane(xi, 16)),
                s2 = __builtin_bit_cast(float, __builtin_amdgcn_readlane(xi, 32)), s3 = __builtin_bit_cast(float, __builtin_amdgcn_readlane(xi, 48));
    return (s0 + s1) + (s2 + s3);
}
template <int SIDE = 1> __device__ __forceinline__ void p5_scan(const Args& a, Frame& F) {
    const unsigned short* RKV = (const unsigned short*)(a.ws + WS_RKV); const unsigned char* EW = (const unsigned char*)(a.ws + WS_EW); const unsigned char* AA = EW + (size_t)2 * T * DA;
    _Float16* YS = (_Float16*)(a.ws + WS_YS); float* BON = (float*)(a.ws + WS_BON);
    const float* k_k = a.in[I_KK]; const float* k_a = a.in[I_KA]; const float* r_k = a.in[I_RK];
    const int grp = F.wave >> 2, wq = F.wave & 3, lane = F.lane, rp = lane >> 3, kq = lane & 7;
    LAS float* buf0 = (LAS float*)F.lds + (grp * 2) * SC_BUF_FLOATS;
    if (F.G != 256) return;
    const int gid = grp == 0 ? (int)blockIdx.x : 256 + (int)blockIdx.x;

    ScanPref P; float bonv[4];
#define SC_LOAD(ci_) do { const int cc_ = (ci_) < SC_NCH ? (ci_) : SC_NCH - 1; int idx_, ch_; scan_locate(gid, cc_, idx_, ch_); const ScanChain c_ = scan_chain(gid, idx_); \
        P.kk = k_k[c_.h * 64 + lane]; P.ka = k_a[c_.h * 64 + lane]; P.rk = r_k[c_.h * 64 + lane]; \
        _Pragma("unroll") for (int j = 0; j < 4; ++j) { const int s_ = ch_ * SC_TS + 4 * wq + j; const int t_ = c_.dir ? c_.L - 1 - s_ : s_; const size_t row_ = (size_t)(c_.row0 + t_); \
            const unsigned short* rp = RKV + row_ * 6144 + c_.h * 64 + lane; P.r[j] = rp[0]; P.k[j] = rp[2048]; P.v[j] = rp[4096]; \
            const size_t o_ = ((size_t)c_.dir * T + row_) * DA + c_.h * 64 + lane; P.e[j] = EW[o_]; P.a[j] = AA[o_]; } } while (0)
#define SC_STAGE(ci_, pb_) do { const int cc_ = (ci_) < SC_NCH ? (ci_) : SC_NCH - 1; int idx_, ch_; scan_locate(gid, cc_, idx_, ch_); const ScanChain c_ = scan_chain(gid, idx_); LAS float* B_ = buf0 + (pb_) * SC_BUF_FLOATS; \
        const float kkw = P.kk, kaw = P.ka, rkw = P.rk;     \
        _Pragma("unroll") for (int j = 0; j < 4; ++j) { const int i_ = 4 * wq + j; \
            const float r_ = h2f(P.r[j]), k_ = h2f(P.k[j]), v_ = h2f(P.v[j]), e_ = (float)P.e[j] * (0.60653065971263342f / 255.0f), a_ = (float)P.a[j] * (1.0f / 255.0f); \
            const float kr_ = k_ * kkw; const float kk_ = kr_ * __builtin_amdgcn_rsqf(wave_sum_u(kr_ * kr_) + 1e-12f); \
            const float kd_ = k_ * (1.0f + (a_ - 1.0f) * kaw); bonv[j] = wave_sum_u(r_ * kd_ * rkw); \
            LAS float* o_ = B_ + i_ * 6 * 64 + lane; o_[0] = -kk_; o_[64] = __expf(-e_); o_[128] = kk_ * a_; o_[192] = kd_; o_[256] = r_; o_[320] = v_; } } while (0)
#define SC_BON(ci_) do { if ((ci_) < SC_NCH && lane < 4) { int idx_, ch_; scan_locate(gid, (ci_), idx_, ch_); const ScanChain c_ = scan_chain(gid, idx_); \
            const int s_ = ch_ * SC_TS + 4 * wq + lane; const int t_ = c_.dir ? c_.L - 1 - s_ : s_; \
            const float bv_ = lane == 0 ? bonv[0] : lane == 1 ? bonv[1] : lane == 2 ? bonv[2] : bonv[3]; \
            BON[((size_t)c_.dir * T + (size_t)(c_.row0 + t_)) * 32 + c_.h] = bv_; } } while (0)

    SC_LOAD(0); SC_STAGE(0, 0); SC_BON(0); SC_LOAD(1);
    asm volatile("s_waitcnt lgkmcnt(0)" ::: "memory"); __syncthreads();

    float S[2][8];
#if SIDE_IN_SCAN
    f32x4 SR[8]; float smx[4] = {0.f, 0.f, 0.f, 0.f}, ssc[4] = {0.f, 0.f, 0.f, 0.f};
#pragma unroll
    for (int j = 0; j < 8; ++j) SR[j] = (f32x4){0.f, 0.f, 0.f, 0.f};
    LAS float* PART = (LAS float*)(F.lds + SIDE_PART_OFF);
    const char* spa = (const char*)a.in[I_WFI]; unsigned sld = 0;
    SidePair sd; sd.kind = 0; sd.first = 0; sd.last = 0; sd.src = a.in[I_WFI]; sd.dst = a.ws; sd.cm = (unsigned*)(a.ws + WS_CMAX); sd.ld = 0; sd.ldt = 0; sd.cs = 3;
#endif
    for (int ci = 0; ci < SC_NCH; ++ci) {
        int idx, chunk; scan_locate(gid, ci, idx, chunk); const ScanChain c = scan_chain(gid, idx);
        const size_t sbase = (size_t)((c.b * 2 + c.dir) * 32 + c.h) * 4096 + (size_t)(16 * wq + 2 * rp) * 64 + 8 * kq;
        if (chunk == 0) {
            if (c.is_sample) {
#pragma unroll
                for (int rr = 0; rr < 2; ++rr) { const f32x4 s0 = *(const f32x4*)(a.in[I_STATE] + sbase + rr * 64), s1 = *(const f32x4*)(a.in[I_STATE] + sbase + rr * 64 + 4);
                    S[rr][0] = s0.x; S[rr][1] = s0.y; S[rr][2] = s0.z; S[rr][3] = s0.w; S[rr][4] = s1.x; S[rr][5] = s1.y; S[rr][6] = s1.z; S[rr][7] = s1.w; }
#pragma unroll
                for (int rr = 0; rr < 2; ++rr)
#pragma unroll
                    for (int j = 0; j < 8; ++j) asm volatile("" : "+v"(S[rr][j]));
            } else {
#pragma unroll
                for (int rr = 0; rr < 2; ++rr)
#pragma unroll
                    for (int j = 0; j < 8; ++j) S[rr][j] = 0.f;
            }
        }
        const LAS float* B = buf0 + (ci & 1) * SC_BUF_FLOATS;
        _Float16* yout = YS + (size_t)c.dir * T * DA + c.h * 64 + 16 * wq + 2 * rp;
        unsigned ypk[SC_TS];
#define SC_RD8(dst, off) do { const f32x4 lo_ = *(const LAS f32x4*)(O + (off) + 8 * kq), hi_ = *(const LAS f32x4*)(O + (off) + 8 * kq + 4); \
                dst[0] = lo_.x; dst[1] = lo_.y; dst[2] = lo_.z; dst[3] = lo_.w; dst[4] = hi_.x; dst[5] = hi_.y; dst[6] = hi_.z; dst[7] = hi_.w; \
                _Pragma("unroll") for (int j = 0; j < 8; ++j) asm("" : "+v"(dst[j])); } while (0)
#define SC_STEP(i) do { \
            const LAS float* O = B + (i) * 6 * 64; \
            float av[8], wv[8], bv[8], kv[8], rv[8], vv[2]; \
            SC_RD8(av, 0); SC_RD8(wv, 64); SC_RD8(bv, 128); SC_RD8(kv, 192); SC_RD8(rv, 256); \
            { const f32x2 v2 = *(const LAS f32x2*)(O + 320 + 16 * wq + 2 * rp); vv[0] = v2.x; vv[1] = v2.y; asm("" : "+v"(vv[0])); asm("" : "+v"(vv[1])); } \
            float sa[2], y[2]; \
            _Pragma("unroll") for (int rr = 0; rr < 2; ++rr) { float t = S[rr][0] * av[0]; \
                _Pragma("unroll") for (int j = 1; j < 8; ++j) t = __builtin_fmaf(S[rr][j], av[j], t); \
                sa[rr] = t; } \
            reduce2_oct(sa[0], sa[1]); \
            _Pragma("unroll") for (int rr = 0; rr < 2; ++rr) { \
                _Pragma("unroll") for (int j = 0; j < 8; ++j) { S[rr][j] = __builtin_fmaf(vv[rr], kv[j], __builtin_fmaf(S[rr][j], wv[j], sa[rr] * bv[j])); asm("" : "+v"(S[rr][j])); } \
                float t = S[rr][0] * rv[0]; \
                _Pragma("unroll") for (int j = 1; j < 8; ++j) t = __builtin_fmaf(S[rr][j], rv[j], t); \
                y[rr] = t; } \
            reduce2_oct(y[0], y[1]); \
            ypk[i] = pg8::pk_f16(y[0], y[1]); } while (0)
        SC_STEP(0); SC_STEP(1); SC_STEP(2); SC_STEP(3); SC_STEP(4); SC_STEP(5); SC_STEP(6); SC_STEP(7);
        {
            SC_STAGE(ci + 1, (ci + 1) & 1);
            SC_BON(ci + 1);
#if SIDE_IN_SCAN
            if constexpr (SIDE != 0) {
            if constexpr (SIDE == 1) side_consume(sd, lane, F.wave, SR, smx, ssc, PART);
            else { _Pragma("unroll") for (int j = 0; j < 8; ++j) { asm volatile("" :: "v"(SR[j])); } }
            side_pair_next(a, (int)blockIdx.x, F.wave, ci, sd);
            spa = side_issue_addr(sd, lane); sld = sd.ld;
            }
#endif
            SC_LOAD(ci + 2);
        }
#if SIDE_IN_SCAN
#define SC_SIDE_LOAD(j) do { if constexpr (SIDE != 0) { SR[j] = side_issue_one(spa, sld, j); __builtin_amdgcn_sched_barrier(0x38F); } } while (0)
#else
#define SC_SIDE_LOAD(j) do { } while (0)
#endif
        SC_STEP(8); SC_SIDE_LOAD(0); SC_STEP(9); SC_SIDE_LOAD(1); SC_STEP(10); SC_SIDE_LOAD(2); SC_STEP(11); SC_SIDE_LOAD(3); SC_STEP(12); SC_SIDE_LOAD(4); SC_STEP(13); SC_SIDE_LOAD(5); SC_STEP(14); SC_SIDE_LOAD(6); SC_STEP(15); SC_SIDE_LOAD(7);
#undef SC_SIDE_LOAD
#undef SC_STEP
#undef SC_RD8
        if (kq == 0) {
#pragma unroll
            for (int i = 0; i < SC_TS; ++i) { const int s = chunk * SC_TS + i; const int t = c.dir ? c.L - 1 - s : s;
                *(GAS unsigned*)(yout + (size_t)(c.row0 + t) * DA) = ypk[i]; }
        }
        if (!c.is_sample && chunk == (c.L / SC_TS) - 1) {
#pragma unroll
            for (int rr = 0; rr < 2; ++rr) { *(GAS f32x4*)(a.out + OUT_STATE + sbase + rr * 64) = (f32x4){S[rr][0], S[rr][1], S[rr][2], S[rr][3]};
                *(GAS f32x4*)(a.out + OUT_STATE + sbase + rr * 64 + 4) = (f32x4){S[rr][4], S[rr][5], S[rr][6], S[rr][7]}; }
        }
        asm volatile("s_waitcnt lgkmcnt(0)\n\ts_barrier" ::: "memory");
    }
    asm volatile("s_waitcnt vmcnt(0) lgkmcnt(0)" ::: "memory");
#undef SC_LOAD
#undef SC_STAGE
#undef SC_BON
}
__device__ __forceinline__ float bf2f(bf16 b) { return __builtin_bit_cast(float, (unsigned)b << 16); }
__device__ __forceinline__ bf16 f2bf_rne(float f) { return (bf16)(pg8::cvt_pk_bf16(f, 0.f) & 0xffffu); }
struct P5Task { unsigned short r0[16], r1[16], r2[16]; float w0, w1, w2, cs, sn, kx2; int pos, isq; size_t orow; };
__device__ __forceinline__ void p5_issue(const Args& a, int task, int lane, P5Task& X) {
    const unsigned short* Q = (const unsigned short*)(a.ws + WS_Q); const unsigned short* KV = (const unsigned short*)(a.ws + WS_KV); const float* KPE = (const float*)(a.ws + WS_KPE);
    const float* COS = (const float*)(a.ws + WS_COS); const float* SIN = (const float*)(a.ws + WS_SIN);
    const bool isq = task < T; int pos = -1; const float* kpe = KPE; size_t qrow = 0, kvrow = 0;
    if (isq) { qrow = task; if (task >= T_P) pos = (task - T_P) & 1023; }
    else { kvrow = task - T;
        if (kvrow < (size_t)T_P) kpe = KPE + kvrow * 64;
        else { const int r = (int)kvrow - T_P, b = r / 1536, p = r % 1536;
            if (p < 512) kpe = a.in[I_CKPE] + (size_t)(b * 512 + p) * 64; else { pos = p - 512; kpe = KPE + (size_t)(T_P + b * 1024 + pos) * 64; } } }
    const float* hn = isq ? a.in[I_QHN] : a.in[I_KHN];
    X.w0 = hn[lane]; X.w1 = hn[64 + lane]; X.w2 = hn[128 + lane];
    X.cs = 1.f; X.sn = 0.f; if (pos >= 0) { X.cs = COS[pos * 32 + (lane & 31)]; X.sn = SIN[pos * 32 + (lane & 31)]; }
    X.kx2 = isq ? 0.f : kpe[lane]; X.pos = pos; X.isq = isq ? 1 : 0; X.orow = isq ? qrow : kvrow;
    if (isq) { const unsigned short* p = Q + qrow * 3072;
#pragma unroll
        for (int h = 0; h < 16; ++h) { X.r0[h] = p[h * 192 + lane]; X.r1[h] = p[h * 192 + 64 + lane]; X.r2[h] = p[h * 192 + 128 + lane]; } }
    else { const unsigned short* p = KV + kvrow * 4096;
#pragma unroll
        for (int h = 0; h < 16; ++h) { X.r0[h] = p[h * 256 + lane]; X.r1[h] = p[h * 256 + 64 + lane]; X.r2[h] = 0; } }
}
__device__ __forceinline__ void p5_qkprep(const Args& a, Frame& F) {
    unsigned short* Q = (unsigned short*)(a.ws + WS_Q); unsigned short* KP = (unsigned short*)(a.ws + WS_KP);
    const int lane = F.lane; constexpr int NTASK = T + KVROWS;
    P5Task A;
    if (F.gw < NTASK) p5_issue(a, F.gw, lane, A);
    for (int task = F.gw; task < NTASK; task += F.ngw) {
        P5Task B = A;
        if (task + F.ngw < NTASK) p5_issue(a, task + F.ngw, lane, B);
        unsigned short o0[16], o1[16], o2[16];
#pragma unroll
        for (int h = 0; h < 16; ++h) {
            const float x0 = bf2f((bf16)A.r0[h]), x1 = bf2f((bf16)A.r1[h]), x2 = A.isq ? bf2f((bf16)A.r2[h]) : A.kx2;
            const float rs = 1.0f / sqrtf(wave_sum_u(x0 * x0 + x1 * x1 + x2 * x2) * (1.0f / 192.0f) + NORM_EPS);
            const float y0 = x0 * rs * A.w0, y1 = x1 * rs * A.w1; float y2 = x2 * rs * A.w2;
            if (A.pos >= 0) { const float pr = __shfl_xor(y2, 32); y2 = (lane < 32) ? y2 * A.cs - pr * A.sn : pr * A.sn + y2 * A.cs; }
            o0[h] = (unsigned short)f2bf_rne(y0); o1[h] = (unsigned short)f2bf_rne(y1); o2[h] = (unsigned short)f2bf_rne(y2);
        }
        { unsigned short* o = (A.isq ? Q : KP) + A.orow * 3072;
#pragma unroll
            for (int h = 0; h < 16; ++h) { o[h * 192 + lane] = o0[h]; o[h * 192 + 64 + lane] = o1[h]; o[h * 192 + 128 + lane] = o2[h]; } }
        A = B;
    }
}

namespace attn {
using bf16x8 = __attribute__((ext_vector_type(8))) short;
using s16x4  = __attribute__((ext_vector_type(4))) short;
using f32x16 = __attribute__((ext_vector_type(16))) float;
using u32x4  = __attribute__((ext_vector_type(4))) unsigned;
constexpr int DQK = 192, DV = 128, NW = 8, QBLK = 32, KVBLK = 64;
constexpr int LDQ = 3072, LDK = 3072, LDV = 4096, LDO = 2048;
constexpr float SCALE = 0.07216878364870322f;
constexpr float THR = 8.f;
constexpr size_t SHM_V = KVBLK * DV * 2, SHM_K = KVBLK * DQK * 2, SHM_ATTN = 2 * SHM_V + 2 * SHM_K + NW * 64 * 4;
#define KSWZ(row, colB) ((row) * 384 + ((colB) ^ (((row) & 7) << 4)))
#define SBAR() __builtin_amdgcn_sched_barrier(0)
__device__ __forceinline__ int crow(int r, int hi) { return (r & 3) + 8 * (r >> 2) + 4 * hi; }
__device__ __forceinline__ unsigned cvtpk(float lo, float hi) { return pg8::cvt_pk_bf16(lo, hi); }

__device__ __forceinline__ void partialSM(f32x16& p0, f32x16& p1, float& m_reg, float& mn, float& alpha) {
  constexpr float C = SCALE * 1.4426950408889634f;
  float pmax = p0[0];
#pragma unroll
  for (int r = 1; r < 16; ++r) pmax = fmaxf(pmax, p0[r]);
#pragma unroll
  for (int r = 0; r < 16; ++r) pmax = fmaxf(pmax, p1[r]);
  { auto rr = __builtin_amdgcn_permlane32_swap(__float_as_uint(pmax), __float_as_uint(pmax), false, false);
    pmax = fmaxf(__uint_as_float(rr[0]), __uint_as_float(rr[1])); }
  if (__builtin_expect(__all(pmax - m_reg <= THR / SCALE), 1)) { mn = m_reg; alpha = 1.f; }
  else { mn = fmaxf(m_reg, pmax); alpha = __builtin_amdgcn_exp2f((m_reg - mn) * C); m_reg = mn; }
  float mnC = -mn * C;
#pragma unroll
  for (int r = 0; r < 16; ++r) p0[r] = fmaf(p0[r], C, mnC);
#pragma unroll
  for (int r = 0; r < 16; ++r) p1[r] = fmaf(p1[r], C, mnC);
#pragma unroll
  for (int r = 0; r < 16; ++r) p0[r] = __builtin_amdgcn_exp2f(p0[r]);
}
__device__ __forceinline__ void finishSM(f32x16& p0, f32x16& p1, float alpha, float& l_reg, bf16x8& pa0, bf16x8& pa1, bf16x8& pa2, bf16x8& pa3) {
#pragma unroll
  for (int r = 0; r < 16; ++r) p1[r] = __builtin_amdgcn_exp2f(p1[r]);
  float ps = 0;
#pragma unroll
  for (int r = 0; r < 16; ++r) ps += p0[r];
#pragma unroll
  for (int r = 0; r < 16; ++r) ps += p1[r];
  { auto rr = __builtin_amdgcn_permlane32_swap(__float_as_uint(ps), __float_as_uint(ps), false, false);
    ps = __uint_as_float(rr[0]) + __uint_as_float(rr[1]); }
  l_reg = l_reg * alpha + ps;
#define PK4(P, BASE, OUT) do { unsigned a0 = cvtpk(P[BASE + 0], P[BASE + 1]), a1 = cvtpk(P[BASE + 2], P[BASE + 3]);   \
    unsigned b0 = cvtpk(P[BASE + 4], P[BASE + 5]), b1 = cvtpk(P[BASE + 6], P[BASE + 7]);                              \
    auto r0 = __builtin_amdgcn_permlane32_swap(a0, b0, false, false); auto r1 = __builtin_amdgcn_permlane32_swap(a1, b1, false, false); \
    u32x4 w = {r0[0], r1[0], r0[1], r1[1]}; OUT = *reinterpret_cast<bf16x8*>(&w); } while (0)
  PK4(p0, 0, pa0); PK4(p0, 8, pa1); PK4(p1, 0, pa2); PK4(p1, 8, pa3);
#undef PK4
}
__device__ __forceinline__ void qkt(f32x16& p0, f32x16& p1, const char* Ks, const bf16x8* qr, int r32, int hi) {
  p0 = f32x16{}; p1 = f32x16{};
#pragma unroll
  for (int d0 = 0; d0 < 12; ++d0) { int cb = (d0 * 16 + hi * 8) * 2;
    bf16x8 b0 = *reinterpret_cast<const bf16x8*>(Ks + KSWZ(r32, cb));
    bf16x8 b1 = *reinterpret_cast<const bf16x8*>(Ks + KSWZ(32 + r32, cb));
    p0 = __builtin_amdgcn_mfma_f32_32x32x16_bf16(b0, qr[d0], p0, 0, 0, 0);
    p1 = __builtin_amdgcn_mfma_f32_32x32x16_bf16(b1, qr[d0], p1, 0, 0, 0); }
}
__device__ __forceinline__ int v_st(int k, int c) { const int kk = (k & ~0xC) | ((k & 4) << 1) | ((k & 8) >> 1); return ((kk >> 3) * 4 + (c >> 5)) * 512 + ((kk & 7) * 32 + (c & 31)) * 2; }
__device__ __forceinline__ int v_rd_base(int lane) { return ((lane & 3) << 3) | (((lane >> 2) & 3) << 6) | (((lane >> 4) & 1) << 5) | (((lane >> 5) & 1) << 8); }
constexpr int v_rd_off(int d0, int ks, int half) { return d0 * 512 + ks * 4096 + half * 2048; }
template <int OFF> __device__ __forceinline__ s16x4 tr_read(int vb) {
  s16x4 r; asm volatile("ds_read_b64_tr_b16 %0, %1 offset:%2" : "=&v"(r) : "v"(vb), "i"(OFF) : "memory"); return r;
}
template <int D0> __device__ __forceinline__ void pv_one(f32x16& od, int vb, bf16x8 pa0, bf16x8 pa1, bf16x8 pa2, bf16x8 pa3) {
#define PK(L, H) (bf16x8){L[0], L[1], L[2], L[3], H[0], H[1], H[2], H[3]}
  { const s16x4 l0 = tr_read<v_rd_off(D0, 0, 0)>(vb), h0 = tr_read<v_rd_off(D0, 0, 1)>(vb), l1 = tr_read<v_rd_off(D0, 1, 0)>(vb), h1 = tr_read<v_rd_off(D0, 1, 1)>(vb);
    asm volatile("s_waitcnt lgkmcnt(0)" ::: "memory"); SBAR();
    od = __builtin_amdgcn_mfma_f32_32x32x16_bf16(pa0, PK(l0, h0), od, 0, 0, 0);
    od = __builtin_amdgcn_mfma_f32_32x32x16_bf16(pa1, PK(l1, h1), od, 0, 0, 0); }
  { const s16x4 l2 = tr_read<v_rd_off(D0, 2, 0)>(vb), h2 = tr_read<v_rd_off(D0, 2, 1)>(vb), l3 = tr_read<v_rd_off(D0, 3, 0)>(vb), h3 = tr_read<v_rd_off(D0, 3, 1)>(vb);
    asm volatile("s_waitcnt lgkmcnt(0)" ::: "memory"); SBAR();
    od = __builtin_amdgcn_mfma_f32_32x32x16_bf16(pa2, PK(l2, h2), od, 0, 0, 0);
    od = __builtin_amdgcn_mfma_f32_32x32x16_bf16(pa3, PK(l3, h3), od, 0, 0, 0); }
#undef PK
}
__device__ __forceinline__ void pv_d0(f32x16* o, int vb, bf16x8 pa0, bf16x8 pa1, bf16x8 pa2, bf16x8 pa3) {
  pv_one<0>(o[0], vb, pa0, pa1, pa2, pa3); pv_one<1>(o[1], vb, pa0, pa1, pa2, pa3); pv_one<2>(o[2], vb, pa0, pa1, pa2, pa3); pv_one<3>(o[3], vb, pa0, pa1, pa2, pa3);
}

__device__ __forceinline__ void attn_dense_body(const bf16* __restrict__ Qb, const bf16* __restrict__ Kh, const bf16* __restrict__ Vh, bf16* __restrict__ Ob, int seq, char* lds) {
  int tid_ = threadIdx.x; asm volatile("" : "+v"(tid_));
  const int tid = tid_, wid = __builtin_amdgcn_readfirstlane(tid >> 6), lane = tid & 63, r32 = lane & 31, hi = lane >> 5;
  char* V_lds = lds; char* K_lds = lds + 2 * SHM_V;
  float* ws = (float*)(lds + 2 * SHM_V + 2 * SHM_K) + wid * 64; float* li_l = ws; float* al_l = ws + 32;
  float m_reg = -1e30f, l_reg = 0; f32x16 o[4] = {}; bf16x8 qr[12];
  const bf16* Qw = Qb + (long)(wid * QBLK + r32) * LDQ + hi * 8;
#pragma unroll
  for (int d0 = 0; d0 < 12; ++d0) qr[d0] = *reinterpret_cast<const bf16x8*>(Qw + d0 * 16);
  const int sr = tid >> 4, sc = (tid & 15) * 8, vst0 = v_st(sr, sc), vst1 = v_st(32 + sr, sc);
  const int kr2 = tid >> 3, kc2 = 128 + (tid & 7) * 8;
  const int vb0 = (int)(uintptr_t)V_lds + v_rd_base(lane);
  bf16x8 vs0, vs1, ks0, ks1, ks2;
  const unsigned ovs0 = (unsigned)(sr * LDV + sc) * 2u, ovs1 = (unsigned)((32 + sr) * LDV + sc) * 2u, oks0 = (unsigned)(sr * LDK + sc) * 2u, oks1 = (unsigned)((32 + sr) * LDK + sc) * 2u, oks2 = (unsigned)(kr2 * LDK + kc2) * 2u;
#define SLOAD(k0) do { const char* vt_ = (const char*)Vh + (size_t)(k0) * (LDV * 2); const char* kt_ = (const char*)Kh + (size_t)(k0) * (LDK * 2); \
    vs0 = *reinterpret_cast<const bf16x8*>(vt_ + ovs0); vs1 = *reinterpret_cast<const bf16x8*>(vt_ + ovs1); \
    ks0 = *reinterpret_cast<const bf16x8*>(kt_ + oks0); ks1 = *reinterpret_cast<const bf16x8*>(kt_ + oks1); ks2 = *reinterpret_cast<const bf16x8*>(kt_ + oks2); } while (0)
#define SWRITE(b) do { *(bf16x8*)(V_lds + (b) * SHM_V + vst0) = vs0; *(bf16x8*)(V_lds + (b) * SHM_V + vst1) = vs1; \
    *(bf16x8*)(K_lds + (b) * SHM_K + KSWZ(sr, sc * 2)) = ks0; *(bf16x8*)(K_lds + (b) * SHM_K + KSWZ(32 + sr, sc * 2)) = ks1; \
    *(bf16x8*)(K_lds + (b) * SHM_K + KSWZ(kr2, kc2 * 2)) = ks2; } while (0)
#define RESC(a) do { if (__any((a) < 1.f)) { if (hi == 0) al_l[r32] = (a); asm volatile("s_waitcnt lgkmcnt(0)" ::: "memory"); \
    _Pragma("unroll") for (int d = 0; d < 4; ++d) _Pragma("unroll") for (int r = 0; r < 16; ++r) o[d][r] *= al_l[crow(r, hi)]; } } while (0)
  f32x16 p0, p1; float mn, al; bf16x8 pa0, pa1, pa2, pa3; const int NT = seq / KVBLK;
  SLOAD(0); asm volatile("s_waitcnt vmcnt(0)" ::: "memory"); SWRITE(0); __syncthreads();
  SLOAD(KVBLK);
  for (int j = 0; j < NT; ++j) {
    const int bsel = j & 1;
    SBAR(); qkt(p0, p1, K_lds + bsel * SHM_K, qr, r32, hi);
    partialSM(p0, p1, m_reg, mn, al); finishSM(p0, p1, al, l_reg, pa0, pa1, pa2, pa3); SBAR();
    RESC(al);
    if (j + 1 < NT) { asm volatile("s_waitcnt vmcnt(0)" ::: "memory"); SWRITE(bsel ^ 1); }
    if (j + 2 < NT) SLOAD((j + 2) * KVBLK);
    SBAR(); pv_d0(o, vb0 + bsel * (int)SHM_V, pa0, pa1, pa2, pa3);
    __syncthreads();
  }
  if (hi == 0) li_l[r32] = l_reg; asm volatile("s_waitcnt lgkmcnt(0)" ::: "memory");
  float rli[16];
#pragma unroll
  for (int r = 0; r < 16; ++r) rli[r] = __builtin_amdgcn_rcpf(li_l[crow(r, hi)]);
  bf16* Ow = Ob + (long)(wid * QBLK) * LDO;
#pragma unroll
  for (int r = 0; r < 16; ++r) { int orow = crow(r, hi);
#pragma unroll
    for (int d0 = 0; d0 < 4; ++d0) Ow[(long)orow * LDO + d0 * 32 + r32] = (bf16)(cvtpk(o[d0][r] * rli[r], 0.f) & 0xffffu); }
  __syncthreads();
#undef SLOAD
#undef SWRITE
#undef RESC
}
#undef KSWZ
#undef SBAR
}

__device__ __forceinline__ void p6_attention(const Args& a, Frame& F) {
    const bf16* QP = (const bf16*)(a.ws + WS_Q); const bf16* KP = (const bf16*)(a.ws + WS_KP); const bf16* KV = (const bf16*)(a.ws + WS_KV); bf16* YB = (bf16*)(a.ws + WS_YB);
    char* lds = (char*)(unsigned char*)F.lds;
    for (int u = blockIdx.x; u < 256; u += F.G) {
        const int b = u >> 6, h = (u >> 2) & 15, qb = u & 3; const size_t row0 = (size_t)T_P + b * 1024 + qb * 256, kv0 = (size_t)T_P + b * 1536;
        attn::attn_dense_body(QP + row0 * 3072 + h * 192, KP + kv0 * 3072 + h * 192, KV + kv0 * 4096 + h * 256 + 128, YB + row0 * 2048 + h * 128, 1536, lds);
    }
    for (int u = blockIdx.x; u < 512; u += F.G) {
        const int b = u >> 4, h = u & 15; const size_t row0 = (size_t)b * 256;
        attn::attn_dense_body(QP + row0 * 3072 + h * 192, KP + row0 * 3072 + h * 192, KV + row0 * 4096 + h * 256 + 128, YB + row0 * 2048 + h * 128, 256, lds);
    }
}

__device__ __forceinline__ float grp16_sum(float v) { v += __shfl_xor(v, 1); v += __shfl_xor(v, 2); v += __shfl_xor(v, 4); v += __shfl_xor(v, 8); return v; }
#ifndef P7_NOLN
#define P7_NOLN 0
#endif
#ifndef P7_TRIVIAL
#define P7_TRIVIAL 0
#endif
__device__ __forceinline__ void p7_postscan(const Args& a, Frame& F) {
    const unsigned short* YS = (const unsigned short*)(a.ws + WS_YS); const float* BON = (const float*)(a.ws + WS_BON); const unsigned short* RKV = (const unsigned short*)(a.ws + WS_RKV);
    const bf16* G = (const bf16*)(a.ws + WS_G); unsigned char* YA = (unsigned char*)(a.ws + WS_YA); float* ROWS = (float*)(a.ws + WS_ROWSYA); const float* lnw = a.in[I_LNW]; const float* lnb = a.in[I_LNB];
    for (int row = F.gw; row < T; row += F.ngw) {
        v2u ybw[8];
#pragma unroll
        for (int p = 0; p < 8; ++p) ybw[p] = *(const GAS v2u*)((const unsigned short*)(a.ws + WS_YB) + (size_t)row * DA + p * 256 + F.lane * 4);
        float ov[8][4]; float mx = 0.f;
#pragma unroll
        for (int p = 0; p < 8; ++p) { const int c = p * 256 + F.lane * 4, h = c >> 6;
            const v2u yf = *(const GAS v2u*)(YS + (size_t)row * DA + c), yb = *(const GAS v2u*)(YS + ((size_t)T + row) * DA + c), vv = *(const GAS v2u*)(RKV + (size_t)row * 6144 + 4096 + c), gg = *(const GAS v2u*)(G + (size_t)row * DA + c);
            const float bon = BON[(size_t)row * 32 + h] + BON[((size_t)T + row) * 32 + h];
            float y[4], v[4], g[4];
            y[0] = h2f(yf.x & 0xffff) + h2f(yb.x & 0xffff); y[1] = h2f(yf.x >> 16) + h2f(yb.x >> 16); y[2] = h2f(yf.y & 0xffff) + h2f(yb.y & 0xffff); y[3] = h2f(yf.y >> 16) + h2f(yb.y >> 16);
            v[0] = h2f(vv.x & 0xffff); v[1] = h2f(vv.x >> 16); v[2] = h2f(vv.y & 0xffff); v[3] = h2f(vv.y >> 16);
            g[0] = pg8::bflo(gg.x); g[1] = pg8::bfhi(gg.x); g[2] = pg8::bflo(gg.y); g[3] = pg8::bfhi(gg.y);
            const float mu = row16_sum((y[0] + y[1]) + (y[2] + y[3])) * (1.0f / 64.0f);
            float d[4]; float q = 0.f;
#pragma unroll
            for (int i = 0; i < 4; ++i) { d[i] = y[i] - mu; q += d[i] * d[i]; }
            const float rstd = 1.0f / sqrtf(row16_sum(q) * (1.0f / 64.0f) + 64e-5f);
            const f32x4 w4 = *(const f32x4*)(lnw + c), b4 = *(const f32x4*)(lnb + c);
#pragma unroll
            for (int i = 0; i < 4; ++i) { ov[p][i] = (d[i] * rstd * w4[i] + b4[i] + bon * v[i]) * g[i]; mx = fmaxf(mx, fabsf(ov[p][i])); } }
        mx = wave_max_d(mx);
        const float qs = mx > 0.f ? 127.0f / mx : 0.f;
        if (F.lane == 0) ROWS[row] = mx * (1.0f / 127.0f);
#pragma unroll
        for (int p = 0; p < 8; ++p) { const int c = p * 256 + F.lane * 4;
            *(GAS unsigned*)(YA + (size_t)row * DA + c) = (unsigned)q8(ov[p][0] * qs) | ((unsigned)q8(ov[p][1] * qs) << 8) | ((unsigned)q8(ov[p][2] * qs) << 16) | ((unsigned)q8(ov[p][3] * qs) << 24); }
        {
            const unsigned short* YBr = (const unsigned short*)(a.ws + WS_YB) + (size_t)row * DA; unsigned char* YB8 = (unsigned char*)(a.ws + WS_YB8) + (size_t)row * DA;
            float yv[8][4]; float mb = 0.f;
#pragma unroll
            for (int p = 0; p < 8; ++p) { const v2u t = ybw[p];
                yv[p][0] = pg8::bflo(t.x); yv[p][1] = pg8::bfhi(t.x); yv[p][2] = pg8::bflo(t.y); yv[p][3] = pg8::bfhi(t.y);
                mb = fmaxf(mb, fmaxf(fmaxf(fabsf(yv[p][0]), fabsf(yv[p][1])), fmaxf(fabsf(yv[p][2]), fabsf(yv[p][3])))); }
            mb = wave_max_d(mb);
            const float qb = mb > 0.f ? 127.0f / mb : 0.f;
            if (F.lane == 0) ((float*)(a.ws + WS_ROWSYB))[row] = mb * (1.0f / 127.0f);
#pragma unroll
            for (int p = 0; p < 8; ++p)
                *(GAS unsigned*)(YB8 + p * 256 + F.lane * 4) = (unsigned)q8(yv[p][0] * qb) | ((unsigned)q8(yv[p][1] * qb) << 8) | ((unsigned)q8(yv[p][2] * qb) << 16) | ((unsigned)q8(yv[p][3] * qb) << 24);
        }
    }
}
#ifndef MK_PER_PHASE
#define MK_PER_PHASE 0
#endif
constexpr int N_PHASES = 14;
__global__ void __launch_bounds__(NWAVES * 64, 2) fwd_kernel(Args args) {
    extern __shared__ __attribute__((aligned(16))) unsigned char lds[];
    Frame F;
    F.lds = (LAS unsigned char*)lds; F.MISC = (volatile LAS unsigned*)(F.lds + MISC_OFF);
    F.tid = threadIdx.x; F.lane = F.tid & 63; F.wave = __builtin_amdgcn_readfirstlane(F.tid >> 6);
    F.G = gridDim.x; F.gw = blockIdx.x * NWAVES + F.wave; F.ngw = F.G * NWAVES;
    unsigned char* ws = args.ws; F.ctl = (gu32*)(ws + WS_CTL);
    for (int u = F.tid; u < (LDS_BYTES - LDSCTL_OFF) / 4; u += NWAVES * 64) ((LAS unsigned*)(F.lds + LDSCTL_OFF))[u] = 0u;
    __syncthreads();
    const int lo = args.ph_lo, hi = args.ph_hi;
    XcdBarrier bar; bar.bar = (unsigned*)(F.ctl + CW_BAR); bar.x = 0; bar.st = nullptr;
    if (hi - lo > 1) bar = xcd_barrier_post((unsigned*)(F.ctl + CW_BAR), F.MISC + 8);
#ifndef P4_MASK
#define P4_MASK 15
#endif
#ifndef PH_MASK
#define PH_MASK 0xFFFFFFFFu
#endif
#define IN(k) (((PH_MASK >> (k)) & 1u) && lo <= (k) && (k) < hi)
#define SEAM(k) do { if (IN(k) && IN((k) + 1)) xcd_barrier(bar); } while (0)
    LAS unsigned char* ring = F.lds + RING_OFF;
    float* MOD = (float*)(ws + WS_MOD);

    if (IN(0)) { p0_adaln(args, F); p0_colmax(args, F); p0_weights(args, F); p0_rope(args, F); }
    SEAM(0);
    if (IN(1)) {
        Frame F2 = F; F2.gw = (int)blockIdx.x * 4 + (F.wave & 3); F2.ngw = F.G * 4;
        if (F.wave < 4) modnorm_rows_dual(F2, args.in[I_XP], args.in[I_XS], args.in[I_NMIX], MOD, 0, (bf16*)(ws + WS_HB), (unsigned char*)(ws + WS_H1Q), (float*)(ws + WS_ROWS1));
        else p1_weights_i8(args, F2); }
    SEAM(1);
    if (IN(2)) {
        {
            int k8 = DM / 2; asm volatile("" : "+s"(k8));
            pg8::Gemm g{(const pg8::bf16_t*)(ws + WS_H1Q), (const pg8::bf16_t*)(ws + WS_WING8 + (size_t)8192 * DM), T, 3584, k8}; pg8::StaticOrder S; S.init(T, 3584, F.G, (int)blockIdx.x);
            pg8::EpiGate8 E{(unsigned char*)(ws + WS_GA), (unsigned char*)(ws + WS_GB), (const float*)(ws + WS_ROWS1), (const unsigned*)(ws + WS_CMAXG), (pg8::f16_t*)(ws + WS_RKV), (pg8::bf16_t*)(ws + WS_LG), (float*)(ws + WS_QLAT), 32};
            pg8::gemm_phase<pg8::EpiGate8, pg8::StaticOrder, true, true, 2>(ring, g, S, E); }
        {
            pg8::Gemm g{(const pg8::bf16_t*)(ws + WS_HB), (const pg8::bf16_t*)(ws + WS_WIN), T, NIN16, DM}; pg8::StaticOrder S; S.init(T, NIN16, F.G, (int)blockIdx.x);
            pg8::EpiIn E{(pg8::f16_t*)(ws + WS_RKV), (pg8::bf16_t*)(ws + WS_LWA), (pg8::bf16_t*)(ws + WS_LG), (float*)(ws + WS_QLAT), (float*)(ws + WS_KVLAT), (float*)(ws + WS_KPE), (pg8::bf16_t*)(ws + WS_GA), (pg8::bf16_t*)(ws + WS_GB)};
            pg8::gemm_phase<pg8::EpiIn, pg8::StaticOrder, true, true>(ring, g, S, E); }
    }
    SEAM(2);
    if (IN(3)) { p3_post(args, F); }
    SEAM(3);
    if (IN(4)) {
        if (P4_MASK & 1) { int kl = 256; asm volatile("" : "+s"(kl));
          pg8::Gemm g{(const pg8::bf16_t*)(ws + WS_LWA), (const pg8::bf16_t*)(ws + WS_WLORA), 2 * T, 8192, kl}; pg8::BatchedOrder S; S.init(T / 256, 16, 2, F.G, (int)blockIdx.x);
          pg8::EpiLora E{(unsigned char*)(ws + WS_EW), (const float*)(ws + WS_LBIAS)};
          pg8::gemm_phase<pg8::EpiLora, pg8::BatchedOrder, true, true>(ring, g, S, E); }
        if (P4_MASK & 2) { int kg = 512; asm volatile("" : "+s"(kg));
          pg8::Gemm g{(const pg8::bf16_t*)(ws + WS_LG), (const pg8::bf16_t*)(ws + WS_WG), T, DA, kg}; pg8::StaticOrder S; S.init(T, DA, F.G, (int)blockIdx.x);
          pg8::EpiPlain E{(pg8::bf16_t*)(ws + WS_G), DA};
          pg8::gemm_phase<pg8::EpiPlain, pg8::StaticOrder, true, true>(ring, g, S, E); }
        if (P4_MASK & 4) { int kq = QL / 2; asm volatile("" : "+s"(kq));
          pg8::Gemm g{(const pg8::bf16_t*)(ws + WS_QN), (const pg8::bf16_t*)(ws + WS_WUQ), T, 3072, kq}; pg8::StaticOrder S; S.init(T, 3072, F.G, (int)blockIdx.x, 128);
          pg8::EpiPlainI8 E{(pg8::bf16_t*)(ws + WS_Q), 3072, (const float*)(ws + WS_ROWSQ), (const unsigned*)(ws + WS_CMAXUQ)};
          pg8::gemm_phase<pg8::EpiPlainI8, pg8::StaticOrder, true, true, 2>(ring, g, S, E); }
        if (P4_MASK & 8) { int kk = KVL / 2; asm volatile("" : "+s"(kk));
          pg8::Gemm g{(const pg8::bf16_t*)(ws + WS_CKVA), (const pg8::bf16_t*)(ws + WS_WUKV), KVROWS, 4096, kk}; pg8::StaticOrder S; S.init(KVROWS, 4096, F.G, (int)blockIdx.x, 64);
          pg8::EpiPlainI8 E{(pg8::bf16_t*)(ws + WS_KV), 4096, (const float*)(ws + WS_ROWSKV), (const unsigned*)(ws + WS_CMAXUKV)};
          pg8::gemm_phase<pg8::EpiPlainI8, pg8::StaticOrder, true, true, 2>(ring, g, S, E); }
    }
    SEAM(4);
    if (IN(5)) { p5_qkprep(args, F); }
    SEAM(5);
    if (IN(6)) { p5_scan(args, F); __syncthreads(); p6_attention(args, F); }
    SEAM(6);
    if (IN(7)) { p7_postscan(args, F); }
    SEAM(7);
    if (IN(8)) {
#pragma unroll
        for (int gb = 0; gb < 2; ++gb) {
            int k8 = DM / 2; asm volatile("" : "+s"(k8));
            pg8::Gemm g{(const pg8::bf16_t*)(ws + WS_H1Q), (const pg8::bf16_t*)(ws + WS_WGATE8 + (size_t)gb * 4096 * DM), T, DM, k8}; pg8::StaticOrder S; S.init(T, DM, F.G, (int)blockIdx.x);
            pg8::EpiGate8 E{(unsigned char*)(ws + WS_GA), (unsigned char*)(ws + WS_GB), (const float*)(ws + WS_ROWS1), (const unsigned*)(ws + WS_CMAXG), (pg8::f16_t*)(ws + WS_RKV), (pg8::bf16_t*)(ws + WS_LG), (float*)(ws + WS_QLAT), 16 * gb};
            pg8::gemm_phase<pg8::EpiGate8, pg8::StaticOrder, true, true, 2>(ring, g, S, E); }
        asm volatile("s_waitcnt vmcnt(0)" ::: "memory"); __syncthreads();
        { int k8 = DA / 2; asm volatile("" : "+s"(k8));
          pg8::Gemm g{(const pg8::bf16_t*)(ws + WS_YA), (const pg8::bf16_t*)(ws + WS_WOR), T, DM, k8}; pg8::StaticOrder S; S.init(T, DM, F.G, (int)blockIdx.x);
          pg8::EpiMix1I8 E{(const unsigned char*)(ws + WS_GA), (pg8::bf16_t*)(ws + WS_TMP), (const float*)(ws + WS_ROWSYA), (const unsigned*)(ws + WS_CMAXR)};
          pg8::gemm_phase<pg8::EpiMix1I8, pg8::StaticOrder, true, true, 2>(ring, g, S, E); }
        { int k8 = DA / 2; asm volatile("" : "+s"(k8));
          pg8::Gemm g{(const pg8::bf16_t*)(ws + WS_YB8), (const pg8::bf16_t*)(ws + WS_WOM), T, DM, k8}; pg8::StaticOrder S; S.init(T, DM, F.G, (int)blockIdx.x);
          pg8::EpiMix2I8 E{(const unsigned char*)(ws + WS_GB), (const pg8::bf16_t*)(ws + WS_TMP), (pg8::bf16_t*)(ws + WS_MIXED), (unsigned*)(ws + WS_RMAXM), (const float*)(ws + WS_ROWSYB), (const unsigned*)(ws + WS_CMAXM)};
          pg8::gemm_phase<pg8::EpiMix2I8, pg8::StaticOrder, true, true, 2>(ring, g, S, E); }
    }
    SEAM(8);
    if (IN(9)) { p8c_quant_mixed(args, F); }
    SEAM(9);
    if (IN(10)) {
        int k8 = DM / 2; asm volatile("" : "+s"(k8));
        pg8::Gemm g{(const pg8::bf16_t*)(ws + WS_MIX8), (const pg8::bf16_t*)(ws + WS_WOUT), T, DM, k8}; pg8::StaticOrder S; S.init(T, DM, F.G, (int)blockIdx.x);
        pg8::EpiResI8 E{args.in[I_XP], args.in[I_XS], (pg8::bf16_t*)(ws + WS_X1), MOD + 2 * DM, (const float*)(ws + WS_ROWSM), (const unsigned*)(ws + WS_CMAXO)};
        pg8::gemm_phase<pg8::EpiResI8, pg8::StaticOrder, true, true, 2>(ring, g, S, E);
    }
    SEAM(10);
    if (IN(11)) { modnorm_rows_i8(F, (const bf16*)(ws + WS_X1), args.in[I_NFFN], MOD, 3, (unsigned char*)(ws + WS_HB), (float*)(ws + WS_ROWS)); }
    SEAM(11);
    if (IN(12)) {
        int k8 = DM / 2; asm volatile("" : "+s"(k8));
        pg8::Gemm g{(const pg8::bf16_t*)(ws + WS_HB), (const pg8::bf16_t*)(ws + WS_WFI), T, 2 * DFF, k8}; pg8::StaticOrder S; S.init(T, 2 * DFF, F.G, (int)blockIdx.x);
        pg8::EpiSwigluI8 E{(unsigned char*)(ws + WS_ACT), (const float*)(ws + WS_ROWS), (const unsigned*)(ws + WS_CMAX)};
        pg8::gemm_phase<pg8::EpiSwigluI8, pg8::StaticOrder, true, true, 2>(ring, g, S, E);
    }
    SEAM(12);
    if (IN(13)) {
        int k8 = DFF / 2; asm volatile("" : "+s"(k8));
        pg8::Gemm g{(const pg8::bf16_t*)(ws + WS_ACT), (const pg8::bf16_t*)(ws + WS_WFO), T, DM, k8}; pg8::StaticOrder S; S.init(T, DM, F.G, (int)blockIdx.x);
        pg8::EpiRes E{(const pg8::bf16_t*)(ws + WS_X1), args.out, MOD + 5 * DM, 0.0078125f};
        pg8::gemm_phase<pg8::EpiRes, pg8::StaticOrder, true, true, 1>(ring, g, S, E);
    }
#undef IN
#undef SEAM
}

extern "C" void kernel_launch(void* const* d_in, const int* in_sizes, int n_in, void* d_out, int out_size, void* d_ws, size_t ws_size, hipStream_t stream) {
    static int grid = 0;
    if (grid == 0) {
        if (n_in != 33 || ws_size < WS_END) { fprintf(stderr, "kernel_launch: n_in %d ws %zu (need 33 inputs, >= %zu bytes)\n", n_in, ws_size, (size_t)WS_END); grid = -1; return; }
        if (hipFuncSetAttribute((const void*)fwd_kernel, hipFuncAttributeMaxDynamicSharedMemorySize, LDS_BYTES) != hipSuccess) { fprintf(stderr, "kernel_launch: hipFuncSetAttribute failed\n"); grid = -1; return; }
        int per_cu = 0;
        if (hipOccupancyMaxActiveBlocksPerMultiprocessor(&per_cu, (const void*)fwd_kernel, NWAVES * 64, LDS_BYTES) != hipSuccess || per_cu < 1) fprintf(stderr, "kernel_launch: occupancy query reports %d\n", per_cu);
        (void)hipGetLastError();
        grid = 256;
    }
    if (grid < 0) return;
    if (hipMemsetAsync((char*)d_ws + WS_CTL, 0, CTL_ZERO_BYTES, stream) != hipSuccess) return;
    Args a{};
    for (int i = 0; i < 33; ++i) a.in[i] = (const float*)d_in[i];
    a.out = (float*)d_out; a.ws = (unsigned char*)d_ws;
#if MK_PER_PHASE
    for (int p = 0; p < N_PHASES; ++p) { a.ph_lo = p; a.ph_hi = p + 1; hipLaunchKernelGGL(fwd_kernel, dim3(grid), dim3(NWAVES * 64), LDS_BYTES, stream, a); }
#else
    a.ph_lo = 0; a.ph_hi = N_PHASES; hipLaunchKernelGGL(fwd_kernel, dim3(grid), dim3(NWAVES * 64), LDS_BYTES, stream, a);
#endif
    const hipError_t le = hipPeekAtLastError();
    if (le != hipSuccess) fprintf(stderr, "kernel_launch: launch failed: %s\n", hipGetErrorName(le));
}
```

```cpp
#include <hip/hip_runtime.h>
#include <cstdio>
#include <cstdint>
namespace pg8 {
#define PG8_LAS __attribute__((address_space(3)))
typedef unsigned short bf16_t;
typedef short bf16x8 __attribute__((ext_vector_type(8)));
typedef float f32x4 __attribute__((ext_vector_type(4)));
typedef unsigned u32x4 __attribute__((ext_vector_type(4)));
constexpr int BM = 256, BK = 64, HALF = 128, HTB = HALF * BK * 2  , STAGE_BYTES = 8 * HTB, NXCD = 8, WGM = 8;

__host__ __device__ __forceinline__ int lds_byte(int r, int c) { const int st = (r >> 4) * 2 + (c >> 5), rr = r & 15, cc = c & 31, ob = rr * 64 + cc * 2; return st * 1024 + (ob ^ (((ob >> 9) & 1) << 5)); }
__host__ __device__ __forceinline__ void stage_rc(int b, int& R, int& C) { const int st = b / 1024, sb = b % 1024, swz = sb ^ (((sb >> 9) & 1) << 5); R = (st >> 1) * 16 + swz / 64; C = (st & 1) * 32 + (swz % 64) / 2; }
__host__ __device__ __forceinline__ int perm32(int rho) { const int n = rho >> 4, i = rho & 15; return 8 * (i >> 2) + 4 * n + (i & 3); }

struct Unit { int pm, pn; };
struct Gemm { const bf16_t* A; const bf16_t* Bt; int M, N, K; };

struct StaticOrder {
    int nM, nN, nwg, G, c;
    __host__ __device__ void init(int M, int N, int G_, int c_, int rot = 0) { nM = M / BM; nN = N / BM; nwg = nM * nN; G = G_; c = (c_ + rot) % G_; }
    __host__ __device__ bool next(int i, Unit& u) const {
        const long L = (long)i * G + c; if (L >= nwg) return false;
        int wgid = (int)L; { const int q = nwg / NXCD, r = nwg % NXCD, xcd = wgid % NXCD, off = wgid / NXCD; wgid = (xcd < r ? xcd * (q + 1) : r * (q + 1) + (xcd - r) * q) + off; }
        const int nig = WGM * nN, gid = wgid / nig, fm = gid * WGM, gsz = (nM - fm) < WGM ? (nM - fm) : WGM;
        u.pm = fm + ((wgid % nig) % gsz); u.pn = (wgid % nig) / gsz; return true;
    }
    __device__ __forceinline__ void a_ready(const Unit&) const {}
    __device__ __forceinline__ void done(const Unit&) const {}
};

typedef float cvt_f32x2_t __attribute__((ext_vector_type(2)));
typedef __bf16 cvt_bf16x2_t __attribute__((ext_vector_type(2)));
__device__ __forceinline__ unsigned cvt_pk_bf16(float lo, float hi) { cvt_f32x2_t v = {lo, hi}; cvt_bf16x2_t b = __builtin_convertvector(v, cvt_bf16x2_t); return __builtin_bit_cast(unsigned, b); }
typedef float f32x2 __attribute__((ext_vector_type(2)));
template <class Epi, class Sched, bool ALIGN_EPI = false, bool SP2 = false, int MODE = 0>
__device__ __forceinline__ void gemm_phase(PG8_LAS unsigned char* lds, const Gemm g, const Sched& S, const Epi& E) {
    int tid_o = threadIdx.x; asm volatile("" : "+v"(tid_o));
    const int tid = tid_o, wid = __builtin_amdgcn_readfirstlane(tid >> 6), lane = tid & 63, wr = wid >> 2, wc = wid & 3, fr = lane & 15, fq = lane >> 4;
    const int K = g.K, nt = K / BK;
    unsigned voffA[2], voffB[2];
#pragma unroll
    for (int i = 0; i < 2; ++i) { int R, C; stage_rc(tid * 16 + i * 8192, R, C); const int Rb = Epi::PERM ? ((R & ~31) + perm32(R & 31)) : R;
        voffA[i] = (unsigned)(R * K + C) * 2u; voffB[i] = (unsigned)(Rb * K + C) * 2u; }
    const size_t kstep = (size_t)(BK * 2);
    const size_t hstep = (size_t)HALF * K * 2;
    const size_t tstep = 2 * hstep;
    const unsigned ldsw = (unsigned)wid * 1024u;
    const int aoff = lds_byte(wr * 64 + fr, fq * 8), boff = lds_byte(wc * 32 + fr, fq * 8);
#define PG8_SA(b, h) (((b) * 2 + (h)) * HTB)
#define PG8_SB(b, h) ((4 + (b) * 2 + (h)) * HTB)
#define PG8_STAGE(bufoff, gbase, voff) do { _Pragma("unroll") for (int _i = 0; _i < 2; ++_i) \
        __builtin_amdgcn_global_load_lds((const unsigned*)((const char*)(gbase) + (voff)[_i]), (PG8_LAS unsigned*)(lds + (bufoff) + ldsw + _i * 8192), 16, 0, 0); } while (0)
#define PG8_LDA(dst, b, h) do { _Pragma("unroll") for (int m = 0; m < 4; ++m) { dst[m].lo = *(const PG8_LAS bf16x8*)(lds + PG8_SA(b, h) + aoff + m * 2048); dst[m].hi = *(const PG8_LAS bf16x8*)(lds + PG8_SA(b, h) + aoff + m * 2048 + 1024); } } while (0)
#define PG8_LDB(dst, b, h) do { _Pragma("unroll") for (int n = 0; n < 2; ++n) { dst[n].lo = *(const PG8_LAS bf16x8*)(lds + PG8_SB(b, h) + boff + n * 2048); dst[n].hi = *(const PG8_LAS bf16x8*)(lds + PG8_SB(b, h) + boff + n * 2048 + 1024); } } while (0)
#define PG8_MMA(ai, bj, At, Bt) do { __builtin_amdgcn_s_setprio(1); _Pragma("unroll") for (int m = 0; m < 4; ++m) _Pragma("unroll") for (int n = 0; n < 2; ++n) { \
        if constexpr (MODE == 1) { typedef int v8i_t __attribute__((ext_vector_type(8))); \
            asm("v_mfma_scale_f32_16x16x128_f8f6f4 %0, %1, %2, %0, %3, %3 op_sel_hi:[0,0,0]" : "+v"(acc[ai][bj][m][n]) : "v"(__builtin_bit_cast(v8i_t, Bt[n])), "v"(__builtin_bit_cast(v8i_t, At[m])), "v"(f8_unit_scale)); } \
        else if constexpr (MODE == 2) { typedef int v4i_t __attribute__((ext_vector_type(4))); \
            v4i_t c_ = __builtin_bit_cast(v4i_t, acc[ai][bj][m][n]); \
            const bf16x8 bl_ = Bt[n].lo, bh_ = Bt[n].hi, al_ = At[m].lo, ah_ = At[m].hi;     \
            c_ = __builtin_amdgcn_mfma_i32_16x16x64_i8(__builtin_bit_cast(v4i_t, bl_), __builtin_bit_cast(v4i_t, al_), c_, 0, 0, 0); \
            c_ = __builtin_amdgcn_mfma_i32_16x16x64_i8(__builtin_bit_cast(v4i_t, bh_), __builtin_bit_cast(v4i_t, ah_), c_, 0, 0, 0); \
            acc[ai][bj][m][n] = __builtin_bit_cast(f32x4, c_); } \
        else { acc[ai][bj][m][n] = __builtin_amdgcn_mfma_f32_16x16x32_bf16(Bt[n].lo, At[m].lo, acc[ai][bj][m][n], 0, 0, 0); \
               acc[ai][bj][m][n] = __builtin_amdgcn_mfma_f32_16x16x32_bf16(Bt[n].hi, At[m].hi, acc[ai][bj][m][n], 0, 0, 0); } } \
        __builtin_amdgcn_s_setprio(0); } while (0)
#define PG8_WAIT_V(n) asm volatile("s_waitcnt vmcnt(" #n ")" ::: "memory")
#define PG8_WAIT_L(n) asm volatile("s_waitcnt lgkmcnt(" #n ")" ::: "memory")
#define PG8_BAR __builtin_amdgcn_s_barrier()
#define PG8_SCHED __builtin_amdgcn_sched_barrier(0)
    Unit cur, nxt; int ui = 0;
    if (!S.next(0, cur)) return;
    f32x4 acc[2][2][4][2];
#pragma unroll
    for (int a = 0; a < 2; ++a)
#pragma unroll
        for (int b = 0; b < 2; ++b)
#pragma unroll
            for (int m = 0; m < 4; ++m)
#pragma unroll
                for (int n = 0; n < 2; ++n) acc[a][b][m][n] = (f32x4){0.f, 0.f, 0.f, 0.f};
    const int f8_unit_scale = 0x7F7F7F7F;
    typedef short bf16x16 __attribute__((ext_vector_type(16)));
    bf16x16 At[4], B0[2], B1[2];
    const char* cA = (const char*)g.A + (size_t)cur.pm * tstep; const char* cB = (const char*)g.Bt + (size_t)cur.pn * tstep;
    S.a_ready(cur);
    if constexpr (SP2) {
        PG8_STAGE(PG8_SB(0, 0), cB, voffB); PG8_STAGE(PG8_SB(0, 1), cB + hstep, voffB); PG8_STAGE(PG8_SA(0, 0), cA, voffA); PG8_STAGE(PG8_SA(0, 1), cA + hstep, voffA);
        if (wr == 1) PG8_BAR;
        PG8_WAIT_V(2); PG8_BAR;
        PG8_STAGE(PG8_SB(1, 0), cB + kstep, voffB); PG8_STAGE(PG8_SA(1, 0), cA + kstep, voffA); PG8_STAGE(PG8_SB(1, 1), cB + hstep + kstep, voffB);
        PG8_WAIT_V(6); PG8_BAR;
    } else {
        PG8_STAGE(PG8_SB(0, 0), cB, voffB); PG8_STAGE(PG8_SA(0, 0), cA, voffA); PG8_STAGE(PG8_SB(0, 1), cB + hstep, voffB); PG8_STAGE(PG8_SA(0, 1), cA + hstep, voffA);
        if (wr == 1) PG8_BAR;
        PG8_WAIT_V(4); PG8_BAR;
        PG8_STAGE(PG8_SB(1, 0), cB + kstep, voffB); PG8_STAGE(PG8_SA(1, 0), cA + kstep, voffA); PG8_STAGE(PG8_SB(1, 1), cB + hstep + kstep, voffB);
        PG8_WAIT_V(6); PG8_BAR;
    }
    for (;;) {
        const bool has_next = S.next(ui + 1, nxt);
        const char* nA = has_next ? (const char*)g.A + (size_t)nxt.pm * tstep : cA; const char* nB = has_next ? (const char*)g.Bt + (size_t)nxt.pn * tstep : cB;
        for (int t = 0; t < nt; t += 2) {
            const bool last = (t == nt - 2);
            const char* a1 = cA + (size_t)(t + 1) * kstep;
            const char* a2 = last ? nA : cA + (size_t)(t + 2) * kstep; const char* b2 = last ? nB : cB + (size_t)(t + 2) * kstep;
            const char* a3 = a2 + kstep; const char* b3 = b2 + kstep;
            if (last && has_next) S.a_ready(nxt);
            if constexpr (SP2) {
            PG8_LDB(B0, 0, 0); PG8_LDB(B1, 0, 1); PG8_SCHED; PG8_LDA(At, 0, 0); PG8_STAGE(PG8_SA(1, 1), a1 + hstep, voffA);
            PG8_WAIT_V(8); PG8_WAIT_L(0); PG8_BAR; PG8_MMA(0, 0, At, B0); PG8_MMA(0, 1, At, B1); PG8_BAR; PG8_SCHED;
            PG8_LDA(At, 0, 1); PG8_STAGE(PG8_SB(0, 0), b2, voffB); PG8_STAGE(PG8_SB(0, 1), b2 + hstep, voffB); PG8_STAGE(PG8_SA(0, 0), a2, voffA);
            PG8_WAIT_V(8); PG8_WAIT_L(0); PG8_BAR; PG8_MMA(1, 0, At, B0); PG8_MMA(1, 1, At, B1); PG8_BAR; PG8_SCHED;
            PG8_LDB(B0, 1, 0); PG8_LDB(B1, 1, 1); PG8_SCHED; PG8_LDA(At, 1, 0); PG8_STAGE(PG8_SA(0, 1), a2 + hstep, voffA);
            PG8_WAIT_V(8); PG8_WAIT_L(0); PG8_BAR; PG8_MMA(0, 0, At, B0); PG8_MMA(0, 1, At, B1); PG8_BAR; PG8_SCHED;
            PG8_LDA(At, 1, 1); PG8_STAGE(PG8_SB(1, 0), b3, voffB); PG8_STAGE(PG8_SB(1, 1), b3 + hstep, voffB); PG8_STAGE(PG8_SA(1, 0), a3, voffA);
            PG8_WAIT_V(8); PG8_WAIT_L(0); PG8_BAR; PG8_MMA(1, 0, At, B0); PG8_MMA(1, 1, At, B1); PG8_BAR; PG8_SCHED;
            } else {
            PG8_LDB(B0, 0, 0); PG8_SCHED; PG8_LDA(At, 0, 0); PG8_STAGE(PG8_SA(1, 1), a1 + hstep, voffA);
            PG8_WAIT_L(8); PG8_BAR; PG8_WAIT_L(0); PG8_MMA(0, 0, At, B0); PG8_BAR; PG8_SCHED;
            PG8_LDB(B1, 0, 1); PG8_STAGE(PG8_SB(0, 0), b2, voffB);
            PG8_BAR; PG8_WAIT_L(0); PG8_MMA(0, 1, At, B1); PG8_BAR;
            PG8_LDA(At, 0, 1); PG8_STAGE(PG8_SA(0, 0), a2, voffA);
            PG8_BAR; PG8_WAIT_L(0); PG8_MMA(1, 0, At, B0); PG8_BAR; PG8_SCHED;
            PG8_STAGE(PG8_SB(0, 1), b2 + hstep, voffB);
            PG8_WAIT_V(6); PG8_BAR; PG8_MMA(1, 1, At, B1); PG8_BAR;
            PG8_LDB(B0, 1, 0); PG8_SCHED; PG8_LDA(At, 1, 0); PG8_STAGE(PG8_SA(0, 1), a2 + hstep, voffA);
            PG8_WAIT_L(8); PG8_BAR; PG8_WAIT_L(0); PG8_MMA(0, 0, At, B0); PG8_BAR; PG8_SCHED;
            PG8_LDB(B1, 1, 1); PG8_STAGE(PG8_SB(1, 0), b3, voffB);
            PG8_BAR; PG8_WAIT_L(0); PG8_MMA(0, 1, At, B1); PG8_BAR;
            PG8_LDA(At, 1, 1); PG8_STAGE(PG8_SA(1, 0), a3, voffA);
            PG8_BAR; PG8_WAIT_L(0); PG8_MMA(1, 0, At, B0); PG8_BAR; PG8_SCHED;
            PG8_STAGE(PG8_SB(1, 1), b3 + hstep, voffB);
            PG8_WAIT_V(6); PG8_BAR; PG8_MMA(1, 1, At, B1); PG8_BAR;
            }
        }
        if constexpr (MODE == 1) asm volatile("s_nop 15\n\ts_nop 15" ::: "memory");
        if constexpr (ALIGN_EPI) { if (wr == 0) PG8_BAR; }
        if constexpr (!Epi::AFTER_DRAIN) { E(acc, cur, wr, wc, fr, fq); S.done(cur); }
        if (!has_next) break;
#pragma unroll
        for (int a = 0; a < 2; ++a)
#pragma unroll
            for (int b = 0; b < 2; ++b)
#pragma unroll
                for (int m = 0; m < 4; ++m)
#pragma unroll
                    for (int n = 0; n < 2; ++n) acc[a][b][m][n] = (f32x4){0.f, 0.f, 0.f, 0.f};
        cur = nxt; cA = nA; cB = nB; ++ui;
        if constexpr (ALIGN_EPI) { if (wr == 1) PG8_BAR; }
    }
    PG8_WAIT_V(0);
    if constexpr (!ALIGN_EPI) { if (wr == 0) PG8_BAR; }
    PG8_BAR;
    if constexpr (Epi::AFTER_DRAIN) { E.fused(acc, cur, wr, wc, fr, fq, lds, wid, lane); S.done(cur); }
#undef PG8_SA
#undef PG8_SB
#undef PG8_STAGE
#undef PG8_LDA
#undef PG8_LDB
#undef PG8_MMA
#undef PG8_WAIT_V
#undef PG8_WAIT_L
#undef PG8_BAR
#undef PG8_SCHED
}
}
constexpr int T_P = 8192, T_S = 4096, T = T_P + T_S;
constexpr int DM = 4096, DA = 2048, DFF = 11008, NIN = 17152  , KVROWS = 14336;
constexpr int QL = 1024, KVL = 512, NMOD = 6 * DM;
constexpr float NORM_EPS = 1e-6f;

namespace pg8 {
typedef _Float16 f16_t;
typedef _Float16 f16x2 __attribute__((ext_vector_type(2)));
typedef unsigned u32x2 __attribute__((ext_vector_type(2)));
__device__ __forceinline__ float ubf(unsigned u) { return __builtin_bit_cast(float, u); }
__device__ __forceinline__ float sigm(float x) { return __builtin_amdgcn_rcpf(1.0f + __builtin_amdgcn_exp2f(-1.4426950408889634f * x)); }
__device__ __forceinline__ f32x4 sigm4(f32x4 v) { return (f32x4){sigm(v[0]), sigm(v[1]), sigm(v[2]), sigm(v[3])}; }
__device__ __forceinline__ unsigned pk_f16(float lo, float hi) { f16x2 h = {(f16_t)lo, (f16_t)hi}; return __builtin_bit_cast(unsigned, h); }
__device__ __forceinline__ u32x4 pack_bf16x8(f32x4 a, f32x4 b) { u32x4 w; w.x = cvt_pk_bf16(a[0], a[1]); w.y = cvt_pk_bf16(a[2], a[3]); w.z = cvt_pk_bf16(b[0], b[1]); w.w = cvt_pk_bf16(b[2], b[3]); return w; }
__device__ __forceinline__ u32x4 pack_f16x8(f32x4 a, f32x4 b) { u32x4 w; w.x = pk_f16(a[0], a[1]); w.y = pk_f16(a[2], a[3]); w.z = pk_f16(b[0], b[1]); w.w = pk_f16(b[2], b[3]); return w; }
__device__ __forceinline__ unsigned pack_u8x4(f32x4 v, float sc) {
    const unsigned q0 = __builtin_bit_cast(unsigned, __builtin_fmaf(v[0], sc, 12582912.0f)), q1 = __builtin_bit_cast(unsigned, __builtin_fmaf(v[1], sc, 12582912.0f));
    const unsigned q2 = __builtin_bit_cast(unsigned, __builtin_fmaf(v[2], sc, 12582912.0f)), q3 = __builtin_bit_cast(unsigned, __builtin_fmaf(v[3], sc, 12582912.0f));
    return __builtin_amdgcn_perm(q1, q0, 0x0c0c0400u) | __builtin_amdgcn_perm(q3, q2, 0x04000c0cu); }
__device__ __forceinline__ f32x4 unpack_u8x4(unsigned w) { return (f32x4){(float)(w & 0xffu), (float)((w >> 8) & 0xffu), (float)((w >> 16) & 0xffu), (float)(w >> 24)}; }
__device__ __forceinline__ float bflo(unsigned w) { return __builtin_bit_cast(float, w << 16); }
__device__ __forceinline__ float bfhi(unsigned w) { return __builtin_bit_cast(float, w & 0xffff0000u); }
__device__ __forceinline__ void unpack_bf16x8(u32x4 w, f32x4& a, f32x4& b) { a = (f32x4){bflo(w.x), bfhi(w.x), bflo(w.y), bfhi(w.y)}; b = (f32x4){bflo(w.z), bfhi(w.z), bflo(w.w), bfhi(w.w)}; }

struct BatchedOrder {
    int nM, nN, nb, G, c;
    __device__ void init(int nM_, int nN_, int nb_, int G_, int c_) { nM = nM_; nN = nN_; nb = nb_; G = G_; c = c_; }
    __device__ bool next(int i, Unit& u) const {
        const int L = i * G + c; const int per = nM * nN; if (L >= per * nb) return false;
        const int b = L / per, l = L - b * per;
        u.pm = b * nM + (l % nM); u.pn = b * nN + (l / nM); return true;
    }
    __device__ __forceinline__ void a_ready(const Unit&) const {}
    __device__ __forceinline__ void done(const Unit&) const {}
};

#define EPI_LANE() int tid_ = (int)threadIdx.x; asm volatile("" : "+v"(tid_)); const int fr_ = tid_ & 15, fq_ = (tid_ >> 4) & 3
#define EPI_LOOP(...) \
    _Pragma("unroll") for (int ai = 0; ai < 2; ++ai) _Pragma("unroll") for (int m = 0; m < 4; ++m) { const int row = row0 + ai * HALF + m * 16; \
    _Pragma("unroll") for (int bj = 0; bj < 2; ++bj) { const f32x4 v0 = acc[ai][bj][m][0], v1 = acc[ai][bj][m][1]; const int colt = bj * HALF + cl; __VA_ARGS__ } }

struct EpiIn {
    static constexpr bool PERM = true, AFTER_DRAIN = false;
    f16_t* RKV; bf16_t* LWA; bf16_t* LG; float* QLAT; float* KVLAT; float* KPE; bf16_t* GA; bf16_t* GB;
    __device__ __forceinline__ void operator()(const f32x4 (&acc)[2][2][4][2], const Unit& u, int wr, int wc, int fr, int fq) const {
        EPI_LANE(); const int pn = u.pn < 16 ? 8 + u.pn : (u.pn < 18 ? 8 + u.pn : 14 + u.pn);
        const int row0 = u.pm * BM + wr * 64 + fr_, cl = wc * 32 + 8 * fq_;
        if (pn < 24) {
            EPI_LOOP( *(u32x4*)(RKV + (size_t)row * 6144 + pn * 256 + colt) = pack_f16x8(v0, v1); )
        } else if (pn == 24) {
            EPI_LOOP( f32x4 a = sigm4(v0 * 2.0f) * 2.0f - 1.0f, b = sigm4(v1 * 2.0f) * 2.0f - 1.0f; *(u32x4*)(LWA + ((size_t)bj * T + row) * 256 + cl) = pack_bf16x8(a, b); )
        } else if (pn == 25) {
            EPI_LOOP( *(u32x4*)(LWA + ((size_t)bj * T + row) * 256 + 128 + cl) = pack_bf16x8(v0, v1); )
        } else if (pn < 28) {
            EPI_LOOP( *(u32x4*)(LG + (size_t)row * 512 + (pn - 26) * 256 + colt) = pack_bf16x8(sigm4(v0), sigm4(v1)); )
        } else if (pn < 32) {
            EPI_LOOP( float* p = QLAT + (size_t)row * QL + (pn - 28) * 256 + colt; *(f32x4*)p = v0; *(f32x4*)(p + 4) = v1; )
        } else if (pn < 34) {
            EPI_LOOP( float* p = KVLAT + (size_t)row * KVL + (pn - 32) * 256 + colt; *(f32x4*)p = v0; *(f32x4*)(p + 4) = v1; )
        } else if (pn == 34) {
            EPI_LOOP( if (colt < 64) { float* p = KPE + (size_t)row * 64 + colt; *(f32x4*)p = v0; *(f32x4*)(p + 4) = v1; } )
        } else if (pn < 51) {
            EPI_LOOP( *(u32x4*)(GA + (size_t)row * DM + (pn - 35) * 256 + colt) = pack_bf16x8(sigm4(v0), sigm4(v1)); )
        } else {
            EPI_LOOP( *(u32x4*)(GB + (size_t)row * DM + (pn - 51) * 256 + colt) = pack_bf16x8(sigm4(v0), sigm4(v1)); )
        }
    }
};

struct EpiLora {
    static constexpr bool PERM = true, AFTER_DRAIN = false;
    unsigned char* EWAA; const float* lbias;
    __device__ __forceinline__ void operator()(const f32x4 (&acc)[2][2][4][2], const Unit& u, int wr, int wc, int fr, int fq) const {
        EPI_LANE(); const int dir = u.pn >> 4, jn = u.pn & 15, row0 = (u.pm - dir * (T / BM)) * BM + wr * 64 + fr_, cl = wc * 32 + 8 * fq_;
        const int isa = jn >> 3;
        const float* bias = lbias + isa * (2 * DA) + dir * DA + (jn & 7) * 256; unsigned char* O = EWAA + (size_t)(isa * 2 + dir) * T * DA + (jn & 7) * 256;
        f32x4 bv[2][2];
#pragma unroll
        for (int bj = 0; bj < 2; ++bj) { bv[bj][0] = *(const f32x4*)(bias + bj * HALF + cl); bv[bj][1] = *(const f32x4*)(bias + bj * HALF + cl + 4); }
        EPI_LOOP( u32x2 w; w.x = pack_u8x4(sigm4(v0 + bv[bj][0]), 255.0f); w.y = pack_u8x4(sigm4(v1 + bv[bj][1]), 255.0f); *(u32x2*)(O + (size_t)row * DA + colt) = w; )
    }
};

struct EpiPlain {
    static constexpr bool PERM = true, AFTER_DRAIN = false;
    bf16_t* O; int ldc;
    __device__ __forceinline__ void operator()(const f32x4 (&acc)[2][2][4][2], const Unit& u, int wr, int wc, int fr, int fq) const {
        EPI_LANE(); const int row0 = u.pm * BM + wr * 64 + fr_, cl = wc * 32 + 8 * fq_;
        EPI_LOOP( *(u32x4*)(O + (size_t)row * ldc + u.pn * 256 + colt) = pack_bf16x8(v0, v1); )
    }
};

struct EpiPlainI8 {
    static constexpr bool PERM = true, AFTER_DRAIN = false;
    bf16_t* O; int ldc; const float* rows; const unsigned* cmax;
    __device__ __forceinline__ void operator()(const f32x4 (&acc)[2][2][4][2], const Unit& u, int wr, int wc, int fr, int fq) const {
        typedef int v4i_t __attribute__((ext_vector_type(4)));
        EPI_LANE(); const int row0 = u.pm * BM + wr * 64 + fr_, cl = wc * 32 + 8 * fq_;
        f32x4 cs[2][2];
#pragma unroll
        for (int bj = 0; bj < 2; ++bj)
#pragma unroll
            for (int n = 0; n < 2; ++n) { const u32x4 m4 = *(const u32x4*)(cmax + u.pn * 256 + bj * HALF + cl + 4 * n);
                cs[bj][n] = (f32x4){ubf(m4.x), ubf(m4.y), ubf(m4.z), ubf(m4.w)} * (1.0f / 127.0f); }
        float rs8[2][4];
#pragma unroll
        for (int ai = 0; ai < 2; ++ai)
#pragma unroll
            for (int m = 0; m < 4; ++m) rs8[ai][m] = rows[row0 + ai * HALF + m * 16];
#pragma unroll
        for (int ai = 0; ai < 2; ++ai)
#pragma unroll
            for (int m = 0; m < 4; ++m) { const int row = row0 + ai * HALF + m * 16; const float rs = rs8[ai][m];
#pragma unroll
                for (int bj = 0; bj < 2; ++bj) { const v4i_t c0 = __builtin_bit_cast(v4i_t, acc[ai][bj][m][0]), c1 = __builtin_bit_cast(v4i_t, acc[ai][bj][m][1]);
                    const f32x4 v0 = (f32x4){(float)c0[0], (float)c0[1], (float)c0[2], (float)c0[3]} * cs[bj][0] * rs, v1 = (f32x4){(float)c1[0], (float)c1[1], (float)c1[2], (float)c1[3]} * cs[bj][1] * rs;
                    *(u32x4*)(O + (size_t)row * ldc + u.pn * 256 + bj * HALF + cl) = pack_bf16x8(v0, v1); } }
    }
};
struct EpiMix1 {
    static constexpr bool PERM = true, AFTER_DRAIN = false;
    const bf16_t* GA; float* TMP;
    __device__ __forceinline__ void operator()(const f32x4 (&acc)[2][2][4][2], const Unit& u, int wr, int wc, int fr, int fq) const {
        EPI_LANE(); const int row0 = u.pm * BM + wr * 64 + fr_, cl = wc * 32 + 8 * fq_;
        EPI_LOOP( const size_t o = (size_t)row * DM + u.pn * 256 + colt; f32x4 g0, g1; unpack_bf16x8(*(const u32x4*)(GA + o), g0, g1); *(f32x4*)(TMP + o) = g0 * v0; *(f32x4*)(TMP + o + 4) = g1 * v1; )
    }
};
struct EpiMix2 {
    static constexpr bool PERM = true, AFTER_DRAIN = false;
    const bf16_t* GB; const float* TMP; bf16_t* MIXED; unsigned* rmax;
    __device__ __forceinline__ void operator()(const f32x4 (&acc)[2][2][4][2], const Unit& u, int wr, int wc, int fr, int fq) const {
        EPI_LANE(); const int row0 = u.pm * BM + wr * 64 + fr_, cl = wc * 32 + 8 * fq_;
#pragma unroll
        for (int ai = 0; ai < 2; ++ai)
#pragma unroll
            for (int m = 0; m < 4; ++m) { const int row = row0 + ai * HALF + m * 16; float mx = 0.f;
#pragma unroll
                for (int bj = 0; bj < 2; ++bj) { const f32x4 v0 = acc[ai][bj][m][0], v1 = acc[ai][bj][m][1]; const size_t o = (size_t)row * DM + u.pn * 256 + bj * HALF + cl;
                    f32x4 g0, g1; unpack_bf16x8(*(const u32x4*)(GB + o), g0, g1); const f32x4 t0 = *(const f32x4*)(TMP + o) + g0 * v0, t1 = *(const f32x4*)(TMP + o + 4) + g1 * v1;
                    *(u32x4*)(MIXED + o) = pack_bf16x8(t0, t1);
                    const f32x4 a0 = __builtin_elementwise_abs(t0), a1 = __builtin_elementwise_abs(t1); mx = fmaxf(mx, fmaxf(fmaxf(fmaxf(a0[0], a0[1]), fmaxf(a0[2], a0[3])), fmaxf(fmaxf(a1[0], a1[1]), fmaxf(a1[2], a1[3])))); }
                mx = fmaxf(mx, __shfl_xor(mx, 16)); mx = fmaxf(mx, __shfl_xor(mx, 32));
                if (fq_ == 0) atomicMax(rmax + row, __builtin_bit_cast(unsigned, mx)); }
    }
};
struct EpiRes {
    static constexpr bool PERM = true, AFTER_DRAIN = false;
    const bf16_t* x1; float* out; const float* gate; float accs;
    __device__ __forceinline__ void operator()(const f32x4 (&acc)[2][2][4][2], const Unit& u, int wr, int wc, int fr, int fq) const {
        EPI_LANE(); const int row0 = u.pm * BM + wr * 64 + fr_, cl = wc * 32 + 8 * fq_;
        const int rbase = u.pm * BM, mi = rbase < T_P ? 0 : 1 + ((rbase - T_P) >> 10);
        const float* gp = gate + (size_t)mi * NMOD + u.pn * 256;
        f32x4 gv[2][2];
#pragma unroll
        for (int bj = 0; bj < 2; ++bj) { gv[bj][0] = *(const f32x4*)(gp + bj * HALF + cl) * accs; gv[bj][1] = *(const f32x4*)(gp + bj * HALF + cl + 4) * accs; }
        EPI_LOOP( const size_t o = (size_t)row * DM + u.pn * 256 + colt; f32x4 b0, b1; unpack_bf16x8(*(const u32x4*)(x1 + o), b0, b1);
                  __builtin_nontemporal_store(b0 + gv[bj][0] * v0, (f32x4*)(out + o)); __builtin_nontemporal_store(b1 + gv[bj][1] * v1, (f32x4*)(out + o + 4)); )
    }
};
struct EpiSwiglu {
    static constexpr bool PERM = true, AFTER_DRAIN = false;
    unsigned char* ACT;
    __device__ __forceinline__ void operator()(const f32x4 (&acc)[2][2][4][2], const Unit& u, int wr, int wc, int fr, int fq) const {
        EPI_LANE(); const int row0 = u.pm * BM + wr * 64 + fr_, cl = wc * 32 + 8 * fq_;
#pragma unroll
        for (int ai = 0; ai < 2; ++ai)
#pragma unroll
            for (int m = 0; m < 4; ++m) { const int row = row0 + ai * HALF + m * 16;
                const f32x4 g0 = acc[ai][0][m][0], g1 = acc[ai][0][m][1], u0 = acc[ai][1][m][0], u1 = acc[ai][1][m][1];
                const f32x4 a0 = g0 * sigm4(g0) * u0, a1 = g1 * sigm4(g1) * u1;
                unsigned w0 = 0u, w1 = 0u;
                w0 = __builtin_amdgcn_cvt_pk_fp8_f32(a0[0], a0[1], w0, false); w0 = __builtin_amdgcn_cvt_pk_fp8_f32(a0[2], a0[3], w0, true);
                w1 = __builtin_amdgcn_cvt_pk_fp8_f32(a1[0], a1[1], w1, false); w1 = __builtin_amdgcn_cvt_pk_fp8_f32(a1[2], a1[3], w1, true);
                u32x2 pk; pk.x = w0; pk.y = w1; *(u32x2*)(ACT + (size_t)row * DFF + u.pn * 128 + cl) = pk; }
    }
};
struct EpiSwigluI8 {
    static constexpr bool PERM = true, AFTER_DRAIN = false;
    unsigned char* ACT; const float* rows; const unsigned* cmax;
    __device__ __forceinline__ void operator()(const f32x4 (&acc)[2][2][4][2], const Unit& u, int wr, int wc, int fr, int fq) const {
        typedef int v4i_t __attribute__((ext_vector_type(4)));
        EPI_LANE(); const int row0 = u.pm * BM + wr * 64 + fr_, cl = wc * 32 + 8 * fq_;
        f32x4 cs[2][2];
#pragma unroll
        for (int bj = 0; bj < 2; ++bj)
#pragma unroll
            for (int n = 0; n < 2; ++n) { const u32x4 m4 = *(const u32x4*)(cmax + bj * DFF + u.pn * 128 + cl + 4 * n);
                cs[bj][n] = (f32x4){ubf(m4.x), ubf(m4.y), ubf(m4.z), ubf(m4.w)} * (1.0f / 127.0f); }
        float rs8[2][4];
#pragma unroll
        for (int ai = 0; ai < 2; ++ai)
#pragma unroll
            for (int m = 0; m < 4; ++m) rs8[ai][m] = rows[row0 + ai * HALF + m * 16];
#pragma unroll
        for (int ai = 0; ai < 2; ++ai)
#pragma unroll
            for (int m = 0; m < 4; ++m) { const int row = row0 + ai * HALF + m * 16; const float rs = rs8[ai][m];
                f32x4 v[2][2];
#pragma unroll
                for (int bj = 0; bj < 2; ++bj)
#pragma unroll
                    for (int n = 0; n < 2; ++n) { const v4i_t c = __builtin_bit_cast(v4i_t, acc[ai][bj][m][n]); v[bj][n] = (f32x4){(float)c[0], (float)c[1], (float)c[2], (float)c[3]} * cs[bj][n] * rs; }
                const f32x4 a0 = v[0][0] * sigm4(v[0][0]) * v[1][0], a1 = v[0][1] * sigm4(v[0][1]) * v[1][1];
                unsigned w0 = 0u, w1 = 0u;
                w0 = __builtin_amdgcn_cvt_pk_fp8_f32(a0[0], a0[1], w0, false); w0 = __builtin_amdgcn_cvt_pk_fp8_f32(a0[2], a0[3], w0, true);
                w1 = __builtin_amdgcn_cvt_pk_fp8_f32(a1[0], a1[1], w1, false); w1 = __builtin_amdgcn_cvt_pk_fp8_f32(a1[2], a1[3], w1, true);
                u32x2 pk; pk.x = w0; pk.y = w1; *(u32x2*)(ACT + (size_t)row * DFF + u.pn * 128 + cl) = pk; }
    }
};
struct EpiGate8 {
    static constexpr bool PERM = true, AFTER_DRAIN = false;
    unsigned char* GA; unsigned char* GB; const float* rows;     const unsigned* cmax; f16_t* RKV; bf16_t* LG; float* QLAT; int pn0;
    __device__ __forceinline__ void operator()(const f32x4 (&acc)[2][2][4][2], const Unit& u, int wr, int wc, int fr, int fq) const {
        typedef int v4i_t __attribute__((ext_vector_type(4)));
        EPI_LANE(); const int row0 = u.pm * BM + wr * 64 + fr_, cl = wc * 32 + 8 * fq_, pn = u.pn + pn0;
        f32x4 cs[2][2];
#pragma unroll
        for (int bj = 0; bj < 2; ++bj)
#pragma unroll
            for (int n = 0; n < 2; ++n) { const u32x4 m4 = *(const u32x4*)(cmax + pn * 256 + bj * HALF + cl + 4 * n);
                cs[bj][n] = (f32x4){ubf(m4.x), ubf(m4.y), ubf(m4.z), ubf(m4.w)} * (1.0f / 127.0f); }
        float rs8[2][4];
#pragma unroll
        for (int ai = 0; ai < 2; ++ai)
#pragma unroll
            for (int m = 0; m < 4; ++m) rs8[ai][m] = rows[row0 + ai * HALF + m * 16];
#pragma unroll
        for (int ai = 0; ai < 2; ++ai)
#pragma unroll
            for (int m = 0; m < 4; ++m) { const int row = row0 + ai * HALF + m * 16; const float rs = rs8[ai][m];
#pragma unroll
                for (int bj = 0; bj < 2; ++bj) { const v4i_t c0 = __builtin_bit_cast(v4i_t, acc[ai][bj][m][0]), c1 = __builtin_bit_cast(v4i_t, acc[ai][bj][m][1]);
                    const f32x4 v0 = (f32x4){(float)c0[0], (float)c0[1], (float)c0[2], (float)c0[3]} * cs[bj][0] * rs, v1 = (f32x4){(float)c1[0], (float)c1[1], (float)c1[2], (float)c1[3]} * cs[bj][1] * rs;
                    const int colt = bj * HALF + cl;
                    if (pn < 32) { unsigned char* O = (pn < 16 ? GA : GB - (size_t)16 * 256) + pn * 256; u32x2 w; w.x = pack_u8x4(sigm4(v0), 255.0f); w.y = pack_u8x4(sigm4(v1), 255.0f); *(u32x2*)(O + (size_t)row * DM + colt) = w; }
                    else if (pn < 40) { *(u32x4*)(RKV + (size_t)row * 6144 + (pn - 32) * 256 + colt) = pack_f16x8(v0, v1); }
                    else if (pn < 42) { *(u32x4*)(LG + (size_t)row * 512 + (pn - 40) * 256 + colt) = pack_bf16x8(sigm4(v0), sigm4(v1)); }
                    else { *(u32x4*)((f16_t*)QLAT + (size_t)row * QL + (pn - 42) * 256 + colt) = pack_f16x8(v0, v1); } } }
    }
};
struct EpiMix1I8 {
    static constexpr bool PERM = true, AFTER_DRAIN = false;
    const unsigned char* GA; bf16_t* TMP;     const float* rows; const unsigned* cmax;
    __device__ __forceinline__ void operator()(const f32x4 (&acc)[2][2][4][2], const Unit& u, int wr, int wc, int fr, int fq) const {
        typedef int v4i_t __attribute__((ext_vector_type(4)));
        EPI_LANE(); const int row0 = u.pm * BM + wr * 64 + fr_, cl = wc * 32 + 8 * fq_;
        f32x4 cs[2][2];
#pragma unroll
        for (int bj = 0; bj < 2; ++bj)
#pragma unroll
            for (int n = 0; n < 2; ++n) { const u32x4 m4 = *(const u32x4*)(cmax + u.pn * 256 + bj * HALF + cl + 4 * n);
                cs[bj][n] = (f32x4){ubf(m4.x), ubf(m4.y), ubf(m4.z), ubf(m4.w)} * (1.0f / 127.0f); }
        float rs8[2][4];
#pragma unroll
        for (int ai = 0; ai < 2; ++ai)
#pragma unroll
            for (int m = 0; m < 4; ++m) rs8[ai][m] = rows[row0 + ai * HALF + m * 16];
#pragma unroll
        for (int ai = 0; ai < 2; ++ai)
#pragma unroll
            for (int m = 0; m < 4; ++m) { const int row = row0 + ai * HALF + m * 16; const float rs = rs8[ai][m];
#pragma unroll
                for (int bj = 0; bj < 2; ++bj) { const v4i_t c0 = __builtin_bit_cast(v4i_t, acc[ai][bj][m][0]), c1 = __builtin_bit_cast(v4i_t, acc[ai][bj][m][1]);
                    const f32x4 v0 = (f32x4){(float)c0[0], (float)c0[1], (float)c0[2], (float)c0[3]} * cs[bj][0] * rs, v1 = (f32x4){(float)c1[0], (float)c1[1], (float)c1[2], (float)c1[3]} * cs[bj][1] * rs;
                    const size_t o = (size_t)row * DM + u.pn * 256 + bj * HALF + cl; const u32x2 gw = *(const u32x2*)(GA + o); const f32x4 g0 = unpack_u8x4(gw.x) * (1.0f / 255.0f), g1 = unpack_u8x4(gw.y) * (1.0f / 255.0f);
                    *(u32x4*)(TMP + o) = pack_bf16x8(g0 * v0, g1 * v1); } }
    }
};
struct EpiMix2I8 {
    static constexpr bool PERM = true, AFTER_DRAIN = false;
    const unsigned char* GB; const bf16_t* TMP; bf16_t* MIXED; unsigned* rmax; const float* rows; const unsigned* cmax;
    __device__ __forceinline__ void operator()(const f32x4 (&acc)[2][2][4][2], const Unit& u, int wr, int wc, int fr, int fq) const {
        typedef int v4i_t __attribute__((ext_vector_type(4)));
        EPI_LANE(); const int row0 = u.pm * BM + wr * 64 + fr_, cl = wc * 32 + 8 * fq_;
        f32x4 cs[2][2];
#pragma unroll
        for (int bj = 0; bj < 2; ++bj)
#pragma unroll
            for (int n = 0; n < 2; ++n) { const u32x4 m4 = *(const u32x4*)(cmax + u.pn * 256 + bj * HALF + cl + 4 * n);
                cs[bj][n] = (f32x4){ubf(m4.x), ubf(m4.y), ubf(m4.z), ubf(m4.w)} * (1.0f / 127.0f); }
        float rs8[2][4];
#pragma unroll
        for (int ai = 0; ai < 2; ++ai)
#pragma unroll
            for (int m = 0; m < 4; ++m) rs8[ai][m] = rows[row0 + ai * HALF + m * 16];
#pragma unroll
        for (int ai = 0; ai < 2; ++ai)
#pragma unroll
            for (int m = 0; m < 4; ++m) { const int row = row0 + ai * HALF + m * 16; const float rs = rs8[ai][m]; float mx = 0.f;
#pragma unroll
                for (int bj = 0; bj < 2; ++bj) { const v4i_t c0 = __builtin_bit_cast(v4i_t, acc[ai][bj][m][0]), c1 = __builtin_bit_cast(v4i_t, acc[ai][bj][m][1]);
                    const f32x4 v0 = (f32x4){(float)c0[0], (float)c0[1], (float)c0[2], (float)c0[3]} * cs[bj][0] * rs, v1 = (f32x4){(float)c1[0], (float)c1[1], (float)c1[2], (float)c1[3]} * cs[bj][1] * rs;
                    const size_t o = (size_t)row * DM + u.pn * 256 + bj * HALF + cl;
                    const u32x2 gw = *(const u32x2*)(GB + o); const f32x4 g0 = unpack_u8x4(gw.x) * (1.0f / 255.0f), g1 = unpack_u8x4(gw.y) * (1.0f / 255.0f); f32x4 p0, p1; unpack_bf16x8(*(const u32x4*)(TMP + o), p0, p1); const f32x4 t0 = p0 + g0 * v0, t1 = p1 + g1 * v1;
                    *(u32x4*)(MIXED + o) = pack_bf16x8(t0, t1);
                    const f32x4 a0 = __builtin_elementwise_abs(t0), a1 = __builtin_elementwise_abs(t1); mx = fmaxf(mx, fmaxf(fmaxf(fmaxf(a0[0], a0[1]), fmaxf(a0[2], a0[3])), fmaxf(fmaxf(a1[0], a1[1]), fmaxf(a1[2], a1[3])))); }
                mx = fmaxf(mx, __shfl_xor(mx, 16)); mx = fmaxf(mx, __shfl_xor(mx, 32));
                if (fq_ == 0) atomicMax(rmax + row, __builtin_bit_cast(unsigned, mx)); }
    }
};
struct EpiResI8 {
    static constexpr bool PERM = true, AFTER_DRAIN = false;
    const float* xp; const float* xs; bf16_t* x1; const float* gate; const float* rows; const unsigned* cmax;
    __device__ __forceinline__ void operator()(const f32x4 (&acc)[2][2][4][2], const Unit& u, int wr, int wc, int fr, int fq) const {
        typedef int v4i_t __attribute__((ext_vector_type(4)));
        EPI_LANE(); const int row0 = u.pm * BM + wr * 64 + fr_, cl = wc * 32 + 8 * fq_;
        const int rbase = u.pm * BM, mi = rbase < T_P ? 0 : 1 + ((rbase - T_P) >> 10);
        const float* gp = gate + (size_t)mi * NMOD + u.pn * 256;
        const float* base = rbase < T_P ? xp : xs - (size_t)T_P * DM;
        f32x4 gv[2][2];
#pragma unroll
        for (int bj = 0; bj < 2; ++bj)
#pragma unroll
            for (int n = 0; n < 2; ++n) { const u32x4 m4 = *(const u32x4*)(cmax + u.pn * 256 + bj * HALF + cl + 4 * n);
                gv[bj][n] = *(const f32x4*)(gp + bj * HALF + cl + 4 * n) * ((f32x4){ubf(m4.x), ubf(m4.y), ubf(m4.z), ubf(m4.w)} * (1.0f / 127.0f)); }
        float rs8[2][4];
#pragma unroll
        for (int ai = 0; ai < 2; ++ai)
#pragma unroll
            for (int m = 0; m < 4; ++m) rs8[ai][m] = rows[row0 + ai * HALF + m * 16];
#pragma unroll
        for (int ai = 0; ai < 2; ++ai)
#pragma unroll
            for (int m = 0; m < 4; ++m) { const int row = row0 + ai * HALF + m * 16; const float rs = rs8[ai][m];
#pragma unroll
                for (int bj = 0; bj < 2; ++bj) { const v4i_t c0 = __builtin_bit_cast(v4i_t, acc[ai][bj][m][0]), c1 = __builtin_bit_cast(v4i_t, acc[ai][bj][m][1]);
                    const f32x4 v0 = (f32x4){(float)c0[0], (float)c0[1], (float)c0[2], (float)c0[3]} * rs, v1 = (f32x4){(float)c1[0], (float)c1[1], (float)c1[2], (float)c1[3]} * rs;
                    const size_t o = (size_t)row * DM + u.pn * 256 + bj * HALF + cl; const f32x4 b0 = *(const f32x4*)(base + o), b1 = *(const f32x4*)(base + o + 4);
                    *(u32x4*)(x1 + o) = pack_bf16x8(b0 + gv[bj][0] * v0, b1 + gv[bj][1] * v1); } }
    }
};
#undef EPI_LOOP
}
#define GAS __attribute__((address_space(1)))
#define LAS __attribute__((address_space(3)))
typedef unsigned short bf16;
typedef unsigned v4u __attribute__((ext_vector_type(4)));
typedef float f32x4 __attribute__((ext_vector_type(4)));
typedef short bf16x8 __attribute__((ext_vector_type(8)));
typedef GAS unsigned gu32;
typedef GAS unsigned long long gu64;
#define RLX_AGENT __ATOMIC_RELAXED, __HIP_MEMORY_SCOPE_AGENT
#define LDS_WAIT() asm volatile("s_waitcnt lgkmcnt(0)" ::: "memory")
#define VM_WAIT() asm volatile("s_waitcnt vmcnt(0)" ::: "memory")
__device__ __forceinline__ unsigned long long rt() { return __builtin_amdgcn_s_memrealtime(); }
__device__ __forceinline__ unsigned f2bf(float f) { unsigned u = __builtin_bit_cast(unsigned, f); return (u + 0x7fffu + ((u >> 16) & 1u)) >> 16; }
__device__ __forceinline__ unsigned pk2(float lo, float hi) { return f2bf(lo) | (f2bf(hi) << 16); }
constexpr size_t MiB = 1u << 20;
constexpr size_t WS_CTL = 0, CTL_ZERO_BYTES = 1 * MiB;
constexpr size_t WS_MOD = 1 * MiB, WS_COS = 1 * MiB + 512 * 1024, WS_SIN = 1 * MiB + 640 * 1024, WS_LBIAS = 1 * MiB + 768 * 1024;
constexpr size_t WS_WFI = 2 * MiB, WS_WFO = 174 * MiB, WS_WOUT = 260 * MiB, WS_WOR = 292 * MiB, WS_WOM = 308 * MiB;
constexpr size_t WS_WIN = 324 * MiB, WS_WUQ = 458 * MiB, WS_WUKV = 464 * MiB, WS_WLORA = 468 * MiB, WS_WG = 472 * MiB;
constexpr size_t WS_YS = 324 * MiB, WS_BON = 420 * MiB, WS_YB = 423 * MiB;
constexpr size_t WS_HB = 474 * MiB;
constexpr size_t WS_RKV = 570 * MiB, WS_GA = 714 * MiB, WS_GB = 810 * MiB;
constexpr size_t WS_MIXED = 570 * MiB, WS_ACT = 570 * MiB;
constexpr size_t WS_LWA = 906 * MiB, WS_LG = 918 * MiB;
constexpr size_t WS_QLAT = 930 * MiB, WS_KVLAT = 978 * MiB, WS_Q = 930 * MiB;
constexpr size_t WS_KPE = 1002 * MiB;
constexpr size_t WS_QN = 1005 * MiB, WS_CKVA = 1029 * MiB;
constexpr size_t WS_EW = 1043 * MiB, WS_AA = 1139 * MiB, WS_TMP = 1043 * MiB;
constexpr size_t WS_G = 1235 * MiB;
constexpr size_t WS_KV = 1283 * MiB, WS_YA = 1479 * MiB;
constexpr size_t WS_KP = 1395 * MiB;
constexpr size_t WS_END = 1527 * MiB;
static_assert(WS_WIN + (size_t)NIN * DM * 2 <= WS_WUQ && WS_WFI + (size_t)2 * DFF * DM * 2 <= WS_WFO && WS_WFO + (size_t)DM * DFF * 2 <= WS_WOUT, "weights map");
static_assert(WS_YS + (size_t)2 * T * DA * 2 <= WS_BON && WS_BON + (size_t)2 * T * 32 * 4 <= WS_YB && WS_YB + (size_t)T * DA * 2 <= WS_HB, "overlay map");
static_assert(WS_RKV + (size_t)T * 6144 * 2 <= WS_GA && WS_ACT + (size_t)T * DFF * 2 <= WS_LWA && WS_Q + (size_t)T * 3072 * 2 <= WS_KPE && WS_KV + (size_t)KVROWS * 4096 * 2 <= WS_KP && WS_KP + (size_t)KVROWS * 3072 * 2 <= WS_YA && WS_YA + (size_t)T * DA * 2 <= WS_END, "act map");
static_assert(WS_AA == WS_EW + (size_t)2 * T * DA * 2, "AA follows EW");
constexpr int CW_BAR = 4096;
constexpr size_t WS_CMAX = 64 * 1024;
constexpr size_t WS_ROWS = 256 * 1024;
constexpr size_t WS_CMAXG = 320 * 1024;
constexpr size_t WS_ROWS1 = 384 * 1024;
static_assert(WS_ROWS + 12288 * 4 <= WS_CMAXG && WS_CMAXG + 11776 * 4 <= WS_ROWS1 && WS_ROWS1 + 12288 * 4 <= CTL_ZERO_BYTES, "scale tables 2");
constexpr size_t WS_CMAXO = 448 * 1024, WS_CMAXR = 464 * 1024, WS_RMAXM = 480 * 1024, WS_ROWSYA = 528 * 1024, WS_ROWSM = 576 * 1024;
static_assert(WS_ROWS1 + 12288 * 4 <= WS_CMAXO && WS_ROWSM + 12288 * 4 <= CTL_ZERO_BYTES, "scale tables 3");
constexpr size_t WS_YB8 = 1395 * MiB;
constexpr size_t WS_ROWSYB = 640 * 1024, WS_CMAXM = 704 * 1024;
static_assert(WS_ROWSM + 12288 * 4 <= WS_ROWSYB && WS_ROWSYB + 12288 * 4 <= WS_CMAXM && WS_CMAXM + 4096 * 4 <= CTL_ZERO_BYTES, "scale tables 4");
constexpr size_t WS_ROWSQ = 720 * 1024, WS_ROWSKV = 768 * 1024, WS_CMAXUQ = 824 * 1024, WS_CMAXUKV = 836 * 1024;
static_assert(WS_CMAXM + 4096 * 4 <= WS_ROWSQ && WS_ROWSQ + 12288 * 4 <= WS_ROWSKV && WS_ROWSKV + 14336 * 4 <= WS_CMAXUQ && WS_CMAXUQ + 3072 * 4 <= WS_CMAXUKV && WS_CMAXUKV + 4096 * 4 <= CTL_ZERO_BYTES, "scale tables 5");
constexpr size_t WS_X1 = 324 * MiB;
constexpr size_t WS_MIX8 = 666 * MiB;
constexpr size_t WS_H1Q = 88 * MiB, WS_WGATE8 = 136 * MiB, WS_WING8 = 1139 * MiB;
static_assert(WS_WFI + (size_t)2 * DFF * DM <= WS_H1Q && WS_H1Q + (size_t)T * DM <= WS_WGATE8 && WS_WGATE8 + (size_t)8192 * DM <= WS_WFO, "int8 tail of the WFI region");
static_assert(WS_CMAX + 22016 * 4 <= WS_ROWS && WS_ROWS + 12288 * 4 <= CTL_ZERO_BYTES, "scale tables inside the control region");

constexpr int RING_OFF = 0, RING_BYTES = 131072;
constexpr int LDSCTL_OFF = RING_BYTES, MISC_OFF = LDSCTL_OFF + 320;
constexpr int LDS_BYTES = 147456;
constexpr int NWAVES = 8;

constexpr size_t OUT_YP = 0, OUT_YS = (size_t)T_P * DM, OUT_STATE = (size_t)T * DM, OUT_CKV = OUT_STATE + (size_t)32 * 2 * 32 * 64 * 64, OUT_KPE = OUT_CKV + (size_t)T_P * KVL;

typedef _Float16 f16;
typedef unsigned v2u __attribute__((ext_vector_type(2)));
typedef float f32x2 __attribute__((ext_vector_type(2)));
#define XB_TMO      128
#define XB_XCNT(j)  (256  + 64 * (j))
#define XB_XSUB(j)  (1280 + 64 * (j))
#define XB_XGEN(j)  (2304 + 64 * (j))
#define XB_TOP      3328
#define XB_TOPGEN   3392
#define XCD_BAR_WORDS 3456
#define XB_SPIN_CAP (1u << 18)

__device__ __forceinline__ unsigned xb_ld(unsigned* p)              { return __hip_atomic_load(p, __ATOMIC_RELAXED, __HIP_MEMORY_SCOPE_AGENT); }
__device__ __forceinline__ unsigned xb_add(unsigned* p, unsigned v) { return __hip_atomic_fetch_add(p, v, __ATOMIC_RELAXED, __HIP_MEMORY_SCOPE_AGENT); }
__device__ __forceinline__ unsigned xb_xcc_id() { return (unsigned)__builtin_amdgcn_s_getreg((3 << 11) | 20) & 0xFu; }
#define XB_SPIN(cond, bar) do { unsigned _sp = 0; while (cond) { __builtin_amdgcn_s_sleep(1); \
    if ((++_sp & 255u) == 0u) { if (xb_ld(&(bar)[XB_TMO])) break; if (_sp > XB_SPIN_CAP) { atomicAdd(&(bar)[XB_TMO], 1u); break; } } } } while (0)

struct XcdBarrier {
    unsigned* bar; unsigned x;
    volatile LAS unsigned* st;
};

__device__ __forceinline__ XcdBarrier xcd_barrier_post(unsigned* bar, volatile LAS unsigned* st) {
    XcdBarrier b; b.bar = bar; b.x = xb_xcc_id(); b.st = st;
    if (threadIdx.x == 0) (void)xb_add(&bar[XB_XCNT(b.x)], 1u);
    return b;
}
__device__ __forceinline__ void xcd_barrier_complete(unsigned* bar, unsigned x, unsigned& nloc, unsigned& nx) {
    const unsigned G = gridDim.x * gridDim.y * gridDim.z;
    unsigned sum, cnt, mine, sp = 0u;
    for (;;) {
        sum = 0u; cnt = 0u; mine = 0u;
#pragma unroll
        for (unsigned j = 0; j < 16; ++j) { const unsigned c = xb_ld(&bar[XB_XCNT(j)]); sum += c; cnt += (c > 0u) ? 1u : 0u; mine = (j == x) ? c : mine; }
        if (sum == G) break;
        __builtin_amdgcn_s_sleep(1);
        if ((++sp & 255u) == 0u) { if (xb_ld(&bar[XB_TMO])) break; if (sp > XB_SPIN_CAP) { atomicAdd(&bar[XB_TMO], 1u); break; } }
    }
    nloc = mine > 0u ? mine : 1u; nx = cnt > 0u ? cnt : 1u;
}

__device__ __forceinline__ void xcd_barrier(const XcdBarrier& b) {
    asm volatile("s_waitcnt vmcnt(0)" ::: "memory");
    __syncthreads();
    if (threadIdx.x == 0) {
        unsigned* bar = b.bar;
        __builtin_amdgcn_s_waitcnt(0);
        unsigned nloc = b.st[0], nx = b.st[1];
        if (nloc == 0u) { xcd_barrier_complete(bar, b.x, nloc, nx); b.st[0] = nloc; b.st[1] = nx; }
        const unsigned old = xb_add(&bar[XB_XSUB(b.x)], 1u);
        const unsigned gen = old / nloc;
        if (old + 1u == (gen + 1u) * nloc) {
            __builtin_amdgcn_fence(__ATOMIC_RELEASE, "agent");
            asm volatile("s_waitcnt vmcnt(0)" ::: "memory");
            const unsigned og = xb_add(&bar[XB_TOP], 1u);
            const unsigned tg = og / nx;
            if (og + 1u == (tg + 1u) * nx) xb_add(&bar[XB_TOPGEN], 1u);
            else XB_SPIN(xb_ld(&bar[XB_TOPGEN]) == tg, bar);
            __builtin_amdgcn_fence(__ATOMIC_ACQUIRE, "agent");
            xb_add(&bar[XB_XGEN(b.x)], 1u);
            asm volatile("s_waitcnt vmcnt(0)" ::: "memory");
        } else {
            XB_SPIN(xb_ld(&bar[XB_XGEN(b.x)]) == gen, bar);
            __builtin_amdgcn_fence(__ATOMIC_ACQUIRE, "agent");
            asm volatile("s_waitcnt vmcnt(0)" ::: "memory");
        }
    }
    __syncthreads();
}
struct Args { const float* in[33]; float* out; unsigned char* ws; int ph_lo, ph_hi; };
enum { I_XP = 0, I_XS, I_C, I_STATE, I_CCKV, I_CKPE, I_CCTX, I_WMOD, I_BMOD, I_NMIX, I_WIN, I_W0, I_WLB, I_A0, I_ALB, I_GLB, I_KK, I_KA, I_RK, I_LNW, I_LNB,
       I_QNW, I_WUQ, I_KVNW, I_WUKV, I_QHN, I_KHN, I_WOR, I_WOM, I_WOUT, I_NFFN, I_WFI, I_WFO };
struct Frame { LAS unsigned char* lds; volatile LAS unsigned* MISC; gu32* ctl; int tid, lane, wave, G, gw, ngw; };

__device__ __forceinline__ float wave_sum(float v) {
#pragma unroll
    for (int o = 1; o < 64; o <<= 1) v += __shfl_xor(v, o);
    return v;
}
__device__ __forceinline__ float dpp_f(float x, const int ctrl_sel) {
    const int xi = __builtin_bit_cast(int, x); int r;
    if (ctrl_sel == 0) r = __builtin_amdgcn_update_dpp(0, xi, 0xB1, 0xF, 0xF, true);
    else if (ctrl_sel == 1) r = __builtin_amdgcn_update_dpp(0, xi, 0x4E, 0xF, 0xF, true);
    else if (ctrl_sel == 2) r = __builtin_amdgcn_update_dpp(0, xi, 0x141, 0xF, 0xF, true);
    else r = __builtin_amdgcn_update_dpp(0, xi, 0x140, 0xF, 0xF, true);
    return __builtin_bit_cast(float, r);
}
__device__ __forceinline__ float row16_sum(float x) { x += dpp_f(x, 0); x += dpp_f(x, 1); x += dpp_f(x, 2); x += dpp_f(x, 3); return x; }
__device__ __forceinline__ float sigm(float x) { return pg8::sigm(x); }
__device__ __forceinline__ int mod_index(int row) { return row < T_P ? 0 : 1 + ((row - T_P) >> 10); }

__device__ __forceinline__ void p0_adaln(const Args& a, Frame& F) {
    LAS float* SC = (LAS float*)(F.lds);
    LAS float* RED = (LAS float*)(F.lds + 81920);
    const float* c = a.in[I_C]; const float* cctx = a.in[I_CCTX]; const float* wmod = a.in[I_WMOD]; const float* bmod = a.in[I_BMOD];
    float* MOD = (float*)(a.ws + WS_MOD);
#pragma unroll
    for (int it = 0; it < 40; ++it) { const int i = F.tid + 512 * it; const int r = i >> 12, k = i & 4095; const float v = (r == 0) ? cctx[k] : c[(r - 1) * 4096 + k]; SC[i] = v * sigm(v); }
    __syncthreads();
    const int kk = F.lane / 24, cg = F.lane % 24;
    for (int cb = blockIdx.x; cb < 256; cb += F.G) {
        f32x4 acc[5];
#pragma unroll
        for (int r = 0; r < 5; ++r) acc[r] = (f32x4){0.f, 0.f, 0.f, 0.f};
        if (F.lane < 48) {
            const float* wp = wmod + (size_t)(512 * F.wave + kk) * NMOD + 96 * cb + 4 * cg;
            const LAS float* sp = SC + 512 * F.wave + kk;
#pragma unroll 16
            for (int k2 = 0; k2 < 512; k2 += 2) {
                const f32x4 w = *(const f32x4*)(wp + (size_t)k2 * NMOD);
#pragma unroll
                for (int r = 0; r < 5; ++r) acc[r] += w * sp[r * 4096 + k2];
            }
#pragma unroll
            for (int r = 0; r < 5; ++r) *(LAS f32x4*)(RED + ((F.wave * 2 + kk) * 5 + r) * 96 + 4 * cg) = acc[r];
        }
        __syncthreads();
        if (F.tid < 480) { const int r = F.tid / 96, col = F.tid % 96; float s = bmod[96 * cb + col];
#pragma unroll
            for (int p = 0; p < 16; ++p) s += RED[(p * 5 + r) * 96 + col];
            MOD[(size_t)r * NMOD + 96 * cb + col] = s; }
        __syncthreads();
    }
}

__device__ __forceinline__ void tr_item(const float* W, int ldw, int k0, int kvalid, int srcn0, bf16* WT, int ldt, int drow0, int dk0, LAS float* scr, int lane) {
    const int c = lane & 7;
    if (srcn0 < 0) {
#pragma unroll
        for (int j = 0; j < 4; ++j) { const int n = (lane >> 3) + 8 * j; *(GAS v4u*)(WT + (size_t)(drow0 + n) * ldt + dk0 + 8 * c) = (v4u){0u, 0u, 0u, 0u}; }
        return;
    }
#pragma unroll 8
    for (int i = 0; i < 32; ++i) { const int kk = 2 * i + (lane >> 5); scr[kk * 33 + (lane & 31)] = (kk < kvalid) ? W[(size_t)(k0 + kk) * ldw + srcn0 + (lane & 31)] : 0.f; }
    LDS_WAIT(); asm volatile("" ::: "memory");
#pragma unroll
    for (int j = 0; j < 4; ++j) { const int n = (lane >> 3) + 8 * j; const LAS float* s = scr + (8 * c) * 33 + n;
        v4u o; o.x = pg8::cvt_pk_bf16(s[0 * 33], s[1 * 33]); o.y = pg8::cvt_pk_bf16(s[2 * 33], s[3 * 33]); o.z = pg8::cvt_pk_bf16(s[4 * 33], s[5 * 33]); o.w = pg8::cvt_pk_bf16(s[6 * 33], s[7 * 33]);
        *(GAS v4u*)(WT + (size_t)(drow0 + n) * ldt + dk0 + 8 * c) = o; }
    LDS_WAIT(); asm volatile("" ::: "memory");
}
__device__ __forceinline__ void tr_item_f8(const float* W, int ldw, int k0, int srcn0, unsigned char* WT, int ldt, int drow0, int dk0, float scale, LAS float* scr, int lane) {
    const int c = lane & 7;
#pragma unroll 8
    for (int i = 0; i < 32; ++i) { const int kk = 2 * i + (lane >> 5); scr[kk * 33 + (lane & 31)] = W[(size_t)(k0 + kk) * ldw + srcn0 + (lane & 31)]; }
    LDS_WAIT(); asm volatile("" ::: "memory");
#pragma unroll
    for (int j = 0; j < 4; ++j) { const int n = (lane >> 3) + 8 * j; const LAS float* s = scr + (8 * c) * 33 + n;
        unsigned w0 = 0u, w1 = 0u;
        w0 = __builtin_amdgcn_cvt_pk_fp8_f32(s[0 * 33] * scale, s[1 * 33] * scale, w0, false); w0 = __builtin_amdgcn_cvt_pk_fp8_f32(s[2 * 33] * scale, s[3 * 33] * scale, w0, true);
        w1 = __builtin_amdgcn_cvt_pk_fp8_f32(s[4 * 33] * scale, s[5 * 33] * scale, w1, false); w1 = __builtin_amdgcn_cvt_pk_fp8_f32(s[6 * 33] * scale, s[7 * 33] * scale, w1, true);
        v2u o; o.x = w0; o.y = w1; *(GAS v2u*)(WT + (size_t)(drow0 + n) * ldt + dk0 + 8 * c) = o; }
    LDS_WAIT(); asm volatile("" ::: "memory");
}
__device__ __forceinline__ int q8(float x) { const int q = (int)__builtin_rintf(x); return (q < -127 ? -127 : (q > 127 ? 127 : q)) & 0xff; }
__device__ __forceinline__ void tr_item_i8(const float* W, int ldw, int k0, int srcn0, unsigned char* WT, int ldt, int drow0, int dk0, const unsigned* cmax  , LAS float* scr, int lane) {
    const int c = lane & 7;
    if (srcn0 < 0) {
#pragma unroll
        for (int j = 0; j < 4; ++j) { const int n = (lane >> 3) + 8 * j; v2u o; o.x = 0u; o.y = 0u; *(GAS v2u*)(WT + (size_t)(drow0 + n) * ldt + dk0 + 8 * c) = o; }
        return;
    }
#pragma unroll 8
    for (int i = 0; i < 32; ++i) { const int kk = 2 * i + (lane >> 5); scr[kk * 33 + (lane & 31)] = W[(size_t)(k0 + kk) * ldw + srcn0 + (lane & 31)]; }
    LDS_WAIT(); asm volatile("" ::: "memory");
#pragma unroll
    for (int j = 0; j < 4; ++j) { const int n = (lane >> 3) + 8 * j; const LAS float* s = scr + (8 * c) * 33 + n;
        const float mx = __builtin_bit_cast(float, cmax[n]); const float sc = mx > 0.f ? 127.0f / mx : 0.f;
        v2u o; o.x = (unsigned)q8(s[0 * 33] * sc) | ((unsigned)q8(s[1 * 33] * sc) << 8) | ((unsigned)q8(s[2 * 33] * sc) << 16) | ((unsigned)q8(s[3 * 33] * sc) << 24);
        o.y = (unsigned)q8(s[4 * 33] * sc) | ((unsigned)q8(s[5 * 33] * sc) << 8) | ((unsigned)q8(s[6 * 33] * sc) << 16) | ((unsigned)q8(s[7 * 33] * sc) << 24);
        *(GAS v2u*)(WT + (size_t)(drow0 + n) * ldt + dk0 + 8 * c) = o; }
    LDS_WAIT(); asm volatile("" ::: "memory");
}
__device__ __forceinline__ void colmax_pass(Frame& F, const float* W, int ld, int col0, int nblk, unsigned* cmax, int K = 4096) {
    const int r8 = F.lane >> 3, c4 = F.lane & 7;
    for (int task = F.gw; task < 4 * nblk; task += F.ngw) { const int kp = task / nblk, nb = task % nblk;
        const int rp = K >> 2; const float* p = W + (size_t)(rp * kp + r8) * ld + col0 + 32 * nb + 4 * c4; f32x4 mx = (f32x4){0.f, 0.f, 0.f, 0.f};
#pragma unroll 8
        for (int i = 0; i < (rp >> 3); ++i) { const f32x4 v = *(const GAS f32x4*)(p + (size_t)(8 * i) * ld); mx = __builtin_elementwise_max(mx, __builtin_elementwise_abs(v)); }
#pragma unroll
        for (int o = 8; o < 64; o <<= 1) { mx.x = fmaxf(mx.x, __shfl_xor(mx.x, o)); mx.y = fmaxf(mx.y, __shfl_xor(mx.y, o)); mx.z = fmaxf(mx.z, __shfl_xor(mx.z, o)); mx.w = fmaxf(mx.w, __shfl_xor(mx.w, o)); }
        if (r8 == 0) { unsigned* q = cmax + 32 * nb + 4 * c4; const float m0 = mx.x, m1 = mx.y, m2 = mx.z, m3 = mx.w;     atomicMax(q, __builtin_bit_cast(unsigned, m0)); atomicMax(q + 1, __builtin_bit_cast(unsigned, m1)); atomicMax(q + 2, __builtin_bit_cast(unsigned, m2)); atomicMax(q + 3, __builtin_bit_cast(unsigned, m3)); }
    }
}
#ifndef SIDE_IN_SCAN
#define SIDE_IN_SCAN 1
#endif
__device__ __forceinline__ void colmax_task(int lane, const float* W, int ld, int col, int row0, int rows, unsigned* cmax) {
    const int r8 = lane >> 3, c4 = lane & 7; const float* p = W + (size_t)(row0 + r8) * ld + col + 4 * c4; f32x4 mx = (f32x4){0.f, 0.f, 0.f, 0.f};
#pragma unroll 8
    for (int i = 0; i < (rows >> 3); ++i) { const f32x4 v = *(const GAS f32x4*)(p + (size_t)(8 * i) * ld); mx = __builtin_elementwise_max(mx, __builtin_elementwise_abs(v)); }
#pragma unroll
    for (int o = 8; o < 64; o <<= 1) { mx.x = fmaxf(mx.x, __shfl_xor(mx.x, o)); mx.y = fmaxf(mx.y, __shfl_xor(mx.y, o)); mx.z = fmaxf(mx.z, __shfl_xor(mx.z, o)); mx.w = fmaxf(mx.w, __shfl_xor(mx.w, o)); }
    if (r8 == 0) { unsigned* q = cmax + 4 * c4; const float m0 = mx.x, m1 = mx.y, m2 = mx.z, m3 = mx.w;
        atomicMax(q, __builtin_bit_cast(unsigned, m0)); atomicMax(q + 1, __builtin_bit_cast(unsigned, m1)); atomicMax(q + 2, __builtin_bit_cast(unsigned, m2)); atomicMax(q + 3, __builtin_bit_cast(unsigned, m3)); }
}
__device__ __forceinline__ void p0_colmax(const Args& a, Frame& F) {
#if SIDE_IN_SCAN
    constexpr int T_R = 64 * 8, T_LG = 15 * 8, T_Q = 32 * 8, T_UQ = 96 * 4, T_UKV = 128 * 4, T_ALL = T_R + T_LG + T_Q + T_UQ + T_UKV;
    unsigned* CG = (unsigned*)(a.ws + WS_CMAXG);
    for (int t = F.gw; t < T_ALL; t += F.ngw) {
        int u = t;
        if (u < T_R) { const int nb = u % 64, kp = u / 64; colmax_task(F.lane, a.in[I_WIN], 16928, 32 * nb, 512 * kp, 512, CG + 8192 + 32 * nb); continue; }
        u -= T_R;
        if (u < T_LG) { const int nb = u % 15, kp = u / 15; colmax_task(F.lane, a.in[I_WIN], 16928, 6656 + 32 * nb, 512 * kp, 512, CG + 10240 + 32 * nb); continue; }
        u -= T_LG;
        if (u < T_Q) { const int nb = u % 32, kp = u / 32; colmax_task(F.lane, a.in[I_WIN], 16928, 7136 + 32 * nb, 512 * kp, 512, CG + 10752 + 32 * nb); continue; }
        u -= T_Q;
        if (u < T_UQ) { const int nb = u % 96, kp = u / 96; colmax_task(F.lane, a.in[I_WUQ], 3072, 32 * nb, 256 * kp, 256, (unsigned*)(a.ws + WS_CMAXUQ) + 32 * nb); continue; }
        u -= T_UQ;
        { const int nb = u % 128, kp = u / 128; colmax_task(F.lane, a.in[I_WUKV], 4096, 32 * nb, 128 * kp, 128, (unsigned*)(a.ws + WS_CMAXUKV) + 32 * nb); }
    }
#else
#if !SIDE_IN_SCAN
    colmax_pass(F, a.in[I_WFI], 2 * DFF, 0, 2 * DFF / 32, (unsigned*)(a.ws + WS_CMAX));
#endif
#if !SIDE_IN_SCAN
    colmax_pass(F, a.in[I_WIN], 16928, 8736, 256, (unsigned*)(a.ws + WS_CMAXG));
#endif
    colmax_pass(F, a.in[I_WIN], 16928, 0, 64, (unsigned*)(a.ws + WS_CMAXG) + 8192);
    colmax_pass(F, a.in[I_WIN], 16928, 6656, 15, (unsigned*)(a.ws + WS_CMAXG) + 10240);
    colmax_pass(F, a.in[I_WIN], 16928, 7136, 32, (unsigned*)(a.ws + WS_CMAXG) + 10752);
    colmax_pass(F, a.in[I_WUQ], 3072, 0, 96, (unsigned*)(a.ws + WS_CMAXUQ), QL);
    colmax_pass(F, a.in[I_WUKV], 4096, 0, 128, (unsigned*)(a.ws + WS_CMAXUKV), KVL);
#if !SIDE_IN_SCAN
    colmax_pass(F, a.in[I_WOUT], DM, 0, 128, (unsigned*)(a.ws + WS_CMAXO));
    colmax_pass(F, a.in[I_WOR], DM, 0, 128, (unsigned*)(a.ws + WS_CMAXR), DA);
#endif
#endif
}
__device__ __forceinline__ void p1_weights_i8(const Args& a, Frame& F) {
    LAS float* scr = (LAS float*)(F.lds + F.wave * 16384);
#if !SIDE_IN_SCAN
    constexpr int I_FI = (2 * DFF / 32) * 64;
    for (int r = F.gw; r < I_FI; r += F.ngw) { const int nblk = 2 * DFF / 32, kb = r / nblk, nb = r % nblk, n0 = 32 * nb, pn = n0 >> 8, j = n0 & 255; const int src = (j < 128) ? 128 * pn + j : DFF + 128 * pn + (j - 128);
        tr_item_i8(a.in[I_WFI], 2 * DFF, 64 * kb, src, (unsigned char*)(a.ws + WS_WFI), DM, n0, 64 * kb, (const unsigned*)(a.ws + WS_CMAX) + src, scr, F.lane); }
    for (int r = F.gw; r < 128 * 64; r += F.ngw) { const int kb = r >> 7, nb = r & 127;
        tr_item_i8(a.in[I_WOUT], DM, 64 * kb, 32 * nb, (unsigned char*)(a.ws + WS_WOUT), DM, 32 * nb, 64 * kb, (const unsigned*)(a.ws + WS_CMAXO) + 32 * nb, scr, F.lane); }
    for (int r = F.gw; r < 128 * 32; r += F.ngw) { const int kb = r >> 7, nb = r & 127;
        tr_item_i8(a.in[I_WOR], DM, 64 * kb, 32 * nb, (unsigned char*)(a.ws + WS_WOR), DA, 32 * nb, 64 * kb, (const unsigned*)(a.ws + WS_CMAXR) + 32 * nb, scr, F.lane); }
#endif
    constexpr int NB0 = SIDE_IN_SCAN ? 256 : 0, NBN = 368 - NB0;
    for (int r = F.gw; r < NBN * 64; r += F.ngw) { const int kb = r / NBN, nb = NB0 + r % NBN;
        const int src = nb < 256 ? 8736 + 32 * nb : (nb < 320 ? 32 * (nb - 256) : (nb < 336 ? (nb < 335 ? 6656 + 32 * (nb - 320) : -1) : 7136 + 32 * (nb - 336)));
        tr_item_i8(a.in[I_WIN], 16928, 64 * kb, src, (unsigned char*)(a.ws + WS_WING8), DM, 32 * nb, 64 * kb, (const unsigned*)(a.ws + WS_CMAXG) + 32 * nb, scr, F.lane); }
    for (int r = F.gw; r < 96 * 16; r += F.ngw) { const int kb = r / 96, nb = r % 96;
        tr_item_i8(a.in[I_WUQ], 3072, 64 * kb, 32 * nb, (unsigned char*)(a.ws + WS_WUQ), QL, 32 * nb, 64 * kb, (const unsigned*)(a.ws + WS_CMAXUQ) + 32 * nb, scr, F.lane); }
    for (int r = F.gw; r < 128 * 8; r += F.ngw) { const int kb = r >> 7, nb = r & 127;
        tr_item_i8(a.in[I_WUKV], 4096, 64 * kb, 32 * nb, (unsigned char*)(a.ws + WS_WUKV), KVL, 32 * nb, 64 * kb, (const unsigned*)(a.ws + WS_CMAXUKV) + 32 * nb, scr, F.lane); }
}
constexpr int NIN16 = 5376;
__device__ __forceinline__ int map_in(int n0) {
    if (n0 < 4608) return 2048 + n0;
    if (n0 < 5120) return 8160 + (n0 - 4608);
    if (n0 < 5184) return 8672 + (n0 - 5120);
    return -1;
}
__device__ __forceinline__ void p0_weights(const Args& a, Frame& F) {
    LAS float* scr = (LAS float*)(F.lds + F.wave * 16384);
    constexpr int I_IN = (NIN16 / 32) * 64, I_FO = SIDE_IN_SCAN ? 0 : (DM / 32) * (DFF / 64), I_OM = SIDE_IN_SCAN ? 0 : 128 * 32, I_UQ = 0, I_UKV = 0  , I_LORA = 256 * 4, I_G = 64 * 8;
    constexpr int NITEMS = I_IN + I_FO + I_OM + I_UQ + I_UKV + I_LORA + I_G;
    unsigned char* ws = a.ws;
    for (int it = F.gw; it < NITEMS; it += F.ngw) {
        int r = it;
        if (r < I_IN) { const int nblk = NIN16 / 32, kb = r / nblk, nb = r % nblk; tr_item(a.in[I_WIN], 16928, 64 * kb, 64, map_in(32 * nb), (bf16*)(ws + WS_WIN), DM, 32 * nb, 64 * kb, scr, F.lane); continue; } r -= I_IN;
        if (r < I_FO) { const int nblk = DM / 32, kb = r / nblk, nb = r % nblk; tr_item_f8(a.in[I_WFO], DM, 64 * kb, 32 * nb, (unsigned char*)(ws + WS_WFO), DFF, 32 * nb, 64 * kb, 128.0f, scr, F.lane); continue; } r -= I_FO;
        if (r < I_OM) { const int nblk = 128, kb = r / nblk, nb = r % nblk; tr_item(a.in[I_WOM], DM, 64 * kb, 64, 32 * nb, (bf16*)(ws + WS_WOM), DA, 32 * nb, 64 * kb, scr, F.lane); continue; } r -= I_OM;
        if (r < I_UQ) { const int nblk = 96, kb = r / nblk, nb = r % nblk; tr_item(a.in[I_WUQ], 3072, 64 * kb, 64, 32 * nb, (bf16*)(ws + WS_WUQ), QL, 32 * nb, 64 * kb, scr, F.lane); continue; } r -= I_UQ;
        if (r < I_UKV) { const int nblk = 128, kb = r / nblk, nb = r % nblk; tr_item(a.in[I_WUKV], 4096, 64 * kb, 64, 32 * nb, (bf16*)(ws + WS_WUKV), KVL, 32 * nb, 64 * kb, scr, F.lane); continue; } r -= I_UKV;
        if (r < I_LORA) {
            const int nblk = 256, kb = r / nblk, nb = r % nblk, n0 = 32 * nb, dir = n0 >> 12, j = n0 & 4095; const bool isw = j < 2048; const bool live = isw ? (kb < 2) : (kb >= 2);
            const float* src = (isw ? a.in[I_WLB] : a.in[I_ALB]) + (size_t)dir * 128 * DA;
            tr_item(src, DA, 64 * (kb & 1), 64, live ? (isw ? j : j - 2048) : -1, (bf16*)(ws + WS_WLORA), 256, n0, 64 * kb, scr, F.lane); continue; } r -= I_LORA;
        { const int nblk = 64, kb = r / nblk, nb = r % nblk; const int kv = 480 - 64 * kb; tr_item(a.in[I_GLB], DA, 64 * kb, kv < 0 ? 0 : kv, 32 * nb, (bf16*)(ws + WS_WG), 512, 32 * nb, 64 * kb, scr, F.lane); }
    }
}

__device__ __forceinline__ void sincos_small(double x, double& s, double& c) {
    const double n = __builtin_rint(x * 0.63661977236758134308);
    double r = __builtin_fma(-n, 1.57079632679489655800e+00, x); r = __builtin_fma(-n, 6.12323399573676603587e-17, r);
    const double r2 = r * r;
    double sp = -7.6471637318198164759e-13; sp = sp * r2 + 1.6059043836821614599e-10; sp = sp * r2 - 2.5052108385441718775e-08; sp = sp * r2 + 2.7557319223985890653e-06;
    sp = sp * r2 - 1.9841269841269841270e-04; sp = sp * r2 + 8.3333333333333333333e-03; sp = sp * r2 - 1.6666666666666666667e-01; const double sr = r + r * r2 * sp;
    double cp = 4.7794773323873852974e-14; cp = cp * r2 - 1.1470745597729724714e-11; cp = cp * r2 + 2.0876756987868098979e-09; cp = cp * r2 - 2.7557319223985890653e-07;
    cp = cp * r2 + 2.4801587301587301587e-05; cp = cp * r2 - 1.3888888888888888889e-03; cp = cp * r2 + 4.1666666666666666667e-02; cp = cp * r2 - 0.5; const double cr = 1.0 + r2 * cp;
    const int q = ((int)n) & 3;
    s = (q == 0) ? sr : (q == 1) ? cr : (q == 2) ? -sr : -cr;
    c = (q == 0) ? cr : (q == 1) ? -sr : (q == 2) ? -cr : sr;
}
__device__ __forceinline__ double rope_inv(int j) {
    switch (j) { case 0: return 1.0; case 1: return 0.56234132519034908; case 2: return 0.31622776601683794; case 3: return 0.17782794100389229; case 4: return 0.1; case 5: return 0.056234132519034911;
        case 6: return 0.031622776601683791; case 7: return 0.017782794100389229; case 8: return 0.01; case 9: return 0.0056234132519034910; case 10: return 0.0031622776601683794; case 11: return 0.0017782794100389228;
        case 12: return 0.001; case 13: return 0.00056234132519034910; case 14: return 0.00031622776601683794; default: return 0.00017782794100389228; }
}
__device__ __forceinline__ void p0_rope(const Args& a, Frame& F) {
    float* COS = (float*)(a.ws + WS_COS); float* SIN = (float*)(a.ws + WS_SIN); float* LB = (float*)(a.ws + WS_LBIAS);
    for (int i = blockIdx.x * 512 + F.tid; i < 8192; i += F.G * 512) LB[i] = (i < 4096) ? a.in[I_W0][i] : a.in[I_A0][i - 4096];
    for (int i = blockIdx.x * 512 + F.tid; i < 1024 * 32; i += F.G * 512) { const int t = i >> 5, f = i & 31;
        const double pos = (f < 16) ? (double)(t >> 6) : (double)(t & 63); const double ang = pos * rope_inv(f & 15);
        double s, c; sincos_small(ang, s, c); COS[i] = (float)c; SIN[i] = (float)s; }
}

__device__ __forceinline__ void modnorm_rows(Frame& F, const float* x0, const float* x1, const float* nw, const float* MOD, int shift_slot, bf16* H) {
    for (int row = F.gw; row < T; row += F.ngw) {
        const float* xr = row < T_P ? x0 + (size_t)row * DM : x1 + (size_t)(row - T_P) * DM;
        const float* md = MOD + (size_t)mod_index(row) * NMOD + shift_slot * DM;
        f32x4 v[16]; float ss = 0.f;
#pragma unroll
        for (int j = 0; j < 16; ++j) { v[j] = *((const GAS f32x4*)xr + F.lane + 64 * j); ss += (v[j].x * v[j].x + v[j].y * v[j].y) + (v[j].z * v[j].z + v[j].w * v[j].w); }
        const float rstd = 1.0f / sqrtf(wave_sum(ss) * (1.0f / DM) + NORM_EPS);
#pragma unroll
        for (int j = 0; j < 16; ++j) { const int col = 4 * (F.lane + 64 * j);
            const f32x4 w = *(const f32x4*)(nw + col), sh = *(const f32x4*)(md + col), sc = *(const f32x4*)(md + DM + col);
            const f32x4 o = v[j] * rstd * w * (sc + 1.0f) + sh;
            v2u p; p.x = pg8::cvt_pk_bf16(o.x, o.y); p.y = pg8::cvt_pk_bf16(o.z, o.w); *(GAS v2u*)(H + (size_t)row * DM + col) = p; }
    }
}

__device__ __forceinline__ void modnorm_rows_dual(Frame& F, const float* x0, const float* x1, const float* nw, const float* MOD, int shift_slot, bf16* H, unsigned char* HQ, float* ROWS) {
    for (int row = F.gw; row < T; row += F.ngw) {
        const float* xr = row < T_P ? x0 + (size_t)row * DM : x1 + (size_t)(row - T_P) * DM;
        const float* md = MOD + (size_t)mod_index(row) * NMOD + shift_slot * DM;
        f32x4 v[16]; float ss = 0.f;
#pragma unroll
        for (int j = 0; j < 16; ++j) { v[j] = *((const GAS f32x4*)xr + F.lane + 64 * j); ss += (v[j].x * v[j].x + v[j].y * v[j].y) + (v[j].z * v[j].z + v[j].w * v[j].w); }
        const float rstd = 1.0f / sqrtf(wave_sum(ss) * (1.0f / DM) + NORM_EPS); float mx = 0.f;
#pragma unroll
        for (int jh = 0; jh < 16; jh += 4) {
#pragma unroll
            for (int j = jh; j < jh + 4; ++j) { const int col = 4 * (F.lane + 64 * j);
                const f32x4 w = *(const f32x4*)(nw + col), sh = *(const f32x4*)(md + col), sc = *(const f32x4*)(md + DM + col);
                v[j] = v[j] * rstd * w * (sc + 1.0f) + sh; mx = fmaxf(mx, fmaxf(fmaxf(fabsf(v[j].x), fabsf(v[j].y)), fmaxf(fabsf(v[j].z), fabsf(v[j].w)))); }
#pragma unroll
            for (int j = jh; j < jh + 4; ++j) { const int col = 4 * (F.lane + 64 * j);
                v2u p; p.x = pg8::cvt_pk_bf16(v[j].x, v[j].y); p.y = pg8::cvt_pk_bf16(v[j].z, v[j].w); *(GAS v2u*)(H + (size_t)row * DM + col) = p; }
        }
#pragma unroll
        for (int o = 1; o < 64; o <<= 1) mx = fmaxf(mx, __shfl_xor(mx, o));
        const float qs = mx > 0.f ? 127.0f / mx : 0.f;
        if (F.lane == 0) ROWS[row] = mx * (1.0f / 127.0f);
#pragma unroll
        for (int j = 0; j < 16; ++j) { const int col = 4 * (F.lane + 64 * j);
            *(GAS unsigned*)(HQ + (size_t)row * DM + col) = (unsigned)q8(v[j].x * qs) | ((unsigned)q8(v[j].y * qs) << 8) | ((unsigned)q8(v[j].z * qs) << 16) | ((unsigned)q8(v[j].w * qs) << 24); }
    }
}

__device__ __forceinline__ void modnorm_rows_i8(Frame& F, const bf16* X1, const float* nw, const float* MOD, int shift_slot, unsigned char* H, float* ROWS) {
    for (int row = F.gw; row < T; row += F.ngw) {
        const bf16* xr = X1 + (size_t)row * DM;
        const float* md = MOD + (size_t)mod_index(row) * NMOD + shift_slot * DM;
        f32x4 v[16]; float ss = 0.f;
#pragma unroll
        for (int j = 0; j < 16; ++j) { const v2u t = *((const GAS v2u*)xr + F.lane + 64 * j); v[j] = (f32x4){pg8::bflo(t.x), pg8::bfhi(t.x), pg8::bflo(t.y), pg8::bfhi(t.y)}; ss += (v[j].x * v[j].x + v[j].y * v[j].y) + (v[j].z * v[j].z + v[j].w * v[j].w); }
        const float rstd = 1.0f / sqrtf(wave_sum(ss) * (1.0f / DM) + NORM_EPS); float mx = 0.f;
#pragma unroll
        for (int j = 0; j < 16; ++j) { const int col = 4 * (F.lane + 64 * j);
            const f32x4 w = *(const f32x4*)(nw + col), sh = *(const f32x4*)(md + col), sc = *(const f32x4*)(md + DM + col);
            v[j] = v[j] * rstd * w * (sc + 1.0f) + sh; mx = fmaxf(mx, fmaxf(fmaxf(fabsf(v[j].x), fabsf(v[j].y)), fmaxf(fabsf(v[j].z), fabsf(v[j].w)))); }
#pragma unroll
        for (int o = 1; o < 64; o <<= 1) mx = fmaxf(mx, __shfl_xor(mx, o));
        const float qs = mx > 0.f ? 127.0f / mx : 0.f;
        if (F.lane == 0) ROWS[row] = mx * (1.0f / 127.0f);
#pragma unroll
        for (int j = 0; j < 16; ++j) { const int col = 4 * (F.lane + 64 * j);
            *(GAS unsigned*)(H + (size_t)row * DM + col) = (unsigned)q8(v[j].x * qs) | ((unsigned)q8(v[j].y * qs) << 8) | ((unsigned)q8(v[j].z * qs) << 16) | ((unsigned)q8(v[j].w * qs) << 24); }
    }
}

__device__ __forceinline__ void p8c_quant_mixed(const Args& a, Frame& F) {
    const bf16* MX = (const bf16*)(a.ws + WS_MIXED); unsigned char* Q = (unsigned char*)(a.ws + WS_MIX8); const unsigned* rmax = (const unsigned*)(a.ws + WS_RMAXM); float* ROWS = (float*)(a.ws + WS_ROWSM);
    for (int row = F.gw; row < T; row += F.ngw) { const float mx = __builtin_bit_cast(float, rmax[row]); const float qs = mx > 0.f ? 127.0f / mx : 0.f;
        if (F.lane == 0) ROWS[row] = mx * (1.0f / 127.0f);
        v4u wv[8];
#pragma unroll
        for (int j = 0; j < 8; ++j) wv[j] = *(const GAS v4u*)(MX + (size_t)row * DM + 8 * (F.lane + 64 * j));
#pragma unroll
        for (int j = 0; j < 8; ++j) { const int col = 8 * (F.lane + 64 * j); const v4u w = wv[j];
            v2u o; o.x = (unsigned)q8(pg8::bflo(w.x) * qs) | ((unsigned)q8(pg8::bfhi(w.x) * qs) << 8) | ((unsigned)q8(pg8::bflo(w.y) * qs) << 16) | ((unsigned)q8(pg8::bfhi(w.y) * qs) << 24);
            o.y = (unsigned)q8(pg8::bflo(w.z) * qs) | ((unsigned)q8(pg8::bfhi(w.z) * qs) << 8) | ((unsigned)q8(pg8::bflo(w.w) * qs) << 16) | ((unsigned)q8(pg8::bfhi(w.w) * qs) << 24);
            *(GAS v2u*)(Q + (size_t)row * DM + col) = o; } }
}

__device__ __forceinline__ int kv_row_of_token(int row) { return row < T_P ? row : T_P + ((row - T_P) >> 10) * 1536 + 512 + ((row - T_P) & 1023); }
__device__ __forceinline__ float h2f_(unsigned u) { return (float)__builtin_bit_cast(_Float16, (unsigned short)u); }
__device__ __forceinline__ unsigned q8x4(f32x4 o, float qs) { return (unsigned)q8(o.x * qs) | ((unsigned)q8(o.y * qs) << 8) | ((unsigned)q8(o.z * qs) << 16) | ((unsigned)q8(o.w * qs) << 24); }
__device__ __forceinline__ float absmax4(f32x4 o) { return fmaxf(fmaxf(fabsf(o.x), fabsf(o.y)), fmaxf(fabsf(o.z), fabsf(o.w))); }
__device__ __forceinline__ float wave_max(float v) {
#pragma unroll
    for (int o = 1; o < 64; o <<= 1) v = fmaxf(v, __shfl_xor(v, o));
    return v;
}
__device__ __forceinline__ float wave_sum_d(float x) { x = row16_sum(x); const int xi = __builtin_bit_cast(int, x);
    return (__builtin_bit_cast(float, __builtin_amdgcn_readlane(xi, 0)) + __builtin_bit_cast(float, __builtin_amdgcn_readlane(xi, 16))) + (__builtin_bit_cast(float, __builtin_amdgcn_readlane(xi, 32)) + __builtin_bit_cast(float, __builtin_amdgcn_readlane(xi, 48))); }
__device__ __forceinline__ float wave_max_d(float x) {
    x = fmaxf(x, dpp_f(x, 0)); x = fmaxf(x, dpp_f(x, 1)); x = fmaxf(x, dpp_f(x, 2)); x = fmaxf(x, dpp_f(x, 3)); const int xi = __builtin_bit_cast(int, x);
    return fmaxf(fmaxf(__builtin_bit_cast(float, __builtin_amdgcn_readlane(xi, 0)), __builtin_bit_cast(float, __builtin_amdgcn_readlane(xi, 16))), fmaxf(__builtin_bit_cast(float, __builtin_amdgcn_readlane(xi, 32)), __builtin_bit_cast(float, __builtin_amdgcn_readlane(xi, 48)))); }
__device__ __forceinline__ void p3_post(const Args& a, Frame& F) {
    const float* QLAT = (const float*)(a.ws + WS_QLAT); const float* KVLAT = (const float*)(a.ws + WS_KVLAT); const float* KPE = (const float*)(a.ws + WS_KPE);
    unsigned char* QN = (unsigned char*)(a.ws + WS_QN); unsigned char* CKVA = (unsigned char*)(a.ws + WS_CKVA); float* ROWSQ = (float*)(a.ws + WS_ROWSQ); float* ROWSKV = (float*)(a.ws + WS_ROWSKV);
    const float* qnw = a.in[I_QNW]; const float* kvnw = a.in[I_KVNW];
    constexpr int NT3 = T + 2048;
    f32x4 wq[4], wk[2];
#pragma unroll
    for (int j = 0; j < 4; ++j) wq[j] = *(const f32x4*)(qnw + 4 * (F.lane + 64 * j));
#pragma unroll
    for (int j = 0; j < 2; ++j) wk[j] = *(const f32x4*)(kvnw + 4 * (F.lane + 64 * j));
    v2u ntq[4]; f32x4 nvk[2]; float nkpe = 0.f;
#pragma unroll
    for (int j = 0; j < 4; ++j) ntq[j] = (v2u){0u, 0u};
#define P3_ISSUE(task_) do { const int tk_ = (task_); \
        if (tk_ < T) { \
            _Pragma("unroll") for (int j = 0; j < 4; ++j) ntq[j] = *((const GAS v2u*)((const unsigned short*)QLAT + (size_t)tk_ * QL) + F.lane + 64 * j);     \
            _Pragma("unroll") for (int j = 0; j < 2; ++j) nvk[j] = *((const GAS f32x4*)(KVLAT + (size_t)tk_ * KVL) + F.lane + 64 * j); \
            nkpe = (tk_ < T_P) ? KPE[(size_t)tk_ * 64 + F.lane] : 0.f; \
        } else { const float* src_ = a.in[I_CCKV] + (size_t)(tk_ - T) * KVL; \
            _Pragma("unroll") for (int j = 0; j < 2; ++j) nvk[j] = *(const GAS f32x4*)(src_ + 4 * (F.lane + 64 * j)); } } while (0)
    if (F.gw < NT3) P3_ISSUE(F.gw);
    for (int task = F.gw; task < NT3; task += F.ngw) {
        v2u tq[4]; f32x4 vk[2]; const float kpev = nkpe;
#pragma unroll
        for (int j = 0; j < 4; ++j) tq[j] = ntq[j];
#pragma unroll
        for (int j = 0; j < 2; ++j) vk[j] = nvk[j];
        if (task + F.ngw < NT3) P3_ISSUE(task + F.ngw);
        if (task < T) { const int row = task;
            f32x4 v[4]; float ss = 0.f;
#pragma unroll
            for (int j = 0; j < 4; ++j) { v[j] = (f32x4){h2f_(tq[j].x & 0xffff), h2f_(tq[j].x >> 16), h2f_(tq[j].y & 0xffff), h2f_(tq[j].y >> 16)}; ss += (v[j].x * v[j].x + v[j].y * v[j].y) + (v[j].z * v[j].z + v[j].w * v[j].w); }
            const float rstd = 1.0f / sqrtf(wave_sum_d(ss) * (1.0f / QL) + NORM_EPS); float mx = 0.f;
#pragma unroll
            for (int j = 0; j < 4; ++j) { v[j] = v[j] * rstd * wq[j]; mx = fmaxf(mx, absmax4(v[j])); }
            mx = wave_max_d(mx); const float qs = mx > 0.f ? 127.0f / mx : 0.f;
            float ss2 = 0.f;
#pragma unroll
            for (int j = 0; j < 2; ++j) ss2 += (vk[j].x * vk[j].x + vk[j].y * vk[j].y) + (vk[j].z * vk[j].z + vk[j].w * vk[j].w);
            const float rstd2 = 1.0f / sqrtf(wave_sum_d(ss2) * (1.0f / KVL) + NORM_EPS); const int kr = kv_row_of_token(row); float mx2 = 0.f;
#pragma unroll
            for (int j = 0; j < 2; ++j) { vk[j] = vk[j] * rstd2 * wk[j]; mx2 = fmaxf(mx2, absmax4(vk[j])); }
            mx2 = wave_max_d(mx2); const float qs2 = mx2 > 0.f ? 127.0f / mx2 : 0.f;
            if (F.lane == 0) { ROWSQ[row] = mx * (1.0f / 127.0f); ROWSKV[kr] = mx2 * (1.0f / 127.0f); }
#pragma unroll
            for (int j = 0; j < 4; ++j) *(GAS unsigned*)(QN + (size_t)row * QL + 4 * (F.lane + 64 * j)) = q8x4(v[j], qs);
#pragma unroll
            for (int j = 0; j < 2; ++j) { const int col = 4 * (F.lane + 64 * j); *(GAS unsigned*)(CKVA + (size_t)kr * KVL + col) = q8x4(vk[j], qs2);
                if (row < T_P) *(GAS f32x4*)(a.out + OUT_CKV + (size_t)row * KVL + col) = vk[j]; }
            if (row < T_P) a.out[OUT_KPE + (size_t)row * 64 + F.lane] = kpev;
        } else { const int idx = task - T, b = idx >> 9, p = idx & 511; const int kr = T_P + b * 1536 + p;
            float mx = fmaxf(absmax4(vk[0]), absmax4(vk[1]));
            mx = wave_max_d(mx); const float qs = mx > 0.f ? 127.0f / mx : 0.f; if (F.lane == 0) ROWSKV[kr] = mx * (1.0f / 127.0f);
#pragma unroll
            for (int j = 0; j < 2; ++j) { const int col = 4 * (F.lane + 64 * j); *(GAS unsigned*)(CKVA + (size_t)kr * KVL + col) = q8x4(vk[j], qs); }
        }
    }
#undef P3_ISSUE
}
struct SidePair { int kind, first, last, cs; const float* src; unsigned char* dst; unsigned* cm; unsigned ld, ldt; };
constexpr int SIDE_PART_OFF = 98304;
static_assert(SIDE_PART_OFF + 1024 <= RING_BYTES, "side-work LDS");
__device__ __forceinline__ void side_pair_next(const Args& a, int b, int w, int p, SidePair& d) {
    const int s8p = b < 96 ? 80 : 72;
    if (p < s8p) {
        const int win = p >> 4, within = p & 15; const bool half = (win == 4 && b >= 48);
        const int wi = half ? (within & 7) : within, nsubp = half ? 4 : 8;
        if (wi != 0 && wi != nsubp) { const int subp = wi >= nsubp ? wi - nsubp : wi; d.src += (size_t)64 * d.ld; d.dst += 64; d.first = 0; d.last = subp == nsubp - 1; return; }
        int K, srcc;
        if (!half) { const int idx = b + 256 * win; K = DM;
            if (idx < 688) { const int n0 = 32 * idx, pn = n0 >> 8, j = n0 & 255; srcc = (j < 128) ? 128 * pn + j : DFF + 128 * pn + (j - 128);
                d.src = a.in[I_WFI]; d.ld = 2 * DFF; d.dst = a.ws + WS_WFI + (size_t)n0 * DM; d.cm = (unsigned*)(a.ws + WS_CMAX) + srcc; }
            else if (idx < 944) { const int nb = idx - 688; srcc = 8736 + 32 * nb; d.src = a.in[I_WIN]; d.ld = 16928; d.dst = a.ws + WS_WGATE8 + (size_t)(32 * nb) * DM; d.cm = (unsigned*)(a.ws + WS_CMAXG) + 32 * nb; }
            else { const int nb = idx - 944; srcc = 32 * nb; d.src = a.in[I_WOUT]; d.ld = DM; d.dst = a.ws + WS_WOUT + (size_t)(32 * nb) * DM; d.cm = (unsigned*)(a.ws + WS_CMAXO) + 32 * nb; }
        } else { K = DA; d.ld = DM;
            if ((within >> 3) == 0 && b < 176) { const int nb = b - 48; srcc = 32 * nb; d.src = a.in[I_WOR]; d.dst = a.ws + WS_WOR + (size_t)(32 * nb) * DA; d.cm = (unsigned*)(a.ws + WS_CMAXR) + 32 * nb; }
            else { const int nb = b >= 176 ? b - 176 : 80 + (b - 48); srcc = 32 * nb; d.src = a.in[I_WOM]; d.dst = a.ws + WS_WOM + (size_t)(32 * nb) * DA; d.cm = (unsigned*)(a.ws + WS_CMAXM) + 32 * nb; } }
        const int pass = wi >= nsubp ? 1 : 0, k0 = w * (K >> 3);
        d.kind = 1 + pass; d.first = 1; d.last = 0; d.ldt = (unsigned)K; d.cs = 3;
        d.src += (size_t)k0 * d.ld + srcc; d.dst += k0;
        return;
    }
    const int f = b + 256 * (p - s8p);
    d.first = 0; d.last = 0; d.ld = DM; d.cs = 4;
    if (f < 2752) { const int nbp = f & 63, k0 = 256 * (f >> 6) + 32 * w; d.kind = 3; d.src = a.in[I_WFO] + (size_t)k0 * DM + 64 * nbp; d.dst = a.ws + WS_WFO + (size_t)(64 * nbp) * DFF + k0; d.ldt = DFF; }
    else { d.kind = 0; d.src = a.in[I_WFI]; d.ld = 0; d.cs = 3; }
}
__device__ __forceinline__ const char* side_issue_addr(const SidePair& d, int lane) {
    const int g = lane >> d.cs, cg = lane & ((1 << d.cs) - 1);
    const unsigned loff = ((unsigned)(8 * g) * d.ld + (unsigned)(4 * cg)) * 4u;
    return (const char*)d.src + loff;
}
__device__ __forceinline__ f32x4 side_issue_one(const char* pa, unsigned ld, int j) { return *(const GAS f32x4*)(pa + (size_t)j * ld * 4u); }
__device__ __forceinline__ unsigned side_pack4(float a, float b, float c, float e, float sc) {
    const unsigned q0 = __builtin_bit_cast(unsigned, __builtin_fmaf(a, sc, 12582912.0f)), q1 = __builtin_bit_cast(unsigned, __builtin_fmaf(b, sc, 12582912.0f));
    const unsigned q2 = __builtin_bit_cast(unsigned, __builtin_fmaf(c, sc, 12582912.0f)), q3 = __builtin_bit_cast(unsigned, __builtin_fmaf(e, sc, 12582912.0f));
    return __builtin_amdgcn_perm(q1, q0, 0x0c0c0400u) | __builtin_amdgcn_perm(q3, q2, 0x04000c0cu);
}
#define SIDE_COL(c_, j_) (c_ == 0 ? R[j_].x : c_ == 1 ? R[j_].y : c_ == 2 ? R[j_].z : R[j_].w)
__device__ __forceinline__ void side_consume(const SidePair& d, int lane, int w, const f32x4 (&R)[8], float (&mx)[4], float (&sc)[4], LAS float* PART) {
    if (d.kind == 0) return;
    const int g = lane >> d.cs, cg = lane & ((1 << d.cs) - 1);
    if (d.kind == 1) {
        f32x4 m = d.first ? (f32x4){0.f, 0.f, 0.f, 0.f} : (f32x4){mx[0], mx[1], mx[2], mx[3]};
#pragma unroll
        for (int j = 0; j < 8; ++j) m = __builtin_elementwise_max(m, __builtin_elementwise_abs(R[j]));
        if (d.last) {
#pragma unroll
            for (int o = 8; o < 64; o <<= 1) { m.x = fmaxf(m.x, __shfl_xor(m.x, o)); m.y = fmaxf(m.y, __shfl_xor(m.y, o)); m.z = fmaxf(m.z, __shfl_xor(m.z, o)); m.w = fmaxf(m.w, __shfl_xor(m.w, o)); }
            if (lane < 8) *(LAS f32x4*)(PART + w * 32 + 4 * lane) = m;
        }
        mx[0] = m.x; mx[1] = m.y; mx[2] = m.z; mx[3] = m.w;
        return;
    }
    if (d.kind == 2) {
        if (d.first) { f32x4 m = *(const LAS f32x4*)(PART + 4 * cg);
#pragma unroll
            for (int r = 1; r < 8; ++r) m = __builtin_elementwise_max(m, *(const LAS f32x4*)(PART + r * 32 + 4 * cg));
            sc[0] = m.x > 0.f ? 127.0f / m.x : 0.f; sc[1] = m.y > 0.f ? 127.0f / m.y : 0.f; sc[2] = m.z > 0.f ? 127.0f / m.z : 0.f; sc[3] = m.w > 0.f ? 127.0f / m.w : 0.f;
            if (w == 0 && g == 0) { const float m0 = m.x, m1 = m.y, m2 = m.z, m3 = m.w; v4u o; o.x = __builtin_bit_cast(unsigned, m0); o.y = __builtin_bit_cast(unsigned, m1); o.z = __builtin_bit_cast(unsigned, m2); o.w = __builtin_bit_cast(unsigned, m3);
                *(GAS v4u*)(d.cm + 4 * cg) = o; } }
        unsigned char* q = d.dst + (size_t)(4 * cg) * d.ldt + 8 * g;
#pragma unroll
        for (int c = 0; c < 4; ++c) { v2u o; o.x = side_pack4(SIDE_COL(c, 0), SIDE_COL(c, 1), SIDE_COL(c, 2), SIDE_COL(c, 3), sc[c]); o.y = side_pack4(SIDE_COL(c, 4), SIDE_COL(c, 5), SIDE_COL(c, 6), SIDE_COL(c, 7), sc[c]);
            *(GAS v2u*)(q + (size_t)c * d.ldt) = o; }
        return;
    }
    if (d.kind == 3) {
        unsigned char* q = d.dst + (size_t)(4 * cg) * d.ldt + 8 * g;
#pragma unroll
        for (int c = 0; c < 4; ++c) { unsigned t0 = 0u, t1 = 0u;
            t0 = __builtin_amdgcn_cvt_pk_fp8_f32(SIDE_COL(c, 0) * 128.0f, SIDE_COL(c, 1) * 128.0f, t0, false); t0 = __builtin_amdgcn_cvt_pk_fp8_f32(SIDE_COL(c, 2) * 128.0f, SIDE_COL(c, 3) * 128.0f, t0, true);
            t1 = __builtin_amdgcn_cvt_pk_fp8_f32(SIDE_COL(c, 4) * 128.0f, SIDE_COL(c, 5) * 128.0f, t1, false); t1 = __builtin_amdgcn_cvt_pk_fp8_f32(SIDE_COL(c, 6) * 128.0f, SIDE_COL(c, 7) * 128.0f, t1, true);
            v2u o; o.x = t0; o.y = t1; *(GAS v2u*)(q + (size_t)c * d.ldt) = o; }
        return;
    }
    {
        unsigned char* q = d.dst + ((size_t)(4 * cg) * d.ldt + 8 * g) * 2;
#pragma unroll
        for (int c = 0; c < 4; ++c) { v4u o; o.x = pg8::cvt_pk_bf16(SIDE_COL(c, 0), SIDE_COL(c, 1)); o.y = pg8::cvt_pk_bf16(SIDE_COL(c, 2), SIDE_COL(c, 3)); o.z = pg8::cvt_pk_bf16(SIDE_COL(c, 4), SIDE_COL(c, 5)); o.w = pg8::cvt_pk_bf16(SIDE_COL(c, 6), SIDE_COL(c, 7));
            *(GAS v4u*)(q + (size_t)c * d.ldt * 2) = o; }
    }
}
constexpr int SC_TS = 16, SC_NCH = 96, SC_BUF_FLOATS = SC_TS * 6 * 64;
struct ScanChain { int row0, L, h, dir, b, is_sample; };
__device__ __forceinline__ ScanChain scan_chain(int gid, int idx) {
    ScanChain c; int code;
    if (gid < 256) { if (idx == 0) { code = gid; c.is_sample = 1; } else { code = 2 * gid + (idx - 1); c.is_sample = 0; } }
    else { code = 512 + 6 * (gid - 256) + idx; c.is_sample = 0; }
    c.b = code >> 6; c.h = (code >> 1) & 31; c.dir = code & 1;
    if (c.is_sample) { c.row0 = T_P + c.b * 1024; c.L = 1024; } else { c.row0 = c.b * 256; c.L = 256; }
    return c;
}
__device__ __forceinline__ void scan_locate(int gid, int ci, int& idx, int& chunk) {
    if (gid < 256) { if (ci < 64) { idx = 0; chunk = ci; } else { idx = 1 + ((ci - 64) >> 4); chunk = (ci - 64) & 15; } }
    else { idx = ci >> 4; chunk = ci & 15; }
}
struct ScanPref { unsigned short r[4], k[4], v[4], e[4], a[4]; float kk, ka, rk; };
__device__ __forceinline__ float h2f(unsigned short u) { return (float)__builtin_bit_cast(_Float16, u); }

__device__ __forceinline__ float fmul_s(float a, float b) { float r; asm("v_mul_f32_e32 %0, %1, %2" : "=v"(r) : "v"(a), "v"(b)); return r; }
__device__ __forceinline__ float ffma_s(float a, float b, float c) { float r; asm("v_fma_f32 %0, %1, %2, %3" : "=v"(r) : "v"(a), "v"(b), "v"(c)); return r; }
__device__ __forceinline__ void reduce2_oct(float& a, float& b) {
    asm("s_nop 1\n\t"
        "v_add_f32_dpp %0, %0, %0 quad_perm:[1,0,3,2] row_mask:0xf bank_mask:0xf bound_ctrl:1\n\t"
        "v_add_f32_dpp %1, %1, %1 quad_perm:[1,0,3,2] row_mask:0xf bank_mask:0xf bound_ctrl:1\n\t"
        "s_nop 0\n\t"
        "v_add_f32_dpp %0, %0, %0 quad_perm:[2,3,0,1] row_mask:0xf bank_mask:0xf bound_ctrl:1\n\t"
        "v_add_f32_dpp %1, %1, %1 quad_perm:[2,3,0,1] row_mask:0xf bank_mask:0xf bound_ctrl:1\n\t"
        "s_nop 0\n\t"
        "v_add_f32_dpp %0, %0, %0 row_half_mirror row_mask:0xf bank_mask:0xf bound_ctrl:1\n\t"
        "v_add_f32_dpp %1, %1, %1 row_half_mirror row_mask:0xf bank_mask:0xf bound_ctrl:1\n\t"
        : "+v"(a), "+v"(b));
}
__device__ __forceinline__ float wave_sum_u(float x) {
    x = row16_sum(x);
    const int xi = __builtin_bit_cast(int, x);
    const float s0 = __builtin_bit_cast(float, __builtin_amdgcn_readlane(xi, 0)), s1 = __builtin_bit_cast(float, __builtin_amdgcn_readlane(xi, 16)),
                s2 = __builtin_bit_cast(float, __builtin_amdgcn_readlane(xi, 32)), s3 = __builtin_bit_cast(float, __builtin_amdgcn_readlane(xi, 48));
    return (s0 + s1) + (s2 + s3);
}
template <int SIDE = 1> __device__ __forceinline__ void p5_scan(const Args& a, Frame& F) {
    const unsigned short* RKV = (const unsigned short*)(a.ws + WS_RKV); const unsigned char* EW = (const unsigned char*)(a.ws + WS_EW); const unsigned char* AA = EW + (size_t)2 * T * DA;
    _Float16* YS = (_Float16*)(a.ws + WS_YS); float* BON = (float*)(a.ws + WS_BON);
    const float* k_k = a.in[I_KK]; const float* k_a = a.in[I_KA]; const float* r_k = a.in[I_RK];
    const int grp = F.wave >> 2, wq = F.wave & 3, lane = F.lane, rp = lane >> 3, kq = lane & 7;
    LAS float* buf0 = (LAS float*)F.lds + (grp * 2) * SC_BUF_FLOATS;
    if (F.G != 256) return;
    const int gid = grp == 0 ? (int)blockIdx.x : 256 + (int)blockIdx.x;

    ScanPref P; float bonv[4];
#define SC_LOAD(ci_) do { const int cc_ = (ci_) < SC_NCH ? (ci_) : SC_NCH - 1; int idx_, ch_; scan_locate(gid, cc_, idx_, ch_); const ScanChain c_ = scan_chain(gid, idx_); \
        P.kk = k_k[c_.h * 64 + lane]; P.ka = k_a[c_.h * 64 + lane]; P.rk = r_k[c_.h * 64 + lane]; \
        _Pragma("unroll") for (int j = 0; j < 4; ++j) { const int s_ = ch_ * SC_TS + 4 * wq + j; const int t_ = c_.dir ? c_.L - 1 - s_ : s_; const size_t row_ = (size_t)(c_.row0 + t_); \
            const unsigned short* rp = RKV + row_ * 6144 + c_.h * 64 + lane; P.r[j] = rp[0]; P.k[j] = rp[2048]; P.v[j] = rp[4096]; \
            const size_t o_ = ((size_t)c_.dir * T + row_) * DA + c_.h * 64 + lane; P.e[j] = EW[o_]; P.a[j] = AA[o_]; } } while (0)
#define SC_STAGE(ci_, pb_) do { const int cc_ = (ci_) < SC_NCH ? (ci_) : SC_NCH - 1; int idx_, ch_; scan_locate(gid, cc_, idx_, ch_); const ScanChain c_ = scan_chain(gid, idx_); LAS float* B_ = buf0 + (pb_) * SC_BUF_FLOATS; \
        const float kkw = P.kk, kaw = P.ka, rkw = P.rk;     \
        _Pragma("unroll") for (int j = 0; j < 4; ++j) { const int i_ = 4 * wq + j; \
            const float r_ = h2f(P.r[j]), k_ = h2f(P.k[j]), v_ = h2f(P.v[j]), e_ = (float)P.e[j] * (0.60653065971263342f / 255.0f), a_ = (float)P.a[j] * (1.0f / 255.0f); \
            const float kr_ = k_ * kkw; const float kk_ = kr_ * __builtin_amdgcn_rsqf(wave_sum_u(kr_ * kr_) + 1e-12f); \
            const float kd_ = k_ * (1.0f + (a_ - 1.0f) * kaw); bonv[j] = wave_sum_u(r_ * kd_ * rkw); \
            LAS float* o_ = B_ + i_ * 6 * 64 + lane; o_[0] = -kk_; o_[64] = __expf(-e_); o_[128] = kk_ * a_; o_[192] = kd_; o_[256] = r_; o_[320] = v_; } } while (0)
#define SC_BON(ci_) do { if ((ci_) < SC_NCH && lane < 4) { int idx_, ch_; scan_locate(gid, (ci_), idx_, ch_); const ScanChain c_ = scan_chain(gid, idx_); \
            const int s_ = ch_ * SC_TS + 4 * wq + lane; const int t_ = c_.dir ? c_.L - 1 - s_ : s_; \
            const float bv_ = lane == 0 ? bonv[0] : lane == 1 ? bonv[1] : lane == 2 ? bonv[2] : bonv[3]; \
            BON[((size_t)c_.dir * T + (size_t)(c_.row0 + t_)) * 32 + c_.h] = bv_; } } while (0)

    SC_LOAD(0); SC_STAGE(0, 0); SC_BON(0); SC_LOAD(1);
    asm volatile("s_waitcnt lgkmcnt(0)" ::: "memory"); __syncthreads();

    float S[2][8];
#if SIDE_IN_SCAN
    f32x4 SR[8]; float smx[4] = {0.f, 0.f, 0.f, 0.f}, ssc[4] = {0.f, 0.f, 0.f, 0.f};
#pragma unroll
    for (int j = 0; j < 8; ++j) SR[j] = (f32x4){0.f, 0.f, 0.f, 0.f};
    LAS float* PART = (LAS float*)(F.lds + SIDE_PART_OFF);
    const char* spa = (const char*)a.in[I_WFI]; unsigned sld = 0;
    SidePair sd; sd.kind = 0; sd.first = 0; sd.last = 0; sd.src = a.in[I_WFI]; sd.dst = a.ws; sd.cm = (unsigned*)(a.ws + WS_CMAX); sd.ld = 0; sd.ldt = 0; sd.cs = 3;
#endif
    for (int ci = 0; ci < SC_NCH; ++ci) {
        int idx, chunk; scan_locate(gid, ci, idx, chunk); const ScanChain c = scan_chain(gid, idx);
        const size_t sbase = (size_t)((c.b * 2 + c.dir) * 32 + c.h) * 4096 + (size_t)(16 * wq + 2 * rp) * 64 + 8 * kq;
        if (chunk == 0) {
            if (c.is_sample) {
#pragma unroll
                for (int rr = 0; rr < 2; ++rr) { const f32x4 s0 = *(const f32x4*)(a.in[I_STATE] + sbase + rr * 64), s1 = *(const f32x4*)(a.in[I_STATE] + sbase + rr * 64 + 4);
                    S[rr][0] = s0.x; S[rr][1] = s0.y; S[rr][2] = s0.z; S[rr][3] = s0.w; S[rr][4] = s1.x; S[rr][5] = s1.y; S[rr][6] = s1.z; S[rr][7] = s1.w; }
#pragma unroll
                for (int rr = 0; rr < 2; ++rr)
#pragma unroll
                    for (int j = 0; j < 8; ++j) asm volatile("" : "+v"(S[rr][j]));
            } else {
#pragma unroll
                for (int rr = 0; rr < 2; ++rr)
#pragma unroll
                    for (int j = 0; j < 8; ++j) S[rr][j] = 0.f;
            }
        }
        const LAS float* B = buf0 + (ci & 1) * SC_BUF_FLOATS;
        _Float16* yout = YS + (size_t)c.dir * T * DA + c.h * 64 + 16 * wq + 2 * rp;
        unsigned ypk[SC_TS];
#define SC_RD8(dst, off) do { const f32x4 lo_ = *(const LAS f32x4*)(O + (off) + 8 * kq), hi_ = *(const LAS f32x4*)(O + (off) + 8 * kq + 4); \
                dst[0] = lo_.x; dst[1] = lo_.y; dst[2] = lo_.z; dst[3] = lo_.w; dst[4] = hi_.x; dst[5] = hi_.y; dst[6] = hi_.z; dst[7] = hi_.w; \
                _Pragma("unroll") for (int j = 0; j < 8; ++j) asm("" : "+v"(dst[j])); } while (0)
#define SC_STEP(i) do { \
            const LAS float* O = B + (i) * 6 * 64; \
            float av[8], wv[8], bv[8], kv[8], rv[8], vv[2]; \
            SC_RD8(av, 0); SC_RD8(wv, 64); SC_RD8(bv, 128); SC_RD8(kv, 192); SC_RD8(rv, 256); \
            { const f32x2 v2 = *(const LAS f32x2*)(O + 320 + 16 * wq + 2 * rp); vv[0] = v2.x; vv[1] = v2.y; asm("" : "+v"(vv[0])); asm("" : "+v"(vv[1])); } \
            float sa[2], y[2]; \
            _Pragma("unroll") for (int rr = 0; rr < 2; ++rr) { float t = S[rr][0] * av[0]; \
                _Pragma("unroll") for (int j = 1; j < 8; ++j) t = __builtin_fmaf(S[rr][j], av[j], t); \
                sa[rr] = t; } \
            reduce2_oct(sa[0], sa[1]); \
            _Pragma("unroll") for (int rr = 0; rr < 2; ++rr) { \
                _Pragma("unroll") for (int j = 0; j < 8; ++j) { S[rr][j] = __builtin_fmaf(vv[rr], kv[j], __builtin_fmaf(S[rr][j], wv[j], sa[rr] * bv[j])); asm("" : "+v"(S[rr][j])); } \
                float t = S[rr][0] * rv[0]; \
                _Pragma("unroll") for (int j = 1; j < 8; ++j) t = __builtin_fmaf(S[rr][j], rv[j], t); \
                y[rr] = t; } \
            reduce2_oct(y[0], y[1]); \
            ypk[i] = pg8::pk_f16(y[0], y[1]); } while (0)
        SC_STEP(0); SC_STEP(1); SC_STEP(2); SC_STEP(3); SC_STEP(4); SC_STEP(5); SC_STEP(6); SC_STEP(7);
        {
            SC_STAGE(ci + 1, (ci + 1) & 1);
            SC_BON(ci + 1);
#if SIDE_IN_SCAN
            if constexpr (SIDE != 0) {
            if constexpr (SIDE == 1) side_consume(sd, lane, F.wave, SR, smx, ssc, PART);
            else { _Pragma("unroll") for (int j = 0; j < 8; ++j) { asm volatile("" :: "v"(SR[j])); } }
            side_pair_next(a, (int)blockIdx.x, F.wave, ci, sd);
            spa = side_issue_addr(sd, lane); sld = sd.ld;
            }
#endif
            SC_LOAD(ci + 2);
        }
#if SIDE_IN_SCAN
#define SC_SIDE_LOAD(j) do { if constexpr (SIDE != 0) { SR[j] = side_issue_one(spa, sld, j); __builtin_amdgcn_sched_barrier(0x38F); } } while (0)
#else
#define SC_SIDE_LOAD(j) do { } while (0)
#endif
        SC_STEP(8); SC_SIDE_LOAD(0); SC_STEP(9); SC_SIDE_LOAD(1); SC_STEP(10); SC_SIDE_LOAD(2); SC_STEP(11); SC_SIDE_LOAD(3); SC_STEP(12); SC_SIDE_LOAD(4); SC_STEP(13); SC_SIDE_LOAD(5); SC_STEP(14); SC_SIDE_LOAD(6); SC_STEP(15); SC_SIDE_LOAD(7);
#undef SC_SIDE_LOAD
#undef SC_STEP
#undef SC_RD8
        if (kq == 0) {
#pragma unroll
            for (int i = 0; i < SC_TS; ++i) { const int s = chunk * SC_TS + i; const int t = c.dir ? c.L - 1 - s : s;
                *(GAS unsigned*)(yout + (size_t)(c.row0 + t) * DA) = ypk[i]; }
        }
        if (!c.is_sample && chunk == (c.L / SC_TS) - 1) {
#pragma unroll
            for (int rr = 0; rr < 2; ++rr) { *(GAS f32x4*)(a.out + OUT_STATE + sbase + rr * 64) = (f32x4){S[rr][0], S[rr][1], S[rr][2], S[rr][3]};
                *(GAS f32x4*)(a.out + OUT_STATE + sbase + rr * 64 + 4) = (f32x4){S[rr][4], S[rr][5], S[rr][6], S[rr][7]}; }
        }
        asm volatile("s_waitcnt lgkmcnt(0)\n\ts_barrier" ::: "memory");
    }
    asm volatile("s_waitcnt vmcnt(0) lgkmcnt(0)" ::: "memory");
#undef SC_LOAD
#undef SC_STAGE
#undef SC_BON
}
__device__ __forceinline__ float bf2f(bf16 b) { return __builtin_bit_cast(float, (unsigned)b << 16); }
__device__ __forceinline__ bf16 f2bf_rne(float f) { return (bf16)(pg8::cvt_pk_bf16(f, 0.f) & 0xffffu); }
struct P5Task { unsigned short r0[16], r1[16], r2[16]; float w0, w1, w2, cs, sn, kx2; int pos, isq; size_t orow; };
__device__ __forceinline__ void p5_issue(const Args& a, int task, int lane, P5Task& X) {
    const unsigned short* Q = (const unsigned short*)(a.ws + WS_Q); const unsigned short* KV = (const unsigned short*)(a.ws + WS_KV); const float* KPE = (const float*)(a.ws + WS_KPE);
    const float* COS = (const float*)(a.ws + WS_COS); const float* SIN = (const float*)(a.ws + WS_SIN);
    const bool isq = task < T; int pos = -1; const float* kpe = KPE; size_t qrow = 0, kvrow = 0;
    if (isq) { qrow = task; if (task >= T_P) pos = (task - T_P) & 1023; }
    else { kvrow = task - T;
        if (kvrow < (size_t)T_P) kpe = KPE + kvrow * 64;
        else { const int r = (int)kvrow - T_P, b = r / 1536, p = r % 1536;
            if (p < 512) kpe = a.in[I_CKPE] + (size_t)(b * 512 + p) * 64; else { pos = p - 512; kpe = KPE + (size_t)(T_P + b * 1024 + pos) * 64; } } }
    const float* hn = isq ? a.in[I_QHN] : a.in[I_KHN];
    X.w0 = hn[lane]; X.w1 = hn[64 + lane]; X.w2 = hn[128 + lane];
    X.cs = 1.f; X.sn = 0.f; if (pos >= 0) { X.cs = COS[pos * 32 + (lane & 31)]; X.sn = SIN[pos * 32 + (lane & 31)]; }
    X.kx2 = isq ? 0.f : kpe[lane]; X.pos = pos; X.isq = isq ? 1 : 0; X.orow = isq ? qrow : kvrow;
    if (isq) { const unsigned short* p = Q + qrow * 3072;
#pragma unroll
        for (int h = 0; h < 16; ++h) { X.r0[h] = p[h * 192 + lane]; X.r1[h] = p[h * 192 + 64 + lane]; X.r2[h] = p[h * 192 + 128 + lane]; } }
    else { const unsigned short* p = KV + kvrow * 4096;
#pragma unroll
        for (int h = 0; h < 16; ++h) { X.r0[h] = p[h * 256 + lane]; X.r1[h] = p[h * 256 + 64 + lane]; X.r2[h] = 0; } }
}
__device__ __forceinline__ void p5_qkprep(const Args& a, Frame& F) {
    unsigned short* Q = (unsigned short*)(a.ws + WS_Q); unsigned short* KP = (unsigned short*)(a.ws + WS_KP);
    const int lane = F.lane; constexpr int NTASK = T + KVROWS;
    P5Task A;
    if (F.gw < NTASK) p5_issue(a, F.gw, lane, A);
    for (int task = F.gw; task < NTASK; task += F.ngw) {
        P5Task B = A;
        if (task + F.ngw < NTASK) p5_issue(a, task + F.ngw, lane, B);
        unsigned short o0[16], o1[16], o2[16];
#pragma unroll
        for (int h = 0; h < 16; ++h) {
            const float x0 = bf2f((bf16)A.r0[h]), x1 = bf2f((bf16)A.r1[h]), x2 = A.isq ? bf2f((bf16)A.r2[h]) : A.kx2;
            const float rs = 1.0f / sqrtf(wave_sum_u(x0 * x0 + x1 * x1 + x2 * x2) * (1.0f / 192.0f) + NORM_EPS);
            const float y0 = x0 * rs * A.w0, y1 = x1 * rs * A.w1; float y2 = x2 * rs * A.w2;
            if (A.pos >= 0) { const float pr = __shfl_xor(y2, 32); y2 = (lane < 32) ? y2 * A.cs - pr * A.sn : pr * A.sn + y2 * A.cs; }
            o0[h] = (unsigned short)f2bf_rne(y0); o1[h] = (unsigned short)f2bf_rne(y1); o2[h] = (unsigned short)f2bf_rne(y2);
        }
        { unsigned short* o = (A.isq ? Q : KP) + A.orow * 3072;
#pragma unroll
            for (int h = 0; h < 16; ++h) { o[h * 192 + lane] = o0[h]; o[h * 192 + 64 + lane] = o1[h]; o[h * 192 + 128 + lane] = o2[h]; } }
        A = B;
    }
}

namespace attn {
using bf16x8 = __attribute__((ext_vector_type(8))) short;
using s16x4  = __attribute__((ext_vector_type(4))) short;
using f32x16 = __attribute__((ext_vector_type(16))) float;
using u32x4  = __attribute__((ext_vector_type(4))) unsigned;
constexpr int DQK = 192, DV = 128, NW = 8, QBLK = 32, KVBLK = 64;
constexpr int LDQ = 3072, LDK = 3072, LDV = 4096, LDO = 2048;
constexpr float SCALE = 0.07216878364870322f;
constexpr float THR = 8.f;
constexpr size_t SHM_V = KVBLK * DV * 2, SHM_K = KVBLK * DQK * 2, SHM_ATTN = 2 * SHM_V + 2 * SHM_K + NW * 64 * 4;
#define KSWZ(row, colB) ((row) * 384 + ((colB) ^ (((row) & 7) << 4)))
#define SBAR() __builtin_amdgcn_sched_barrier(0)
__device__ __forceinline__ int crow(int r, int hi) { return (r & 3) + 8 * (r >> 2) + 4 * hi; }
__device__ __forceinline__ unsigned cvtpk(float lo, float hi) { return pg8::cvt_pk_bf16(lo, hi); }

__device__ __forceinline__ void partialSM(f32x16& p0, f32x16& p1, float& m_reg, float& mn, float& alpha) {
  constexpr float C = SCALE * 1.4426950408889634f;
  float pmax = p0[0];
#pragma unroll
  for (int r = 1; r < 16; ++r) pmax = fmaxf(pmax, p0[r]);
#pragma unroll
  for (int r = 0; r < 16; ++r) pmax = fmaxf(pmax, p1[r]);
  { auto rr = __builtin_amdgcn_permlane32_swap(__float_as_uint(pmax), __float_as_uint(pmax), false, false);
    pmax = fmaxf(__uint_as_float(rr[0]), __uint_as_float(rr[1])); }
  if (__builtin_expect(__all(pmax - m_reg <= THR / SCALE), 1)) { mn = m_reg; alpha = 1.f; }
  else { mn = fmaxf(m_reg, pmax); alpha = __builtin_amdgcn_exp2f((m_reg - mn) * C); m_reg = mn; }
  float mnC = -mn * C;
#pragma unroll
  for (int r = 0; r < 16; ++r) p0[r] = fmaf(p0[r], C, mnC);
#pragma unroll
  for (int r = 0; r < 16; ++r) p1[r] = fmaf(p1[r], C, mnC);
#pragma unroll
  for (int r = 0; r < 16; ++r) p0[r] = __builtin_amdgcn_exp2f(p0[r]);
}
__device__ __forceinline__ void finishSM(f32x16& p0, f32x16& p1, float alpha, float& l_reg, bf16x8& pa0, bf16x8& pa1, bf16x8& pa2, bf16x8& pa3) {
#pragma unroll
  for (int r = 0; r < 16; ++r) p1[r] = __builtin_amdgcn_exp2f(p1[r]);
  float ps = 0;
#pragma unroll
  for (int r = 0; r < 16; ++r) ps += p0[r];
#pragma unroll
  for (int r = 0; r < 16; ++r) ps += p1[r];
  { auto rr = __builtin_amdgcn_permlane32_swap(__float_as_uint(ps), __float_as_uint(ps), false, false);
    ps = __uint_as_float(rr[0]) + __uint_as_float(rr[1]); }
  l_reg = l_reg * alpha + ps;
#define PK4(P, BASE, OUT) do { unsigned a0 = cvtpk(P[BASE + 0], P[BASE + 1]), a1 = cvtpk(P[BASE + 2], P[BASE + 3]);   \
    unsigned b0 = cvtpk(P[BASE + 4], P[BASE + 5]), b1 = cvtpk(P[BASE + 6], P[BASE + 7]);                              \
    auto r0 = __builtin_amdgcn_permlane32_swap(a0, b0, false, false); auto r1 = __builtin_amdgcn_permlane32_swap(a1, b1, false, false); \
    u32x4 w = {r0[0], r1[0], r0[1], r1[1]}; OUT = *reinterpret_cast<bf16x8*>(&w); } while (0)
  PK4(p0, 0, pa0); PK4(p0, 8, pa1); PK4(p1, 0, pa2); PK4(p1, 8, pa3);
#undef PK4
}
__device__ __forceinline__ void qkt(f32x16& p0, f32x16& p1, const char* Ks, const bf16x8* qr, int r32, int hi) {
  p0 = f32x16{}; p1 = f32x16{};
#pragma unroll
  for (int d0 = 0; d0 < 12; ++d0) { int cb = (d0 * 16 + hi * 8) * 2;
    bf16x8 b0 = *reinterpret_cast<const bf16x8*>(Ks + KSWZ(r32, cb));
    bf16x8 b1 = *reinterpret_cast<const bf16x8*>(Ks + KSWZ(32 + r32, cb));
    p0 = __builtin_amdgcn_mfma_f32_32x32x16_bf16(b0, qr[d0], p0, 0, 0, 0);
    p1 = __builtin_amdgcn_mfma_f32_32x32x16_bf16(b1, qr[d0], p1, 0, 0, 0); }
}
__device__ __forceinline__ int v_st(int k, int c) { const int kk = (k & ~0xC) | ((k & 4) << 1) | ((k & 8) >> 1); return ((kk >> 3) * 4 + (c >> 5)) * 512 + ((kk & 7) * 32 + (c & 31)) * 2; }
__device__ __forceinline__ int v_rd_base(int lane) { return ((lane & 3) << 3) | (((lane >> 2) & 3) << 6) | (((lane >> 4) & 1) << 5) | (((lane >> 5) & 1) << 8); }
constexpr int v_rd_off(int d0, int ks, int half) { return d0 * 512 + ks * 4096 + half * 2048; }
template <int OFF> __device__ __forceinline__ s16x4 tr_read(int vb) {
  s16x4 r; asm volatile("ds_read_b64_tr_b16 %0, %1 offset:%2" : "=&v"(r) : "v"(vb), "i"(OFF) : "memory"); return r;
}
template <int D0> __device__ __forceinline__ void pv_one(f32x16& od, int vb, bf16x8 pa0, bf16x8 pa1, bf16x8 pa2, bf16x8 pa3) {
#define PK(L, H) (bf16x8){L[0], L[1], L[2], L[3], H[0], H[1], H[2], H[3]}
  { const s16x4 l0 = tr_read<v_rd_off(D0, 0, 0)>(vb), h0 = tr_read<v_rd_off(D0, 0, 1)>(vb), l1 = tr_read<v_rd_off(D0, 1, 0)>(vb), h1 = tr_read<v_rd_off(D0, 1, 1)>(vb);
    asm volatile("s_waitcnt lgkmcnt(0)" ::: "memory"); SBAR();
    od = __builtin_amdgcn_mfma_f32_32x32x16_bf16(pa0, PK(l0, h0), od, 0, 0, 0);
    od = __builtin_amdgcn_mfma_f32_32x32x16_bf16(pa1, PK(l1, h1), od, 0, 0, 0); }
  { const s16x4 l2 = tr_read<v_rd_off(D0, 2, 0)>(vb), h2 = tr_read<v_rd_off(D0, 2, 1)>(vb), l3 = tr_read<v_rd_off(D0, 3, 0)>(vb), h3 = tr_read<v_rd_off(D0, 3, 1)>(vb);
    asm volatile("s_waitcnt lgkmcnt(0)" ::: "memory"); SBAR();
    od = __builtin_amdgcn_mfma_f32_32x32x16_bf16(pa2, PK(l2, h2), od, 0, 0, 0);
    od = __builtin_amdgcn_mfma_f32_32x32x16_bf16(pa3, PK(l3, h3), od, 0, 0, 0); }
#undef PK
}
__device__ __forceinline__ void pv_d0(f32x16* o, int vb, bf16x8 pa0, bf16x8 pa1, bf16x8 pa2, bf16x8 pa3) {
  pv_one<0>(o[0], vb, pa0, pa1, pa2, pa3); pv_one<1>(o[1], vb, pa0, pa1, pa2, pa3); pv_one<2>(o[2], vb, pa0, pa1, pa2, pa3); pv_one<3>(o[3], vb, pa0, pa1, pa2, pa3);
}

__device__ __forceinline__ void attn_dense_body(const bf16* __restrict__ Qb, const bf16* __restrict__ Kh, const bf16* __restrict__ Vh, bf16* __restrict__ Ob, int seq, char* lds) {
  int tid_ = threadIdx.x; asm volatile("" : "+v"(tid_));
  const int tid = tid_, wid = __builtin_amdgcn_readfirstlane(tid >> 6), lane = tid & 63, r32 = lane & 31, hi = lane >> 5;
  char* V_lds = lds; char* K_lds = lds + 2 * SHM_V;
  float* ws = (float*)(lds + 2 * SHM_V + 2 * SHM_K) + wid * 64; float* li_l = ws; float* al_l = ws + 32;
  float m_reg = -1e30f, l_reg = 0; f32x16 o[4] = {}; bf16x8 qr[12];
  const bf16* Qw = Qb + (long)(wid * QBLK + r32) * LDQ + hi * 8;
#pragma unroll
  for (int d0 = 0; d0 < 12; ++d0) qr[d0] = *reinterpret_cast<const bf16x8*>(Qw + d0 * 16);
  const int sr = tid >> 4, sc = (tid & 15) * 8, vst0 = v_st(sr, sc), vst1 = v_st(32 + sr, sc);
  const int kr2 = tid >> 3, kc2 = 128 + (tid & 7) * 8;
  const int vb0 = (int)(uintptr_t)V_lds + v_rd_base(lane);
  bf16x8 vs0, vs1, ks0, ks1, ks2;
  const unsigned ovs0 = (unsigned)(sr * LDV + sc) * 2u, ovs1 = (unsigned)((32 + sr) * LDV + sc) * 2u, oks0 = (unsigned)(sr * LDK + sc) * 2u, oks1 = (unsigned)((32 + sr) * LDK + sc) * 2u, oks2 = (unsigned)(kr2 * LDK + kc2) * 2u;
#define SLOAD(k0) do { const char* vt_ = (const char*)Vh + (size_t)(k0) * (LDV * 2); const char* kt_ = (const char*)Kh + (size_t)(k0) * (LDK * 2); \
    vs0 = *reinterpret_cast<const bf16x8*>(vt_ + ovs0); vs1 = *reinterpret_cast<const bf16x8*>(vt_ + ovs1); \
    ks0 = *reinterpret_cast<const bf16x8*>(kt_ + oks0); ks1 = *reinterpret_cast<const bf16x8*>(kt_ + oks1); ks2 = *reinterpret_cast<const bf16x8*>(kt_ + oks2); } while (0)
#define SWRITE(b) do { *(bf16x8*)(V_lds + (b) * SHM_V + vst0) = vs0; *(bf16x8*)(V_lds + (b) * SHM_V + vst1) = vs1; \
    *(bf16x8*)(K_lds + (b) * SHM_K + KSWZ(sr, sc * 2)) = ks0; *(bf16x8*)(K_lds + (b) * SHM_K + KSWZ(32 + sr, sc * 2)) = ks1; \
    *(bf16x8*)(K_lds + (b) * SHM_K + KSWZ(kr2, kc2 * 2)) = ks2; } while (0)
#define RESC(a) do { if (__any((a) < 1.f)) { if (hi == 0) al_l[r32] = (a); asm volatile("s_waitcnt lgkmcnt(0)" ::: "memory"); \
    _Pragma("unroll") for (int d = 0; d < 4; ++d) _Pragma("unroll") for (int r = 0; r < 16; ++r) o[d][r] *= al_l[crow(r, hi)]; } } while (0)
  f32x16 p0, p1; float mn, al; bf16x8 pa0, pa1, pa2, pa3; const int NT = seq / KVBLK;
  SLOAD(0); asm volatile("s_waitcnt vmcnt(0)" ::: "memory"); SWRITE(0); __syncthreads();
  SLOAD(KVBLK);
  for (int j = 0; j < NT; ++j) {
    const int bsel = j & 1;
    SBAR(); qkt(p0, p1, K_lds + bsel * SHM_K, qr, r32, hi);
    partialSM(p0, p1, m_reg, mn, al); finishSM(p0, p1, al, l_reg, pa0, pa1, pa2, pa3); SBAR();
    RESC(al);
    if (j + 1 < NT) { asm volatile("s_waitcnt vmcnt(0)" ::: "memory"); SWRITE(bsel ^ 1); }
    if (j + 2 < NT) SLOAD((j + 2) * KVBLK);
    SBAR(); pv_d0(o, vb0 + bsel * (int)SHM_V, pa0, pa1, pa2, pa3);
    __syncthreads();
  }
  if (hi == 0) li_l[r32] = l_reg; asm volatile("s_waitcnt lgkmcnt(0)" ::: "memory");
  float rli[16];
#pragma unroll
  for (int r = 0; r < 16; ++r) rli[r] = __builtin_amdgcn_rcpf(li_l[crow(r, hi)]);
  bf16* Ow = Ob + (long)(wid * QBLK) * LDO;
#pragma unroll
  for (int r = 0; r < 16; ++r) { int orow = crow(r, hi);
#pragma unroll
    for (int d0 = 0; d0 < 4; ++d0) Ow[(long)orow * LDO + d0 * 32 + r32] = (bf16)(cvtpk(o[d0][r] * rli[r], 0.f) & 0xffffu); }
  __syncthreads();
#undef SLOAD
#undef SWRITE
#undef RESC
}
#undef KSWZ
#undef SBAR
}

__device__ __forceinline__ void p6_attention(const Args& a, Frame& F) {
    const bf16* QP = (const bf16*)(a.ws + WS_Q); const bf16* KP = (const bf16*)(a.ws + WS_KP); const bf16* KV = (const bf16*)(a.ws + WS_KV); bf16* YB = (bf16*)(a.ws + WS_YB);
    char* lds = (char*)(unsigned char*)F.lds;
    for (int u = blockIdx.x; u < 256; u += F.G) {
        const int b = u >> 6, h = (u >> 2) & 15, qb = u & 3; const size_t row0 = (size_t)T_P + b * 1024 + qb * 256, kv0 = (size_t)T_P + b * 1536;
        attn::attn_dense_body(QP + row0 * 3072 + h * 192, KP + kv0 * 3072 + h * 192, KV + kv0 * 4096 + h * 256 + 128, YB + row0 * 2048 + h * 128, 1536, lds);
    }
    for (int u = blockIdx.x; u < 512; u += F.G) {
        const int b = u >> 4, h = u & 15; const size_t row0 = (size_t)b * 256;
        attn::attn_dense_body(QP + row0 * 3072 + h * 192, KP + row0 * 3072 + h * 192, KV + row0 * 4096 + h * 256 + 128, YB + row0 * 2048 + h * 128, 256, lds);
    }
}

__device__ __forceinline__ float grp16_sum(float v) { v += __shfl_xor(v, 1); v += __shfl_xor(v, 2); v += __shfl_xor(v, 4); v += __shfl_xor(v, 8); return v; }
#ifndef P7_NOLN
#define P7_NOLN 0
#endif
#ifndef P7_TRIVIAL
#define P7_TRIVIAL 0
#endif
__device__ __forceinline__ void p7_postscan(const Args& a, Frame& F) {
    const unsigned short* YS = (const unsigned short*)(a.ws + WS_YS); const float* BON = (const float*)(a.ws + WS_BON); const unsigned short* RKV = (const unsigned short*)(a.ws + WS_RKV);
    const bf16* G = (const bf16*)(a.ws + WS_G); unsigned char* YA = (unsigned char*)(a.ws + WS_YA); float* ROWS = (float*)(a.ws + WS_ROWSYA); const float* lnw = a.in[I_LNW]; const float* lnb = a.in[I_LNB];
    for (int row = F.gw; row < T; row += F.ngw) {
        v2u ybw[8];
#pragma unroll
        for (int p = 0; p < 8; ++p) ybw[p] = *(const GAS v2u*)((const unsigned short*)(a.ws + WS_YB) + (size_t)row * DA + p * 256 + F.lane * 4);
        float ov[8][4]; float mx = 0.f;
#pragma unroll
        for (int p = 0; p < 8; ++p) { const int c = p * 256 + F.lane * 4, h = c >> 6;
            const v2u yf = *(const GAS v2u*)(YS + (size_t)row * DA + c), yb = *(const GAS v2u*)(YS + ((size_t)T + row) * DA + c), vv = *(const GAS v2u*)(RKV + (size_t)row * 6144 + 4096 + c), gg = *(const GAS v2u*)(G + (size_t)row * DA + c);
            const float bon = BON[(size_t)row * 32 + h] + BON[((size_t)T + row) * 32 + h];
            float y[4], v[4], g[4];
            y[0] = h2f(yf.x & 0xffff) + h2f(yb.x & 0xffff); y[1] = h2f(yf.x >> 16) + h2f(yb.x >> 16); y[2] = h2f(yf.y & 0xffff) + h2f(yb.y & 0xffff); y[3] = h2f(yf.y >> 16) + h2f(yb.y >> 16);
            v[0] = h2f(vv.x & 0xffff); v[1] = h2f(vv.x >> 16); v[2] = h2f(vv.y & 0xffff); v[3] = h2f(vv.y >> 16);
            g[0] = pg8::bflo(gg.x); g[1] = pg8::bfhi(gg.x); g[2] = pg8::bflo(gg.y); g[3] = pg8::bfhi(gg.y);
            const float mu = row16_sum((y[0] + y[1]) + (y[2] + y[3])) * (1.0f / 64.0f);
            float d[4]; float q = 0.f;
#pragma unroll
            for (int i = 0; i < 4; ++i) { d[i] = y[i] - mu; q += d[i] * d[i]; }
            const float rstd = 1.0f / sqrtf(row16_sum(q) * (1.0f / 64.0f) + 64e-5f);
            const f32x4 w4 = *(const f32x4*)(lnw + c), b4 = *(const f32x4*)(lnb + c);
#pragma unroll
            for (int i = 0; i < 4; ++i) { ov[p][i] = (d[i] * rstd * w4[i] + b4[i] + bon * v[i]) * g[i]; mx = fmaxf(mx, fabsf(ov[p][i])); } }
        mx = wave_max_d(mx);
        const float qs = mx > 0.f ? 127.0f / mx : 0.f;
        if (F.lane == 0) ROWS[row] = mx * (1.0f / 127.0f);
#pragma unroll
        for (int p = 0; p < 8; ++p) { const int c = p * 256 + F.lane * 4;
            *(GAS unsigned*)(YA + (size_t)row * DA + c) = (unsigned)q8(ov[p][0] * qs) | ((unsigned)q8(ov[p][1] * qs) << 8) | ((unsigned)q8(ov[p][2] * qs) << 16) | ((unsigned)q8(ov[p][3] * qs) << 24); }
        {
            const unsigned short* YBr = (const unsigned short*)(a.ws + WS_YB) + (size_t)row * DA; unsigned char* YB8 = (unsigned char*)(a.ws + WS_YB8) + (size_t)row * DA;
            float yv[8][4]; float mb = 0.f;
#pragma unroll
            for (int p = 0; p < 8; ++p) { const v2u t = ybw[p];
                yv[p][0] = pg8::bflo(t.x); yv[p][1] = pg8::bfhi(t.x); yv[p][2] = pg8::bflo(t.y); yv[p][3] = pg8::bfhi(t.y);
                mb = fmaxf(mb, fmaxf(fmaxf(fabsf(yv[p][0]), fabsf(yv[p][1])), fmaxf(fabsf(yv[p][2]), fabsf(yv[p][3])))); }
            mb = wave_max_d(mb);
            const float qb = mb > 0.f ? 127.0f / mb : 0.f;
            if (F.lane == 0) ((float*)(a.ws + WS_ROWSYB))[row] = mb * (1.0f / 127.0f);
#pragma unroll
            for (int p = 0; p < 8; ++p)
                *(GAS unsigned*)(YB8 + p * 256 + F.lane * 4) = (unsigned)q8(yv[p][0] * qb) | ((unsigned)q8(yv[p][1] * qb) << 8) | ((unsigned)q8(yv[p][2] * qb) << 16) | ((unsigned)q8(yv[p][3] * qb) << 24);
        }
    }
}
#ifndef MK_PER_PHASE
#define MK_PER_PHASE 0
#endif
constexpr int N_PHASES = 14;
__global__ void __launch_bounds__(NWAVES * 64, 2) fwd_kernel(Args args) {
    extern __shared__ __attribute__((aligned(16))) unsigned char lds[];
    Frame F;
    F.lds = (LAS unsigned char*)lds; F.MISC = (volatile LAS unsigned*)(F.lds + MISC_OFF);
    F.tid = threadIdx.x; F.lane = F.tid & 63; F.wave = __builtin_amdgcn_readfirstlane(F.tid >> 6);
    F.G = gridDim.x; F.gw = blockIdx.x * NWAVES + F.wave; F.ngw = F.G * NWAVES;
    unsigned char* ws = args.ws; F.ctl = (gu32*)(ws + WS_CTL);
    for (int u = F.tid; u < (LDS_BYTES - LDSCTL_OFF) / 4; u += NWAVES * 64) ((LAS unsigned*)(F.lds + LDSCTL_OFF))[u] = 0u;
    __syncthreads();
    const int lo = args.ph_lo, hi = args.ph_hi;
    XcdBarrier bar; bar.bar = (unsigned*)(F.ctl + CW_BAR); bar.x = 0; bar.st = nullptr;
    if (hi - lo > 1) bar = xcd_barrier_post((unsigned*)(F.ctl + CW_BAR), F.MISC + 8);
#ifndef P4_MASK
#define P4_MASK 15
#endif
#ifndef PH_MASK
#define PH_MASK 0xFFFFFFFFu
#endif
#define IN(k) (((PH_MASK >> (k)) & 1u) && lo <= (k) && (k) < hi)
#define SEAM(k) do { if (IN(k) && IN((k) + 1)) xcd_barrier(bar); } while (0)
    LAS unsigned char* ring = F.lds + RING_OFF;
    float* MOD = (float*)(ws + WS_MOD);

    if (IN(0)) { p0_adaln(args, F); p0_colmax(args, F); p0_weights(args, F); p0_rope(args, F); }
    SEAM(0);
    if (IN(1)) {
        Frame F2 = F; F2.gw = (int)blockIdx.x * 4 + (F.wave & 3); F2.ngw = F.G * 4;
        if (F.wave < 4) modnorm_rows_dual(F2, args.in[I_XP], args.in[I_XS], args.in[I_NMIX], MOD, 0, (bf16*)(ws + WS_HB), (unsigned char*)(ws + WS_H1Q), (float*)(ws + WS_ROWS1));
        else p1_weights_i8(args, F2); }
    SEAM(1);
    if (IN(2)) {
        {
            int k8 = DM / 2; asm volatile("" : "+s"(k8));
            pg8::Gemm g{(const pg8::bf16_t*)(ws + WS_H1Q), (const pg8::bf16_t*)(ws + WS_WING8 + (size_t)8192 * DM), T, 3584, k8}; pg8::StaticOrder S; S.init(T, 3584, F.G, (int)blockIdx.x);
            pg8::EpiGate8 E{(unsigned char*)(ws + WS_GA), (unsigned char*)(ws + WS_GB), (const float*)(ws + WS_ROWS1), (const unsigned*)(ws + WS_CMAXG), (pg8::f16_t*)(ws + WS_RKV), (pg8::bf16_t*)(ws + WS_LG), (float*)(ws + WS_QLAT), 32};
            pg8::gemm_phase<pg8::EpiGate8, pg8::StaticOrder, true, true, 2>(ring, g, S, E); }
        {
            pg8::Gemm g{(const pg8::bf16_t*)(ws + WS_HB), (const pg8::bf16_t*)(ws + WS_WIN), T, NIN16, DM}; pg8::StaticOrder S; S.init(T, NIN16, F.G, (int)blockIdx.x);
            pg8::EpiIn E{(pg8::f16_t*)(ws + WS_RKV), (pg8::bf16_t*)(ws + WS_LWA), (pg8::bf16_t*)(ws + WS_LG), (float*)(ws + WS_QLAT), (float*)(ws + WS_KVLAT), (float*)(ws + WS_KPE), (pg8::bf16_t*)(ws + WS_GA), (pg8::bf16_t*)(ws + WS_GB)};
            pg8::gemm_phase<pg8::EpiIn, pg8::StaticOrder, true, true>(ring, g, S, E); }
    }
    SEAM(2);
    if (IN(3)) { p3_post(args, F); }
    SEAM(3);
    if (IN(4)) {
        if (P4_MASK & 1) { int kl = 256; asm volatile("" : "+s"(kl));
          pg8::Gemm g{(const pg8::bf16_t*)(ws + WS_LWA), (const pg8::bf16_t*)(ws + WS_WLORA), 2 * T, 8192, kl}; pg8::BatchedOrder S; S.init(T / 256, 16, 2, F.G, (int)blockIdx.x);
          pg8::EpiLora E{(unsigned char*)(ws + WS_EW), (const float*)(ws + WS_LBIAS)};
          pg8::gemm_phase<pg8::EpiLora, pg8::BatchedOrder, true, true>(ring, g, S, E); }
        if (P4_MASK & 2) { int kg = 512; asm volatile("" : "+s"(kg));
          pg8::Gemm g{(const pg8::bf16_t*)(ws + WS_LG), (const pg8::bf16_t*)(ws + WS_WG), T, DA, kg}; pg8::StaticOrder S; S.init(T, DA, F.G, (int)blockIdx.x);
          pg8::EpiPlain E{(pg8::bf16_t*)(ws + WS_G), DA};
          pg8::gemm_phase<pg8::EpiPlain, pg8::StaticOrder, true, true>(ring, g, S, E); }
        if (P4_MASK & 4) { int kq = QL / 2; asm volatile("" : "+s"(kq));
          pg8::Gemm g{(const pg8::bf16_t*)(ws + WS_QN), (const pg8::bf16_t*)(ws + WS_WUQ), T, 3072, kq}; pg8::StaticOrder S; S.init(T, 3072, F.G, (int)blockIdx.x, 128);
          pg8::EpiPlainI8 E{(pg8::bf16_t*)(ws + WS_Q), 3072, (const float*)(ws + WS_ROWSQ), (const unsigned*)(ws + WS_CMAXUQ)};
          pg8::gemm_phase<pg8::EpiPlainI8, pg8::StaticOrder, true, true, 2>(ring, g, S, E); }
        if (P4_MASK & 8) { int kk = KVL / 2; asm volatile("" : "+s"(kk));
          pg8::Gemm g{(const pg8::bf16_t*)(ws + WS_CKVA), (const pg8::bf16_t*)(ws + WS_WUKV), KVROWS, 4096, kk}; pg8::StaticOrder S; S.init(KVROWS, 4096, F.G, (int)blockIdx.x, 64);
          pg8::EpiPlainI8 E{(pg8::bf16_t*)(ws + WS_KV), 4096, (const float*)(ws + WS_ROWSKV), (const unsigned*)(ws + WS_CMAXUKV)};
          pg8::gemm_phase<pg8::EpiPlainI8, pg8::StaticOrder, true, true, 2>(ring, g, S, E); }
    }
    SEAM(4);
    if (IN(5)) { p5_qkprep(args, F); }
    SEAM(5);
    if (IN(6)) { p5_scan(args, F); __syncthreads(); p6_attention(args, F); }
    SEAM(6);
    if (IN(7)) { p7_postscan(args, F); }
    SEAM(7);
    if (IN(8)) {
#pragma unroll
        for (int gb = 0; gb < 2; ++gb) {
            int k8 = DM / 2; asm volatile("" : "+s"(k8));
            pg8::Gemm g{(const pg8::bf16_t*)(ws + WS_H1Q), (const pg8::bf16_t*)(ws + WS_WGATE8 + (size_t)gb * 4096 * DM), T, DM, k8}; pg8::StaticOrder S; S.init(T, DM, F.G, (int)blockIdx.x);
            pg8::EpiGate8 E{(unsigned char*)(ws + WS_GA), (unsigned char*)(ws + WS_GB), (const float*)(ws + WS_ROWS1), (const unsigned*)(ws + WS_CMAXG), (pg8::f16_t*)(ws + WS_RKV), (pg8::bf16_t*)(ws + WS_LG), (float*)(ws + WS_QLAT), 16 * gb};
            pg8::gemm_phase<pg8::EpiGate8, pg8::StaticOrder, true, true, 2>(ring, g, S, E); }
        asm volatile("s_waitcnt vmcnt(0)" ::: "memory"); __syncthreads();
        { int k8 = DA / 2; asm volatile("" : "+s"(k8));
          pg8::Gemm g{(const pg8::bf16_t*)(ws + WS_YA), (const pg8::bf16_t*)(ws + WS_WOR), T, DM, k8}; pg8::StaticOrder S; S.init(T, DM, F.G, (int)blockIdx.x);
          pg8::EpiMix1I8 E{(const unsigned char*)(ws + WS_GA), (pg8::bf16_t*)(ws + WS_TMP), (const float*)(ws + WS_ROWSYA), (const unsigned*)(ws + WS_CMAXR)};
          pg8::gemm_phase<pg8::EpiMix1I8, pg8::StaticOrder, true, true, 2>(ring, g, S, E); }
        { int k8 = DA / 2; asm volatile("" : "+s"(k8));
          pg8::Gemm g{(const pg8::bf16_t*)(ws + WS_YB8), (const pg8::bf16_t*)(ws + WS_WOM), T, DM, k8}; pg8::StaticOrder S; S.init(T, DM, F.G, (int)blockIdx.x);
          pg8::EpiMix2I8 E{(const unsigned char*)(ws + WS_GB), (const pg8::bf16_t*)(ws + WS_TMP), (pg8::bf16_t*)(ws + WS_MIXED), (unsigned*)(ws + WS_RMAXM), (const float*)(ws + WS_ROWSYB), (const unsigned*)(ws + WS_CMAXM)};
          pg8::gemm_phase<pg8::EpiMix2I8, pg8::StaticOrder, true, true, 2>(ring, g, S, E); }
    }
    SEAM(8);
    if (IN(9)) { p8c_quant_mixed(args, F); }
    SEAM(9);
    if (IN(10)) {
        int k8 = DM / 2; asm volatile("" : "+s"(k8));
        pg8::Gemm g{(const pg8::bf16_t*)(ws + WS_MIX8), (const pg8::bf16_t*)(ws + WS_WOUT), T, DM, k8}; pg8::StaticOrder S; S.init(T, DM, F.G, (int)blockIdx.x);
        pg8::EpiResI8 E{args.in[I_XP], args.in[I_XS], (pg8::bf16_t*)(ws + WS_X1), MOD + 2 * DM, (const float*)(ws + WS_ROWSM), (const unsigned*)(ws + WS_CMAXO)};
        pg8::gemm_phase<pg8::EpiResI8, pg8::StaticOrder, true, true, 2>(ring, g, S, E);
    }
    SEAM(10);
    if (IN(11)) { modnorm_rows_i8(F, (const bf16*)(ws + WS_X1), args.in[I_NFFN], MOD, 3, (unsigned char*)(ws + WS_HB), (float*)(ws + WS_ROWS)); }
    SEAM(11);
    if (IN(12)) {
        int k8 = DM / 2; asm volatile("" : "+s"(k8));
        pg8::Gemm g{(const pg8::bf16_t*)(ws + WS_HB), (const pg8::bf16_t*)(ws + WS_WFI), T, 2 * DFF, k8}; pg8::StaticOrder S; S.init(T, 2 * DFF, F.G, (int)blockIdx.x);
        pg8::EpiSwigluI8 E{(unsigned char*)(ws + WS_ACT), (const float*)(ws + WS_ROWS), (const unsigned*)(ws + WS_CMAX)};
        pg8::gemm_phase<pg8::EpiSwigluI8, pg8::StaticOrder, true, true, 2>(ring, g, S, E);
    }
    SEAM(12);
    if (IN(13)) {
        int k8 = DFF / 2; asm volatile("" : "+s"(k8));
        pg8::Gemm g{(const pg8::bf16_t*)(ws + WS_ACT), (const pg8::bf16_t*)(ws + WS_WFO), T, DM, k8}; pg8::StaticOrder S; S.init(T, DM, F.G, (int)blockIdx.x);
        pg8::EpiRes E{(const pg8::bf16_t*)(ws + WS_X1), args.out, MOD + 5 * DM, 0.0078125f};
        pg8::gemm_phase<pg8::EpiRes, pg8::StaticOrder, true, true, 1>(ring, g, S, E);
    }
#undef IN
#undef SEAM
}

extern "C" void kernel_launch(void* const* d_in, const int* in_sizes, int n_in, void* d_out, int out_size, void* d_ws, size_t ws_size, hipStream_t stream) {
    static int grid = 0;
    if (grid == 0) {
        if (n_in != 33 || ws_size < WS_END) { fprintf(stderr, "kernel_launch: n_in %d ws %zu (need 33 inputs, >= %zu bytes)\n", n_in, ws_size, (size_t)WS_END); grid = -1; return; }
        if (hipFuncSetAttribute((const void*)fwd_kernel, hipFuncAttributeMaxDynamicSharedMemorySize, LDS_BYTES) != hipSuccess) { fprintf(stderr, "kernel_launch: hipFuncSetAttribute failed\n"); grid = -1; return; }
        int per_cu = 0;
        if (hipOccupancyMaxActiveBlocksPerMultiprocessor(&per_cu, (const void*)fwd_kernel, NWAVES * 64, LDS_BYTES) != hipSuccess || per_cu < 1) fprintf(stderr, "kernel_launch: occupancy query reports %d\n", per_cu);
        (void)hipGetLastError();
        grid = 256;
    }
    if (grid < 0) return;
    if (hipMemsetAsync((char*)d_ws + WS_CTL, 0, CTL_ZERO_BYTES, stream) != hipSuccess) return;
    Args a{};
    for (int i = 0; i < 33; ++i) a.in[i] = (const float*)d_in[i];
    a.out = (float*)d_out; a.ws = (unsigned char*)d_ws;
#if MK_PER_PHASE
    for (int p = 0; p < N_PHASES; ++p) { a.ph_lo = p; a.ph_hi = p + 1; hipLaunchKernelGGL(fwd_kernel, dim3(grid), dim3(NWAVES * 64), LDS_BYTES, stream, a); }
#else
    a.ph_lo = 0; a.ph_hi = N_PHASES; hipLaunchKernelGGL(fwd_kernel, dim3(grid), dim3(NWAVES * 64), LDS_BYTES, stream, a);
#endif
    const hipError_t le = hipPeekAtLastError();
    if (le != hipSuccess) fprintf(stderr, "kernel_launch: launch failed: %s\n", hipGetErrorName(le));
}
```

```cpp
#include <hip/hip_runtime.h>
#include <cstdio>
#include <cstdint>
namespace pg8 {
#define PG8_LAS __attribute__((address_space(3)))
typedef unsigned short bf16_t;
typedef short bf16x8 __attribute__((ext_vector_type(8)));
typedef float f32x4 __attribute__((ext_vector_type(4)));
typedef unsigned u32x4 __attribute__((ext_vector_type(4)));
constexpr int BM = 256, BK = 64, HALF = 128, HTB = HALF * BK * 2  , STAGE_BYTES = 8 * HTB, NXCD = 8, WGM = 8;

__host__ __device__ __forceinline__ int lds_byte(int r, int c) { const int st = (r >> 4) * 2 + (c >> 5), rr = r & 15, cc = c & 31, ob = rr * 64 + cc * 2; return st * 1024 + (ob ^ (((ob >> 9) & 1) << 5)); }
__host__ __device__ __forceinline__ void stage_rc(int b, int& R, int& C) { const int st = b / 1024, sb = b % 1024, swz = sb ^ (((sb >> 9) & 1) << 5); R = (st >> 1) * 16 + swz / 64; C = (st & 1) * 32 + (swz % 64) / 2; }
__host__ __device__ __forceinline__ int perm32(int rho) { const int n = rho >> 4, i = rho & 15; return 8 * (i >> 2) + 4 * n + (i & 3); }

struct Unit { int pm, pn; };
struct Gemm { const bf16_t* A; const bf16_t* Bt; int M, N, K; };

struct StaticOrder {
    int nM, nN, nwg, G, c;
    __host__ __device__ void init(int M, int N, int G_, int c_, int rot = 0) { nM = M / BM; nN = N / BM; nwg = nM * nN; G = G_; c = (c_ + rot) % G_; }
    __host__ __device__ bool next(int i, Unit& u) const {
        const long L = (long)i * G + c; if (L >= nwg) return false;
        int wgid = (int)L; { const int q = nwg / NXCD, r = nwg % NXCD, xcd = wgid % NXCD, off = wgid / NXCD; wgid = (xcd < r ? xcd * (q + 1) : r * (q + 1) + (xcd - r) * q) + off; }
        const int nig = WGM * nN, gid = wgid / nig, fm = gid * WGM, gsz = (nM - fm) < WGM ? (nM - fm) : WGM;
        u.pm = fm + ((wgid % nig) % gsz); u.pn = (wgid % nig) / gsz; return true;
    }
    __device__ __forceinline__ void a_ready(const Unit&) const {}
    __device__ __forceinline__ void done(const Unit&) const {}
};

typedef float cvt_f32x2_t __attribute__((ext_vector_type(2)));
typedef __bf16 cvt_bf16x2_t __attribute__((ext_vector_type(2)));
__device__ __forceinline__ unsigned cvt_pk_bf16(float lo, float hi) { cvt_f32x2_t v = {lo, hi}; cvt_bf16x2_t b = __builtin_convertvector(v, cvt_bf16x2_t); return __builtin_bit_cast(unsigned, b); }
typedef float f32x2 __attribute__((ext_vector_type(2)));
template <class Epi, class Sched, bool ALIGN_EPI = false, bool SP2 = false, int MODE = 0>
__device__ __forceinline__ void gemm_phase(PG8_LAS unsigned char* lds, const Gemm g, const Sched& S, const Epi& E) {
    int tid_o = threadIdx.x; asm volatile("" : "+v"(tid_o));
    const int tid = tid_o, wid = __builtin_amdgcn_readfirstlane(tid >> 6), lane = tid & 63, wr = wid >> 2, wc = wid & 3, fr = lane & 15, fq = lane >> 4;
    const int K = g.K, nt = K / BK;
    unsigned voffA[2], voffB[2];
#pragma unroll
    for (int i = 0; i < 2; ++i) { int R, C; stage_rc(tid * 16 + i * 8192, R, C); const int Rb = Epi::PERM ? ((R & ~31) + perm32(R & 31)) : R;
        voffA[i] = (unsigned)(R * K + C) * 2u; voffB[i] = (unsigned)(Rb * K + C) * 2u; }
    const size_t kstep = (size_t)(BK * 2);
    const size_t hstep = (size_t)HALF * K * 2;
    const size_t tstep = 2 * hstep;
    const unsigned ldsw = (unsigned)wid * 1024u;
    const int aoff = lds_byte(wr * 64 + fr, fq * 8), boff = lds_byte(wc * 32 + fr, fq * 8);
#define PG8_SA(b, h) (((b) * 2 + (h)) * HTB)
#define PG8_SB(b, h) ((4 + (b) * 2 + (h)) * HTB)
#define PG8_STAGE(bufoff, gbase, voff) do { _Pragma("unroll") for (int _i = 0; _i < 2; ++_i) \
        __builtin_amdgcn_global_load_lds((const unsigned*)((const char*)(gbase) + (voff)[_i]), (PG8_LAS unsigned*)(lds + (bufoff) + ldsw + _i * 8192), 16, 0, 0); } while (0)
#define PG8_LDA(dst, b, h) do { _Pragma("unroll") for (int m = 0; m < 4; ++m) { dst[m].lo = *(const PG8_LAS bf16x8*)(lds + PG8_SA(b, h) + aoff + m * 2048); dst[m].hi = *(const PG8_LAS bf16x8*)(lds + PG8_SA(b, h) + aoff + m * 2048 + 1024); } } while (0)
#define PG8_LDB(dst, b, h) do { _Pragma("unroll") for (int n = 0; n < 2; ++n) { dst[n].lo = *(const PG8_LAS bf16x8*)(lds + PG8_SB(b, h) + boff + n * 2048); dst[n].hi = *(const PG8_LAS bf16x8*)(lds + PG8_SB(b, h) + boff + n * 2048 + 1024); } } while (0)
#define PG8_MMA(ai, bj, At, Bt) do { __builtin_amdgcn_s_setprio(1); _Pragma("unroll") for (int m = 0; m < 4; ++m) _Pragma("unroll") for (int n = 0; n < 2; ++n) { \
        if constexpr (MODE == 1) { typedef int v8i_t __attribute__((ext_vector_type(8))); \
            asm("v_mfma_scale_f32_16x16x128_f8f6f4 %0, %1, %2, %0, %3, %3 op_sel_hi:[0,0,0]" : "+v"(acc[ai][bj][m][n]) : "v"(__builtin_bit_cast(v8i_t, Bt[n])), "v"(__builtin_bit_cast(v8i_t, At[m])), "v"(f8_unit_scale)); } \
        else if constexpr (MODE == 2) { typedef int v4i_t __attribute__((ext_vector_type(4))); \
            v4i_t c_ = __builtin_bit_cast(v4i_t, acc[ai][bj][m][n]); \
            const bf16x8 bl_ = Bt[n].lo, bh_ = Bt[n].hi, al_ = At[m].lo, ah_ = At[m].hi;     \
            c_ = __builtin_amdgcn_mfma_i32_16x16x64_i8(__builtin_bit_cast(v4i_t, bl_), __builtin_bit_cast(v4i_t, al_), c_, 0, 0, 0); \
            c_ = __builtin_amdgcn_mfma_i32_16x16x64_i8(__builtin_bit_cast(v4i_t, bh_), __builtin_bit_cast(v4i_t, ah_), c_, 0, 0, 0); \
            acc[ai][bj][m][n] = __builtin_bit_cast(f32x4, c_); } \
        else { acc[ai][bj][m][n] = __builtin_amdgcn_mfma_f32_16x16x32_bf16(Bt[n].lo, At[m].lo, acc[ai][bj][m][n], 0, 0, 0); \
               acc[ai][bj][m][n] = __builtin_amdgcn_mfma_f32_16x16x32_bf16(Bt[n].hi, At[m].hi, acc[ai][bj][m][n], 0, 0, 0); } } \
        __builtin_amdgcn_s_setprio(0); } while (0)
#define PG8_WAIT_V(n) asm volatile("s_waitcnt vmcnt(" #n ")" ::: "memory")
#define PG8_WAIT_L(n) asm volatile("s_waitcnt lgkmcnt(" #n ")" ::: "memory")
#define PG8_BAR __builtin_amdgcn_s_barrier()
#define PG8_SCHED __builtin_amdgcn_sched_barrier(0)
    Unit cur, nxt; int ui = 0;
    if (!S.next(0, cur)) return;
    f32x4 acc[2][2][4][2];
#pragma unroll
    for (int a = 0; a < 2; ++a)
#pragma unroll
        for (int b = 0; b < 2; ++b)
#pragma unroll
            for (int m = 0; m < 4; ++m)
#pragma unroll
                for (int n = 0; n < 2; ++n) acc[a][b][m][n] = (f32x4){0.f, 0.f, 0.f, 0.f};
    const int f8_unit_scale = 0x7F7F7F7F;
    typedef short bf16x16 __attribute__((ext_vector_type(16)));
    bf16x16 At[4], B0[2], B1[2];
    const char* cA = (const char*)g.A + (size_t)cur.pm * tstep; const char* cB = (const char*)g.Bt + (size_t)cur.pn * tstep;
    S.a_ready(cur);
    if constexpr (SP2) {
        PG8_STAGE(PG8_SB(0, 0), cB, voffB); PG8_STAGE(PG8_SB(0, 1), cB + hstep, voffB); PG8_STAGE(PG8_SA(0, 0), cA, voffA); PG8_STAGE(PG8_SA(0, 1), cA + hstep, voffA);
        if (wr == 1) PG8_BAR;
        PG8_WAIT_V(2); PG8_BAR;
        PG8_STAGE(PG8_SB(1, 0), cB + kstep, voffB); PG8_STAGE(PG8_SA(1, 0), cA + kstep, voffA); PG8_STAGE(PG8_SB(1, 1), cB + hstep + kstep, voffB);
        PG8_WAIT_V(6); PG8_BAR;
    } else {
        PG8_STAGE(PG8_SB(0, 0), cB, voffB); PG8_STAGE(PG8_SA(0, 0), cA, voffA); PG8_STAGE(PG8_SB(0, 1), cB + hstep, voffB); PG8_STAGE(PG8_SA(0, 1), cA + hstep, voffA);
        if (wr == 1) PG8_BAR;
        PG8_WAIT_V(4); PG8_BAR;
        PG8_STAGE(PG8_SB(1, 0), cB + kstep, voffB); PG8_STAGE(PG8_SA(1, 0), cA + kstep, voffA); PG8_STAGE(PG8_SB(1, 1), cB + hstep + kstep, voffB);
        PG8_WAIT_V(6); PG8_BAR;
    }
    for (;;) {
        const bool has_next = S.next(ui + 1, nxt);
        const char* nA = has_next ? (const char*)g.A + (size_t)nxt.pm * tstep : cA; const char* nB = has_next ? (const char*)g.Bt + (size_t)nxt.pn * tstep : cB;
        for (int t = 0; t < nt; t += 2) {
            const bool last = (t == nt - 2);
            const char* a1 = cA + (size_t)(t + 1) * kstep;
            const char* a2 = last ? nA : cA + (size_t)(t + 2) * kstep; const char* b2 = last ? nB : cB + (size_t)(t + 2) * kstep;
            const char* a3 = a2 + kstep; const char* b3 = b2 + kstep;
            if (last && has_next) S.a_ready(nxt);
            if constexpr (SP2) {
            PG8_LDB(B0, 0, 0); PG8_LDB(B1, 0, 1); PG8_SCHED; PG8_LDA(At, 0, 0); PG8_STAGE(PG8_SA(1, 1), a1 + hstep, voffA);
            PG8_WAIT_V(8); PG8_WAIT_L(0); PG8_BAR; PG8_MMA(0, 0, At, B0); PG8_MMA(0, 1, At, B1); PG8_BAR; PG8_SCHED;
            PG8_LDA(At, 0, 1); PG8_STAGE(PG8_SB(0, 0), b2, voffB); PG8_STAGE(PG8_SB(0, 1), b2 + hstep, voffB); PG8_STAGE(PG8_SA(0, 0), a2, voffA);
            PG8_WAIT_V(8); PG8_WAIT_L(0); PG8_BAR; PG8_MMA(1, 0, At, B0); PG8_MMA(1, 1, At, B1); PG8_BAR; PG8_SCHED;
            PG8_LDB(B0, 1, 0); PG8_LDB(B1, 1, 1); PG8_SCHED; PG8_LDA(At, 1, 0); PG8_STAGE(PG8_SA(0, 1), a2 + hstep, voffA);
            PG8_WAIT_V(8); PG8_WAIT_L(0); PG8_BAR; PG8_MMA(0, 0, At, B0); PG8_MMA(0, 1, At, B1); PG8_BAR; PG8_SCHED;
            PG8_LDA(At, 1, 1); PG8_STAGE(PG8_SB(1, 0), b3, voffB); PG8_STAGE(PG8_SB(1, 1), b3 + hstep, voffB); PG8_STAGE(PG8_SA(1, 0), a3, voffA);
            PG8_WAIT_V(8); PG8_WAIT_L(0); PG8_BAR; PG8_MMA(1, 0, At, B0); PG8_MMA(1, 1, At, B1); PG8_BAR; PG8_SCHED;
            } else {
            PG8_LDB(B0, 0, 0); PG8_SCHED; PG8_LDA(At, 0, 0); PG8_STAGE(PG8_SA(1, 1), a1 + hstep, voffA);
            PG8_WAIT_L(8); PG8_BAR; PG8_WAIT_L(0); PG8_MMA(0, 0, At, B0); PG8_BAR; PG8_SCHED;
            PG8_LDB(B1, 0, 1); PG8_STAGE(PG8_SB(0, 0), b2, voffB);
            PG8_BAR; PG8_WAIT_L(0); PG8_MMA(0, 1, At, B1); PG8_BAR;
            PG8_LDA(At, 0, 1); PG8_STAGE(PG8_SA(0, 0), a2, voffA);
            PG8_BAR; PG8_WAIT_L(0); PG8_MMA(1, 0, At, B0); PG8_BAR; PG8_SCHED;
            PG8_STAGE(PG8_SB(0, 1), b2 + hstep, voffB);
            PG8_WAIT_V(6); PG8_BAR; PG8_MMA(1, 1, At, B1); PG8_BAR;
            PG8_LDB(B0, 1, 0); PG8_SCHED; PG8_LDA(At, 1, 0); PG8_STAGE(PG8_SA(0, 1), a2 + hstep, voffA);
            PG8_WAIT_L(8); PG8_BAR; PG8_WAIT_L(0); PG8_MMA(0, 0, At, B0); PG8_BAR; PG8_SCHED;
            PG8_LDB(B1, 1, 1); PG8_STAGE(PG8_SB(1, 0), b3, voffB);
            PG8_BAR; PG8_WAIT_L(0); PG8_MMA(0, 1, At, B1); PG8_BAR;
            PG8_LDA(At, 1, 1); PG8_STAGE(PG8_SA(1, 0), a3, voffA);
            PG8_BAR; PG8_WAIT_L(0); PG8_MMA(1, 0, At, B0); PG8_BAR; PG8_SCHED;
            PG8_STAGE(PG8_SB(1, 1), b3 + hstep, voffB);
            PG8_WAIT_V(6); PG8_BAR; PG8_MMA(1, 1, At, B1); PG8_BAR;
            }
        }
        if constexpr (MODE == 1) asm volatile("s_nop 15\n\ts_nop 15" ::: "memory");
        if constexpr (ALIGN_EPI) { if (wr == 0) PG8_BAR; }
        if constexpr (!Epi::AFTER_DRAIN) { E(acc, cur, wr, wc, fr, fq); S.done(cur); }
        if (!has_next) break;
#pragma unroll
        for (int a = 0; a < 2; ++a)
#pragma unroll
            for (int b = 0; b < 2; ++b)
#pragma unroll
                for (int m = 0; m < 4; ++m)
#pragma unroll
                    for (int n = 0; n < 2; ++n) acc[a][b][m][n] = (f32x4){0.f, 0.f, 0.f, 0.f};
        cur = nxt; cA = nA; cB = nB; ++ui;
        if constexpr (ALIGN_EPI) { if (wr == 1) PG8_BAR; }
    }
    PG8_WAIT_V(0);
    if constexpr (!ALIGN_EPI) { if (wr == 0) PG8_BAR; }
    PG8_BAR;
    if constexpr (Epi::AFTER_DRAIN) { E.fused(acc, cur, wr, wc, fr, fq, lds, wid, lane); S.done(cur); }
#undef PG8_SA
#undef PG8_SB
#undef PG8_STAGE
#undef PG8_LDA
#undef PG8_LDB
#undef PG8_MMA
#undef PG8_WAIT_V
#undef PG8_WAIT_L
#undef PG8_BAR
#undef PG8_SCHED
}
}
constexpr int T_P = 8192, T_S = 4096, T = T_P + T_S;
constexpr int DM = 4096, DA = 2048, DFF = 11008, NIN = 17152  , KVROWS = 14336;
constexpr int QL = 1024, KVL = 512, NMOD = 6 * DM;
constexpr float NORM_EPS = 1e-6f;

namespace pg8 {
typedef _Float16 f16_t;
typedef _Float16 f16x2 __attribute__((ext_vector_type(2)));
typedef unsigned u32x2 __attribute__((ext_vector_type(2)));
__device__ __forceinline__ float ubf(unsigned u) { return __builtin_bit_cast(float, u); }
__device__ __forceinline__ float sigm(float x) { return __builtin_amdgcn_rcpf(1.0f + __builtin_amdgcn_exp2f(-1.4426950408889634f * x)); }
__device__ __forceinline__ f32x4 sigm4(f32x4 v) { return (f32x4){sigm(v[0]), sigm(v[1]), sigm(v[2]), sigm(v[3])}; }
__device__ __forceinline__ unsigned pk_f16(float lo, float hi) { f16x2 h = {(f16_t)lo, (f16_t)hi}; return __builtin_bit_cast(unsigned, h); }
__device__ __forceinline__ u32x4 pack_bf16x8(f32x4 a, f32x4 b) { u32x4 w; w.x = cvt_pk_bf16(a[0], a[1]); w.y = cvt_pk_bf16(a[2], a[3]); w.z = cvt_pk_bf16(b[0], b[1]); w.w = cvt_pk_bf16(b[2], b[3]); return w; }
__device__ __forceinline__ u32x4 pack_f16x8(f32x4 a, f32x4 b) { u32x4 w; w.x = pk_f16(a[0], a[1]); w.y = pk_f16(a[2], a[3]); w.z = pk_f16(b[0], b[1]); w.w = pk_f16(b[2], b[3]); return w; }
__device__ __forceinline__ unsigned pack_u8x4(f32x4 v, float sc) {
    const unsigned q0 = __builtin_bit_cast(unsigned, __builtin_fmaf(v[0], sc, 12582912.0f)), q1 = __builtin_bit_cast(unsigned, __builtin_fmaf(v[1], sc, 12582912.0f));
    const unsigned q2 = __builtin_bit_cast(unsigned, __builtin_fmaf(v[2], sc, 12582912.0f)), q3 = __builtin_bit_cast(unsigned, __builtin_fmaf(v[3], sc, 12582912.0f));
    return __builtin_amdgcn_perm(q1, q0, 0x0c0c0400u) | __builtin_amdgcn_perm(q3, q2, 0x04000c0cu); }
__device__ __forceinline__ f32x4 unpack_u8x4(unsigned w) { return (f32x4){(float)(w & 0xffu), (float)((w >> 8) & 0xffu), (float)((w >> 16) & 0xffu), (float)(w >> 24)}; }
__device__ __forceinline__ float bflo(unsigned w) { return __builtin_bit_cast(float, w << 16); }
__device__ __forceinline__ float bfhi(unsigned w) { return __builtin_bit_cast(float, w & 0xffff0000u); }
__device__ __forceinline__ void unpack_bf16x8(u32x4 w, f32x4& a, f32x4& b) { a = (f32x4){bflo(w.x), bfhi(w.x), bflo(w.y), bfhi(w.y)}; b = (f32x4){bflo(w.z), bfhi(w.z), bflo(w.w), bfhi(w.w)}; }

struct BatchedOrder {
    int nM, nN, nb, G, c;
    __device__ void init(int nM_, int nN_, int nb_, int G_, int c_) { nM = nM_; nN = nN_; nb = nb_; G = G_; c = c_; }
    __device__ bool next(int i, Unit& u) const {
        const int L = i * G + c; const int per = nM * nN; if (L >= per * nb) return false;
        const int b = L / per, l = L - b * per;
        u.pm = b * nM + (l % nM); u.pn = b * nN + (l / nM); return true;
    }
    __device__ __forceinline__ void a_ready(const Unit&) const {}
    __device__ __forceinline__ void done(const Unit&) const {}
};

#define EPI_LANE() int tid_ = (int)threadIdx.x; asm volatile("" : "+v"(tid_)); const int fr_ = tid_ & 15, fq_ = (tid_ >> 4) & 3
#define EPI_LOOP(...) \
    _Pragma("unroll") for (int ai = 0; ai < 2; ++ai) _Pragma("unroll") for (int m = 0; m < 4; ++m) { const int row = row0 + ai * HALF + m * 16; \
    _Pragma("unroll") for (int bj = 0; bj < 2; ++bj) { const f32x4 v0 = acc[ai][bj][m][0], v1 = acc[ai][bj][m][1]; const int colt = bj * HALF + cl; __VA_ARGS__ } }

struct EpiIn {
    static constexpr bool PERM = true, AFTER_DRAIN = false;
    f16_t* RKV; bf16_t* LWA; bf16_t* LG; float* QLAT; float* KVLAT; float* KPE; bf16_t* GA; bf16_t* GB;
    __device__ __forceinline__ void operator()(const f32x4 (&acc)[2][2][4][2], const Unit& u, int wr, int wc, int fr, int fq) const {
        EPI_LANE(); const int pn = u.pn < 16 ? 8 + u.pn : (u.pn < 18 ? 8 + u.pn : 14 + u.pn);
        const int row0 = u.pm * BM + wr * 64 + fr_, cl = wc * 32 + 8 * fq_;
        if (pn < 24) {
            EPI_LOOP( *(u32x4*)(RKV + (size_t)row * 6144 + pn * 256 + colt) = pack_f16x8(v0, v1); )
        } else if (pn == 24) {
            EPI_LOOP( f32x4 a = sigm4(v0 * 2.0f) * 2.0f - 1.0f, b = sigm4(v1 * 2.0f) * 2.0f - 1.0f; *(u32x4*)(LWA + ((size_t)bj * T + row) * 256 + cl) = pack_bf16x8(a, b); )
        } else if (pn == 25) {
            EPI_LOOP( *(u32x4*)(LWA + ((size_t)bj * T + row) * 256 + 128 + cl) = pack_bf16x8(v0, v1); )
        } else if (pn < 28) {
            EPI_LOOP( *(u32x4*)(LG + (size_t)row * 512 + (pn - 26) * 256 + colt) = pack_bf16x8(sigm4(v0), sigm4(v1)); )
        } else if (pn < 32) {
            EPI_LOOP( float* p = QLAT + (size_t)row * QL + (pn - 28) * 256 + colt; *(f32x4*)p = v0; *(f32x4*)(p + 4) = v1; )
        } else if (pn < 34) {
            EPI_LOOP( float* p = KVLAT + (size_t)row * KVL + (pn - 32) * 256 + colt; *(f32x4*)p = v0; *(f32x4*)(p + 4) = v1; )
        } else if (pn == 34) {
            EPI_LOOP( if (colt < 64) { float* p = KPE + (size_t)row * 64 + colt; *(f32x4*)p = v0; *(f32x4*)(p + 4) = v1; } )
        } else if (pn < 51) {
            EPI_LOOP( *(u32x4*)(GA + (size_t)row * DM + (pn - 35) * 256 + colt) = pack_bf16x8(sigm4(v0), sigm4(v1)); )
        } else {
            EPI_LOOP( *(u32x4*)(GB + (size_t)row * DM + (pn - 51) * 256 + colt) = pack_bf16x8(sigm4(v0), sigm4(v1)); )
        }
    }
};

struct EpiLora {
    static constexpr bool PERM = true, AFTER_DRAIN = false;
    unsigned char* EWAA; const float* lbias;
    __device__ __forceinline__ void operator()(const f32x4 (&acc)[2][2][4][2], const Unit& u, int wr, int wc, int fr, int fq) const {
        EPI_LANE(); const int dir = u.pn >> 4, jn = u.pn & 15, row0 = (u.pm - dir * (T / BM)) * BM + wr * 64 + fr_, cl = wc * 32 + 8 * fq_;
        const int isa = jn >> 3;
        const float* bias = lbias + isa * (2 * DA) + dir * DA + (jn & 7) * 256; unsigned char* O = EWAA + (size_t)(isa * 2 + dir) * T * DA + (jn & 7) * 256;
        f32x4 bv[2][2];
#pragma unroll
        for (int bj = 0; bj < 2; ++bj) { bv[bj][0] = *(const f32x4*)(bias + bj * HALF + cl); bv[bj][1] = *(const f32x4*)(bias + bj * HALF + cl + 4); }
        EPI_LOOP( u32x2 w; w.x = pack_u8x4(sigm4(v0 + bv[bj][0]), 255.0f); w.y = pack_u8x4(sigm4(v1 + bv[bj][1]), 255.0f); *(u32x2*)(O + (size_t)row * DA + colt) = w; )
    }
};

struct EpiPlain {
    static constexpr bool PERM = true, AFTER_DRAIN = false;
    bf16_t* O; int ldc;
    __device__ __forceinline__ void operator()(const f32x4 (&acc)[2][2][4][2], const Unit& u, int wr, int wc, int fr, int fq) const {
        EPI_LANE(); const int row0 = u.pm * BM + wr * 64 + fr_, cl = wc * 32 + 8 * fq_;
        EPI_LOOP( *(u32x4*)(O + (size_t)row * ldc + u.pn * 256 + colt) = pack_bf16x8(v0, v1); )
    }
};

struct EpiPlainI8 {
    static constexpr bool PERM = true, AFTER_DRAIN = false;
    bf16_t* O; int ldc; const float* rows; const unsigned* cmax;
    __device__ __forceinline__ void operator()(const f32x4 (&acc)[2][2][4][2], const Unit& u, int wr, int wc, int fr, int fq) const {
        typedef int v4i_t __attribute__((ext_vector_type(4)));
        EPI_LANE(); const int row0 = u.pm * BM + wr * 64 + fr_, cl = wc * 32 + 8 * fq_;
        f32x4 cs[2][2];
#pragma unroll
        for (int bj = 0; bj < 2; ++bj)
#pragma unroll
            for (int n = 0; n < 2; ++n) { const u32x4 m4 = *(const u32x4*)(cmax + u.pn * 256 + bj * HALF + cl + 4 * n);
                cs[bj][n] = (f32x4){ubf(m4.x), ubf(m4.y), ubf(m4.z), ubf(m4.w)} * (1.0f / 127.0f); }
        float rs8[2][4];
#pragma unroll
        for (int ai = 0; ai < 2; ++ai)
#pragma unroll
            for (int m = 0; m < 4; ++m) rs8[ai][m] = rows[row0 + ai * HALF + m * 16];
#pragma unroll
        for (int ai = 0; ai < 2; ++ai)
#pragma unroll
            for (int m = 0; m < 4; ++m) { const int row = row0 + ai * HALF + m * 16; const float rs = rs8[ai][m];
#pragma unroll
                for (int bj = 0; bj < 2; ++bj) { const v4i_t c0 = __builtin_bit_cast(v4i_t, acc[ai][bj][m][0]), c1 = __builtin_bit_cast(v4i_t, acc[ai][bj][m][1]);
                    const f32x4 v0 = (f32x4){(float)c0[0], (float)c0[1], (float)c0[2], (float)c0[3]} * cs[bj][0] * rs, v1 = (f32x4){(float)c1[0], (float)c1[1], (float)c1[2], (float)c1[3]} * cs[bj][1] * rs;
                    *(u32x4*)(O + (size_t)row * ldc + u.pn * 256 + bj * HALF + cl) = pack_bf16x8(v0, v1); } }
    }
};
struct EpiMix1 {
    static constexpr bool PERM = true, AFTER_DRAIN = false;
    const bf16_t* GA; float* TMP;
    __device__ __forceinline__ void operator()(const f32x4 (&acc)[2][2][4][2], const Unit& u, int wr, int wc, int fr, int fq) const {
        EPI_LANE(); const int row0 = u.pm * BM + wr * 64 + fr_, cl = wc * 32 + 8 * fq_;
        EPI_LOOP( const size_t o = (size_t)row * DM + u.pn * 256 + colt; f32x4 g0, g1; unpack_bf16x8(*(const u32x4*)(GA + o), g0, g1); *(f32x4*)(TMP + o) = g0 * v0; *(f32x4*)(TMP + o + 4) = g1 * v1; )
    }
};
struct EpiMix2 {
    static constexpr bool PERM = true, AFTER_DRAIN = false;
    const bf16_t* GB; const float* TMP; bf16_t* MIXED; unsigned* rmax;
    __device__ __forceinline__ void operator()(const f32x4 (&acc)[2][2][4][2], const Unit& u, int wr, int wc, int fr, int fq) const {
        EPI_LANE(); const int row0 = u.pm * BM + wr * 64 + fr_, cl = wc * 32 + 8 * fq_;
#pragma unroll
        for (int ai = 0; ai < 2; ++ai)
#pragma unroll
            for (int m = 0; m < 4; ++m) { const int row = row0 + ai * HALF + m * 16; float mx = 0.f;
#pragma unroll
                for (int bj = 0; bj < 2; ++bj) { const f32x4 v0 = acc[ai][bj][m][0], v1 = acc[ai][bj][m][1]; const size_t o = (size_t)row * DM + u.pn * 256 + bj * HALF + cl;
                    f32x4 g0, g1; unpack_bf16x8(*(const u32x4*)(GB + o), g0, g1); const f32x4 t0 = *(const f32x4*)(TMP + o) + g0 * v0, t1 = *(const f32x4*)(TMP + o + 4) + g1 * v1;
                    *(u32x4*)(MIXED + o) = pack_bf16x8(t0, t1);
                    const f32x4 a0 = __builtin_elementwise_abs(t0), a1 = __builtin_elementwise_abs(t1); mx = fmaxf(mx, fmaxf(fmaxf(fmaxf(a0[0], a0[1]), fmaxf(a0[2], a0[3])), fmaxf(fmaxf(a1[0], a1[1]), fmaxf(a1[2], a1[3])))); }
                mx = fmaxf(mx, __shfl_xor(mx, 16)); mx = fmaxf(mx, __shfl_xor(mx, 32));
                if (fq_ == 0) atomicMax(rmax + row, __builtin_bit_cast(unsigned, mx)); }
    }
};
struct EpiRes {
    static constexpr bool PERM = true, AFTER_DRAIN = false;
    const bf16_t* x1; float* out; const float* gate; float accs;
    __device__ __forceinline__ void operator()(const f32x4 (&acc)[2][2][4][2], const Unit& u, int wr, int wc, int fr, int fq) const {
        EPI_LANE(); const int row0 = u.pm * BM + wr * 64 + fr_, cl = wc * 32 + 8 * fq_;
        const int rbase = u.pm * BM, mi = rbase < T_P ? 0 : 1 + ((rbase - T_P) >> 10);
        const float* gp = gate + (size_t)mi * NMOD + u.pn * 256;
        f32x4 gv[2][2];
#pragma unroll
        for (int bj = 0; bj < 2; ++bj) { gv[bj][0] = *(const f32x4*)(gp + bj * HALF + cl) * accs; gv[bj][1] = *(const f32x4*)(gp + bj * HALF + cl + 4) * accs; }
        EPI_LOOP( const size_t o = (size_t)row * DM + u.pn * 256 + colt; f32x4 b0, b1; unpack_bf16x8(*(const u32x4*)(x1 + o), b0, b1);
                  __builtin_nontemporal_store(b0 + gv[bj][0] * v0, (f32x4*)(out + o)); __builtin_nontemporal_store(b1 + gv[bj][1] * v1, (f32x4*)(out + o + 4)); )
    }
};
struct EpiSwiglu {
    static constexpr bool PERM = true, AFTER_DRAIN = false;
    unsigned char* ACT;
    __device__ __forceinline__ void operator()(const f32x4 (&acc)[2][2][4][2], const Unit& u, int wr, int wc, int fr, int fq) const {
        EPI_LANE(); const int row0 = u.pm * BM + wr * 64 + fr_, cl = wc * 32 + 8 * fq_;
#pragma unroll
        for (int ai = 0; ai < 2; ++ai)
#pragma unroll
            for (int m = 0; m < 4; ++m) { const int row = row0 + ai * HALF + m * 16;
                const f32x4 g0 = acc[ai][0][m][0], g1 = acc[ai][0][m][1], u0 = acc[ai][1][m][0], u1 = acc[ai][1][m][1];
                const f32x4 a0 = g0 * sigm4(g0) * u0, a1 = g1 * sigm4(g1) * u1;
                unsigned w0 = 0u, w1 = 0u;
                w0 = __builtin_amdgcn_cvt_pk_fp8_f32(a0[0], a0[1], w0, false); w0 = __builtin_amdgcn_cvt_pk_fp8_f32(a0[2], a0[3], w0, true);
                w1 = __builtin_amdgcn_cvt_pk_fp8_f32(a1[0], a1[1], w1, false); w1 = __builtin_amdgcn_cvt_pk_fp8_f32(a1[2], a1[3], w1, true);
                u32x2 pk; pk.x = w0; pk.y = w1; *(u32x2*)(ACT + (size_t)row * DFF + u.pn * 128 + cl) = pk; }
    }
};
struct EpiSwigluI8 {
    static constexpr bool PERM = true, AFTER_DRAIN = false;
    unsigned char* ACT; const float* rows; const unsigned* cmax;
    __device__ __forceinline__ void operator()(const f32x4 (&acc)[2][2][4][2], const Unit& u, int wr, int wc, int fr, int fq) const {
        typedef int v4i_t __attribute__((ext_vector_type(4)));
        EPI_LANE(); const int row0 = u.pm * BM + wr * 64 + fr_, cl = wc * 32 + 8 * fq_;
        f32x4 cs[2][2];
#pragma unroll
        for (int bj = 0; bj < 2; ++bj)
#pragma unroll
            for (int n = 0; n < 2; ++n) { const u32x4 m4 = *(const u32x4*)(cmax + bj * DFF + u.pn * 128 + cl + 4 * n);
                cs[bj][n] = (f32x4){ubf(m4.x), ubf(m4.y), ubf(m4.z), ubf(m4.w)} * (1.0f / 127.0f); }
        float rs8[2][4];
#pragma unroll
        for (int ai = 0; ai < 2; ++ai)
#pragma unroll
            for (int m = 0; m < 4; ++m) rs8[ai][m] = rows[row0 + ai * HALF + m * 16];
#pragma unroll
        for (int ai = 0; ai < 2; ++ai)
#pragma unroll
            for (int m = 0; m < 4; ++m) { const int row = row0 + ai * HALF + m * 16; const float rs = rs8[ai][m];
                f32x4 v[2][2];
#pragma unroll
                for (int bj = 0; bj < 2; ++bj)
#pragma unroll
                    for (int n = 0; n < 2; ++n) { const v4i_t c = __builtin_bit_cast(v4i_t, acc[ai][bj][m][n]); v[bj][n] = (f32x4){(float)c[0], (float)c[1], (float)c[2], (float)c[3]} * cs[bj][n] * rs; }
                const f32x4 a0 = v[0][0] * sigm4(v[0][0]) * v[1][0], a1 = v[0][1] * sigm4(v[0][1]) * v[1][1];
                unsigned w0 = 0u, w1 = 0u;
                w0 = __builtin_amdgcn_cvt_pk_fp8_f32(a0[0], a0[1], w0, false); w0 = __builtin_amdgcn_cvt_pk_fp8_f32(a0[2], a0[3], w0, true);
                w1 = __builtin_amdgcn_cvt_pk_fp8_f32(a1[0], a1[1], w1, false); w1 = __builtin_amdgcn_cvt_pk_fp8_f32(a1[2], a1[3], w1, true);
                u32x2 pk; pk.x = w0; pk.y = w1; *(u32x2*)(ACT + (size_t)row * DFF + u.pn * 128 + cl) = pk; }
    }
};
struct EpiGate8 {
    static constexpr bool PERM = true, AFTER_DRAIN = false;
    unsigned char* GA; unsigned char* GB; const float* rows;     const unsigned* cmax; f16_t* RKV; bf16_t* LG; float* QLAT; int pn0;
    __device__ __forceinline__ void operator()(const f32x4 (&acc)[2][2][4][2], const Unit& u, int wr, int wc, int fr, int fq) const {
        typedef int v4i_t __attribute__((ext_vector_type(4)));
        EPI_LANE(); const int row0 = u.pm * BM + wr * 64 + fr_, cl = wc * 32 + 8 * fq_, pn = u.pn + pn0;
        f32x4 cs[2][2];
#pragma unroll
        for (int bj = 0; bj < 2; ++bj)
#pragma unroll
            for (int n = 0; n < 2; ++n) { const u32x4 m4 = *(const u32x4*)(cmax + pn * 256 + bj * HALF + cl + 4 * n);
                cs[bj][n] = (f32x4){ubf(m4.x), ubf(m4.y), ubf(m4.z), ubf(m4.w)} * (1.0f / 127.0f); }
        float rs8[2][4];
#pragma unroll
        for (int ai = 0; ai < 2; ++ai)
#pragma unroll
            for (int m = 0; m < 4; ++m) rs8[ai][m] = rows[row0 + ai * HALF + m * 16];
#pragma unroll
        for (int ai = 0; ai < 2; ++ai)
#pragma unroll
            for (int m = 0; m < 4; ++m) { const int row = row0 + ai * HALF + m * 16; const float rs = rs8[ai][m];
#pragma unroll
                for (int bj = 0; bj < 2; ++bj) { const v4i_t c0 = __builtin_bit_cast(v4i_t, acc[ai][bj][m][0]), c1 = __builtin_bit_cast(v4i_t, acc[ai][bj][m][1]);
                    const f32x4 v0 = (f32x4){(float)c0[0], (float)c0[1], (float)c0[2], (float)c0[3]} * cs[bj][0] * rs, v1 = (f32x4){(float)c1[0], (float)c1[1], (float)c1[2], (float)c1[3]} * cs[bj][1] * rs;
                    const int colt = bj * HALF + cl;
                    if (pn < 32) { unsigned char* O = (pn < 16 ? GA : GB - (size_t)16 * 256) + pn * 256; u32x2 w; w.x = pack_u8x4(sigm4(v0), 255.0f); w.y = pack_u8x4(sigm4(v1), 255.0f); *(u32x2*)(O + (size_t)row * DM + colt) = w; }
                    else if (pn < 40) { *(u32x4*)(RKV + (size_t)row * 6144 + (pn - 32) * 256 + colt) = pack_f16x8(v0, v1); }
                    else if (pn < 42) { *(u32x4*)(LG + (size_t)row * 512 + (pn - 40) * 256 + colt) = pack_bf16x8(sigm4(v0), sigm4(v1)); }
                    else { *(u32x4*)((f16_t*)QLAT + (size_t)row * QL + (pn - 42) * 256 + colt) = pack_f16x8(v0, v1); } } }
    }
};
struct EpiMix1I8 {
    static constexpr bool PERM = true, AFTER_DRAIN = false;
    const unsigned char* GA; bf16_t* TMP;     const float* rows; const unsigned* cmax;
    __device__ __forceinline__ void operator()(const f32x4 (&acc)[2][2][4][2], const Unit& u, int wr, int wc, int fr, int fq) const {
        typedef int v4i_t __attribute__((ext_vector_type(4)));
        EPI_LANE(); const int row0 = u.pm * BM + wr * 64 + fr_, cl = wc * 32 + 8 * fq_;
        f32x4 cs[2][2];
#pragma unroll
        for (int bj = 0; bj < 2; ++bj)
#pragma unroll
            for (int n = 0; n < 2; ++n) { const u32x4 m4 = *(const u32x4*)(cmax + u.pn * 256 + bj * HALF + cl + 4 * n);
                cs[bj][n] = (f32x4){ubf(m4.x), ubf(m4.y), ubf(m4.z), ubf(m4.w)} * (1.0f / 127.0f); }
        float rs8[2][4];
#pragma unroll
        for (int ai = 0; ai < 2; ++ai)
#pragma unroll
            for (int m = 0; m < 4; ++m) rs8[ai][m] = rows[row0 + ai * HALF + m * 16];
#pragma unroll
        for (int ai = 0; ai < 2; ++ai)
#pragma unroll
            for (int m = 0; m < 4; ++m) { const int row = row0 + ai * HALF + m * 16; const float rs = rs8[ai][m];
#pragma unroll
                for (int bj = 0; bj < 2; ++bj) { const v4i_t c0 = __builtin_bit_cast(v4i_t, acc[ai][bj][m][0]), c1 = __builtin_bit_cast(v4i_t, acc[ai][bj][m][1]);
                    const f32x4 v0 = (f32x4){(float)c0[0], (float)c0[1], (float)c0[2], (float)c0[3]} * cs[bj][0] * rs, v1 = (f32x4){(float)c1[0], (float)c1[1], (float)c1[2], (float)c1[3]} * cs[bj][1] * rs;
                    const size_t o = (size_t)row * DM + u.pn * 256 + bj * HALF + cl; const u32x2 gw = *(const u32x2*)(GA + o); const f32x4 g0 = unpack_u8x4(gw.x) * (1.0f / 255.0f), g1 = unpack_u8x4(gw.y) * (1.0f / 255.0f);
                    *(u32x4*)(TMP + o) = pack_bf16x8(g0 * v0, g1 * v1); } }
    }
};
struct EpiMix2I8 {
    static constexpr bool PERM = true, AFTER_DRAIN = false;
    const unsigned char* GB; const bf16_t* TMP; bf16_t* MIXED; unsigned* rmax; const float* rows; const unsigned* cmax;
    __device__ __forceinline__ void operator()(const f32x4 (&acc)[2][2][4][2], const Unit& u, int wr, int wc, int fr, int fq) const {
        typedef int v4i_t __attribute__((ext_vector_type(4)));
        EPI_LANE(); const int row0 = u.pm * BM + wr * 64 + fr_, cl = wc * 32 + 8 * fq_;
        f32x4 cs[2][2];
#pragma unroll
        for (int bj = 0; bj < 2; ++bj)
#pragma unroll
            for (int n = 0; n < 2; ++n) { const u32x4 m4 = *(const u32x4*)(cmax + u.pn * 256 + bj * HALF + cl + 4 * n);
                cs[bj][n] = (f32x4){ubf(m4.x), ubf(m4.y), ubf(m4.z), ubf(m4.w)} * (1.0f / 127.0f); }
        float rs8[2][4];
#pragma unroll
        for (int ai = 0; ai < 2; ++ai)
#pragma unroll
            for (int m = 0; m < 4; ++m) rs8[ai][m] = rows[row0 + ai * HALF + m * 16];
#pragma unroll
        for (int ai = 0; ai < 2; ++ai)
#pragma unroll
            for (int m = 0; m < 4; ++m) { const int row = row0 + ai * HALF + m * 16; const float rs = rs8[ai][m]; float mx = 0.f;
#pragma unroll
                for (int bj = 0; bj < 2; ++bj) { const v4i_t c0 = __builtin_bit_cast(v4i_t, acc[ai][bj][m][0]), c1 = __builtin_bit_cast(v4i_t, acc[ai][bj][m][1]);
                    const f32x4 v0 = (f32x4){(float)c0[0], (float)c0[1], (float)c0[2], (float)c0[3]} * cs[bj][0] * rs, v1 = (f32x4){(float)c1[0], (float)c1[1], (float)c1[2], (float)c1[3]} * cs[bj][1] * rs;
                    const size_t o = (size_t)row * DM + u.pn * 256 + bj * HALF + cl;
                    const u32x2 gw = *(const u32x2*)(GB + o); const f32x4 g0 = unpack_u8x4(gw.x) * (1.0f / 255.0f), g1 = unpack_u8x4(gw.y) * (1.0f / 255.0f); f32x4 p0, p1; unpack_bf16x8(*(const u32x4*)(TMP + o), p0, p1); const f32x4 t0 = p0 + g0 * v0, t1 = p1 + g1 * v1;
                    *(u32x4*)(MIXED + o) = pack_bf16x8(t0, t1);
                    const f32x4 a0 = __builtin_elementwise_abs(t0), a1 = __builtin_elementwise_abs(t1); mx = fmaxf(mx, fmaxf(fmaxf(fmaxf(a0[0], a0[1]), fmaxf(a0[2], a0[3])), fmaxf(fmaxf(a1[0], a1[1]), fmaxf(a1[2], a1[3])))); }
                mx = fmaxf(mx, __shfl_xor(mx, 16)); mx = fmaxf(mx, __shfl_xor(mx, 32));
                if (fq_ == 0) atomicMax(rmax + row, __builtin_bit_cast(unsigned, mx)); }
    }
};
struct EpiResI8 {
    static constexpr bool PERM = true, AFTER_DRAIN = false;
    const float* xp; const float* xs; bf16_t* x1; const float* gate; const float* rows; const unsigned* cmax;
    __device__ __forceinline__ void operator()(const f32x4 (&acc)[2][2][4][2], const Unit& u, int wr, int wc, int fr, int fq) const {
        typedef int v4i_t __attribute__((ext_vector_type(4)));
        EPI_LANE(); const int row0 = u.pm * BM + wr * 64 + fr_, cl = wc * 32 + 8 * fq_;
        const int rbase = u.pm * BM, mi = rbase < T_P ? 0 : 1 + ((rbase - T_P) >> 10);
        const float* gp = gate + (size_t)mi * NMOD + u.pn * 256;
        const float* base = rbase < T_P ? xp : xs - (size_t)T_P * DM;
        f32x4 gv[2][2];
#pragma unroll
        for (int bj = 0; bj < 2; ++bj)
#pragma unroll
            for (int n = 0; n < 2; ++n) { const u32x4 m4 = *(const u32x4*)(cmax + u.pn * 256 + bj * HALF + cl + 4 * n);
                gv[bj][n] = *(const f32x4*)(gp + bj * HALF + cl + 4 * n) * ((f32x4){ubf(m4.x), ubf(m4.y), ubf(m4.z), ubf(m4.w)} * (1.0f / 127.0f)); }
        float rs8[2][4];
#pragma unroll
        for (int ai = 0; ai < 2; ++ai)
#pragma unroll
            for (int m = 0; m < 4; ++m) rs8[ai][m] = rows[row0 + ai * HALF + m * 16];
#pragma unroll
        for (int ai = 0; ai < 2; ++ai)
#pragma unroll
            for (int m = 0; m < 4; ++m) { const int row = row0 + ai * HALF + m * 16; const float rs = rs8[ai][m];
#pragma unroll
                for (int bj = 0; bj < 2; ++bj) { const v4i_t c0 = __builtin_bit_cast(v4i_t, acc[ai][bj][m][0]), c1 = __builtin_bit_cast(v4i_t, acc[ai][bj][m][1]);
                    const f32x4 v0 = (f32x4){(float)c0[0], (float)c0[1], (float)c0[2], (float)c0[3]} * rs, v1 = (f32x4){(float)c1[0], (float)c1[1], (float)c1[2], (float)c1[3]} * rs;
                    const size_t o = (size_t)row * DM + u.pn * 256 + bj * HALF + cl; const f32x4 b0 = *(const f32x4*)(base + o), b1 = *(const f32x4*)(base + o + 4);
                    *(u32x4*)(x1 + o) = pack_bf16x8(b0 + gv[bj][0] * v0, b1 + gv[bj][1] * v1); } }
    }
};
#undef EPI_LOOP
}
#define GAS __attribute__((address_space(1)))
#define LAS __attribute__((address_space(3)))
typedef unsigned short bf16;
typedef unsigned v4u __attribute__((ext_vector_type(4)));
typedef float f32x4 __attribute__((ext_vector_type(4)));
typedef short bf16x8 __attribute__((ext_vector_type(8)));
typedef GAS unsigned gu32;
typedef GAS unsigned long long gu64;
#define RLX_AGENT __ATOMIC_RELAXED, __HIP_MEMORY_SCOPE_AGENT
#define LDS_WAIT() asm volatile("s_waitcnt lgkmcnt(0)" ::: "memory")
#define VM_WAIT() asm volatile("s_waitcnt vmcnt(0)" ::: "memory")
__device__ __forceinline__ unsigned long long rt() { return __builtin_amdgcn_s_memrealtime(); }
__device__ __forceinline__ unsigned f2bf(float f) { unsigned u = __builtin_bit_cast(unsigned, f); return (u + 0x7fffu + ((u >> 16) & 1u)) >> 16; }
__device__ __forceinline__ unsigned pk2(float lo, float hi) { return f2bf(lo) | (f2bf(hi) << 16); }
constexpr size_t MiB = 1u << 20;
constexpr size_t WS_CTL = 0, CTL_ZERO_BYTES = 1 * MiB;
constexpr size_t WS_MOD = 1 * MiB, WS_COS = 1 * MiB + 512 * 1024, WS_SIN = 1 * MiB + 640 * 1024, WS_LBIAS = 1 * MiB + 768 * 1024;
constexpr size_t WS_WFI = 2 * MiB, WS_WFO = 174 * MiB, WS_WOUT = 260 * MiB, WS_WOR = 292 * MiB, WS_WOM = 308 * MiB;
constexpr size_t WS_WIN = 324 * MiB, WS_WUQ = 458 * MiB, WS_WUKV = 464 * MiB, WS_WLORA = 468 * MiB, WS_WG = 472 * MiB;
constexpr size_t WS_YS = 324 * MiB, WS_BON = 420 * MiB, WS_YB = 423 * MiB;
constexpr size_t WS_HB = 474 * MiB;
constexpr size_t WS_RKV = 570 * MiB, WS_GA = 714 * MiB, WS_GB = 810 * MiB;
constexpr size_t WS_MIXED = 570 * MiB, WS_ACT = 570 * MiB;
constexpr size_t WS_LWA = 906 * MiB, WS_LG = 918 * MiB;
constexpr size_t WS_QLAT = 930 * MiB, WS_KVLAT = 978 * MiB, WS_Q = 930 * MiB;
constexpr size_t WS_KPE = 1002 * MiB;
constexpr size_t WS_QN = 1005 * MiB, WS_CKVA = 1029 * MiB;
constexpr size_t WS_EW = 1043 * MiB, WS_AA = 1139 * MiB, WS_TMP = 1043 * MiB;
constexpr size_t WS_G = 1235 * MiB;
constexpr size_t WS_KV = 1283 * MiB, WS_YA = 1479 * MiB;
constexpr size_t WS_KP = 1395 * MiB;
constexpr size_t WS_END = 1527 * MiB;
static_assert(WS_WIN + (size_t)NIN * DM * 2 <= WS_WUQ && WS_WFI + (size_t)2 * DFF * DM * 2 <= WS_WFO && WS_WFO + (size_t)DM * DFF * 2 <= WS_WOUT, "weights map");
static_assert(WS_YS + (size_t)2 * T * DA * 2 <= WS_BON && WS_BON + (size_t)2 * T * 32 * 4 <= WS_YB && WS_YB + (size_t)T * DA * 2 <= WS_HB, "overlay map");
static_assert(WS_RKV + (size_t)T * 6144 * 2 <= WS_GA && WS_ACT + (size_t)T * DFF * 2 <= WS_LWA && WS_Q + (size_t)T * 3072 * 2 <= WS_KPE && WS_KV + (size_t)KVROWS * 4096 * 2 <= WS_KP && WS_KP + (size_t)KVROWS * 3072 * 2 <= WS_YA && WS_YA + (size_t)T * DA * 2 <= WS_END, "act map");
static_assert(WS_AA == WS_EW + (size_t)2 * T * DA * 2, "AA follows EW");
constexpr int CW_BAR = 4096;
constexpr size_t WS_CMAX = 64 * 1024;
constexpr size_t WS_ROWS = 256 * 1024;
constexpr size_t WS_CMAXG = 320 * 1024;
constexpr size_t WS_ROWS1 = 384 * 1024;
static_assert(WS_ROWS + 12288 * 4 <= WS_CMAXG && WS_CMAXG + 11776 * 4 <= WS_ROWS1 && WS_ROWS1 + 12288 * 4 <= CTL_ZERO_BYTES, "scale tables 2");
constexpr size_t WS_CMAXO = 448 * 1024, WS_CMAXR = 464 * 1024, WS_RMAXM = 480 * 1024, WS_ROWSYA = 528 * 1024, WS_ROWSM = 576 * 1024;
static_assert(WS_ROWS1 + 12288 * 4 <= WS_CMAXO && WS_ROWSM + 12288 * 4 <= CTL_ZERO_BYTES, "scale tables 3");
constexpr size_t WS_YB8 = 1395 * MiB;
constexpr size_t WS_ROWSYB = 640 * 1024, WS_CMAXM = 704 * 1024;
static_assert(WS_ROWSM + 12288 * 4 <= WS_ROWSYB && WS_ROWSYB + 12288 * 4 <= WS_CMAXM && WS_CMAXM + 4096 * 4 <= CTL_ZERO_BYTES, "scale tables 4");
constexpr size_t WS_ROWSQ = 720 * 1024, WS_ROWSKV = 768 * 1024, WS_CMAXUQ = 824 * 1024, WS_CMAXUKV = 836 * 1024;
static_assert(WS_CMAXM + 4096 * 4 <= WS_ROWSQ && WS_ROWSQ + 12288 * 4 <= WS_ROWSKV && WS_ROWSKV + 14336 * 4 <= WS_CMAXUQ && WS_CMAXUQ + 3072 * 4 <= WS_CMAXUKV && WS_CMAXUKV + 4096 * 4 <= CTL_ZERO_BYTES, "scale tables 5");
constexpr size_t WS_X1 = 324 * MiB;
constexpr size_t WS_MIX8 = 666 * MiB;
constexpr size_t WS_H1Q = 88 * MiB, WS_WGATE8 = 136 * MiB, WS_WING8 = 1139 * MiB;
static_assert(WS_WFI + (size_t)2 * DFF * DM <= WS_H1Q && WS_H1Q + (size_t)T * DM <= WS_WGATE8 && WS_WGATE8 + (size_t)8192 * DM <= WS_WFO, "int8 tail of the WFI region");
static_assert(WS_CMAX + 22016 * 4 <= WS_ROWS && WS_ROWS + 12288 * 4 <= CTL_ZERO_BYTES, "scale tables inside the control region");

constexpr int RING_OFF = 0, RING_BYTES = 131072;
constexpr int LDSCTL_OFF = RING_BYTES, MISC_OFF = LDSCTL_OFF + 320;
constexpr int LDS_BYTES = 147456;
constexpr int NWAVES = 8;

constexpr size_t OUT_YP = 0, OUT_YS = (size_t)T_P * DM, OUT_STATE = (size_t)T * DM, OUT_CKV = OUT_STATE + (size_t)32 * 2 * 32 * 64 * 64, OUT_KPE = OUT_CKV + (size_t)T_P * KVL;

typedef _Float16 f16;
typedef unsigned v2u __attribute__((ext_vector_type(2)));
typedef float f32x2 __attribute__((ext_vector_type(2)));
#define XB_TMO      128
#define XB_XCNT(j)  (256  + 64 * (j))
#define XB_XSUB(j)  (1280 + 64 * (j))
#define XB_XGEN(j)  (2304 + 64 * (j))
#define XB_TOP      3328
#define XB_TOPGEN   3392
#define XCD_BAR_WORDS 3456
#define XB_SPIN_CAP (1u << 18)

__device__ __forceinline__ unsigned xb_ld(unsigned* p)              { return __hip_atomic_load(p, __ATOMIC_RELAXED, __HIP_MEMORY_SCOPE_AGENT); }
__device__ __forceinline__ unsigned xb_add(unsigned* p, unsigned v) { return __hip_atomic_fetch_add(p, v, __ATOMIC_RELAXED, __HIP_MEMORY_SCOPE_AGENT); }
__device__ __forceinline__ unsigned xb_xcc_id() { return (unsigned)__builtin_amdgcn_s_getreg((3 << 11) | 20) & 0xFu; }
#define XB_SPIN(cond, bar) do { unsigned _sp = 0; while (cond) { __builtin_amdgcn_s_sleep(1); \
    if ((++_sp & 255u) == 0u) { if (xb_ld(&(bar)[XB_TMO])) break; if (_sp > XB_SPIN_CAP) { atomicAdd(&(bar)[XB_TMO], 1u); break; } } } } while (0)

struct XcdBarrier {
    unsigned* bar; unsigned x;
    volatile LAS unsigned* st;
};

__device__ __forceinline__ XcdBarrier xcd_barrier_post(unsigned* bar, volatile LAS unsigned* st) {
    XcdBarrier b; b.bar = bar; b.x = xb_xcc_id(); b.st = st;
    if (threadIdx.x == 0) (void)xb_add(&bar[XB_XCNT(b.x)], 1u);
    return b;
}
__device__ __forceinline__ void xcd_barrier_complete(unsigned* bar, unsigned x, unsigned& nloc, unsigned& nx) {
    const unsigned G = gridDim.x * gridDim.y * gridDim.z;
    unsigned sum, cnt, mine, sp = 0u;
    for (;;) {
        sum = 0u; cnt = 0u; mine = 0u;
#pragma unroll
        for (unsigned j = 0; j < 16; ++j) { const unsigned c = xb_ld(&bar[XB_XCNT(j)]); sum += c; cnt += (c > 0u) ? 1u : 0u; mine = (j == x) ? c : mine; }
        if (sum == G) break;
        __builtin_amdgcn_s_sleep(1);
        if ((++sp & 255u) == 0u) { if (xb_ld(&bar[XB_TMO])) break; if (sp > XB_SPIN_CAP) { atomicAdd(&bar[XB_TMO], 1u); break; } }
    }
    nloc = mine > 0u ? mine : 1u; nx = cnt > 0u ? cnt : 1u;
}

__device__ __forceinline__ void xcd_barrier(const XcdBarrier& b) {
    asm volatile("s_waitcnt vmcnt(0)" ::: "memory");
    __syncthreads();
    if (threadIdx.x == 0) {
        unsigned* bar = b.bar;
        __builtin_amdgcn_s_waitcnt(0);
        unsigned nloc = b.st[0], nx = b.st[1];
        if (nloc == 0u) { xcd_barrier_complete(bar, b.x, nloc, nx); b.st[0] = nloc; b.st[1] = nx; }
        const unsigned old = xb_add(&bar[XB_XSUB(b.x)], 1u);
        const unsigned gen = old / nloc;
        if (old + 1u == (gen + 1u) * nloc) {
            __builtin_amdgcn_fence(__ATOMIC_RELEASE, "agent");
            asm volatile("s_waitcnt vmcnt(0)" ::: "memory");
            const unsigned og = xb_add(&bar[XB_TOP], 1u);
            const unsigned tg = og / nx;
            if (og + 1u == (tg + 1u) * nx) xb_add(&bar[XB_TOPGEN], 1u);
            else XB_SPIN(xb_ld(&bar[XB_TOPGEN]) == tg, bar);
            __builtin_amdgcn_fence(__ATOMIC_ACQUIRE, "agent");
            xb_add(&bar[XB_XGEN(b.x)], 1u);
            asm volatile("s_waitcnt vmcnt(0)" ::: "memory");
        } else {
            XB_SPIN(xb_ld(&bar[XB_XGEN(b.x)]) == gen, bar);
            __builtin_amdgcn_fence(__ATOMIC_ACQUIRE, "agent");
            asm volatile("s_waitcnt vmcnt(0)" ::: "memory");
        }
    }
    __syncthreads();
}
struct Args { const float* in[33]; float* out; unsigned char* ws; int ph_lo, ph_hi; };
enum { I_XP = 0, I_XS, I_C, I_STATE, I_CCKV, I_CKPE, I_CCTX, I_WMOD, I_BMOD, I_NMIX, I_WIN, I_W0, I_WLB, I_A0, I_ALB, I_GLB, I_KK, I_KA, I_RK, I_LNW, I_LNB,
       I_QNW, I_WUQ, I_KVNW, I_WUKV, I_QHN, I_KHN, I_WOR, I_WOM, I_WOUT, I_NFFN, I_WFI, I_WFO };
struct Frame { LAS unsigned char* lds; volatile LAS unsigned* MISC; gu32* ctl; int tid, lane, wave, G, gw, ngw; };

__device__ __forceinline__ float wave_sum(float v) {
#pragma unroll
    for (int o = 1; o < 64; o <<= 1) v += __shfl_xor(v, o);
    return v;
}
__device__ __forceinline__ float dpp_f(float x, const int ctrl_sel) {
    const int xi = __builtin_bit_cast(int, x); int r;
    if (ctrl_sel == 0) r = __builtin_amdgcn_update_dpp(0, xi, 0xB1, 0xF, 0xF, true);
    else if (ctrl_sel == 1) r = __builtin_amdgcn_update_dpp(0, xi, 0x4E, 0xF, 0xF, true);
    else if (ctrl_sel == 2) r = __builtin_amdgcn_update_dpp(0, xi, 0x141, 0xF, 0xF, true);
    else r = __builtin_amdgcn_update_dpp(0, xi, 0x140, 0xF, 0xF, true);
    return __builtin_bit_cast(float, r);
}
__device__ __forceinline__ float row16_sum(float x) { x += dpp_f(x, 0); x += dpp_f(x, 1); x += dpp_f(x, 2); x += dpp_f(x, 3); return x; }
__device__ __forceinline__ float sigm(float x) { return pg8::sigm(x); }
__device__ __forceinline__ int mod_index(int row) { return row < T_P ? 0 : 1 + ((row - T_P) >> 10); }

__device__ __forceinline__ void p0_adaln(const Args& a, Frame& F) {
    LAS float* SC = (LAS float*)(F.lds);
    LAS float* RED = (LAS float*)(F.lds + 81920);
    const float* c = a.in[I_C]; const float* cctx = a.in[I_CCTX]; const float* wmod = a.in[I_WMOD]; const float* bmod = a.in[I_BMOD];
    float* MOD = (float*)(a.ws + WS_MOD);
#pragma unroll
    for (int it = 0; it < 40; ++it) { const int i = F.tid + 512 * it; const int r = i >> 12, k = i & 4095; const float v = (r == 0) ? cctx[k] : c[(r - 1) * 4096 + k]; SC[i] = v * sigm(v); }
    __syncthreads();
    const int kk = F.lane / 24, cg = F.lane % 24;
    for (int cb = blockIdx.x; cb < 256; cb += F.G) {
        f32x4 acc[5];
#pragma unroll
        for (int r = 0; r < 5; ++r) acc[r] = (f32x4){0.f, 0.f, 0.f, 0.f};
        if (F.lane < 48) {
            const float* wp = wmod + (size_t)(512 * F.wave + kk) * NMOD + 96 * cb + 4 * cg;
            const LAS float* sp = SC + 512 * F.wave + kk;
#pragma unroll 16
            for (int k2 = 0; k2 < 512; k2 += 2) {
                const f32x4 w = *(const f32x4*)(wp + (size_t)k2 * NMOD);
#pragma unroll
                for (int r = 0; r < 5; ++r) acc[r] += w * sp[r * 4096 + k2];
            }
#pragma unroll
            for (int r = 0; r < 5; ++r) *(LAS f32x4*)(RED + ((F.wave * 2 + kk) * 5 + r) * 96 + 4 * cg) = acc[r];
        }
        __syncthreads();
        if (F.tid < 480) { const int r = F.tid / 96, col = F.tid % 96; float s = bmod[96 * cb + col];
#pragma unroll
            for (int p = 0; p < 16; ++p) s += RED[(p * 5 + r) * 96 + col];
            MOD[(size_t)r * NMOD + 96 * cb + col] = s; }
        __syncthreads();
    }
}

__device__ __forceinline__ void tr_item(const float* W, int ldw, int k0, int kvalid, int srcn0, bf16* WT, int ldt, int drow0, int dk0, LAS float* scr, int lane) {
    const int c = lane & 7;
    if (srcn0 < 0) {
#pragma unroll
        for (int j = 0; j < 4; ++j) { const int n = (lane >> 3) + 8 * j; *(GAS v4u*)(WT + (size_t)(drow0 + n) * ldt + dk0 + 8 * c) = (v4u){0u, 0u, 0u, 0u}; }
        return;
    }
#pragma unroll 8
    for (int i = 0; i < 32; ++i) { const int kk = 2 * i + (lane >> 5); scr[kk * 33 + (lane & 31)] = (kk < kvalid) ? W[(size_t)(k0 + kk) * ldw + srcn0 + (lane & 31)] : 0.f; }
    LDS_WAIT(); asm volatile("" ::: "memory");
#pragma unroll
    for (int j = 0; j < 4; ++j) { const int n = (lane >> 3) + 8 * j; const LAS float* s = scr + (8 * c) * 33 + n;
        v4u o; o.x = pg8::cvt_pk_bf16(s[0 * 33], s[1 * 33]); o.y = pg8::cvt_pk_bf16(s[2 * 33], s[3 * 33]); o.z = pg8::cvt_pk_bf16(s[4 * 33], s[5 * 33]); o.w = pg8::cvt_pk_bf16(s[6 * 33], s[7 * 33]);
        *(GAS v4u*)(WT + (size_t)(drow0 + n) * ldt + dk0 + 8 * c) = o; }
    LDS_WAIT(); asm volatile("" ::: "memory");
}
__device__ __forceinline__ void tr_item_f8(const float* W, int ldw, int k0, int srcn0, unsigned char* WT, int ldt, int drow0, int dk0, float scale, LAS float* scr, int lane) {
    const int c = lane & 7;
#pragma unroll 8
    for (int i = 0; i < 32; ++i) { const int kk = 2 * i + (lane >> 5); scr[kk * 33 + (lane & 31)] = W[(size_t)(k0 + kk) * ldw + srcn0 + (lane & 31)]; }
    LDS_WAIT(); asm volatile("" ::: "memory");
#pragma unroll
    for (int j = 0; j < 4; ++j) { const int n = (lane >> 3) + 8 * j; const LAS float* s = scr + (8 * c) * 33 + n;
        unsigned w0 = 0u, w1 = 0u;
        w0 = __builtin_amdgcn_cvt_pk_fp8_f32(s[0 * 33] * scale, s[1 * 33] * scale, w0, false); w0 = __builtin_amdgcn_cvt_pk_fp8_f32(s[2 * 33] * scale, s[3 * 33] * scale, w0, true);
        w1 = __builtin_amdgcn_cvt_pk_fp8_f32(s[4 * 33] * scale, s[5 * 33] * scale, w1, false); w1 = __builtin_amdgcn_cvt_pk_fp8_f32(s[6 * 33] * scale, s[7 * 33] * scale, w1, true);
        v2u o; o.x = w0; o.y = w1; *(GAS v2u*)(WT + (size_t)(drow0 + n) * ldt + dk0 + 8 * c) = o; }
    LDS_WAIT(); asm volatile("" ::: "memory");
}
__device__ __forceinline__ int q8(float x) { const int q = (int)__builtin_rintf(x); return (q < -127 ? -127 : (q > 127 ? 127 : q)) & 0xff; }
__device__ __forceinline__ void tr_item_i8(const float* W, int ldw, int k0, int srcn0, unsigned char* WT, int ldt, int drow0, int dk0, const unsigned* cmax  , LAS float* scr, int lane) {
    const int c = lane & 7;
    if (srcn0 < 0) {
#pragma unroll
        for (int j = 0; j < 4; ++j) { const int n = (lane >> 3) + 8 * j; v2u o; o.x = 0u; o.y = 0u; *(GAS v2u*)(WT + (size_t)(drow0 + n) * ldt + dk0 + 8 * c) = o; }
        return;
    }
#pragma unroll 8
    for (int i = 0; i < 32; ++i) { const int kk = 2 * i + (lane >> 5); scr[kk * 33 + (lane & 31)] = W[(size_t)(k0 + kk) * ldw + srcn0 + (lane & 31)]; }
    LDS_WAIT(); asm volatile("" ::: "memory");
#pragma unroll
    for (int j = 0; j < 4; ++j) { const int n = (lane >> 3) + 8 * j; const LAS float* s = scr + (8 * c) * 33 + n;
        const float mx = __builtin_bit_cast(float, cmax[n]); const float sc = mx > 0.f ? 127.0f / mx : 0.f;
        v2u o; o.x = (unsigned)q8(s[0 * 33] * sc) | ((unsigned)q8(s[1 * 33] * sc) << 8) | ((unsigned)q8(s[2 * 33] * sc) << 16) | ((unsigned)q8(s[3 * 33] * sc) << 24);
        o.y = (unsigned)q8(s[4 * 33] * sc) | ((unsigned)q8(s[5 * 33] * sc) << 8) | ((unsigned)q8(s[6 * 33] * sc) << 16) | ((unsigned)q8(s[7 * 33] * sc) << 24);
        *(GAS v2u*)(WT + (size_t)(drow0 + n) * ldt + dk0 + 8 * c) = o; }
    LDS_WAIT(); asm volatile("" ::: "memory");
}
__device__ __forceinline__ void colmax_pass(Frame& F, const float* W, int ld, int col0, int nblk, unsigned* cmax, int K = 4096) {
    const int r8 = F.lane >> 3, c4 = F.lane & 7;
    for (int task = F.gw; task < 4 * nblk; task += F.ngw) { const int kp = task / nblk, nb = task % nblk;
        const int rp = K >> 2; const float* p = W + (size_t)(rp * kp + r8) * ld + col0 + 32 * nb + 4 * c4; f32x4 mx = (f32x4){0.f, 0.f, 0.f, 0.f};
#pragma unroll 8
        for (int i = 0; i < (rp >> 3); ++i) { const f32x4 v = *(const GAS f32x4*)(p + (size_t)(8 * i) * ld); mx = __builtin_elementwise_max(mx, __builtin_elementwise_abs(v)); }
#pragma unroll
        for (int o = 8; o < 64; o <<= 1) { mx.x = fmaxf(mx.x, __shfl_xor(mx.x, o)); mx.y = fmaxf(mx.y, __shfl_xor(mx.y, o)); mx.z = fmaxf(mx.z, __shfl_xor(mx.z, o)); mx.w = fmaxf(mx.w, __shfl_xor(mx.w, o)); }
        if (r8 == 0) { unsigned* q = cmax + 32 * nb + 4 * c4; const float m0 = mx.x, m1 = mx.y, m2 = mx.z, m3 = mx.w;     atomicMax(q, __builtin_bit_cast(unsigned, m0)); atomicMax(q + 1, __builtin_bit_cast(unsigned, m1)); atomicMax(q + 2, __builtin_bit_cast(unsigned, m2)); atomicMax(q + 3, __builtin_bit_cast(unsigned, m3)); }
    }
}
#ifndef SIDE_IN_SCAN
#define SIDE_IN_SCAN 1
#endif
__device__ __forceinline__ void colmax_task(int lane, const float* W, int ld, int col, int row0, int rows, unsigned* cmax) {
    const int r8 = lane >> 3, c4 = lane & 7; const float* p = W + (size_t)(row0 + r8) * ld + col + 4 * c4; f32x4 mx = (f32x4){0.f, 0.f, 0.f, 0.f};
#pragma unroll 8
    for (int i = 0; i < (rows >> 3); ++i) { const f32x4 v = *(const GAS f32x4*)(p + (size_t)(8 * i) * ld); mx = __builtin_elementwise_max(mx, __builtin_elementwise_abs(v)); }
#pragma unroll
    for (int o = 8; o < 64; o <<= 1) { mx.x = fmaxf(mx.x, __shfl_xor(mx.x, o)); mx.y = fmaxf(mx.y, __shfl_xor(mx.y, o)); mx.z = fmaxf(mx.z, __shfl_xor(mx.z, o)); mx.w = fmaxf(mx.w, __shfl_xor(mx.w, o)); }
    if (r8 == 0) { unsigned* q = cmax + 4 * c4; const float m0 = mx.x, m1 = mx.y, m2 = mx.z, m3 = mx.w;
        atomicMax(q, __builtin_bit_cast(unsigned, m0)); atomicMax(q + 1, __builtin_bit_cast(unsigned, m1)); atomicMax(q + 2, __builtin_bit_cast(unsigned, m2)); atomicMax(q + 3, __builtin_bit_cast(unsigned, m3)); }
}
__device__ __forceinline__ void p0_colmax(const Args& a, Frame& F) {
#if SIDE_IN_SCAN
    constexpr int T_R = 64 * 8, T_LG = 15 * 8, T_Q = 32 * 8, T_UQ = 96 * 4, T_UKV = 128 * 4, T_ALL = T_R + T_LG + T_Q + T_UQ + T_UKV;
    unsigned* CG = (unsigned*)(a.ws + WS_CMAXG);
    for (int t = F.gw; t < T_ALL; t += F.ngw) {
        int u = t;
        if (u < T_R) { const int nb = u % 64, kp = u / 64; colmax_task(F.lane, a.in[I_WIN], 16928, 32 * nb, 512 * kp, 512, CG + 8192 + 32 * nb); continue; }
        u -= T_R;
        if (u < T_LG) { const int nb = u % 15, kp = u / 15; colmax_task(F.lane, a.in[I_WIN], 16928, 6656 + 32 * nb, 512 * kp, 512, CG + 10240 + 32 * nb); continue; }
        u -= T_LG;
        if (u < T_Q) { const int nb = u % 32, kp = u / 32; colmax_task(F.lane, a.in[I_WIN], 16928, 7136 + 32 * nb, 512 * kp, 512, CG + 10752 + 32 * nb); continue; }
        u -= T_Q;
        if (u < T_UQ) { const int nb = u % 96, kp = u / 96; colmax_task(F.lane, a.in[I_WUQ], 3072, 32 * nb, 256 * kp, 256, (unsigned*)(a.ws + WS_CMAXUQ) + 32 * nb); continue; }
        u -= T_UQ;
        { const int nb = u % 128, kp = u / 128; colmax_task(F.lane, a.in[I_WUKV], 4096, 32 * nb, 128 * kp, 128, (unsigned*)(a.ws + WS_CMAXUKV) + 32 * nb); }
    }
#else
#if !SIDE_IN_SCAN
    colmax_pass(F, a.in[I_WFI], 2 * DFF, 0, 2 * DFF / 32, (unsigned*)(a.ws + WS_CMAX));
#endif
#if !SIDE_IN_SCAN
    colmax_pass(F, a.in[I_WIN], 16928, 8736, 256, (unsigned*)(a.ws + WS_CMAXG));
#endif
    colmax_pass(F, a.in[I_WIN], 16928, 0, 64, (unsigned*)(a.ws + WS_CMAXG) + 8192);
    colmax_pass(F, a.in[I_WIN], 16928, 6656, 15, (unsigned*)(a.ws + WS_CMAXG) + 10240);
    colmax_pass(F, a.in[I_WIN], 16928, 7136, 32, (unsigned*)(a.ws + WS_CMAXG) + 10752);
    colmax_pass(F, a.in[I_WUQ], 3072, 0, 96, (unsigned*)(a.ws + WS_CMAXUQ), QL);
    colmax_pass(F, a.in[I_WUKV], 4096, 0, 128, (unsigned*)(a.ws + WS_CMAXUKV), KVL);
#if !SIDE_IN_SCAN
    colmax_pass(F, a.in[I_WOUT], DM, 0, 128, (unsigned*)(a.ws + WS_CMAXO));
    colmax_pass(F, a.in[I_WOR], DM, 0, 128, (unsigned*)(a.ws + WS_CMAXR), DA);
#endif
#endif
}
__device__ __forceinline__ void p1_weights_i8(const Args& a, Frame& F) {
    LAS float* scr = (LAS float*)(F.lds + F.wave * 16384);
#if !SIDE_IN_SCAN
    constexpr int I_FI = (2 * DFF / 32) * 64;
    for (int r = F.gw; r < I_FI; r += F.ngw) { const int nblk = 2 * DFF / 32, kb = r / nblk, nb = r % nblk, n0 = 32 * nb, pn = n0 >> 8, j = n0 & 255; const int src = (j < 128) ? 128 * pn + j : DFF + 128 * pn + (j - 128);
        tr_item_i8(a.in[I_WFI], 2 * DFF, 64 * kb, src, (unsigned char*)(a.ws + WS_WFI), DM, n0, 64 * kb, (const unsigned*)(a.ws + WS_CMAX) + src, scr, F.lane); }
    for (int r = F.gw; r < 128 * 64; r += F.ngw) { const int kb = r >> 7, nb = r & 127;
        tr_item_i8(a.in[I_WOUT], DM, 64 * kb, 32 * nb, (unsigned char*)(a.ws + WS_WOUT), DM, 32 * nb, 64 * kb, (const unsigned*)(a.ws + WS_CMAXO) + 32 * nb, scr, F.lane); }
    for (int r = F.gw; r < 128 * 32; r += F.ngw) { const int kb = r >> 7, nb = r & 127;
        tr_item_i8(a.in[I_WOR], DM, 64 * kb, 32 * nb, (unsigned char*)(a.ws + WS_WOR), DA, 32 * nb, 64 * kb, (const unsigned*)(a.ws + WS_CMAXR) + 32 * nb, scr, F.lane); }
#endif
    constexpr int NB0 = SIDE_IN_SCAN ? 256 : 0, NBN = 368 - NB0;
    for (int r = F.gw; r < NBN * 64; r += F.ngw) { const int kb = r / NBN, nb = NB0 + r % NBN;
        const int src = nb < 256 ? 8736 + 32 * nb : (nb < 320 ? 32 * (nb - 256) : (nb < 336 ? (nb < 335 ? 6656 + 32 * (nb - 320) : -1) : 7136 + 32 * (nb - 336)));
        tr_item_i8(a.in[I_WIN], 16928, 64 * kb, src, (unsigned char*)(a.ws + WS_WING8), DM, 32 * nb, 64 * kb, (const unsigned*)(a.ws + WS_CMAXG) + 32 * nb, scr, F.lane); }
    for (int r = F.gw; r < 96 * 16; r += F.ngw) { const int kb = r / 96, nb = r % 96;
        tr_item_i8(a.in[I_WUQ], 3072, 64 * kb, 32 * nb, (unsigned char*)(a.ws + WS_WUQ), QL, 32 * nb, 64 * kb, (const unsigned*)(a.ws + WS_CMAXUQ) + 32 * nb, scr, F.lane); }
    for (int r = F.gw; r < 128 * 8; r += F.ngw) { const int kb = r >> 7, nb = r & 127;
        tr_item_i8(a.in[I_WUKV], 4096, 64 * kb, 32 * nb, (unsigned char*)(a.ws + WS_WUKV), KVL, 32 * nb, 64 * kb, (const unsigned*)(a.ws + WS_CMAXUKV) + 32 * nb, scr, F.lane); }
}
constexpr int NIN16 = 5376;
__device__ __forceinline__ int map_in(int n0) {
    if (n0 < 4608) return 2048 + n0;
    if (n0 < 5120) return 8160 + (n0 - 4608);
    if (n0 < 5184) return 8672 + (n0 - 5120);
    return -1;
}
__device__ __forceinline__ void p0_weights(const Args& a, Frame& F) {
    LAS float* scr = (LAS float*)(F.lds + F.wave * 16384);
    constexpr int I_IN = (NIN16 / 32) * 64, I_FO = SIDE_IN_SCAN ? 0 : (DM / 32) * (DFF / 64), I_OM = SIDE_IN_SCAN ? 0 : 128 * 32, I_UQ = 0, I_UKV = 0  , I_LORA = 256 * 4, I_G = 64 * 8;
    constexpr int NITEMS = I_IN + I_FO + I_OM + I_UQ + I_UKV + I_LORA + I_G;
    unsigned char* ws = a.ws;
    for (int it = F.gw; it < NITEMS; it += F.ngw) {
        int r = it;
        if (r < I_IN) { const int nblk = NIN16 / 32, kb = r / nblk, nb = r % nblk; tr_item(a.in[I_WIN], 16928, 64 * kb, 64, map_in(32 * nb), (bf16*)(ws + WS_WIN), DM, 32 * nb, 64 * kb, scr, F.lane); continue; } r -= I_IN;
        if (r < I_FO) { const int nblk = DM / 32, kb = r / nblk, nb = r % nblk; tr_item_f8(a.in[I_WFO], DM, 64 * kb, 32 * nb, (unsigned char*)(ws + WS_WFO), DFF, 32 * nb, 64 * kb, 128.0f, scr, F.lane); continue; } r -= I_FO;
        if (r < I_OM) { const int nblk = 128, kb = r / nblk, nb = r % nblk; tr_item(a.in[I_WOM], DM, 64 * kb, 64, 32 * nb, (bf16*)(ws + WS_WOM), DA, 32 * nb, 64 * kb, scr, F.lane); continue; } r -= I_OM;
        if (r < I_UQ) { const int nblk = 96, kb = r / nblk, nb = r % nblk; tr_item(a.in[I_WUQ], 3072, 64 * kb, 64, 32 * nb, (bf16*)(ws + WS_WUQ), QL, 32 * nb, 64 * kb, scr, F.lane); continue; } r -= I_UQ;
        if (r < I_UKV) { const int nblk = 128, kb = r / nblk, nb = r % nblk; tr_item(a.in[I_WUKV], 4096, 64 * kb, 64, 32 * nb, (bf16*)(ws + WS_WUKV), KVL, 32 * nb, 64 * kb, scr, F.lane); continue; } r -= I_UKV;
        if (r < I_LORA) {
            const int nblk = 256, kb = r / nblk, nb = r % nblk, n0 = 32 * nb, dir = n0 >> 12, j = n0 & 4095; const bool isw = j < 2048; const bool live = isw ? (kb < 2) : (kb >= 2);
            const float* src = (isw ? a.in[I_WLB] : a.in[I_ALB]) + (size_t)dir * 128 * DA;
            tr_item(src, DA, 64 * (kb & 1), 64, live ? (isw ? j : j - 2048) : -1, (bf16*)(ws + WS_WLORA), 256, n0, 64 * kb, scr, F.lane); continue; } r -= I_LORA;
        { const int nblk = 64, kb = r / nblk, nb = r % nblk; const int kv = 480 - 64 * kb; tr_item(a.in[I_GLB], DA, 64 * kb, kv < 0 ? 0 : kv, 32 * nb, (bf16*)(ws + WS_WG), 512, 32 * nb, 64 * kb, scr, F.lane); }
    }
}

__device__ __forceinline__ void sincos_small(double x, double& s, double& c) {
    const double n = __builtin_rint(x * 0.63661977236758134308);
    double r = __builtin_fma(-n, 1.57079632679489655800e+00, x); r = __builtin_fma(-n, 6.12323399573676603587e-17, r);
    const double r2 = r * r;
    double sp = -7.6471637318198164759e-13; sp = sp * r2 + 1.6059043836821614599e-10; sp = sp * r2 - 2.5052108385441718775e-08; sp = sp * r2 + 2.7557319223985890653e-06;
    sp = sp * r2 - 1.9841269841269841270e-04; sp = sp * r2 + 8.3333333333333333333e-03; sp = sp * r2 - 1.6666666666666666667e-01; const double sr = r + r * r2 * sp;
    double cp = 4.7794773323873852974e-14; cp = cp * r2 - 1.1470745597729724714e-11; cp = cp * r2 + 2.0876756987868098979e-09; cp = cp * r2 - 2.7557319223985890653e-07;
    cp = cp * r2 + 2.4801587301587301587e-05; cp = cp * r2 - 1.3888888888888888889e-03; cp = cp * r2 + 4.1666666666666666667e-02; cp = cp * r2 - 0.5; const double cr = 1.0 + r2 * cp;
    const int q = ((int)n) & 3;
    s = (q == 0) ? sr : (q == 1) ? cr : (q == 2) ? -sr : -cr;
    c = (q == 0) ? cr : (q == 1) ? -sr : (q == 2) ? -cr : sr;
}
__device__ __forceinline__ double rope_inv(int j) {
    switch (j) { case 0: return 1.0; case 1: return 0.56234132519034908; case 2: return 0.31622776601683794; case 3: return 0.17782794100389229; case 4: return 0.1; case 5: return 0.056234132519034911;
        case 6: return 0.031622776601683791; case 7: return 0.017782794100389229; case 8: return 0.01; case 9: return 0.0056234132519034910; case 10: return 0.0031622776601683794; case 11: return 0.0017782794100389228;
        case 12: return 0.001; case 13: return 0.00056234132519034910; case 14: return 0.00031622776601683794; default: return 0.00017782794100389228; }
}
__device__ __forceinline__ void p0_rope(const Args& a, Frame& F) {
    float* COS = (float*)(a.ws + WS_COS); float* SIN = (float*)(a.ws + WS_SIN); float* LB = (float*)(a.ws + WS_LBIAS);
    for (int i = blockIdx.x * 512 + F.tid; i < 8192; i += F.G * 512) LB[i] = (i < 4096) ? a.in[I_W0][i] : a.in[I_A0][i - 4096];
    for (int i = blockIdx.x * 512 + F.tid; i < 1024 * 32; i += F.G * 512) { const int t = i >> 5, f = i & 31;
        const double pos = (f < 16) ? (double)(t >> 6) : (double)(t & 63); const double ang = pos * rope_inv(f & 15);
        double s, c; sincos_small(ang, s, c); COS[i] = (float)c; SIN[i] = (float)s; }
}

__device__ __forceinline__ void modnorm_rows(Frame& F, const float* x0, const float* x1, const float* nw, const float* MOD, int shift_slot, bf16* H) {
    for (int row = F.gw; row < T; row += F.ngw) {
        const float* xr = row < T_P ? x0 + (size_t)row * DM : x1 + (size_t)(row - T_P) * DM;
        const float* md = MOD + (size_t)mod_index(row) * NMOD + shift_slot * DM;
        f32x4 v[16]; float ss = 0.f;
#pragma unroll
        for (int j = 0; j < 16; ++j) { v[j] = *((const GAS f32x4*)xr + F.lane + 64 * j); ss += (v[j].x * v[j].x + v[j].y * v[j].y) + (v[j].z * v[j].z + v[j].w * v[j].w); }
        const float rstd = 1.0f / sqrtf(wave_sum(ss) * (1.0f / DM) + NORM_EPS);
#pragma unroll
        for (int j = 0; j < 16; ++j) { const int col = 4 * (F.lane + 64 * j);
            const f32x4 w = *(const f32x4*)(nw + col), sh = *(const f32x4*)(md + col), sc = *(const f32x4*)(md + DM + col);
            const f32x4 o = v[j] * rstd * w * (sc + 1.0f) + sh;
            v2u p; p.x = pg8::cvt_pk_bf16(o.x, o.y); p.y = pg8::cvt_pk_bf16(o.z, o.w); *(GAS v2u*)(H + (size_t)row * DM + col) = p; }
    }
}

__device__ __forceinline__ void modnorm_rows_dual(Frame& F, const float* x0, const float* x1, const float* nw, const float* MOD, int shift_slot, bf16* H, unsigned char* HQ, float* ROWS) {
    for (int row = F.gw; row < T; row += F.ngw) {
        const float* xr = row < T_P ? x0 + (size_t)row * DM : x1 + (size_t)(row - T_P) * DM;
        const float* md = MOD + (size_t)mod_index(row) * NMOD + shift_slot * DM;
        f32x4 v[16]; float ss = 0.f;
#pragma unroll
        for (int j = 0; j < 16; ++j) { v[j] = *((const GAS f32x4*)xr + F.lane + 64 * j); ss += (v[j].x * v[j].x + v[j].y * v[j].y) + (v[j].z * v[j].z + v[j].w * v[j].w); }
        const float rstd = 1.0f / sqrtf(wave_sum(ss) * (1.0f / DM) + NORM_EPS); float mx = 0.f;
#pragma unroll
        for (int jh = 0; jh < 16; jh += 4) {
#pragma unroll
            for (int j = jh; j < jh + 4; ++j) { const int col = 4 * (F.lane + 64 * j);
                const f32x4 w = *(const f32x4*)(nw + col), sh = *(const f32x4*)(md + col), sc = *(const f32x4*)(md + DM + col);
                v[j] = v[j] * rstd * w * (sc + 1.0f) + sh; mx = fmaxf(mx, fmaxf(fmaxf(fabsf(v[j].x), fabsf(v[j].y)), fmaxf(fabsf(v[j].z), fabsf(v[j].w)))); }
#pragma unroll
            for (int j = jh; j < jh + 4; ++j) { const int col = 4 * (F.lane + 64 * j);
                v2u p; p.x = pg8::cvt_pk_bf16(v[j].x, v[j].y); p.y = pg8::cvt_pk_bf16(v[j].z, v[j].w); *(GAS v2u*)(H + (size_t)row * DM + col) = p; }
        }
#pragma unroll
        for (int o = 1; o < 64; o <<= 1) mx = fmaxf(mx, __shfl_xor(mx, o));
        const float qs = mx > 0.f ? 127.0f / mx : 0.f;
        if (F.lane == 0) ROWS[row] = mx * (1.0f / 127.0f);
#pragma unroll
        for (int j = 0; j < 16; ++j) { const int col = 4 * (F.lane + 64 * j);
            *(GAS unsigned*)(HQ + (size_t)row * DM + col) = (unsigned)q8(v[j].x * qs) | ((unsigned)q8(v[j].y * qs) << 8) | ((unsigned)q8(v[j].z * qs) << 16) | ((unsigned)q8(v[j].w * qs) << 24); }
    }
}

__device__ __forceinline__ void modnorm_rows_i8(Frame& F, const bf16* X1, const float* nw, const float* MOD, int shift_slot, unsigned char* H, float* ROWS) {
    for (int row = F.gw; row < T; row += F.ngw) {
        const bf16* xr = X1 + (size_t)row * DM;
        const float* md = MOD + (size_t)mod_index(row) * NMOD + shift_slot * DM;
        f32x4 v[16]; float ss = 0.f;
#pragma unroll
        for (int j = 0; j < 16; ++j) { const v2u t = *((const GAS v2u*)xr + F.lane + 64 * j); v[j] = (f32x4){pg8::bflo(t.x), pg8::bfhi(t.x), pg8::bflo(t.y), pg8::bfhi(t.y)}; ss += (v[j].x * v[j].x + v[j].y * v[j].y) + (v[j].z * v[j].z + v[j].w * v[j].w); }
        const float rstd = 1.0f / sqrtf(wave_sum(ss) * (1.0f / DM) + NORM_EPS); float mx = 0.f;
#pragma unroll
        for (int j = 0; j < 16; ++j) { const int col = 4 * (F.lane + 64 * j);
            const f32x4 w = *(const f32x4*)(nw + col), sh = *(const f32x4*)(md + col), sc = *(const f32x4*)(md + DM + col);
            v[j] = v[j] * rstd * w * (sc + 1.0f) + sh; mx = fmaxf(mx, fmaxf(fmaxf(fabsf(v[j].x), fabsf(v[j].y)), fmaxf(fabsf(v[j].z), fabsf(v[j].w)))); }
#pragma unroll
        for (int o = 1; o < 64; o <<= 1) mx = fmaxf(mx, __shfl_xor(mx, o));
        const float qs = mx > 0.f ? 127.0f / mx : 0.f;
        if (F.lane == 0) ROWS[row] = mx * (1.0f / 127.0f);
#pragma unroll
        for (int j = 0; j < 16; ++j) { const int col = 4 * (F.lane + 64 * j);
            *(GAS unsigned*)(H + (size_t)row * DM + col) = (unsigned)q8(v[j].x * qs) | ((unsigned)q8(v[j].y * qs) << 8) | ((unsigned)q8(v[j].z * qs) << 16) | ((unsigned)q8(v[j].w * qs) << 24); }
    }
}

__device__ __forceinline__ void p8c_quant_mixed(const Args& a, Frame& F) {
    const bf16* MX = (const bf16*)(a.ws + WS_MIXED); unsigned char* Q = (unsigned char*)(a.ws + WS_MIX8); const unsigned* rmax = (const unsigned*)(a.ws + WS_RMAXM); float* ROWS = (float*)(a.ws + WS_ROWSM);
    for (int row = F.gw; row < T; row += F.ngw) { const float mx = __builtin_bit_cast(float, rmax[row]); const float qs = mx > 0.f ? 127.0f / mx : 0.f;
        if (F.lane == 0) ROWS[row] = mx * (1.0f / 127.0f);
        v4u wv[8];
#pragma unroll
        for (int j = 0; j < 8; ++j) wv[j] = *(const GAS v4u*)(MX + (size_t)row * DM + 8 * (F.lane + 64 * j));
#pragma unroll
        for (int j = 0; j < 8; ++j) { const int col = 8 * (F.lane + 64 * j); const v4u w = wv[j];
            v2u o; o.x = (unsigned)q8(pg8::bflo(w.x) * qs) | ((unsigned)q8(pg8::bfhi(w.x) * qs) << 8) | ((unsigned)q8(pg8::bflo(w.y) * qs) << 16) | ((unsigned)q8(pg8::bfhi(w.y) * qs) << 24);
            o.y = (unsigned)q8(pg8::bflo(w.z) * qs) | ((unsigned)q8(pg8::bfhi(w.z) * qs) << 8) | ((unsigned)q8(pg8::bflo(w.w) * qs) << 16) | ((unsigned)q8(pg8::bfhi(w.w) * qs) << 24);
            *(GAS v2u*)(Q + (size_t)row * DM + col) = o; } }
}

__device__ __forceinline__ int kv_row_of_token(int row) { return row < T_P ? row : T_P + ((row - T_P) >> 10) * 1536 + 512 + ((row - T_P) & 1023); }
__device__ __forceinline__ float h2f_(unsigned u) { return (float)__builtin_bit_cast(_Float16, (unsigned short)u); }
__device__ __forceinline__ unsigned q8x4(f32x4 o, float qs) { return (unsigned)q8(o.x * qs) | ((unsigned)q8(o.y * qs) << 8) | ((unsigned)q8(o.z * qs) << 16) | ((unsigned)q8(o.w * qs) << 24); }
__device__ __forceinline__ float absmax4(f32x4 o) { return fmaxf(fmaxf(fabsf(o.x), fabsf(o.y)), fmaxf(fabsf(o.z), fabsf(o.w))); }
__device__ __forceinline__ float wave_max(float v) {
#pragma unroll
    for (int o = 1; o < 64; o <<= 1) v = fmaxf(v, __shfl_xor(v, o));
    return v;
}
__device__ __forceinline__ float wave_sum_d(float x) { x = row16_sum(x); const int xi = __builtin_bit_cast(int, x);
    return (__builtin_bit_cast(float, __builtin_amdgcn_readlane(xi, 0)) + __builtin_bit_cast(float, __builtin_amdgcn_readlane(xi, 16))) + (__builtin_bit_cast(float, __builtin_amdgcn_readlane(xi, 32)) + __builtin_bit_cast(float, __builtin_amdgcn_readlane(xi, 48))); }
__device__ __forceinline__ float wave_max_d(float x) {
    x = fmaxf(x, dpp_f(x, 0)); x = fmaxf(x, dpp_f(x, 1)); x = fmaxf(x, dpp_f(x, 2)); x = fmaxf(x, dpp_f(x, 3)); const int xi = __builtin_bit_cast(int, x);
    return fmaxf(fmaxf(__builtin_bit_cast(float, __builtin_amdgcn_readlane(xi, 0)), __builtin_bit_cast(float, __builtin_amdgcn_readlane(xi, 16))), fmaxf(__builtin_bit_cast(float, __builtin_amdgcn_readlane(xi, 32)), __builtin_bit_cast(float, __builtin_amdgcn_readlane(xi, 48)))); }
__device__ __forceinline__ void p3_post(const Args& a, Frame& F) {
    const float* QLAT = (const float*)(a.ws + WS_QLAT); const float* KVLAT = (const float*)(a.ws + WS_KVLAT); const float* KPE = (const float*)(a.ws + WS_KPE);
    unsigned char* QN = (unsigned char*)(a.ws + WS_QN); unsigned char* CKVA = (unsigned char*)(a.ws + WS_CKVA); float* ROWSQ = (float*)(a.ws + WS_ROWSQ); float* ROWSKV = (float*)(a.ws + WS_ROWSKV);
    const float* qnw = a.in[I_QNW]; const float* kvnw = a.in[I_KVNW];
    constexpr int NT3 = T + 2048;
    f32x4 wq[4], wk[2];
#pragma unroll
    for (int j = 0; j < 4; ++j) wq[j] = *(const f32x4*)(qnw + 4 * (F.lane + 64 * j));
#pragma unroll
    for (int j = 0; j < 2; ++j) wk[j] = *(const f32x4*)(kvnw + 4 * (F.lane + 64 * j));
    v2u ntq[4]; f32x4 nvk[2]; float nkpe = 0.f;
#pragma unroll
    for (int j = 0; j < 4; ++j) ntq[j] = (v2u){0u, 0u};
#define P3_ISSUE(task_) do { const int tk_ = (task_); \
        if (tk_ < T) { \
            _Pragma("unroll") for (int j = 0; j < 4; ++j) ntq[j] = *((const GAS v2u*)((const unsigned short*)QLAT + (size_t)tk_ * QL) + F.lane + 64 * j);     \
            _Pragma("unroll") for (int j = 0; j < 2; ++j) nvk[j] = *((const GAS f32x4*)(KVLAT + (size_t)tk_ * KVL) + F.lane + 64 * j); \
            nkpe = (tk_ < T_P) ? KPE[(size_t)tk_ * 64 + F.lane] : 0.f; \
        } else { const float* src_ = a.in[I_CCKV] + (size_t)(tk_ - T) * KVL; \
            _Pragma("unroll") for (int j = 0; j < 2; ++j) nvk[j] = *(const GAS f32x4*)(src_ + 4 * (F.lane + 64 * j)); } } while (0)
    if (F.gw < NT3) P3_ISSUE(F.gw);
    for (int task = F.gw; task < NT3; task += F.ngw) {
        v2u tq[4]; f32x4 vk[2]; const float kpev = nkpe;
#pragma unroll
        for (int j = 0; j < 4; ++j) tq[j] = ntq[j];
#pragma unroll
        for (int j = 0; j < 2; ++j) vk[j] = nvk[j];
        if (task + F.ngw < NT3) P3_ISSUE(task + F.ngw);
        if (task < T) { const int row = task;
            f32x4 v[4]; float ss = 0.f;
#pragma unroll
            for (int j = 0; j < 4; ++j) { v[j] = (f32x4){h2f_(tq[j].x & 0xffff), h2f_(tq[j].x >> 16), h2f_(tq[j].y & 0xffff), h2f_(tq[j].y >> 16)}; ss += (v[j].x * v[j].x + v[j].y * v[j].y) + (v[j].z * v[j].z + v[j].w * v[j].w); }
            const float rstd = 1.0f / sqrtf(wave_sum_d(ss) * (1.0f / QL) + NORM_EPS); float mx = 0.f;
#pragma unroll
            for (int j = 0; j < 4; ++j) { v[j] = v[j] * rstd * wq[j]; mx = fmaxf(mx, absmax4(v[j])); }
            mx = wave_max_d(mx); const float qs = mx > 0.f ? 127.0f / mx : 0.f;
            float ss2 = 0.f;
#pragma unroll
            for (int j = 0; j < 2; ++j) ss2 += (vk[j].x * vk[j].x + vk[j].y * vk[j].y) + (vk[j].z * vk[j].z + vk[j].w * vk[j].w);
            const float rstd2 = 1.0f / sqrtf(wave_sum_d(ss2) * (1.0f / KVL) + NORM_EPS); const int kr = kv_row_of_token(row); float mx2 = 0.f;
#pragma unroll
            for (int j = 0; j < 2; ++j) { vk[j] = vk[j] * rstd2 * wk[j]; mx2 = fmaxf(mx2, absmax4(vk[j])); }
            mx2 = wave_max_d(mx2); const float qs2 = mx2 > 0.f ? 127.0f / mx2 : 0.f;
            if (F.lane == 0) { ROWSQ[row] = mx * (1.0f / 127.0f); ROWSKV[kr] = mx2 * (1.0f / 127.0f); }
#pragma unroll
            for (int j = 0; j < 4; ++j) *(GAS unsigned*)(QN + (size_t)row * QL + 4 * (F.lane + 64 * j)) = q8x4(v[j], qs);
#pragma unroll
            for (int j = 0; j < 2; ++j) { const int col = 4 * (F.lane + 64 * j); *(GAS unsigned*)(CKVA + (size_t)kr * KVL + col) = q8x4(vk[j], qs2);
                if (row < T_P) *(GAS f32x4*)(a.out + OUT_CKV + (size_t)row * KVL + col) = vk[j]; }
            if (row < T_P) a.out[OUT_KPE + (size_t)row * 64 + F.lane] = kpev;
        } else { const int idx = task - T, b = idx >> 9, p = idx & 511; const int kr = T_P + b * 1536 + p;
            float mx = fmaxf(absmax4(vk[0]), absmax4(vk[1]));
            mx = wave_max_d(mx); const float qs = mx > 0.f ? 127.0f / mx : 0.f; if (F.lane == 0) ROWSKV[kr] = mx * (1.0f / 127.0f);
#pragma unroll
            for (int j = 0; j < 2; ++j) { const int col = 4 * (F.lane + 64 * j); *(GAS unsigned*)(CKVA + (size_t)kr * KVL + col) = q8x4(vk[j], qs); }
        }
    }
#undef P3_ISSUE
}
struct SidePair { int kind, first, last, cs; const float* src; unsigned char* dst; unsigned* cm; unsigned ld, ldt; };
constexpr int SIDE_PART_OFF = 98304;
static_assert(SIDE_PART_OFF + 1024 <= RING_BYTES, "side-work LDS");
__device__ __forceinline__ void side_pair_next(const Args& a, int b, int w, int p, SidePair& d) {
    const int s8p = b < 96 ? 80 : 72;
    if (p < s8p) {
        const int win = p >> 4, within = p & 15; const bool half = (win == 4 && b >= 48);
        const int wi = half ? (within & 7) : within, nsubp = half ? 4 : 8;
        if (wi != 0 && wi != nsubp) { const int subp = wi >= nsubp ? wi - nsubp : wi; d.src += (size_t)64 * d.ld; d.dst += 64; d.first = 0; d.last = subp == nsubp - 1; return; }
        int K, srcc;
        if (!half) { const int idx = b + 256 * win; K = DM;
            if (idx < 688) { const int n0 = 32 * idx, pn = n0 >> 8, j = n0 & 255; srcc = (j < 128) ? 128 * pn + j : DFF + 128 * pn + (j - 128);
                d.src = a.in[I_WFI]; d.ld = 2 * DFF; d.dst = a.ws + WS_WFI + (size_t)n0 * DM; d.cm = (unsigned*)(a.ws + WS_CMAX) + srcc; }
            else if (idx < 944) { const int nb = idx - 688; srcc = 8736 + 32 * nb; d.src = a.in[I_WIN]; d.ld = 16928; d.dst = a.ws + WS_WGATE8 + (size_t)(32 * nb) * DM; d.cm = (unsigned*)(a.ws + WS_CMAXG) + 32 * nb; }
            else { const int nb = idx - 944; srcc = 32 * nb; d.src = a.in[I_WOUT]; d.ld = DM; d.dst = a.ws + WS_WOUT + (size_t)(32 * nb) * DM; d.cm = (unsigned*)(a.ws + WS_CMAXO) + 32 * nb; }
        } else { K = DA; d.ld = DM;
            if ((within >> 3) == 0 && b < 176) { const int nb = b - 48; srcc = 32 * nb; d.src = a.in[I_WOR]; d.dst = a.ws + WS_WOR + (size_t)(32 * nb) * DA; d.cm = (unsigned*)(a.ws + WS_CMAXR) + 32 * nb; }
            else { const int nb = b >= 176 ? b - 176 : 80 + (b - 48); srcc = 32 * nb; d.src = a.in[I_WOM]; d.dst = a.ws + WS_WOM + (size_t)(32 * nb) * DA; d.cm = (unsigned*)(a.ws + WS_CMAXM) + 32 * nb; } }
        const int pass = wi >= nsubp ? 1 : 0, k0 = w * (K >> 3);
        d.kind = 1 + pass; d.first = 1; d.last = 0; d.ldt = (unsigned)K; d.cs = 3;
        d.src += (size_t)k0 * d.ld + srcc; d.dst += k0;
        return;
    }
    const int f = b + 256 * (p - s8p);
    d.first = 0; d.last = 0; d.ld = DM; d.cs = 4;
    if (f < 2752) { const int nbp = f & 63, k0 = 256 * (f >> 6) + 32 * w; d.kind = 3; d.src = a.in[I_WFO] + (size_t)k0 * DM + 64 * nbp; d.dst = a.ws + WS_WFO + (size_t)(64 * nbp) * DFF + k0; d.ldt = DFF; }
    else { d.kind = 0; d.src = a.in[I_WFI]; d.ld = 0; d.cs = 3; }
}
__device__ __forceinline__ const char* side_issue_addr(const SidePair& d, int lane) {
    const int g = lane >> d.cs, cg = lane & ((1 << d.cs) - 1);
    const unsigned loff = ((unsigned)(8 * g) * d.ld + (unsigned)(4 * cg)) * 4u;
    return (const char*)d.src + loff;
}
__device__ __forceinline__ f32x4 side_issue_one(const char* pa, unsigned ld, int j) { return *(const GAS f32x4*)(pa + (size_t)j * ld * 4u); }
__device__ __forceinline__ unsigned side_pack4(float a, float b, float c, float e, float sc) {
    const unsigned q0 = __builtin_bit_cast(unsigned, __builtin_fmaf(a, sc, 12582912.0f)), q1 = __builtin_bit_cast(unsigned, __builtin_fmaf(b, sc, 12582912.0f));
    const unsigned q2 = __builtin_bit_cast(unsigned, __builtin_fmaf(c, sc, 12582912.0f)), q3 = __builtin_bit_cast(unsigned, __builtin_fmaf(e, sc, 12582912.0f));
    return __builtin_amdgcn_perm(q1, q0, 0x0c0c0400u) | __builtin_amdgcn_perm(q3, q2, 0x04000c0cu);
}
#define SIDE_COL(c_, j_) (c_ == 0 ? R[j_].x : c_ == 1 ? R[j_].y : c_ == 2 ? R[j_].z : R[j_].w)
__device__ __forceinline__ void side_consume(const SidePair& d, int lane, int w, const f32x4 (&R)[8], float (&mx)[4], float (&sc)[4], LAS float* PART) {
    if (d.kind == 0) return;
    const int g = lane >> d.cs, cg = lane & ((1 << d.cs) - 1);
    if (d.kind == 1) {
        f32x4 m = d.first ? (f32x4){0.f, 0.f, 0.f, 0.f} : (f32x4){mx[0], mx[1], mx[2], mx[3]};
#pragma unroll
        for (int j = 0; j < 8; ++j) m = __builtin_elementwise_max(m, __builtin_elementwise_abs(R[j]));
        if (d.last) {
#pragma unroll
            for (int o = 8; o < 64; o <<= 1) { m.x = fmaxf(m.x, __shfl_xor(m.x, o)); m.y = fmaxf(m.y, __shfl_xor(m.y, o)); m.z = fmaxf(m.z, __shfl_xor(m.z, o)); m.w = fmaxf(m.w, __shfl_xor(m.w, o)); }
            if (lane < 8) *(LAS f32x4*)(PART + w * 32 + 4 * lane) = m;
        }
        mx[0] = m.x; mx[1] = m.y; mx[2] = m.z; mx[3] = m.w;
        return;
    }
    if (d.kind == 2) {
        if (d.first) { f32x4 m = *(const LAS f32x4*)(PART + 4 * cg);
#pragma unroll
            for (int r = 1; r < 8; ++r) m = __builtin_elementwise_max(m, *(const LAS f32x4*)(PART + r * 32 + 4 * cg));
            sc[0] = m.x > 0.f ? 127.0f / m.x : 0.f; sc[1] = m.y > 0.f ? 127.0f / m.y : 0.f; sc[2] = m.z > 0.f ? 127.0f / m.z : 0.f; sc[3] = m.w > 0.f ? 127.0f / m.w : 0.f;
            if (w == 0 && g == 0) { const float m0 = m.x, m1 = m.y, m2 = m.z, m3 = m.w; v4u o; o.x = __builtin_bit_cast(unsigned, m0); o.y = __builtin_bit_cast(unsigned, m1); o.z = __builtin_bit_cast(unsigned, m2); o.w = __builtin_bit_cast(unsigned, m3);
                *(GAS v4u*)(d.cm + 4 * cg) = o; } }
        unsigned char* q = d.dst + (size_t)(4 * cg) * d.ldt + 8 * g;
#pragma unroll
        for (int c = 0; c < 4; ++c) { v2u o; o.x = side_pack4(SIDE_COL(c, 0), SIDE_COL(c, 1), SIDE_COL(c, 2), SIDE_COL(c, 3), sc[c]); o.y = side_pack4(SIDE_COL(c, 4), SIDE_COL(c, 5), SIDE_COL(c, 6), SIDE_COL(c, 7), sc[c]);
            *(GAS v2u*)(q + (size_t)c * d.ldt) = o; }
        return;
    }
    if (d.kind == 3) {
        unsigned char* q = d.dst + (size_t)(4 * cg) * d.ldt + 8 * g;
#pragma unroll
        for (int c = 0; c < 4; ++c) { unsigned t0 = 0u, t1 = 0u;
            t0 = __builtin_amdgcn_cvt_pk_fp8_f32(SIDE_COL(c, 0) * 128.0f, SIDE_COL(c, 1) * 128.0f, t0, false); t0 = __builtin_amdgcn_cvt_pk_fp8_f32(SIDE_COL(c, 2) * 128.0f, SIDE_COL(c, 3) * 128.0f, t0, true);
            t1 = __builtin_amdgcn_cvt_pk_fp8_f32(SIDE_COL(c, 4) * 128.0f, SIDE_COL(c, 5) * 128.0f, t1, false); t1 = __builtin_amdgcn_cvt_pk_fp8_f32(SIDE_COL(c, 6) * 128.0f, SIDE_COL(c, 7) * 128.0f, t1, true);
            v2u o; o.x = t0; o.y = t1; *(GAS v2u*)(q + (size_t)c * d.ldt) = o; }
        return;
    }
    {
        unsigned char* q = d.dst + ((size_t)(4 * cg) * d.ldt + 8 * g) * 2;
#pragma unroll
        for (int c = 0; c < 4; ++c) { v4u o; o.x = pg8::cvt_pk_bf16(SIDE_COL(c, 0), SIDE_COL(c, 1)); o.y = pg8::cvt_pk_bf16(SIDE_COL(c, 2), SIDE_COL(c, 3)); o.z = pg8::cvt_pk_bf16(SIDE_COL(c, 4), SIDE_COL(c, 5)); o.w = pg8::cvt_pk_bf16(SIDE_COL(c, 6), SIDE_COL(c, 7));
            *(GAS v4u*)(q + (size_t)c * d.ldt * 2) = o; }
    }
}
constexpr int SC_TS = 16, SC_NCH = 96, SC_BUF_FLOATS = SC_TS * 6 * 64;
struct ScanChain { int row0, L, h, dir, b, is_sample; };
__device__ __forceinline__ ScanChain scan_chain(int gid, int idx) {
    ScanChain c; int code;
    if (gid < 256) { if (idx == 0) { code = gid; c.is_sample = 1; } else { code = 2 * gid + (idx - 1); c.is_sample = 0; } }
    else { code = 512 + 6 * (gid - 256) + idx; c.is_sample = 0; }
    c.b = code >> 6; c.h = (code >> 1) & 31; c.dir = code & 1;
    if (c.is_sample) { c.row0 = T_P + c.b * 1024; c.L = 1024; } else { c.row0 = c.b * 256; c.L = 256; }
    return c;
}
__device__ __forceinline__ void scan_locate(int gid, int ci, int& idx, int& chunk) {
    if (gid < 256) { if (ci < 64) { idx = 0; chunk = ci; } else { idx = 1 + ((ci - 64) >> 4); chunk = (ci - 64) & 15; } }
    else { idx = ci >> 4; chunk = ci & 15; }
}
struct ScanPref { unsigned short r[4], k[4], v[4], e[4], a[4]; float kk, ka, rk; };
__device__ __forceinline__ float h2f(unsigned short u) { return (float)__builtin_bit_cast(_Float16, u); }

__device__ __forceinline__ float fmul_s(float a, float b) { float r; asm("v_mul_f32_e32 %0, %1, %2" : "=v"(r) : "v"(a), "v"(b)); return r; }
__device__ __forceinline__ float ffma_s(float a, float b, float c) { float r; asm("v_fma_f32 %0, %1, %2, %3" : "=v"(r) : "v"(a), "v"(b), "v"(c)); return r; }
__device__ __forceinline__ void reduce2_oct(float& a, float& b) {
    asm("s_nop 1\n\t"
        "v_add_f32_dpp %0, %0, %0 quad_perm:[1,0,3,2] row_mask:0xf bank_mask:0xf bound_ctrl:1\n\t"
        "v_add_f32_dpp %1, %1, %1 quad_perm:[1,0,3,2] row_mask:0xf bank_mask:0xf bound_ctrl:1\n\t"
        "s_nop 0\n\t"
        "v_add_f32_dpp %0, %0, %0 quad_perm:[2,3,0,1] row_mask:0xf bank_mask:0xf bound_ctrl:1\n\t"
        "v_add_f32_dpp %1, %1, %1 quad_perm:[2,3,0,1] row_mask:0xf bank_mask:0xf bound_ctrl:1\n\t"
        "s_nop 0\n\t"
        "v_add_f32_dpp %0, %0, %0 row_half_mirror row_mask:0xf bank_mask:0xf bound_ctrl:1\n\t"
        "v_add_f32_dpp %1, %1, %1 row_half_mirror row_mask:0xf bank_mask:0xf bound_ctrl:1\n\t"
        : "+v"(a), "+v"(b));
}
__device__ __forceinline__ float wave_sum_u(float x) {
    x = row16_sum(x);
    const int xi = __builtin_bit_cast(int, x);
    const float s0 = __builtin_bit_cast(float, __builtin_amdgcn_readlane(xi, 0)), s1 = __builtin_bit_cast(float, __builtin_amdgcn_readlane(xi, 16)),
                s2 = __builtin_bit_cast(float, __builtin_amdgcn_readlane(xi, 32)), s3 = __builtin_bit_cast(float, __builtin_amdgcn_readlane(xi, 48));
    return (s0 + s1) + (s2 + s3);
}
template <int SIDE = 1> __device__ __forceinline__ void p5_scan(const Args& a, Frame& F) {
    const unsigned short* RKV = (const unsigned short*)(a.ws + WS_RKV); const unsigned char* EW = (const unsigned char*)(a.ws + WS_EW); const unsigned char* AA = EW + (size_t)2 * T * DA;
    _Float16* YS = (_Float16*)(a.ws + WS_YS); float* BON = (float*)(a.ws + WS_BON);
    const float* k_k = a.in[I_KK]; const float* k_a = a.in[I_KA]; const float* r_k = a.in[I_RK];
    const int grp = F.wave >> 2, wq = F.wave & 3, lane = F.lane, rp = lane >> 3, kq = lane & 7;
    LAS float* buf0 = (LAS float*)F.lds + (grp * 2) * SC_BUF_FLOATS;
    if (F.G != 256) return;
    const int gid = grp == 0 ? (int)blockIdx.x : 256 + (int)blockIdx.x;

    ScanPref P; float bonv[4];
#define SC_LOAD(ci_) do { const int cc_ = (ci_) < SC_NCH ? (ci_) : SC_NCH - 1; int idx_, ch_; scan_locate(gid, cc_, idx_, ch_); const ScanChain c_ = scan_chain(gid, idx_); \
        P.kk = k_k[c_.h * 64 + lane]; P.ka = k_a[c_.h * 64 + lane]; P.rk = r_k[c_.h * 64 + lane]; \
        _Pragma("unroll") for (int j = 0; j < 4; ++j) { const int s_ = ch_ * SC_TS + 4 * wq + j; const int t_ = c_.dir ? c_.L - 1 - s_ : s_; const size_t row_ = (size_t)(c_.row0 + t_); \
            const unsigned short* rp = RKV + row_ * 6144 + c_.h * 64 + lane; P.r[j] = rp[0]; P.k[j] = rp[2048]; P.v[j] = rp[4096]; \
            const size_t o_ = ((size_t)c_.dir * T + row_) * DA + c_.h * 64 + lane; P.e[j] = EW[o_]; P.a[j] = AA[o_]; } } while (0)
#define SC_STAGE(ci_, pb_) do { const int cc_ = (ci_) < SC_NCH ? (ci_) : SC_NCH - 1; int idx_, ch_; scan_locate(gid, cc_, idx_, ch_); const ScanChain c_ = scan_chain(gid, idx_); LAS float* B_ = buf0 + (pb_) * SC_BUF_FLOATS; \
        const float kkw = P.kk, kaw = P.ka, rkw = P.rk;     \
        _Pragma("unroll") for (int j = 0; j < 4; ++j) { const int i_ = 4 * wq + j; \
            const float r_ = h2f(P.r[j]), k_ = h2f(P.k[j]), v_ = h2f(P.v[j]), e_ = (float)P.e[j] * (0.60653065971263342f / 255.0f), a_ = (float)P.a[j] * (1.0f / 255.0f); \
            const float kr_ = k_ * kkw; const float kk_ = kr_ * __builtin_amdgcn_rsqf(wave_sum_u(kr_ * kr_) + 1e-12f); \
            const float kd_ = k_ * (1.0f + (a_ - 1.0f) * kaw); bonv[j] = wave_sum_u(r_ * kd_ * rkw); \
            LAS float* o_ = B_ + i_ * 6 * 64 + lane; o_[0] = -kk_; o_[64] = __expf(-e_); o_[128] = kk_ * a_; o_[192] = kd_; o_[256] = r_; o_[320] = v_; } } while (0)
#define SC_BON(ci_) do { if ((ci_) < SC_NCH && lane < 4) { int idx_, ch_; scan_locate(gid, (ci_), idx_, ch_); const ScanChain c_ = scan_chain(gid, idx_); \
            const int s_ = ch_ * SC_TS + 4 * wq + lane; const int t_ = c_.dir ? c_.L - 1 - s_ : s_; \
            const float bv_ = lane == 0 ? bonv[0] : lane == 1 ? bonv[1] : lane == 2 ? bonv[2] : bonv[3]; \
            BON[((size_t)c_.dir * T + (size_t)(c_.row0 + t_)) * 32 + c_.h] = bv_; } } while (0)

    SC_LOAD(0); SC_STAGE(0, 0); SC_BON(0); SC_LOAD(1);
    asm volatile("s_waitcnt lgkmcnt(0)" ::: "memory"); __syncthreads();

    float S[2][8];
#if SIDE_IN_SCAN
    f32x4 SR[8]; float smx[4] = {0.f, 0.f, 0.f, 0.f}, ssc[4] = {0.f, 0.f, 0.f, 0.f};
#pragma unroll
    for (int j = 0; j < 8; ++j) SR[j] = (f32x4){0.f, 0.f, 0.f, 0.f};
    LAS float* PART = (LAS float*)(F.lds + SIDE_PART_OFF);
    const char* spa = (const char*)a.in[I_WFI]; unsigned sld = 0;
    SidePair sd; sd.kind = 0; sd.first = 0; sd.last = 0; sd.src = a.in[I_WFI]; sd.dst = a.ws; sd.cm = (unsigned*)(a.ws + WS_CMAX); sd.ld = 0; sd.ldt = 0; sd.cs = 3;
#endif
    for (int ci = 0; ci < SC_NCH; ++ci) {
        int idx, chunk; scan_locate(gid, ci, idx, chunk); const ScanChain c = scan_chain(gid, idx);
        const size_t sbase = (size_t)((c.b * 2 + c.dir) * 32 + c.h) * 4096 + (size_t)(16 * wq + 2 * rp) * 64 + 8 * kq;
        if (chunk == 0) {
            if (c.is_sample) {
#pragma unroll
                for (int rr = 0; rr < 2; ++rr) { const f32x4 s0 = *(const f32x4*)(a.in[I_STATE] + sbase + rr * 64), s1 = *(const f32x4*)(a.in[I_STATE] + sbase + rr * 64 + 4);
                    S[rr][0] = s0.x; S[rr][1] = s0.y; S[rr][2] = s0.z; S[rr][3] = s0.w; S[rr][4] = s1.x; S[rr][5] = s1.y; S[rr][6] = s1.z; S[rr][7] = s1.w; }
#pragma unroll
                for (int rr = 0; rr < 2; ++rr)
#pragma unroll
                    for (int j = 0; j < 8; ++j) asm volatile("" : "+v"(S[rr][j]));
            } else {
#pragma unroll
                for (int rr = 0; rr < 2; ++rr)
#pragma unroll
                    for (int j = 0; j < 8; ++j) S[rr][j] = 0.f;
            }
        }
        const LAS float* B = buf0 + (ci & 1) * SC_BUF_FLOATS;
        _Float16* yout = YS + (size_t)c.dir * T * DA + c.h * 64 + 16 * wq + 2 * rp;
        unsigned ypk[SC_TS];
#define SC_RD8(dst, off) do { const f32x4 lo_ = *(const LAS f32x4*)(O + (off) + 8 * kq), hi_ = *(const LAS f32x4*)(O + (off) + 8 * kq + 4); \
                dst[0] = lo_.x; dst[1] = lo_.y; dst[2] = lo_.z; dst[3] = lo_.w; dst[4] = hi_.x; dst[5] = hi_.y; dst[6] = hi_.z; dst[7] = hi_.w; \
                _Pragma("unroll") for (int j = 0; j < 8; ++j) asm("" : "+v"(dst[j])); } while (0)
#define SC_STEP(i) do { \
            const LAS float* O = B + (i) * 6 * 64; \
            float av[8], wv[8], bv[8], kv[8], rv[8], vv[2]; \
            SC_RD8(av, 0); SC_RD8(wv, 64); SC_RD8(bv, 128); SC_RD8(kv, 192); SC_RD8(rv, 256); \
            { const f32x2 v2 = *(const LAS f32x2*)(O + 320 + 16 * wq + 2 * rp); vv[0] = v2.x; vv[1] = v2.y; asm("" : "+v"(vv[0])); asm("" : "+v"(vv[1])); } \
            float sa[2], y[2]; \
            _Pragma("unroll") for (int rr = 0; rr < 2; ++rr) { float t = S[rr][0] * av[0]; \
                _Pragma("unroll") for (int j = 1; j < 8; ++j) t = __builtin_fmaf(S[rr][j], av[j], t); \
                sa[rr] = t; } \
            reduce2_oct(sa[0], sa[1]); \
            _Pragma("unroll") for (int rr = 0; rr < 2; ++rr) { \
                _Pragma("unroll") for (int j = 0; j < 8; ++j) { S[rr][j] = __builtin_fmaf(vv[rr], kv[j], __builtin_fmaf(S[rr][j], wv[j], sa[rr] * bv[j])); asm("" : "+v"(S[rr][j])); } \
                float t = S[rr][0] * rv[0]; \
                _Pragma("unroll") for (int j = 1; j < 8; ++j) t = __builtin_fmaf(S[rr][j], rv[j], t); \
                y[rr] = t; } \
            reduce2_oct(y[0], y[1]); \
            ypk[i] = pg8::pk_f16(y[0], y[1]); } while (0)
        SC_STEP(0); SC_STEP(1); SC_STEP(2); SC_STEP(3); SC_STEP(4); SC_STEP(5); SC_STEP(6); SC_STEP(7);
        {
            SC_STAGE(ci + 1, (ci + 1) & 1);
            SC_BON(ci + 1);
#if SIDE_IN_SCAN
            if constexpr (SIDE != 0) {
            if constexpr (SIDE == 1) side_consume(sd, lane, F.wave, SR, smx, ssc, PART);
            else { _Pragma("unroll") for (int j = 0; j < 8; ++j) { asm volatile("" :: "v"(SR[j])); } }
            side_pair_next(a, (int)blockIdx.x, F.wave, ci, sd);
            spa = side_issue_addr(sd, lane); sld = sd.ld;
            }
#endif
            SC_LOAD(ci + 2);
        }
#if SIDE_IN_SCAN
#define SC_SIDE_LOAD(j) do { if constexpr (SIDE != 0) { SR[j] = side_issue_one(spa, sld, j); __builtin_amdgcn_sched_barrier(0x38F); } } while (0)
#else
#define SC_SIDE_LOAD(j) do { } while (0)
#endif
        SC_STEP(8); SC_SIDE_LOAD(0); SC_STEP(9); SC_SIDE_LOAD(1); SC_STEP(10); SC_SIDE_LOAD(2); SC_STEP(11); SC_SIDE_LOAD(3); SC_STEP(12); SC_SIDE_LOAD(4); SC_STEP(13); SC_SIDE_LOAD(5); SC_STEP(14); SC_SIDE_LOAD(6); SC_STEP(15); SC_SIDE_LOAD(7);
#undef SC_SIDE_LOAD
#undef SC_STEP
#undef SC_RD8
        if (kq == 0) {
#pragma unroll
            for (int i = 0; i < SC_TS; ++i) { const int s = chunk * SC_TS + i; const int t = c.dir ? c.L - 1 - s : s;
                *(GAS unsigned*)(yout + (size_t)(c.row0 + t) * DA) = ypk[i]; }
        }
        if (!c.is_sample && chunk == (c.L / SC_TS) - 1) {
#pragma unroll
            for (int rr = 0; rr < 2; ++rr) { *(GAS f32x4*)(a.out + OUT_STATE + sbase + rr * 64) = (f32x4){S[rr][0], S[rr][1], S[rr][2], S[rr][3]};
                *(GAS f32x4*)(a.out + OUT_STATE + sbase + rr * 64 + 4) = (f32x4){S[rr][4], S[rr][5], S[rr][6], S[rr][7]}; }
        }
        asm volatile("s_waitcnt lgkmcnt(0)\n\ts_barrier" ::: "memory");
    }
    asm volatile("s_waitcnt vmcnt(0) lgkmcnt(0)" ::: "memory");
#undef SC_LOAD
#undef SC_STAGE
#undef SC_BON
}
__device__ __forceinline__ float bf2f(bf16 b) { return __builtin_bit_cast(float, (unsigned)b << 16); }
__device__ __forceinline__ bf16 f2bf_rne(float f) { return (bf16)(pg8::cvt_pk_bf16(f, 0.f) & 0xffffu); }
struct P5Task { unsigned short r0[16], r1[16], r2[16]; float w0, w1, w2, cs, sn, kx2; int pos, isq; size_t orow; };
__device__ __forceinline__ void p5_issue(const Args& a, int task, int lane, P5Task& X) {
    const unsigned short* Q = (const unsigned short*)(a.ws + WS_Q); const unsigned short* KV = (const unsigned short*)(a.ws + WS_KV); const float* KPE = (const float*)(a.ws + WS_KPE);
    const float* COS = (const float*)(a.ws + WS_COS); const float* SIN = (const float*)(a.ws + WS_SIN);
    const bool isq = task < T; int pos = -1; const float* kpe = KPE; size_t qrow = 0, kvrow = 0;
    if (isq) { qrow = task; if (task >= T_P) pos = (task - T_P) & 1023; }
    else { kvrow = task - T;
        if (kvrow < (size_t)T_P) kpe = KPE + kvrow * 64;
        else { const int r = (int)kvrow - T_P, b = r / 1536, p = r % 1536;
            if (p < 512) kpe = a.in[I_CKPE] + (size_t)(b * 512 + p) * 64; else { pos = p - 512; kpe = KPE + (size_t)(T_P + b * 1024 + pos) * 64; } } }
    const float* hn = isq ? a.in[I_QHN] : a.in[I_KHN];
    X.w0 = hn[lane]; X.w1 = hn[64 + lane]; X.w2 = hn[128 + lane];
    X.cs = 1.f; X.sn = 0.f; if (pos >= 0) { X.cs = COS[pos * 32 + (lane & 31)]; X.sn = SIN[pos * 32 + (lane & 31)]; }
    X.kx2 = isq ? 0.f : kpe[lane]; X.pos = pos; X.isq = isq ? 1 : 0; X.orow = isq ? qrow : kvrow;
    if (isq) { const unsigned short* p = Q + qrow * 3072;
#pragma unroll
        for (int h = 0; h < 16; ++h) { X.r0[h] = p[h * 192 + lane]; X.r1[h] = p[h * 192 + 64 + lane]; X.r2[h] = p[h * 192 + 128 + lane]; } }
    else { const unsigned short* p = KV + kvrow * 4096;
#pragma unroll
        for (int h = 0; h < 16; ++h) { X.r0[h] = p[h * 256 + lane]; X.r1[h] = p[h * 256 + 64 + lane]; X.r2[h] = 0; } }
}
__device__ __forceinline__ void p5_qkprep(const Args& a, Frame& F) {
    unsigned short* Q = (unsigned short*)(a.ws + WS_Q); unsigned short* KP = (unsigned short*)(a.ws + WS_KP);
    const int lane = F.lane; constexpr int NTASK = T + KVROWS;
    P5Task A;
    if (F.gw < NTASK) p5_issue(a, F.gw, lane, A);
    for (int task = F.gw; task < NTASK; task += F.ngw) {
        P5Task B = A;
        if (task + F.ngw < NTASK) p5_issue(a, task + F.ngw, lane, B);
        unsigned short o0[16], o1[16], o2[16];
#pragma unroll
        for (int h = 0; h < 16; ++h) {
            const float x0 = bf2f((bf16)A.r0[h]), x1 = bf2f((bf16)A.r1[h]), x2 = A.isq ? bf2f((bf16)A.r2[h]) : A.kx2;
            const float rs = 1.0f / sqrtf(wave_sum_u(x0 * x0 + x1 * x1 + x2 * x2) * (1.0f / 192.0f) + NORM_EPS);
            const float y0 = x0 * rs * A.w0, y1 = x1 * rs * A.w1; float y2 = x2 * rs * A.w2;
            if (A.pos >= 0) { const float pr = __shfl_xor(y2, 32); y2 = (lane < 32) ? y2 * A.cs - pr * A.sn : pr * A.sn + y2 * A.cs; }
            o0[h] = (unsigned short)f2bf_rne(y0); o1[h] = (unsigned short)f2bf_rne(y1); o2[h] = (unsigned short)f2bf_rne(y2);
        }
        { unsigned short* o = (A.isq ? Q : KP) + A.orow * 3072;
#pragma unroll
            for (int h = 0; h < 16; ++h) { o[h * 192 + lane] = o0[h]; o[h * 192 + 64 + lane] = o1[h]; o[h * 192 + 128 + lane] = o2[h]; } }
        A = B;
    }
}

namespace attn {
using bf16x8 = __attribute__((ext_vector_type(8))) short;
using s16x4  = __attribute__((ext_vector_type(4))) short;
using f32x16 = __attribute__((ext_vector_type(16))) float;
using u32x4  = __attribute__((ext_vector_type(4))) unsigned;
constexpr int DQK = 192, DV = 128, NW = 8, QBLK = 32, KVBLK = 64;
constexpr int LDQ = 3072, LDK = 3072, LDV = 4096, LDO = 2048;
constexpr float SCALE = 0.07216878364870322f;
constexpr float THR = 8.f;
constexpr size_t SHM_V = KVBLK * DV * 2, SHM_K = KVBLK * DQK * 2, SHM_ATTN = 2 * SHM_V + 2 * SHM_K + NW * 64 * 4;
#define KSWZ(row, colB) ((row) * 384 + ((colB) ^ (((row) & 7) << 4)))
#define SBAR() __builtin_amdgcn_sched_barrier(0)
__device__ __forceinline__ int crow(int r, int hi) { return (r & 3) + 8 * (r >> 2) + 4 * hi; }
__device__ __forceinline__ unsigned cvtpk(float lo, float hi) { return pg8::cvt_pk_bf16(lo, hi); }

__device__ __forceinline__ void partialSM(f32x16& p0, f32x16& p1, float& m_reg, float& mn, float& alpha) {
  constexpr float C = SCALE * 1.4426950408889634f;
  float pmax = p0[0];
#pragma unroll
  for (int r = 1; r < 16; ++r) pmax = fmaxf(pmax, p0[r]);
#pragma unroll
  for (int r = 0; r < 16; ++r) pmax = fmaxf(pmax, p1[r]);
  { auto rr = __builtin_amdgcn_permlane32_swap(__float_as_uint(pmax), __float_as_uint(pmax), false, false);
    pmax = fmaxf(__uint_as_float(rr[0]), __uint_as_float(rr[1])); }
  if (__builtin_expect(__all(pmax - m_reg <= THR / SCALE), 1)) { mn = m_reg; alpha = 1.f; }
  else { mn = fmaxf(m_reg, pmax); alpha = __builtin_amdgcn_exp2f((m_reg - mn) * C); m_reg = mn; }
  float mnC = -mn * C;
#pragma unroll
  for (int r = 0; r < 16; ++r) p0[r] = fmaf(p0[r], C, mnC);
#pragma unroll
  for (int r = 0; r < 16; ++r) p1[r] = fmaf(p1[r], C, mnC);
#pragma unroll
  for (int r = 0; r < 16; ++r) p0[r] = __builtin_amdgcn_exp2f(p0[r]);
}
__device__ __forceinline__ void finishSM(f32x16& p0, f32x16& p1, float alpha, float& l_reg, bf16x8& pa0, bf16x8& pa1, bf16x8& pa2, bf16x8& pa3) {
#pragma unroll
  for (int r = 0; r < 16; ++r) p1[r] = __builtin_amdgcn_exp2f(p1[r]);
  float ps = 0;
#pragma unroll
  for (int r = 0; r < 16; ++r) ps += p0[r];
#pragma unroll
  for (int r = 0; r < 16; ++r) ps += p1[r];
  { auto rr = __builtin_amdgcn_permlane32_swap(__float_as_uint(ps), __float_as_uint(ps), false, false);
    ps = __uint_as_float(rr[0]) + __uint_as_float(rr[1]); }
  l_reg = l_reg * alpha + ps;
#define PK4(P, BASE, OUT) do { unsigned a0 = cvtpk(P[BASE + 0], P[BASE + 1]), a1 = cvtpk(P[BASE + 2], P[BASE + 3]);   \
    unsigned b0 = cvtpk(P[BASE + 4], P[BASE + 5]), b1 = cvtpk(P[BASE + 6], P[BASE + 7]);                              \
    auto r0 = __builtin_amdgcn_permlane32_swap(a0, b0, false, false); auto r1 = __builtin_amdgcn_permlane32_swap(a1, b1, false, false); \
    u32x4 w = {r0[0], r1[0], r0[1], r1[1]}; OUT = *reinterpret_cast<bf16x8*>(&w); } while (0)
  PK4(p0, 0, pa0); PK4(p0, 8, pa1); PK4(p1, 0, pa2); PK4(p1, 8, pa3);
#undef PK4
}
__device__ __forceinline__ void qkt(f32x16& p0, f32x16& p1, const char* Ks, const bf16x8* qr, int r32, int hi) {
  p0 = f32x16{}; p1 = f32x16{};
#pragma unroll
  for (int d0 = 0; d0 < 12; ++d0) { int cb = (d0 * 16 + hi * 8) * 2;
    bf16x8 b0 = *reinterpret_cast<const bf16x8*>(Ks + KSWZ(r32, cb));
    bf16x8 b1 = *reinterpret_cast<const bf16x8*>(Ks + KSWZ(32 + r32, cb));
    p0 = __builtin_amdgcn_mfma_f32_32x32x16_bf16(b0, qr[d0], p0, 0, 0, 0);
    p1 = __builtin_amdgcn_mfma_f32_32x32x16_bf16(b1, qr[d0], p1, 0, 0, 0); }
}
__device__ __forceinline__ int v_st(int k, int c) { const int kk = (k & ~0xC) | ((k & 4) << 1) | ((k & 8) >> 1); return ((kk >> 3) * 4 + (c >> 5)) * 512 + ((kk & 7) * 32 + (c & 31)) * 2; }
__device__ __forceinline__ int v_rd_base(int lane) { return ((lane & 3) << 3) | (((lane >> 2) & 3) << 6) | (((lane >> 4) & 1) << 5) | (((lane >> 5) & 1) << 8); }
constexpr int v_rd_off(int d0, int ks, int half) { return d0 * 512 + ks * 4096 + half * 2048; }
template <int OFF> __device__ __forceinline__ s16x4 tr_read(int vb) {
  s16x4 r; asm volatile("ds_read_b64_tr_b16 %0, %1 offset:%2" : "=&v"(r) : "v"(vb), "i"(OFF) : "memory"); return r;
}
template <int D0> __device__ __forceinline__ void pv_one(f32x16& od, int vb, bf16x8 pa0, bf16x8 pa1, bf16x8 pa2, bf16x8 pa3) {
#define PK(L, H) (bf16x8){L[0], L[1], L[2], L[3], H[0], H[1], H[2], H[3]}
  { const s16x4 l0 = tr_read<v_rd_off(D0, 0, 0)>(vb), h0 = tr_read<v_rd_off(D0, 0, 1)>(vb), l1 = tr_read<v_rd_off(D0, 1, 0)>(vb), h1 = tr_read<v_rd_off(D0, 1, 1)>(vb);
    asm volatile("s_waitcnt lgkmcnt(0)" ::: "memory"); SBAR();
    od = __builtin_amdgcn_mfma_f32_32x32x16_bf16(pa0, PK(l0, h0), od, 0, 0, 0);
    od = __builtin_amdgcn_mfma_f32_32x32x16_bf16(pa1, PK(l1, h1), od, 0, 0, 0); }
  { const s16x4 l2 = tr_read<v_rd_off(D0, 2, 0)>(vb), h2 = tr_read<v_rd_off(D0, 2, 1)>(vb), l3 = tr_read<v_rd_off(D0, 3, 0)>(vb), h3 = tr_read<v_rd_off(D0, 3, 1)>(vb);
    asm volatile("s_waitcnt lgkmcnt(0)" ::: "memory"); SBAR();
    od = __builtin_amdgcn_mfma_f32_32x32x16_bf16(pa2, PK(l2, h2), od, 0, 0, 0);
    od = __builtin_amdgcn_mfma_f32_32x32x16_bf16(pa3, PK(l3, h3), od, 0, 0, 0); }
#undef PK
}
__device__ __forceinline__ void pv_d0(f32x16* o, int vb, bf16x8 pa0, bf16x8 pa1, bf16x8 pa2, bf16x8 pa3) {
  pv_one<0>(o[0], vb, pa0, pa1, pa2, pa3); pv_one<1>(o[1], vb, pa0, pa1, pa2, pa3); pv_one<2>(o[2], vb, pa0, pa1, pa2, pa3); pv_one<3>(o[3], vb, pa0, pa1, pa2, pa3);
}

__device__ __forceinline__ void attn_dense_body(const bf16* __restrict__ Qb, const bf16* __restrict__ Kh, const bf16* __restrict__ Vh, bf16* __restrict__ Ob, int seq, char* lds) {
  int tid_ = threadIdx.x; asm volatile("" : "+v"(tid_));
  const int tid = tid_, wid = __builtin_amdgcn_readfirstlane(tid >> 6), lane = tid & 63, r32 = lane & 31, hi = lane >> 5;
  char* V_lds = lds; char* K_lds = lds + 2 * SHM_V;
  float* ws = (float*)(lds + 2 * SHM_V + 2 * SHM_K) + wid * 64; float* li_l = ws; float* al_l = ws + 32;
  float m_reg = -1e30f, l_reg = 0; f32x16 o[4] = {}; bf16x8 qr[12];
  const bf16* Qw = Qb + (long)(wid * QBLK + r32) * LDQ + hi * 8;
#pragma unroll
  for (int d0 = 0; d0 < 12; ++d0) qr[d0] = *reinterpret_cast<const bf16x8*>(Qw + d0 * 16);
  const int sr = tid >> 4, sc = (tid & 15) * 8, vst0 = v_st(sr, sc), vst1 = v_st(32 + sr, sc);
  const int kr2 = tid >> 3, kc2 = 128 + (tid & 7) * 8;
  const int vb0 = (int)(uintptr_t)V_lds + v_rd_base(lane);
  bf16x8 vs0, vs1, ks0, ks1, ks2;
  const unsigned ovs0 = (unsigned)(sr * LDV + sc) * 2u, ovs1 = (unsigned)((32 + sr) * LDV + sc) * 2u, oks0 = (unsigned)(sr * LDK + sc) * 2u, oks1 = (unsigned)((32 + sr) * LDK + sc) * 2u, oks2 = (unsigned)(kr2 * LDK + kc2) * 2u;
#define SLOAD(k0) do { const char* vt_ = (const char*)Vh + (size_t)(k0) * (LDV * 2); const char* kt_ = (const char*)Kh + (size_t)(k0) * (LDK * 2); \
    vs0 = *reinterpret_cast<const bf16x8*>(vt_ + ovs0); vs1 = *reinterpret_cast<const bf16x8*>(vt_ + ovs1); \
    ks0 = *reinterpret_cast<const bf16x8*>(kt_ + oks0); ks1 = *reinterpret_cast<const bf16x8*>(kt_ + oks1); ks2 = *reinterpret_cast<const bf16x8*>(kt_ + oks2); } while (0)
#define SWRITE(b) do { *(bf16x8*)(V_lds + (b) * SHM_V + vst0) = vs0; *(bf16x8*)(V_lds + (b) * SHM_V + vst1) = vs1; \
    *(bf16x8*)(K_lds + (b) * SHM_K + KSWZ(sr, sc * 2)) = ks0; *(bf16x8*)(K_lds + (b) * SHM_K + KSWZ(32 + sr, sc * 2)) = ks1; \
    *(bf16x8*)(K_lds + (b) * SHM_K + KSWZ(kr2, kc2 * 2)) = ks2; } while (0)
#define RESC(a) do { if (__any((a) < 1.f)) { if (hi == 0) al_l[r32] = (a); asm volatile("s_waitcnt lgkmcnt(0)" ::: "memory"); \
    _Pragma("unroll") for (int d = 0; d < 4; ++d) _Pragma("unroll") for (int r = 0; r < 16; ++r) o[d][r] *= al_l[crow(r, hi)]; } } while (0)
  f32x16 p0, p1; float mn, al; bf16x8 pa0, pa1, pa2, pa3; const int NT = seq / KVBLK;
  SLOAD(0); asm volatile("s_waitcnt vmcnt(0)" ::: "memory"); SWRITE(0); __syncthreads();
  SLOAD(KVBLK);
  for (int j = 0; j < NT; ++j) {
    const int bsel = j & 1;
    SBAR(); qkt(p0, p1, K_lds + bsel * SHM_K, qr, r32, hi);
    partialSM(p0, p1, m_reg, mn, al); finishSM(p0, p1, al, l_reg, pa0, pa1, pa2, pa3); SBAR();
    RESC(al);
    if (j + 1 < NT) { asm volatile("s_waitcnt vmcnt(0)" ::: "memory"); SWRITE(bsel ^ 1); }
    if (j + 2 < NT) SLOAD((j + 2) * KVBLK);
    SBAR(); pv_d0(o, vb0 + bsel * (int)SHM_V, pa0, pa1, pa2, pa3);
    __syncthreads();
  }
  if (hi == 0) li_l[r32] = l_reg; asm volatile("s_waitcnt lgkmcnt(0)" ::: "memory");
  float rli[16];
#pragma unroll
  for (int r = 0; r < 16; ++r) rli[r] = __builtin_amdgcn_rcpf(li_l[crow(r, hi)]);
  bf16* Ow = Ob + (long)(wid * QBLK) * LDO;
#pragma unroll
  for (int r = 0; r < 16; ++r) { int orow = crow(r, hi);
#pragma unroll
    for (int d0 = 0; d0 < 4; ++d0) Ow[(long)orow * LDO + d0 * 32 + r32] = (bf16)(cvtpk(o[d0][r] * rli[r], 0.f) & 0xffffu); }
  __syncthreads();
#undef SLOAD
#undef SWRITE
#undef RESC
}
#undef KSWZ
#undef SBAR
}

__device__ __forceinline__ void p6_attention(const Args& a, Frame& F) {
    const bf16* QP = (const bf16*)(a.ws + WS_Q); const bf16* KP = (const bf16*)(a.ws + WS_KP); const bf16* KV = (const bf16*)(a.ws + WS_KV); bf16* YB = (bf16*)(a.ws + WS_YB);
    char* lds = (char*)(unsigned char*)F.lds;
    for (int u = blockIdx.x; u < 256; u += F.G) {
        const int b = u >> 6, h = (u >> 2) & 15, qb = u & 3; const size_t row0 = (size_t)T_P + b * 1024 + qb * 256, kv0 = (size_t)T_P + b * 1536;
        attn::attn_dense_body(QP + row0 * 3072 + h * 192, KP + kv0 * 3072 + h * 192, KV + kv0 * 4096 + h * 256 + 128, YB + row0 * 2048 + h * 128, 1536, lds);
    }
    for (int u = blockIdx.x; u < 512; u += F.G) {
        const int b = u >> 4, h = u & 15; const size_t row0 = (size_t)b * 256;
        attn::attn_dense_body(QP + row0 * 3072 + h * 192, KP + row0 * 3072 + h * 192, KV + row0 * 4096 + h * 256 + 128, YB + row0 * 2048 + h * 128, 256, lds);
    }
}

__device__ __forceinline__ float grp16_sum(float v) { v += __shfl_xor(v, 1); v += __shfl_xor(v, 2); v += __shfl_xor(v, 4); v += __shfl_xor(v, 8); return v; }
#ifndef P7_NOLN
#define P7_NOLN 0
#endif
#ifndef P7_TRIVIAL
#define P7_TRIVIAL 0
#endif
__device__ __forceinline__ void p7_postscan(const Args& a, Frame& F) {
    const unsigned short* YS = (const unsigned short*)(a.ws + WS_YS); const float* BON = (const float*)(a.ws + WS_BON); const unsigned short* RKV = (const unsigned short*)(a.ws + WS_RKV);
    const bf16* G = (const bf16*)(a.ws + WS_G); unsigned char* YA = (unsigned char*)(a.ws + WS_YA); float* ROWS = (float*)(a.ws + WS_ROWSYA); const float* lnw = a.in[I_LNW]; const float* lnb = a.in[I_LNB];
    f32x4 lw4[8], lb4[8];
#pragma unroll
    for (int p = 0; p < 8; ++p) { lw4[p] = *(const f32x4*)(lnw + p * 256 + F.lane * 4); lb4[p] = *(const f32x4*)(lnb + p * 256 + F.lane * 4); }
    for (int row = F.gw; row < T; row += F.ngw) {
        v2u ybw[8];
#pragma unroll
        for (int p = 0; p < 8; ++p) ybw[p] = *(const GAS v2u*)((const unsigned short*)(a.ws + WS_YB) + (size_t)row * DA + p * 256 + F.lane * 4);
        float ov[8][4]; float mx = 0.f;
#pragma unroll
        for (int p = 0; p < 8; ++p) { const int c = p * 256 + F.lane * 4, h = c >> 6;
            const v2u yf = *(const GAS v2u*)(YS + (size_t)row * DA + c), yb = *(const GAS v2u*)(YS + ((size_t)T + row) * DA + c), vv = *(const GAS v2u*)(RKV + (size_t)row * 6144 + 4096 + c), gg = *(const GAS v2u*)(G + (size_t)row * DA + c);
            const float bon = BON[(size_t)row * 32 + h] + BON[((size_t)T + row) * 32 + h];
            float y[4], v[4], g[4];
            y[0] = h2f(yf.x & 0xffff) + h2f(yb.x & 0xffff); y[1] = h2f(yf.x >> 16) + h2f(yb.x >> 16); y[2] = h2f(yf.y & 0xffff) + h2f(yb.y & 0xffff); y[3] = h2f(yf.y >> 16) + h2f(yb.y >> 16);
            v[0] = h2f(vv.x & 0xffff); v[1] = h2f(vv.x >> 16); v[2] = h2f(vv.y & 0xffff); v[3] = h2f(vv.y >> 16);
            g[0] = pg8::bflo(gg.x); g[1] = pg8::bfhi(gg.x); g[2] = pg8::bflo(gg.y); g[3] = pg8::bfhi(gg.y);
            const float mu = row16_sum((y[0] + y[1]) + (y[2] + y[3])) * (1.0f / 64.0f);
            float d[4]; float q = 0.f;
#pragma unroll
            for (int i = 0; i < 4; ++i) { d[i] = y[i] - mu; q += d[i] * d[i]; }
            const float rstd = 1.0f / sqrtf(row16_sum(q) * (1.0f / 64.0f) + 64e-5f);
            const f32x4 w4 = lw4[p], b4 = lb4[p];
#pragma unroll
            for (int i = 0; i < 4; ++i) { ov[p][i] = (d[i] * rstd * w4[i] + b4[i] + bon * v[i]) * g[i]; mx = fmaxf(mx, fabsf(ov[p][i])); } }
        mx = wave_max_d(mx);
        const float qs = mx > 0.f ? 127.0f / mx : 0.f;
        if (F.lane == 0) ROWS[row] = mx * (1.0f / 127.0f);
#pragma unroll
        for (int p = 0; p < 8; ++p) { const int c = p * 256 + F.lane * 4;
            *(GAS unsigned*)(YA + (size_t)row * DA + c) = (unsigned)q8(ov[p][0] * qs) | ((unsigned)q8(ov[p][1] * qs) << 8) | ((unsigned)q8(ov[p][2] * qs) << 16) | ((unsigned)q8(ov[p][3] * qs) << 24); }
        {
            const unsigned short* YBr = (const unsigned short*)(a.ws + WS_YB) + (size_t)row * DA; unsigned char* YB8 = (unsigned char*)(a.ws + WS_YB8) + (size_t)row * DA;
            float yv[8][4]; float mb = 0.f;
#pragma unroll
            for (int p = 0; p < 8; ++p) { const v2u t = ybw[p];
                yv[p][0] = pg8::bflo(t.x); yv[p][1] = pg8::bfhi(t.x); yv[p][2] = pg8::bflo(t.y); yv[p][3] = pg8::bfhi(t.y);
                mb = fmaxf(mb, fmaxf(fmaxf(fabsf(yv[p][0]), fabsf(yv[p][1])), fmaxf(fabsf(yv[p][2]), fabsf(yv[p][3])))); }
            mb = wave_max_d(mb);
            const float qb = mb > 0.f ? 127.0f / mb : 0.f;
            if (F.lane == 0) ((float*)(a.ws + WS_ROWSYB))[row] = mb * (1.0f / 127.0f);
#pragma unroll
            for (int p = 0; p < 8; ++p)
                *(GAS unsigned*)(YB8 + p * 256 + F.lane * 4) = (unsigned)q8(yv[p][0] * qb) | ((unsigned)q8(yv[p][1] * qb) << 8) | ((unsigned)q8(yv[p][2] * qb) << 16) | ((unsigned)q8(yv[p][3] * qb) << 24);
        }
    }
}
#ifndef MK_PER_PHASE
#define MK_PER_PHASE 0
#endif
constexpr int N_PHASES = 14;
__global__ void __launch_bounds__(NWAVES * 64, 2) fwd_kernel(Args args) {
    extern __shared__ __attribute__((aligned(16))) unsigned char lds[];
    Frame F;
    F.lds = (LAS unsigned char*)lds; F.MISC = (volatile LAS unsigned*)(F.lds + MISC_OFF);
    F.tid = threadIdx.x; F.lane = F.tid & 63; F.wave = __builtin_amdgcn_readfirstlane(F.tid >> 6);
    F.G = gridDim.x; F.gw = blockIdx.x * NWAVES + F.wave; F.ngw = F.G * NWAVES;
    unsigned char* ws = args.ws; F.ctl = (gu32*)(ws + WS_CTL);
    for (int u = F.tid; u < (LDS_BYTES - LDSCTL_OFF) / 4; u += NWAVES * 64) ((LAS unsigned*)(F.lds + LDSCTL_OFF))[u] = 0u;
    __syncthreads();
    const int lo = args.ph_lo, hi = args.ph_hi;
    XcdBarrier bar; bar.bar = (unsigned*)(F.ctl + CW_BAR); bar.x = 0; bar.st = nullptr;
    if (hi - lo > 1) bar = xcd_barrier_post((unsigned*)(F.ctl + CW_BAR), F.MISC + 8);
#ifndef P4_MASK
#define P4_MASK 15
#endif
#ifndef PH_MASK
#define PH_MASK 0xFFFFFFFFu
#endif
#define IN(k) (((PH_MASK >> (k)) & 1u) && lo <= (k) && (k) < hi)
#define SEAM(k) do { if (IN(k) && IN((k) + 1)) xcd_barrier(bar); } while (0)
    LAS unsigned char* ring = F.lds + RING_OFF;
    float* MOD = (float*)(ws + WS_MOD);

    if (IN(0)) { p0_adaln(args, F); p0_colmax(args, F); p0_weights(args, F); p0_rope(args, F); }
    SEAM(0);
    if (IN(1)) {
        Frame F2 = F; F2.gw = (int)blockIdx.x * 4 + (F.wave & 3); F2.ngw = F.G * 4;
        if (F.wave < 4) modnorm_rows_dual(F2, args.in[I_XP], args.in[I_XS], args.in[I_NMIX], MOD, 0, (bf16*)(ws + WS_HB), (unsigned char*)(ws + WS_H1Q), (float*)(ws + WS_ROWS1));
        else p1_weights_i8(args, F2); }
    SEAM(1);
    if (IN(2)) {
        {
            int k8 = DM / 2; asm volatile("" : "+s"(k8));
            pg8::Gemm g{(const pg8::bf16_t*)(ws + WS_H1Q), (const pg8::bf16_t*)(ws + WS_WING8 + (size_t)8192 * DM), T, 3584, k8}; pg8::StaticOrder S; S.init(T, 3584, F.G, (int)blockIdx.x);
            pg8::EpiGate8 E{(unsigned char*)(ws + WS_GA), (unsigned char*)(ws + WS_GB), (const float*)(ws + WS_ROWS1), (const unsigned*)(ws + WS_CMAXG), (pg8::f16_t*)(ws + WS_RKV), (pg8::bf16_t*)(ws + WS_LG), (float*)(ws + WS_QLAT), 32};
            pg8::gemm_phase<pg8::EpiGate8, pg8::StaticOrder, true, true, 2>(ring, g, S, E); }
        {
            pg8::Gemm g{(const pg8::bf16_t*)(ws + WS_HB), (const pg8::bf16_t*)(ws + WS_WIN), T, NIN16, DM}; pg8::StaticOrder S; S.init(T, NIN16, F.G, (int)blockIdx.x);
            pg8::EpiIn E{(pg8::f16_t*)(ws + WS_RKV), (pg8::bf16_t*)(ws + WS_LWA), (pg8::bf16_t*)(ws + WS_LG), (float*)(ws + WS_QLAT), (float*)(ws + WS_KVLAT), (float*)(ws + WS_KPE), (pg8::bf16_t*)(ws + WS_GA), (pg8::bf16_t*)(ws + WS_GB)};
            pg8::gemm_phase<pg8::EpiIn, pg8::StaticOrder, true, true>(ring, g, S, E); }
    }
    SEAM(2);
    if (IN(3)) { p3_post(args, F); }
    SEAM(3);
    if (IN(4)) {
        if (P4_MASK & 1) { int kl = 256; asm volatile("" : "+s"(kl));
          pg8::Gemm g{(const pg8::bf16_t*)(ws + WS_LWA), (const pg8::bf16_t*)(ws + WS_WLORA), 2 * T, 8192, kl}; pg8::BatchedOrder S; S.init(T / 256, 16, 2, F.G, (int)blockIdx.x);
          pg8::EpiLora E{(unsigned char*)(ws + WS_EW), (const float*)(ws + WS_LBIAS)};
          pg8::gemm_phase<pg8::EpiLora, pg8::BatchedOrder, true, true>(ring, g, S, E); }
        if (P4_MASK & 2) { int kg = 512; asm volatile("" : "+s"(kg));
          pg8::Gemm g{(const pg8::bf16_t*)(ws + WS_LG), (const pg8::bf16_t*)(ws + WS_WG), T, DA, kg}; pg8::StaticOrder S; S.init(T, DA, F.G, (int)blockIdx.x);
          pg8::EpiPlain E{(pg8::bf16_t*)(ws + WS_G), DA};
          pg8::gemm_phase<pg8::EpiPlain, pg8::StaticOrder, true, true>(ring, g, S, E); }
        if (P4_MASK & 4) { int kq = QL / 2; asm volatile("" : "+s"(kq));
          pg8::Gemm g{(const pg8::bf16_t*)(ws + WS_QN), (const pg8::bf16_t*)(ws + WS_WUQ), T, 3072, kq}; pg8::StaticOrder S; S.init(T, 3072, F.G, (int)blockIdx.x, 128);
          pg8::EpiPlainI8 E{(pg8::bf16_t*)(ws + WS_Q), 3072, (const float*)(ws + WS_ROWSQ), (const unsigned*)(ws + WS_CMAXUQ)};
          pg8::gemm_phase<pg8::EpiPlainI8, pg8::StaticOrder, true, true, 2>(ring, g, S, E); }
        if (P4_MASK & 8) { int kk = KVL / 2; asm volatile("" : "+s"(kk));
          pg8::Gemm g{(const pg8::bf16_t*)(ws + WS_CKVA), (const pg8::bf16_t*)(ws + WS_WUKV), KVROWS, 4096, kk}; pg8::StaticOrder S; S.init(KVROWS, 4096, F.G, (int)blockIdx.x, 64);
          pg8::EpiPlainI8 E{(pg8::bf16_t*)(ws + WS_KV), 4096, (const float*)(ws + WS_ROWSKV), (const unsigned*)(ws + WS_CMAXUKV)};
          pg8::gemm_phase<pg8::EpiPlainI8, pg8::StaticOrder, true, true, 2>(ring, g, S, E); }
    }
    SEAM(4);
    if (IN(5)) { p5_qkprep(args, F); }
    SEAM(5);
    if (IN(6)) { p5_scan(args, F); __syncthreads(); p6_attention(args, F); }
    SEAM(6);
    if (IN(7)) { p7_postscan(args, F); }
    SEAM(7);
    if (IN(8)) {
#pragma unroll
        for (int gb = 0; gb < 2; ++gb) {
            int k8 = DM / 2; asm volatile("" : "+s"(k8));
            pg8::Gemm g{(const pg8::bf16_t*)(ws + WS_H1Q), (const pg8::bf16_t*)(ws + WS_WGATE8 + (size_t)gb * 4096 * DM), T, DM, k8}; pg8::StaticOrder S; S.init(T, DM, F.G, (int)blockIdx.x);
            pg8::EpiGate8 E{(unsigned char*)(ws + WS_GA), (unsigned char*)(ws + WS_GB), (const float*)(ws + WS_ROWS1), (const unsigned*)(ws + WS_CMAXG), (pg8::f16_t*)(ws + WS_RKV), (pg8::bf16_t*)(ws + WS_LG), (float*)(ws + WS_QLAT), 16 * gb};
            pg8::gemm_phase<pg8::EpiGate8, pg8::StaticOrder, true, true, 2>(ring, g, S, E); }
        asm volatile("s_waitcnt vmcnt(0)" ::: "memory"); __syncthreads();
        { int k8 = DA / 2; asm volatile("" : "+s"(k8));
          pg8::Gemm g{(const pg8::bf16_t*)(ws + WS_YA), (const pg8::bf16_t*)(ws + WS_WOR), T, DM, k8}; pg8::StaticOrder S; S.init(T, DM, F.G, (int)blockIdx.x);
          pg8::EpiMix1I8 E{(const unsigned char*)(ws + WS_GA), (pg8::bf16_t*)(ws + WS_TMP), (const float*)(ws + WS_ROWSYA), (const unsigned*)(ws + WS_CMAXR)};
          pg8::gemm_phase<pg8::EpiMix1I8, pg8::StaticOrder, true, true, 2>(ring, g, S, E); }
        { int k8 = DA / 2; asm volatile("" : "+s"(k8));
          pg8::Gemm g{(const pg8::bf16_t*)(ws + WS_YB8), (const pg8::bf16_t*)(ws + WS_WOM), T, DM, k8}; pg8::StaticOrder S; S.init(T, DM, F.G, (int)blockIdx.x);
          pg8::EpiMix2I8 E{(const unsigned char*)(ws + WS_GB), (const pg8::bf16_t*)(ws + WS_TMP), (pg8::bf16_t*)(ws + WS_MIXED), (unsigned*)(ws + WS_RMAXM), (const float*)(ws + WS_ROWSYB), (const unsigned*)(ws + WS_CMAXM)};
          pg8::gemm_phase<pg8::EpiMix2I8, pg8::StaticOrder, true, true, 2>(ring, g, S, E); }
    }
    SEAM(8);
    if (IN(9)) { p8c_quant_mixed(args, F); }
    SEAM(9);
    if (IN(10)) {
        int k8 = DM / 2; asm volatile("" : "+s"(k8));
        pg8::Gemm g{(const pg8::bf16_t*)(ws + WS_MIX8), (const pg8::bf16_t*)(ws + WS_WOUT), T, DM, k8}; pg8::StaticOrder S; S.init(T, DM, F.G, (int)blockIdx.x);
        pg8::EpiResI8 E{args.in[I_XP], args.in[I_XS], (pg8::bf16_t*)(ws + WS_X1), MOD + 2 * DM, (const float*)(ws + WS_ROWSM), (const unsigned*)(ws + WS_CMAXO)};
        pg8::gemm_phase<pg8::EpiResI8, pg8::StaticOrder, true, true, 2>(ring, g, S, E);
    }
    SEAM(10);
    if (IN(11)) { modnorm_rows_i8(F, (const bf16*)(ws + WS_X1), args.in[I_NFFN], MOD, 3, (unsigned char*)(ws + WS_HB), (float*)(ws + WS_ROWS)); }
    SEAM(11);
    if (IN(12)) {
        int k8 = DM / 2; asm volatile("" : "+s"(k8));
        pg8::Gemm g{(const pg8::bf16_t*)(ws + WS_HB), (const pg8::bf16_t*)(ws + WS_WFI), T, 2 * DFF, k8}; pg8::StaticOrder S; S.init(T, 2 * DFF, F.G, (int)blockIdx.x);
        pg8::EpiSwigluI8 E{(unsigned char*)(ws + WS_ACT), (const float*)(ws + WS_ROWS), (const unsigned*)(ws + WS_CMAX)};
        pg8::gemm_phase<pg8::EpiSwigluI8, pg8::StaticOrder, true, true, 2>(ring, g, S, E);
    }
    SEAM(12);
    if (IN(13)) {
        int k8 = DFF / 2; asm volatile("" : "+s"(k8));
        pg8::Gemm g{(const pg8::bf16_t*)(ws + WS_ACT), (const pg8::bf16_t*)(ws + WS_WFO), T, DM, k8}; pg8::StaticOrder S; S.init(T, DM, F.G, (int)blockIdx.x);
        pg8::EpiRes E{(const pg8::bf16_t*)(ws + WS_X1), args.out, MOD + 5 * DM, 0.0078125f};
        pg8::gemm_phase<pg8::EpiRes, pg8::StaticOrder, true, true, 1>(ring, g, S, E);
    }
#undef IN
#undef SEAM
}

extern "C" void kernel_launch(void* const* d_in, const int* in_sizes, int n_in, void* d_out, int out_size, void* d_ws, size_t ws_size, hipStream_t stream) {
    static int grid = 0;
    if (grid == 0) {
        if (n_in != 33 || ws_size < WS_END) { fprintf(stderr, "kernel_launch: n_in %d ws %zu (need 33 inputs, >= %zu bytes)\n", n_in, ws_size, (size_t)WS_END); grid = -1; return; }
        if (hipFuncSetAttribute((const void*)fwd_kernel, hipFuncAttributeMaxDynamicSharedMemorySize, LDS_BYTES) != hipSuccess) { fprintf(stderr, "kernel_launch: hipFuncSetAttribute failed\n"); grid = -1; return; }
        int per_cu = 0;
        if (hipOccupancyMaxActiveBlocksPerMultiprocessor(&per_cu, (const void*)fwd_kernel, NWAVES * 64, LDS_BYTES) != hipSuccess || per_cu < 1) fprintf(stderr, "kernel_launch: occupancy query reports %d\n", per_cu);
        (void)hipGetLastError();
        grid = 256;
    }
    if (grid < 0) return;
    if (hipMemsetAsync((char*)d_ws + WS_CTL, 0, CTL_ZERO_BYTES, stream) != hipSuccess) return;
    Args a{};
    for (int i = 0; i < 33; ++i) a.in[i] = (const float*)d_in[i];
    a.out = (float*)d_out; a.ws = (unsigned char*)d_ws;
#if MK_PER_PHASE
    for (int p = 0; p < N_PHASES; ++p) { a.ph_lo = p; a.ph_hi = p + 1; hipLaunchKernelGGL(fwd_kernel, dim3(grid), dim3(NWAVES * 64), LDS_BYTES, stream, a); }
#else
    a.ph_lo = 0; a.ph_hi = N_PHASES; hipLaunchKernelGGL(fwd_kernel, dim3(grid), dim3(NWAVES * 64), LDS_BYTES, stream, a);
#endif
    const hipError_t le = hipPeekAtLastError();
    if (le != hipSuccess) fprintf(stderr, "kernel_launch: launch failed: %s\n", hipGetErrorName(le));
}
```
